# Optimizing an MI355X kernel written in HIP

```python
import jax, jax.numpy as jnp
from jax import lax
import numpy as np

D_MODEL = 1024
BATCH = 8
SEQ = 4096
DEPTH = 4
DEC_BATCH = 8
DEC_SEQ = 16
PAST_LEN = 2048

CHUNK = 64
N_MIXERS = 2
N_GMLP = (DEPTH + 1) // 2
N_FOX = DEPTH // 2
EXPAND = 2
D_BRANCH = EXPAND * D_MODEL
GMLP_BLOCK = 128
GMLP_GROUPS = 16
GMLP_GROUP_DIM = D_BRANCH // GMLP_GROUPS
FOX_HEADS = 16
FOX_HEAD_DIM = D_BRANCH // FOX_HEADS
Q_BLOCK = 128
PLE_DIM = 256
FORGET_BIAS_INIT = 4.0
RMS_EPS = 1e-6
LN_EPS = 1e-5

kernel_name = "hybrid_gmlp_fox_streaming_step"


def rms_norm(x, g):
    xf = x.astype(jnp.float32)
    y = xf * lax.rsqrt(jnp.mean(xf * xf, axis=-1, keepdims=True) + RMS_EPS)
    return (y * g.astype(jnp.float32)).astype(x.dtype)


def layer_norm(x, g, b):
    xf = x.astype(jnp.float32)
    mu = jnp.mean(xf, axis=-1, keepdims=True)
    var = jnp.mean(jnp.square(xf - mu), axis=-1, keepdims=True)
    y = (xf - mu) * lax.rsqrt(var + LN_EPS) * g.astype(jnp.float32) + b.astype(jnp.float32)
    return y.astype(x.dtype)


def chunk_causal_mask(n):
    i = jnp.arange(n)
    return (i[None, :] // CHUNK) <= (i[:, None] // CHUNK)


def gmlp_branch(h, w_in, ln_g, ln_b, w_s, b_s, w_out):
    B, T, _ = h.shape
    E = D_BRANCH
    proj = h @ w_in
    uv = jax.nn.gelu(proj[..., :2 * E])
    z = proj[..., 2 * E:]
    u = uv[..., :E]
    v = layer_norm(uv[..., E:], ln_g, ln_b)
    n = min(T, GMLP_BLOCK)
    nb = T // n
    wm = jnp.where(chunk_causal_mask(n)[None], w_s[:, :n, :n], 0.0).astype(v.dtype)
    vb = v.reshape(B, nb, n, GMLP_GROUPS, GMLP_GROUP_DIM)
    s = jnp.einsum('gij,bnjgc->bnigc', wm, vb) + b_s[:, :n].T[None, None, :, :, None].astype(v.dtype)
    y = u * s.reshape(B, T, E) * jax.nn.silu(z)
    return y @ w_out, v


def fox_project(h, w_in, b_f):
    B, T, _ = h.shape
    E = D_BRANCH
    proj = h @ w_in
    shp = (B, T, FOX_HEADS, FOX_HEAD_DIM)
    q = proj[..., :E].reshape(shp)
    k = proj[..., E:2 * E].reshape(shp)
    v = proj[..., 2 * E:3 * E].reshape(shp)
    z = proj[..., 3 * E:4 * E]
    logf = jax.nn.log_sigmoid(proj[..., 4 * E:].astype(jnp.float32) + b_f.astype(jnp.float32))
    return q, k, v, z, logf


def fox_attend_prompt(q, k, v, logf):
    B, S, H, dh = q.shape
    scale = dh ** -0.5
    cT = jnp.cumsum(logf, axis=1).transpose(0, 2, 1)
    nq = S // Q_BLOCK
    qb = q.reshape(B, nq, Q_BLOCK, H, dh).transpose(1, 0, 2, 3, 4)
    cqb = cT.reshape(B, H, nq, Q_BLOCK).transpose(2, 0, 1, 3)
    key_pos = jnp.arange(S)

    def block(args):
        qi, ci, start = args
        s = jnp.einsum('bqhd,bkhd->bhqk', qi, k).astype(jnp.float32) * scale
        s = s + ci[..., :, None] - cT[:, :, None, :]
        qpos = start + jnp.arange(Q_BLOCK)
        s = jnp.where(key_pos[None, :] <= qpos[:, None], s, -jnp.inf)
        p = jax.nn.softmax(s, axis=-1).astype(v.dtype)
        return jnp.einsum('bhqk,bkhd->bqhd', p, v)

    o = lax.map(block, (qb, cqb, jnp.arange(nq, dtype=jnp.int32) * Q_BLOCK))
    return o.transpose(1, 0, 2, 3, 4).reshape(B, S, H * dh)


def fox_attend_sample(q, k_new, v_new, logf_new, k_cache, v_cache, logf_cache):
    B, T, H, dh = q.shape
    P = k_cache.shape[1]
    scale = dh ** -0.5
    k = jnp.concatenate([k_cache.astype(k_new.dtype), k_new], axis=1)
    v = jnp.concatenate([v_cache.astype(v_new.dtype), v_new], axis=1)
    cT = jnp.cumsum(jnp.concatenate([logf_cache.astype(jnp.float32), logf_new], axis=1), axis=1).transpose(0, 2, 1)
    s = jnp.einsum('bqhd,bkhd->bhqk', q, k).astype(jnp.float32) * scale
    s = s + cT[:, :, P:, None] - cT[:, :, None, :]
    mask = jnp.arange(P + T)[None, :] <= (P + jnp.arange(T))[:, None]
    s = jnp.where(mask, s, -jnp.inf)
    p = jax.nn.softmax(s, axis=-1).astype(v.dtype)
    return jnp.einsum('bhqk,bkhd->bqhd', p, v).reshape(B, T, H * dh)


def setup_inputs(seed: int = 0) -> dict:
    key = jax.random.key(seed)
    ks = jax.random.split(key, 20)
    f32 = jnp.float32
    E = D_BRANCH

    def nrm(k, shape, scale=1.0):
        return jax.random.normal(k, shape, f32) * scale

    return {
        "x_prompt": nrm(ks[0], (BATCH, SEQ, D_MODEL)),
        "x_sample": nrm(ks[1], (DEC_BATCH, DEC_SEQ, D_MODEL)),
        "cache_fox_k": nrm(ks[2], (N_FOX, DEC_BATCH, PAST_LEN, FOX_HEADS, FOX_HEAD_DIM)),
        "cache_fox_v": nrm(ks[3], (N_FOX, DEC_BATCH, PAST_LEN, FOX_HEADS, FOX_HEAD_DIM)),
        "cache_fox_logf": jax.nn.log_sigmoid(FORGET_BIAS_INIT + nrm(ks[4], (N_FOX, DEC_BATCH, PAST_LEN, FOX_HEADS))),
        "p_prompt": nrm(ks[5], (DEPTH, BATCH, SEQ, PLE_DIM)),
        "p_sample": nrm(ks[6], (DEPTH, DEC_BATCH, DEC_SEQ, PLE_DIM)),
        "norm_pre": 1.0 + 0.1 * nrm(ks[7], (DEPTH, D_MODEL)),
        "norm_post": 1.0 + 0.1 * nrm(ks[8], (DEPTH, D_MODEL)),
        "gmlp_w_in": nrm(ks[9], (N_GMLP, D_MODEL, 3 * E), D_MODEL ** -0.5),
        "gmlp_ln_g": 1.0 + 0.1 * nrm(ks[10], (N_GMLP, E)),
        "gmlp_ln_b": 0.02 * nrm(ks[11], (N_GMLP, E)),
        "gmlp_w_s": nrm(ks[12], (N_GMLP, GMLP_GROUPS, GMLP_BLOCK, GMLP_BLOCK), GMLP_BLOCK ** -0.5),
        "gmlp_b_s": 1.0 + 0.1 * nrm(ks[13], (N_GMLP, GMLP_GROUPS, GMLP_BLOCK)),
        "gmlp_w_out": nrm(ks[14], (N_GMLP, E, D_MODEL), E ** -0.5),
        "fox_w_in": nrm(ks[15], (N_FOX, D_MODEL, 4 * E + FOX_HEADS), D_MODEL ** -0.5),
        "fox_b_f": FORGET_BIAS_INIT + 0.5 * nrm(ks[16], (N_FOX, FOX_HEADS)),
        "fox_w_out": nrm(ks[17], (N_FOX, E, D_MODEL), E ** -0.5),
        "ple_w_proj": nrm(ks[18], (DEPTH, PLE_DIM, D_MODEL), PLE_DIM ** -0.5),
        "ple_w_gate": nrm(ks[19], (DEPTH, D_MODEL, D_MODEL), D_MODEL ** -0.5),
    }


def reference(x_prompt, x_sample, cache_fox_k, cache_fox_v, cache_fox_logf, p_prompt, p_sample,
              norm_pre, norm_post, gmlp_w_in, gmlp_ln_g, gmlp_ln_b, gmlp_w_s, gmlp_b_s, gmlp_w_out,
              fox_w_in, fox_b_f, fox_w_out, ple_w_proj, ple_w_gate):
    xp, xs = x_prompt, x_sample
    gmlp_v_s = []
    fk_p, fv_p, flf_p = [], [], []
    fk_s, fv_s, flf_s = [], [], []
    for i in range(DEPTH):
        j = i // N_MIXERS
        hp = rms_norm(xp, norm_pre[i])
        hs = rms_norm(xs, norm_pre[i])
        if i % N_MIXERS == 0:
            op, _ = gmlp_branch(hp, gmlp_w_in[j], gmlp_ln_g[j], gmlp_ln_b[j], gmlp_w_s[j], gmlp_b_s[j], gmlp_w_out[j])
            os_, vs = gmlp_branch(hs, gmlp_w_in[j], gmlp_ln_g[j], gmlp_ln_b[j], gmlp_w_s[j], gmlp_b_s[j], gmlp_w_out[j])
            gmlp_v_s.append(vs)
        else:
            qp, kp, vp, zp, lfp = fox_project(hp, fox_w_in[j], fox_b_f[j])
            op = (fox_attend_prompt(qp, kp, vp, lfp) * jax.nn.silu(zp)) @ fox_w_out[j]
            qs, ks_, vs_, zs, lfs = fox_project(hs, fox_w_in[j], fox_b_f[j])
            att_s = fox_attend_sample(qs, ks_, vs_, lfs, cache_fox_k[j], cache_fox_v[j], cache_fox_logf[j])
            os_ = (att_s * jax.nn.silu(zs)) @ fox_w_out[j]
            fk_p.append(kp); fv_p.append(vp); flf_p.append(lfp)
            fk_s.append(ks_); fv_s.append(vs_); flf_s.append(lfs)
        xp = xp + rms_norm(op, norm_post[i])
        xs = xs + rms_norm(os_, norm_post[i])
        xp = xp + jax.nn.sigmoid(xp @ ple_w_gate[i]) * (p_prompt[i] @ ple_w_proj[i])
        xs = xs + jax.nn.sigmoid(xs @ ple_w_gate[i]) * (p_sample[i] @ ple_w_proj[i])
    state_gmlp_v_sample = jnp.stack(gmlp_v_s)
    fox_k_prompt = jnp.stack(fk_p)
    fox_v_prompt = jnp.stack(fv_p)
    fox_logf_prompt = jnp.stack(flf_p)
    fox_k_sample = jnp.stack(fk_s)
    fox_v_sample = jnp.stack(fv_s)
    fox_logf_sample = jnp.stack(flf_s)
    return (xp, xs, state_gmlp_v_sample, fox_k_prompt, fox_v_prompt, fox_logf_prompt, fox_k_sample, fox_v_sample, fox_logf_sample)
```

```cpp
#include <hip/hip_runtime.h>
#include <hip/hip_bf16.h>
#include <hip/hip_cooperative_groups.h>
#include <cstdio>
#include <cstdint>
extern __shared__ __attribute__((aligned(16))) unsigned char g_lds[];
constexpr int LDS_TOTAL = 147456, LDS_WIDTAB = LDS_TOTAL - 512;
__device__ __forceinline__ int otid() {
    const unsigned hw = (unsigned)__builtin_amdgcn_s_getreg((5 << 11) | 4) & 63u;
    int w = ((volatile __attribute__((address_space(3))) int*)((__attribute__((address_space(3))) unsigned char*)g_lds + LDS_WIDTAB))[hw];
    w = __builtin_amdgcn_readfirstlane(w);
    int l; asm volatile("v_mbcnt_lo_u32_b32 %0, -1, 0" : "=v"(l)); asm volatile("v_mbcnt_hi_u32_b32 %0, -1, %0" : "+v"(l));
    return w * 64 + l;
}
namespace pg8 {
#define PG8_LAS __attribute__((address_space(3)))
typedef unsigned short bf16_t;
typedef short bf16x8 __attribute__((ext_vector_type(8)));
typedef float f32x4 __attribute__((ext_vector_type(4)));
typedef unsigned u32x4 __attribute__((ext_vector_type(4)));
constexpr int BM = 256, BK = 64, HALF = 128, HTB = HALF * BK * 2  , STAGE_BYTES = 8 * HTB, NXCD = 8, WGM = 8;

__host__ __device__ __forceinline__ int lds_byte(int r, int c) { const int st = (r >> 4) * 2 + (c >> 5), rr = r & 15, cc = c & 31, ob = rr * 64 + cc * 2; return st * 1024 + (ob ^ (((ob >> 9) & 1) << 5)); }
__host__ __device__ __forceinline__ void stage_rc(int b, int& R, int& C) { const int st = b / 1024, sb = b % 1024, swz = sb ^ (((sb >> 9) & 1) << 5); R = (st >> 1) * 16 + swz / 64; C = (st & 1) * 32 + (swz % 64) / 2; }
__host__ __device__ __forceinline__ int perm32(int rho) { const int n = rho >> 4, i = rho & 15; return 8 * (i >> 2) + 4 * n + (i & 3); }

struct Unit { int pm, pn, ko; };
struct Gemm { const bf16_t* A; const bf16_t* Bt; int M, N, K, ldk; };

struct StaticOrder {
    int nM, nN, nwg, G, c;
    __host__ __device__ void init(int M, int N, int G_, int c_) { nM = M / BM; nN = N / BM; nwg = nM * nN; G = G_; c = c_; }
    __host__ __device__ bool next(int i, Unit& u) const {
        const long L = (long)i * G + c; if (L >= nwg) return false;
        int wgid = (int)L; { const int q = nwg / NXCD, r = nwg % NXCD, xcd = wgid % NXCD, off = wgid / NXCD; wgid = (xcd < r ? xcd * (q + 1) : r * (q + 1) + (xcd - r) * q) + off; }
        const int nig = WGM * nN, gid = wgid / nig, fm = gid * WGM, gsz = (nM - fm) < WGM ? (nM - fm) : WGM;
        u.pm = fm + ((wgid % nig) % gsz); u.pn = (wgid % nig) / gsz; u.ko = 0; return true;
    }
    __device__ __forceinline__ void a_ready(const Unit&) const {}
    __device__ __forceinline__ void done(const Unit&) const {}
};

__device__ __forceinline__ unsigned cvt_pk_bf16(float lo, float hi) { unsigned r; asm volatile("v_cvt_pk_bf16_f32 %0, %1, %2" : "=v"(r) : "v"(lo), "v"(hi)); return r; }
typedef float f32x2 __attribute__((ext_vector_type(2)));
__device__ __forceinline__ f32x2 gelu_pk(f32x2 v) {
    const f32x2 av = __builtin_elementwise_abs(v), d = av * 0.2316418882f + 1.0f;
    f32x2 t; t.x = __builtin_amdgcn_rcpf(d.x); t.y = __builtin_amdgcn_rcpf(d.y);
    f32x2 q = t * 0.5307027145f + (-0.7265760135f); q = q * t + 0.7107068705f; q = q * t + (-0.142248368f); q = q * t + 0.127414796f; q = q * t;
    const f32x2 s = (v * v) * (-0.72134752044f);
    f32x2 e; e.x = __builtin_amdgcn_exp2f(s.x); e.y = __builtin_amdgcn_exp2f(s.y);
    const f32x2 m = v * (q * e), r = v - m;
    f32x2 o; o.x = v.x < 0.f ? m.x : r.x; o.y = v.y < 0.f ? m.y : r.y; return o;
}

template <int ACT  > struct EpiBf16 {
    static constexpr bool PERM = true, AFTER_DRAIN = false; static_assert(ACT == 0 || ACT == 1, "EpiBf16: ACT is 0 (none) or 1 (gelu_pk)");
    bf16_t* O; int ldc; const float* bias; int split_cols; size_t split_stride; float scale0;
    __device__ __forceinline__ void operator()(const f32x4 (&acc)[2][2][4][2], const Unit& u, int wr, int wc, int fr, int fq) const {
        const int row0 = u.pm * BM + wr * 64 + fr; int colt = u.pn * BM; bf16_t* base = O;
        float sc = 1.f; if (split_cols) { const int t = colt / split_cols; base += (size_t)t * split_stride; colt -= t * split_cols; if (t == 0) sc = scale0; }
        const int col0 = colt + wc * 32 + 8 * fq, bcol0 = u.pn * BM + wc * 32 + 8 * fq;
        f32x4 bv[2][2];
#pragma unroll
        for (int bj = 0; bj < 2; ++bj)
#pragma unroll
            for (int n = 0; n < 2; ++n) bv[bj][n] = bias ? *(const f32x4*)(bias + bcol0 + bj * HALF + 4 * n) : (f32x4){0.f, 0.f, 0.f, 0.f};
#pragma unroll
        for (int ai = 0; ai < 2; ++ai)
#pragma unroll
            for (int m = 0; m < 4; ++m) { bf16_t* rowp = base + (size_t)(row0 + ai * HALF + m * 16) * ldc + col0;
#pragma unroll
                for (int bj = 0; bj < 2; ++bj) { f32x4 v0 = acc[ai][bj][m][0] + bv[bj][0], v1 = acc[ai][bj][m][1] + bv[bj][1];
                    if (ACT == 1) { f32x2 a = gelu_pk((f32x2){v0[0], v0[1]}), b = gelu_pk((f32x2){v0[2], v0[3]}), c = gelu_pk((f32x2){v1[0], v1[1]}), d = gelu_pk((f32x2){v1[2], v1[3]});
                        v0 = (f32x4){a.x, a.y, b.x, b.y}; v1 = (f32x4){c.x, c.y, d.x, d.y}; }
                    v0 = v0 * sc; v1 = v1 * sc; u32x4 w; w.x = cvt_pk_bf16(v0[0], v0[1]); w.y = cvt_pk_bf16(v0[2], v0[3]); w.z = cvt_pk_bf16(v1[0], v1[1]); w.w = cvt_pk_bf16(v1[2], v1[3]);
                    *(u32x4*)(rowp + bj * HALF) = w; } }
    }
};


template <class Epi, class Sched, bool ALIGN_EPI = false, bool SP2 = false>
__device__ __forceinline__ void gemm_phase(PG8_LAS unsigned char* lds, const Gemm g, const Sched& S, const Epi& E) {
    const int tid = otid(), wid = __builtin_amdgcn_readfirstlane(tid >> 6), lane = tid & 63, wr = wid >> 2, wc = wid & 3, fr = lane & 15, fq = lane >> 4;
    const int K = g.K, nt = K / BK, LDK = g.ldk ? g.ldk : g.K;
    unsigned voffA[2], voffB[2];
#pragma unroll
    for (int i = 0; i < 2; ++i) { int R, C; stage_rc(tid * 16 + i * 8192, R, C); const int Rb = Epi::PERM ? ((R & ~31) + perm32(R & 31)) : R;
        voffA[i] = (unsigned)(R * LDK + C) * 2u; voffB[i] = (unsigned)(Rb * LDK + C) * 2u; }
    const size_t kstep = (size_t)(BK * 2);
    const size_t hstep = (size_t)HALF * LDK * 2;
    const size_t tstep = 2 * hstep;
    const unsigned ldsw = (unsigned)wid * 1024u;
    const int aoff = lds_byte(wr * 64 + fr, fq * 8), boff = lds_byte(wc * 32 + fr, fq * 8);
#define PG8_SA(b, h) (((b) * 2 + (h)) * HTB)
#define PG8_SB(b, h) ((4 + (b) * 2 + (h)) * HTB)
#define PG8_STAGE(bufoff, gbase, voff) do { _Pragma("unroll") for (int _i = 0; _i < 2; ++_i) \
        __builtin_amdgcn_global_load_lds((const unsigned*)((const char*)(gbase) + (voff)[_i]), (PG8_LAS unsigned*)(lds + (bufoff) + ldsw + _i * 8192), 16, 0, 0); } while (0)
#define PG8_LDA(dst, b, h) do { _Pragma("unroll") for (int m = 0; m < 4; ++m) _Pragma("unroll") for (int k = 0; k < 2; ++k) dst[m][k] = *(const PG8_LAS bf16x8*)(lds + PG8_SA(b, h) + aoff + m * 2048 + k * 1024); } while (0)
#define PG8_LDB(dst, b, h) do { _Pragma("unroll") for (int n = 0; n < 2; ++n) _Pragma("unroll") for (int k = 0; k < 2; ++k) dst[n][k] = *(const PG8_LAS bf16x8*)(lds + PG8_SB(b, h) + boff + n * 2048 + k * 1024); } while (0)
#define PG8_MMA(ai, bj, At, Bt) do { __builtin_amdgcn_s_setprio(1); _Pragma("unroll") for (int m = 0; m < 4; ++m) _Pragma("unroll") for (int n = 0; n < 2; ++n) _Pragma("unroll") for (int k = 0; k < 2; ++k) \
        acc[ai][bj][m][n] = __builtin_amdgcn_mfma_f32_16x16x32_bf16(Bt[n][k], At[m][k], acc[ai][bj][m][n], 0, 0, 0); __builtin_amdgcn_s_setprio(0); } while (0)
#define PG8_WAIT_V(n) asm volatile("s_waitcnt vmcnt(" #n ")" ::: "memory")
#define PG8_WAIT_L(n) asm volatile("s_waitcnt lgkmcnt(" #n ")" ::: "memory")
#define PG8_BAR __builtin_amdgcn_s_barrier()
#define PG8_SCHED __builtin_amdgcn_sched_barrier(0)
    Unit cur, nxt; int ui = 0;
    if (!S.next(0, cur)) return;
    f32x4 acc[2][2][4][2];
#pragma unroll
    for (int a = 0; a < 2; ++a)
#pragma unroll
        for (int b = 0; b < 2; ++b)
#pragma unroll
            for (int m = 0; m < 4; ++m)
#pragma unroll
                for (int n = 0; n < 2; ++n) acc[a][b][m][n] = (f32x4){0.f, 0.f, 0.f, 0.f};
    bf16x8 At[4][2], B0[2][2], B1[2][2];
    const char* cA = (const char*)g.A + (size_t)cur.pm * tstep + (size_t)cur.ko * 2; const char* cB = (const char*)g.Bt + (size_t)cur.pn * tstep + (size_t)cur.ko * 2;
    S.a_ready(cur);
    if constexpr (SP2) {
        PG8_STAGE(PG8_SB(0, 0), cB, voffB); PG8_STAGE(PG8_SB(0, 1), cB + hstep, voffB); PG8_STAGE(PG8_SA(0, 0), cA, voffA); PG8_STAGE(PG8_SA(0, 1), cA + hstep, voffA);
        if (wr == 1) PG8_BAR;
        PG8_WAIT_V(2); PG8_BAR;
        PG8_STAGE(PG8_SB(1, 0), cB + kstep, voffB); PG8_STAGE(PG8_SA(1, 0), cA + kstep, voffA); PG8_STAGE(PG8_SB(1, 1), cB + hstep + kstep, voffB);
        PG8_WAIT_V(6); PG8_BAR;
    } else {
        PG8_STAGE(PG8_SB(0, 0), cB, voffB); PG8_STAGE(PG8_SA(0, 0), cA, voffA); PG8_STAGE(PG8_SB(0, 1), cB + hstep, voffB); PG8_STAGE(PG8_SA(0, 1), cA + hstep, voffA);
        if (wr == 1) PG8_BAR;
        PG8_WAIT_V(4); PG8_BAR;
        PG8_STAGE(PG8_SB(1, 0), cB + kstep, voffB); PG8_STAGE(PG8_SA(1, 0), cA + kstep, voffA); PG8_STAGE(PG8_SB(1, 1), cB + hstep + kstep, voffB);
        PG8_WAIT_V(6); PG8_BAR;
    }
    for (;;) {
        const bool has_next = S.next(ui + 1, nxt);
        const char* nA = has_next ? (const char*)g.A + (size_t)nxt.pm * tstep + (size_t)nxt.ko * 2 : cA; const char* nB = has_next ? (const char*)g.Bt + (size_t)nxt.pn * tstep + (size_t)nxt.ko * 2 : cB;
        for (int t = 0; t < nt; t += 2) {
            const bool last = (t == nt - 2);
            const char* a1 = cA + (size_t)(t + 1) * kstep;
            const char* a2 = last ? nA : cA + (size_t)(t + 2) * kstep; const char* b2 = last ? nB : cB + (size_t)(t + 2) * kstep;
            const char* a3 = a2 + kstep; const char* b3 = b2 + kstep;
            if (last && has_next) S.a_ready(nxt);
            if constexpr (SP2) {
            PG8_LDB(B0, 0, 0); PG8_LDB(B1, 0, 1); PG8_SCHED; PG8_LDA(At, 0, 0); PG8_STAGE(PG8_SA(1, 1), a1 + hstep, voffA);
            PG8_WAIT_V(8); PG8_WAIT_L(0); PG8_BAR; PG8_MMA(0, 0, At, B0); PG8_MMA(0, 1, At, B1); PG8_BAR; PG8_SCHED;
            PG8_LDA(At, 0, 1); PG8_STAGE(PG8_SB(0, 0), b2, voffB); PG8_STAGE(PG8_SB(0, 1), b2 + hstep, voffB); PG8_STAGE(PG8_SA(0, 0), a2, voffA);
            PG8_WAIT_V(8); PG8_WAIT_L(0); PG8_BAR; PG8_MMA(1, 0, At, B0); PG8_MMA(1, 1, At, B1); PG8_BAR; PG8_SCHED;
            PG8_LDB(B0, 1, 0); PG8_LDB(B1, 1, 1); PG8_SCHED; PG8_LDA(At, 1, 0); PG8_STAGE(PG8_SA(0, 1), a2 + hstep, voffA);
            PG8_WAIT_V(8); PG8_WAIT_L(0); PG8_BAR; PG8_MMA(0, 0, At, B0); PG8_MMA(0, 1, At, B1); PG8_BAR; PG8_SCHED;
            PG8_LDA(At, 1, 1); PG8_STAGE(PG8_SB(1, 0), b3, voffB); PG8_STAGE(PG8_SB(1, 1), b3 + hstep, voffB); PG8_STAGE(PG8_SA(1, 0), a3, voffA);
            PG8_WAIT_V(8); PG8_WAIT_L(0); PG8_BAR; PG8_MMA(1, 0, At, B0); PG8_MMA(1, 1, At, B1); PG8_BAR; PG8_SCHED;
            } else {
            PG8_LDB(B0, 0, 0); PG8_SCHED; PG8_LDA(At, 0, 0); PG8_STAGE(PG8_SA(1, 1), a1 + hstep, voffA);
            PG8_WAIT_L(8); PG8_BAR; PG8_WAIT_L(0); PG8_MMA(0, 0, At, B0); PG8_BAR; PG8_SCHED;
            PG8_LDB(B1, 0, 1); PG8_STAGE(PG8_SB(0, 0), b2, voffB);
            PG8_BAR; PG8_WAIT_L(0); PG8_MMA(0, 1, At, B1); PG8_BAR;
            PG8_LDA(At, 0, 1); PG8_STAGE(PG8_SA(0, 0), a2, voffA);
            PG8_BAR; PG8_WAIT_L(0); PG8_MMA(1, 0, At, B0); PG8_BAR; PG8_SCHED;
            PG8_STAGE(PG8_SB(0, 1), b2 + hstep, voffB);
            PG8_WAIT_V(6); PG8_BAR; PG8_MMA(1, 1, At, B1); PG8_BAR;
            PG8_LDB(B0, 1, 0); PG8_SCHED; PG8_LDA(At, 1, 0); PG8_STAGE(PG8_SA(0, 1), a2 + hstep, voffA);
            PG8_WAIT_L(8); PG8_BAR; PG8_WAIT_L(0); PG8_MMA(0, 0, At, B0); PG8_BAR; PG8_SCHED;
            PG8_LDB(B1, 1, 1); PG8_STAGE(PG8_SB(1, 0), b3, voffB);
            PG8_BAR; PG8_WAIT_L(0); PG8_MMA(0, 1, At, B1); PG8_BAR;
            PG8_LDA(At, 1, 1); PG8_STAGE(PG8_SA(1, 0), a3, voffA);
            PG8_BAR; PG8_WAIT_L(0); PG8_MMA(1, 0, At, B0); PG8_BAR; PG8_SCHED;
            PG8_STAGE(PG8_SB(1, 1), b3 + hstep, voffB);
            PG8_WAIT_V(6); PG8_BAR; PG8_MMA(1, 1, At, B1); PG8_BAR;
            }
        }
        if constexpr (ALIGN_EPI) { if (wr == 0) PG8_BAR; }
        if constexpr (!Epi::AFTER_DRAIN) { E(acc, cur, wr, wc, fr, fq); S.done(cur); }
        if (!has_next) break;
#pragma unroll
        for (int a = 0; a < 2; ++a)
#pragma unroll
            for (int b = 0; b < 2; ++b)
#pragma unroll
                for (int m = 0; m < 4; ++m)
#pragma unroll
                    for (int n = 0; n < 2; ++n) acc[a][b][m][n] = (f32x4){0.f, 0.f, 0.f, 0.f};
        cur = nxt; cA = nA; cB = nB; ++ui;
        if constexpr (ALIGN_EPI) { if (wr == 1) PG8_BAR; }
    }
    PG8_WAIT_V(0);
    if constexpr (!ALIGN_EPI) { if (wr == 0) PG8_BAR; }
    PG8_BAR;
    if constexpr (Epi::AFTER_DRAIN) { E.fused(acc, cur, wr, wc, fr, fq, lds, wid, lane); S.done(cur); }
#undef PG8_SA
#undef PG8_SB
#undef PG8_STAGE
#undef PG8_LDA
#undef PG8_LDB
#undef PG8_MMA
#undef PG8_WAIT_V
#undef PG8_WAIT_L
#undef PG8_BAR
#undef PG8_SCHED
}
}
namespace att {
constexpr int D = 128, PITCH = 2048;
constexpr float THR = 8.f;
constexpr bool WSKIP = false;
constexpr float SCALE = 0.08838834764831845f;
constexpr int NW = 8, QBLK = 32, KVBLK = 64, QB = NW * QBLK;
constexpr int SHM_V = KVBLK * D * 2, SHM_K = KVBLK * D * 2;
constexpr int LDS_BYTES = 2 * SHM_V + 2 * SHM_K + NW * 64 * 4 + 512;
using bf16 = __hip_bfloat16;
typedef short bf16x8 __attribute__((ext_vector_type(8)));
typedef short s16x4 __attribute__((ext_vector_type(4)));
typedef float f32x16 __attribute__((ext_vector_type(16)));
typedef float f32x4 __attribute__((ext_vector_type(4)));
typedef unsigned u32x4 __attribute__((ext_vector_type(4)));
template <class A, class Bt> struct same_t { static constexpr bool v = false; };
template <class A> struct same_t<A, A> { static constexpr bool v = true; };

#define BPERM(k) ((((k) >> 2) & 1) * 32 + (((k) >> 3) & 3) * 4 + ((k) & 3))
#define KSWZ(row, colB) ((row) * 256 + ((colB) ^ (((row) & 7) << 4)))
#define SBAR() __builtin_amdgcn_sched_barrier(0)
__device__ __forceinline__ int v_st(int k, int c) { const int kk = (k & ~0xC) | ((k & 4) << 1) | ((k & 8) >> 1); return ((kk >> 3) * 4 + (c >> 5)) * 512 + ((kk & 7) * 32 + (c & 31)) * 2; }
__device__ __forceinline__ int v_rd_base(int lane) { return ((lane & 3) << 3) | (((lane >> 2) & 3) << 6) | (((lane >> 4) & 1) << 5) | (((lane >> 5) & 1) << 8); }
constexpr int v_rd_off(int d0, int ks, int half) { return d0 * 512 + ks * 4096 + half * 2048; }
__device__ __forceinline__ int crow(int r, int hi) { return (r & 3) + 8 * (r >> 2) + 4 * hi; }
__device__ __forceinline__ unsigned cvtpk(float lo, float hi) {
    unsigned r; asm volatile("v_cvt_pk_bf16_f32 %0, %1, %2" : "=v"(r) : "v"(lo), "v"(hi)); return r;
}
__device__ __forceinline__ bf16x8 pack8(f32x4 a, f32x4 b) {
    u32x4 w = {cvtpk(a[0], a[1]), cvtpk(a[2], a[3]), cvtpk(b[0], b[1]), cvtpk(b[2], b[3])};
    return *reinterpret_cast<bf16x8*>(&w);
}
template <class T> __device__ __forceinline__ bf16x8 load8(const T* p) {
    if constexpr (same_t<T, float>::v) { return pack8(*(const f32x4*)p, *(const f32x4*)(p + 4)); }
    else { return *reinterpret_cast<const bf16x8*>(p); }
}
__device__ __forceinline__ void mask_tile(f32x16& p0, f32x16& p1, int dq, unsigned W) {
    const float NEG = -__builtin_inff();
#pragma unroll
    for (int r = 0; r < 16; ++r) {
        const int c = (r & 3) + 8 * (r >> 2);
        if ((unsigned)(dq - c) >= W) p0[r] = NEG;
        if ((unsigned)(dq - c - 32) >= W) p1[r] = NEG;
    }
}
__device__ __forceinline__ void partialSM(f32x16& p0, f32x16& p1, float& m_reg, float& mn, float& alpha) {
    float pmax = p0[0]; for (int r = 1; r < 16; ++r) pmax = fmaxf(pmax, p0[r]); for (int r = 0; r < 16; ++r) pmax = fmaxf(pmax, p1[r]);
    { auto rr = __builtin_amdgcn_permlane32_swap(__float_as_uint(pmax), __float_as_uint(pmax), false, false);
      pmax = fmaxf(__uint_as_float(rr[0]), __uint_as_float(rr[1])); }
    constexpr float C2 = 1.4426950408889634f * SCALE;
    if (__builtin_expect(__all((pmax - m_reg) * SCALE <= THR), 1)) { mn = m_reg; alpha = 1.f; }
    else { mn = fmaxf(m_reg, pmax); alpha = __builtin_amdgcn_exp2f((m_reg - mn) * C2); m_reg = mn; }
    const float mnL = -mn * C2;
    for (int r = 0; r < 16; ++r) p0[r] = fmaf(p0[r], C2, mnL); for (int r = 0; r < 16; ++r) p1[r] = fmaf(p1[r], C2, mnL);
    for (int r = 0; r < 16; ++r) p0[r] = __builtin_amdgcn_exp2f(p0[r]);
}
__device__ __forceinline__ void finishSM(f32x16& p0, f32x16& p1, float alpha, float& l_reg, bf16x8& pa0, bf16x8& pa1, bf16x8& pa2, bf16x8& pa3) {
    for (int r = 0; r < 16; ++r) p1[r] = __builtin_amdgcn_exp2f(p1[r]);
    float ps = 0; for (int r = 0; r < 16; ++r) ps += p0[r]; for (int r = 0; r < 16; ++r) ps += p1[r];
    { auto rr = __builtin_amdgcn_permlane32_swap(__float_as_uint(ps), __float_as_uint(ps), false, false);
      ps = __uint_as_float(rr[0]) + __uint_as_float(rr[1]); }
    l_reg = l_reg * alpha + ps;
#define PK4(P, B_, OUT) do { unsigned a0 = cvtpk(P[B_+0], P[B_+1]), a1 = cvtpk(P[B_+2], P[B_+3]);                          \
        unsigned b0 = cvtpk(P[B_+4], P[B_+5]), b1 = cvtpk(P[B_+6], P[B_+7]);                                             \
        auto r0 = __builtin_amdgcn_permlane32_swap(a0, b0, false, false); auto r1 = __builtin_amdgcn_permlane32_swap(a1, b1, false, false); \
        u32x4 w = {r0[0], r1[0], r0[1], r1[1]}; OUT = *reinterpret_cast<bf16x8*>(&w); } while (0)
    PK4(p0, 0, pa0); PK4(p0, 8, pa1); PK4(p1, 0, pa2); PK4(p1, 8, pa3);
#undef PK4
}
template <int KB, bool SK>
__device__ __forceinline__ void qkt(f32x16& p0, f32x16& p1, const char* K_lds, const float* B_lds, int r32, int hi, const bf16x8* qr, bool act) {
    if (SK && !act) { const float NEG = -__builtin_inff();
#pragma unroll
        for (int r = 0; r < 16; ++r) { p0[r] = NEG; p1[r] = NEG; } return; }
#ifdef ATT_NOBIAS
    p0 = f32x16{}; p1 = f32x16{};
#else
    p0 = *(const f32x16*)(B_lds + KB * 64 + hi * 32); p1 = *(const f32x16*)(B_lds + KB * 64 + hi * 32 + 16);
#endif
    const char* kb[4];
#pragma unroll
    for (int dd = 0; dd < 4; ++dd) kb[dd] = K_lds + KB * SHM_K + KSWZ(r32, (dd * 16 + hi * 8) * 2);
#pragma unroll
    for (int d0 = 0; d0 < 8; ++d0) { const char* a = kb[d0 & 3] + (d0 >> 2) * 128;
        bf16x8 b0 = *reinterpret_cast<const bf16x8*>(a);
        bf16x8 b1 = *reinterpret_cast<const bf16x8*>(a + 32 * 256);
        p0 = __builtin_amdgcn_mfma_f32_32x32x16_bf16(b0, qr[d0], p0, 0, 0, 0);
        p1 = __builtin_amdgcn_mfma_f32_32x32x16_bf16(b1, qr[d0], p1, 0, 0, 0); }
}
template <int VB, bool SK>
__device__ __forceinline__ void pv_tile(f32x16* o, int vb0, bf16x8 pa0, bf16x8 pa1, bf16x8 pa2, bf16x8 pa3, bool act) {
    if (SK && !act) return;
#define TRRD(dst, off) asm volatile("ds_read_b64_tr_b16 %0, %1 offset:%2" : "=&v"(dst) : "v"(vb0), "i"(off) : "memory")
#define PV_D0(d0) do { s16x4 l0, l1, l2, l3, h0, h1, h2, h3; constexpr int b_ = VB * SHM_V + v_rd_off(d0, 0, 0);     \
        TRRD(l0, b_); TRRD(h0, b_ + 2048); TRRD(l1, b_ + 4096); TRRD(h1, b_ + 6144); TRRD(l2, b_ + 8192); TRRD(h2, b_ + 10240); TRRD(l3, b_ + 12288); TRRD(h3, b_ + 14336); \
        asm volatile("s_waitcnt lgkmcnt(0)" ::: "memory"); SBAR();                 \
        o[d0] = __builtin_amdgcn_mfma_f32_32x32x16_bf16(pa0, (bf16x8){l0[0], l0[1], l0[2], l0[3], h0[0], h0[1], h0[2], h0[3]}, o[d0], 0, 0, 0);   \
        o[d0] = __builtin_amdgcn_mfma_f32_32x32x16_bf16(pa1, (bf16x8){l1[0], l1[1], l1[2], l1[3], h1[0], h1[1], h1[2], h1[3]}, o[d0], 0, 0, 0);   \
        o[d0] = __builtin_amdgcn_mfma_f32_32x32x16_bf16(pa2, (bf16x8){l2[0], l2[1], l2[2], l2[3], h2[0], h2[1], h2[2], h2[3]}, o[d0], 0, 0, 0);   \
        o[d0] = __builtin_amdgcn_mfma_f32_32x32x16_bf16(pa3, (bf16x8){l3[0], l3[1], l3[2], l3[3], h3[0], h3[1], h3[2], h3[3]}, o[d0], 0, 0, 0); } while (0)
    PV_D0(0); PV_D0(1); PV_D0(2); PV_D0(3);
#undef PV_D0
#undef TRRD
}

template <class TIn, class TOut> struct BlockRef { const TIn* Q; const TIn* K; const TIn* V; TOut* O; const float* CB; const TIn* Z; int P0; };
template <class TIn> struct Seam {
    bf16x8 qr[8];
    bf16x8 st_v0, st_v1, st_k0, st_k1; float st_b0; f32x4 sf0, sf1, sf2, sf3;
    f32x4 tq[16];
};
__device__ __forceinline__ int swa_jlo(int P0, int W) { const int lowk = P0 - W + 1; return lowk > 0 ? lowk / KVBLK : 0; }
#define ROW(p, k0, rr) ((p) + (unsigned)(((k0) + (rr)) * PITCH + sc))
#define VMW() asm volatile("s_waitcnt vmcnt(0)" ::: "memory")
#define VMWN(n) asm volatile("s_waitcnt vmcnt(%0)" :: "i"(n) : "memory")
#define SLOAD_H(Kp, Vp, Cp, k0) do { S.st_b0 = (Cp)[(unsigned)((k0) + sr + 32 * (tid & 1))]; S.st_v0 = load8<TIn>(ROW(Vp, k0, sr)); S.st_v1 = load8<TIn>(ROW(Vp, k0, 32 + sr));              \
                         S.st_k0 = load8<TIn>(ROW(Kp, k0, sr)); S.st_k1 = load8<TIn>(ROW(Kp, k0, 32 + sr)); } while (0)
#define SWRITE_HK(bf) do { B_lds[(bf) * 64 + sr + 32 * (tid & 1)] = S.st_b0; *(bf16x8*)(K_lds + (bf) * SHM_K + kws) = S.st_k0; *(bf16x8*)(K_lds + (bf) * SHM_K + kws + 32 * 256) = S.st_k1; } while (0)
#define SWRITE_HV(bf) do { *(bf16x8*)(V_lds + (bf) * SHM_V + vst0) = S.st_v0; *(bf16x8*)(V_lds + (bf) * SHM_V + vst1) = S.st_v1; } while (0)
#define SWRITE_H(bf) do { SWRITE_HV(bf); SWRITE_HK(bf); } while (0)
#define SLOAD_F(p, k0) do { S.sf0 = *(const f32x4*)ROW(p, k0, sr); S.sf1 = *(const f32x4*)(ROW(p, k0, sr) + 4);                \
                            S.sf2 = *(const f32x4*)ROW(p, k0, 32 + sr); S.sf3 = *(const f32x4*)(ROW(p, k0, 32 + sr) + 4); } while (0)
#define SWRITE_KF(bf) do { *(bf16x8*)(K_lds + (bf) * SHM_K + kws) = pack8(S.sf0, S.sf1); *(bf16x8*)(K_lds + (bf) * SHM_K + kws + 32 * 256) = pack8(S.sf2, S.sf3); } while (0)
#define SWRITE_VF(bf) do { *(bf16x8*)(V_lds + (bf) * SHM_V + vst0) = pack8(S.sf0, S.sf1); *(bf16x8*)(V_lds + (bf) * SHM_V + vst1) = pack8(S.sf2, S.sf3); } while (0)
template <class TIn, class TOut>
__device__ __forceinline__ void causal_swa_prime(const BlockRef<TIn, TOut>& cur, int W, char* lds, Seam<TIn>& S) {
    constexpr bool F32 = same_t<TIn, float>::v;
    const int tid = otid(), wid = __builtin_amdgcn_readfirstlane(tid >> 6), lane = tid & 63, r32 = lane & 31, hi = lane >> 5;
    const int sr = tid >> 4, sc = (tid & 15) * 8, kws = KSWZ(sr, sc * 2); char* K_lds = lds + 2 * SHM_V; float* B_lds = (float*)(lds + 2 * SHM_V + 2 * SHM_K + NW * 64 * 4);
    const int kb0 = swa_jlo(cur.P0, W) * KVBLK;
    for (int d0 = 0; d0 < 8; ++d0) S.qr[d0] = load8<TIn>(cur.Q + (unsigned)((wid * QBLK + r32) * PITCH + d0 * 16 + hi * 8));
    if constexpr (F32) { SLOAD_F((const float*)cur.K, kb0); VMW(); SWRITE_KF(0); SBAR(); SLOAD_F((const float*)cur.V, kb0); }
    else { SLOAD_H(cur.K, cur.V, cur.CB, kb0); VMW(); SWRITE_HK(0); }
    __syncthreads();
}
template <class TIn, class TOut>
__device__ __forceinline__ void causal_swa_block(const BlockRef<TIn, TOut>& cur, const BlockRef<TIn, TOut>& nxt, int skv, int W, char* lds, Seam<TIn>& S) {
    constexpr bool F32 = same_t<TIn, float>::v;
    const int tid = otid(), wid = __builtin_amdgcn_readfirstlane(tid >> 6), lane = tid & 63, r32 = lane & 31, hi = lane >> 5;
    const int j_lo = swa_jlo(cur.P0, W);
    int j_hi = (cur.P0 + QB - 1) / KVBLK + 1; if (j_hi > skv / KVBLK) j_hi = skv / KVBLK;
    const int NT = j_hi - j_lo;
    const int kbn = swa_jlo(nxt.P0, W) * KVBLK;
    const int qlo = cur.P0 + wid * QBLK, qm = qlo + r32 - 4 * hi;
    char* V_lds = lds; char* K_lds = lds + 2 * SHM_V; float* B_lds = (float*)(lds + 2 * SHM_V + 2 * SHM_K + NW * 64 * 4);
    float* ws = (float*)(lds + 2 * SHM_V + 2 * SHM_K) + wid * 64; float* li_l = ws, * al_l = ws + 32;
    float m_reg = -1e30f, l_reg = 0; f32x16 o[4] = {};
    const int sr = tid >> 4, sc = (tid & 15) * 8, vst0 = v_st(sr, sc), vst1 = v_st(32 + sr, sc), kws = KSWZ(sr, sc * 2);
    const int vb0 = (int)(uintptr_t)V_lds + v_rd_base(lane);
    const TIn* Kh = cur.K; const TIn* Vh = cur.V; const float* Ch = cur.CB;
#define RESC(a) do { if (__any((a) < 1.f)) { if (hi == 0) al_l[r32] = (a); asm volatile("s_waitcnt lgkmcnt(0)" ::: "memory");              \
                     for (int d_ = 0; d_ < 4; ++d_) for (int r = 0; r < 16; ++r) o[d_][r] *= al_l[crow(r, hi)]; } } while (0)
#define KBASE(t) ((j_lo + (t)) * KVBLK)
#define ACT(t) (KBASE(t) <= qlo + QBLK - 1 && KBASE(t) + KVBLK - 1 >= qlo - W + 1)
#define MASKT(P0_, P1_, t) do { const int kb_ = KBASE(t); if ((!SK || ACT(t)) && (kb_ + KVBLK - 1 > qlo || kb_ <= qlo + QBLK - 1 - W)) mask_tile(P0_, P1_, qm - kb_, (unsigned)W); } while (0)
    constexpr int NQL = F32 ? 16 : 8;
    constexpr bool SK = WSKIP && !F32;
#define SEAM_K0() do { VMWN(NQL); if constexpr (F32) { SWRITE_KF(0); SBAR(); SLOAD_F((const float*)nxt.V, kbn); } else { SWRITE_HK(0); } SBAR(); } while (0)
    f32x16 pA0, pA1, pB0, pB1; float mnA, mnB, alA, alB; bf16x8 pa0, pa1, pa2, pa3;
    if constexpr (F32) { VMW(); SWRITE_VF(0); SBAR(); } else { SWRITE_HV(0); SBAR(); }
    if (NT > 1) { if constexpr (F32) SLOAD_F((const float*)Kh, KBASE(1)); else SLOAD_H(Kh, Vh, Ch, KBASE(1)); }
    SBAR(); qkt<0, SK>(pA0, pA1, K_lds, B_lds, r32, hi, S.qr, ACT(0));
    if constexpr (F32) { if (NT > 1) { VMW(); SWRITE_KF(1); SBAR(); SLOAD_F((const float*)Vh, KBASE(1)); } }
    MASKT(pA0, pA1, 0); partialSM(pA0, pA1, m_reg, mnA, alA);
    if (NT > 1) { VMW(); if constexpr (F32) { SWRITE_VF(1); SBAR(); if (NT > 2) SLOAD_F((const float*)Kh, KBASE(2)); } else SWRITE_H(1); }
    __syncthreads();
#define HALF_STEP(PX0, PX1, mnX, alX, PY0, PY1, alY, t, KB, VB, SB) do {                                                      \
        SBAR(); qkt<KB, SK>(PX0, PX1, K_lds, B_lds, r32, hi, S.qr, ACT(t));                                             \
        finishSM(PY0, PY1, alY, l_reg, pa0, pa1, pa2, pa3); SBAR();                                                           \
        if ((t) + 1 < NT) { if constexpr (F32) { VMW(); SWRITE_KF(SB); SBAR(); SLOAD_F((const float*)Vh, KBASE((t) + 1)); }  \
                            else { SLOAD_H(Kh, Vh, Ch, KBASE((t) + 1)); } SBAR(); }                                               \
        pv_tile<VB, SK>(o, vb0, pa0, pa1, pa2, pa3, ACT((t) - 1)); MASKT(PX0, PX1, (t)); partialSM(PX0, PX1, m_reg, mnX, alX);                                        \
        __syncthreads();                                                                                                      \
        if ((t) + 1 < NT) { VMW(); if constexpr (F32) { SWRITE_VF(SB); SBAR(); if ((t) + 2 < NT) SLOAD_F((const float*)Kh, KBASE((t) + 2)); } \
                            else { SWRITE_H(SB); } }                                                                          \
        RESC(alX); __syncthreads(); } while (0)
    for (int t = 1; t + 1 < NT; t += 2) {
        HALF_STEP(pB0, pB1, mnB, alB, pA0, pA1, alA, t, 1, 0, 0);
        HALF_STEP(pA0, pA1, mnA, alA, pB0, pB1, alB, t + 1, 0, 1, 1);
    }
    const bool even = (NT & 1) == 0;
    if (even) { SBAR(); qkt<1, SK>(pB0, pB1, K_lds, B_lds, r32, hi, S.qr, ACT(NT - 1)); SBAR(); }
#define QROW(e) (nxt.Q + (size_t)(wid * QBLK + r32) * PITCH + ((e) >> 1) * 16 + hi * 8 + ((e) & 1) * 4)
    if constexpr (F32) { SLOAD_F((const float*)nxt.K, kbn); SBAR();
#pragma unroll
        for (int e = 0; e < 8; ++e) S.tq[e] = *(const f32x4*)QROW(e); }
    else { SLOAD_H(nxt.K, nxt.V, nxt.CB, kbn); SBAR();
#pragma unroll
        for (int d0 = 0; d0 < 8; ++d0) S.qr[d0] = load8<TIn>(nxt.Q + (unsigned)((wid * QBLK + r32) * PITCH + d0 * 16 + hi * 8)); }
    SBAR();
    finishSM(pA0, pA1, alA, l_reg, pa0, pa1, pa2, pa3); SBAR();
    if constexpr (F32) {
#pragma unroll
        for (int e = 8; e < 16; ++e) S.tq[e] = *(const f32x4*)QROW(e); SBAR(); }
#undef QROW
    pv_tile<0, SK>(o, vb0, pa0, pa1, pa2, pa3, ACT(even ? NT - 2 : NT - 1));
    if (even) { MASKT(pB0, pB1, NT - 1); partialSM(pB0, pB1, m_reg, mnB, alB); __syncthreads(); RESC(alB);
        finishSM(pB0, pB1, alB, l_reg, pa0, pa1, pa2, pa3); SBAR(); pv_tile<1, SK>(o, vb0, pa0, pa1, pa2, pa3, ACT(NT - 1)); }
    SBAR(); SEAM_K0();
    if (hi == 0) li_l[r32] = l_reg; asm volatile("s_waitcnt lgkmcnt(0)" ::: "memory");
    float rli[16];
#pragma unroll
    for (int r = 0; r < 16; ++r) rli[r] = __builtin_amdgcn_rcpf(li_l[crow(r, hi)]);
    TOut* Ow = cur.O + (size_t)(wid * QBLK) * PITCH; const TIn* Zw = cur.Z + (size_t)(wid * QBLK) * PITCH; unsigned lo_ = (unsigned)(4 * hi) * PITCH + r32; asm volatile("" : "+v"(lo_));
#pragma unroll
    for (int r = 0; r < 16; ++r) { const int orow = crow(r, hi);
#pragma unroll
        for (int d0 = 0; d0 < 4; ++d0) { const float v = o[d0][r] * rli[r];
            if constexpr (same_t<TOut, float>::v) { Ow[(size_t)orow * PITCH + d0 * 32 + r32] = v; }
            else { const float vn = __shfl_xor(v, 1);
                   if ((r32 & 1) == 0) { const unsigned of_ = lo_ + (unsigned)(orow - 4 * hi) * PITCH + d0 * 32; const unsigned zz = *(const unsigned*)(Zw + of_);
                       *(unsigned*)(Ow + of_) = cvtpk(v * __uint_as_float(zz << 16), vn * __uint_as_float(zz & 0xffff0000u)); } } } }
    if constexpr (F32) {
#pragma unroll
        for (int d0 = 0; d0 < 8; ++d0) S.qr[d0] = pack8(S.tq[2 * d0], S.tq[2 * d0 + 1]); }
    __syncthreads();
#undef RESC
#undef KBASE
#undef ACT
#undef MASKT
#undef SEAM_K0
#undef HALF_STEP
}
#undef ROW
#undef VMW
#undef VMWN
#undef SLOAD_H
#undef SWRITE_HK
#undef SWRITE_HV
#undef SWRITE_H
#undef SLOAD_F
#undef SWRITE_KF
#undef SWRITE_VF
}

namespace cg = cooperative_groups;
#define LAS __attribute__((address_space(3)))
typedef unsigned short bf16_t;
typedef float f32x4 __attribute__((ext_vector_type(4)));
typedef float f32x2 __attribute__((ext_vector_type(2)));
typedef unsigned u32x4 __attribute__((ext_vector_type(4)));
typedef unsigned u32x2 __attribute__((ext_vector_type(2)));
typedef short bf16x8 __attribute__((ext_vector_type(8)));

constexpr int DM = 1024, EB = 2048, MP = 32768, MS = 128, MV = MP + MS  , MA = 33024  ;
constexpr int SEQ = 4096, NBH = 128, PAST = 2048, TS = 16, SKS = 2112  ;
constexpr int NFIN = 8448;
constexpr float RMS_EPS = 1e-6f, LN_EPS = 1e-5f;
constexpr size_t O_YP = 0, O_YS = 33554432, O_GV = 33685504, O_FKP = 34209792, O_FVP = 168427520, O_FLP = 302645248, O_FKS = 303693824, O_FVS = 304218112, O_FLS = 304742400;
constexpr size_t MiB = 1u << 20;
constexpr size_t WS_WGIN = 1 * MiB;
constexpr size_t WS_WGOUT = 25 * MiB;
constexpr size_t WS_WFIN = 33 * MiB;
constexpr size_t WS_WFOUT = 66 * MiB;
constexpr size_t WS_WPP = 74 * MiB;
constexpr size_t WS_WPG = 76 * MiB;
constexpr size_t WS_WM = 84 * MiB;
constexpr size_t WS_WMS = 85 * MiB;
constexpr size_t WS_PB = 88 * MiB;
constexpr size_t WS_HX = 105 * MiB;
constexpr size_t WS_TB = 170 * MiB;
constexpr size_t WS_STAT = 756 * MiB;
constexpr size_t WS_CBP = 236 * MiB;
constexpr size_t WS_CBS = 238 * MiB + 512 * 1024;
constexpr size_t WS_R0 = 240 * MiB, RSZ = 129 * MiB;
constexpr size_t WS_END = 775 * MiB;
constexpr size_t WS_PART = 766 * MiB;
constexpr size_t WS_DUMMY = 776 * MiB;
constexpr int LDS_BYTES = LDS_TOTAL;
#ifndef PROBE_DUP
#define PROBE_DUP 0
#endif

struct ArgsS { const float* in[20]; float* out; unsigned char* ws; };
typedef const __attribute__((address_space(4))) ArgsS* ArgsP;
struct Args { ArgsP p; };
__device__ __forceinline__ Args getargs() { ArgsP p = (ArgsP)__builtin_amdgcn_kernarg_segment_ptr(); asm volatile("" : "+s"(p)); Args a; a.p = p; return a; }

__device__ __forceinline__ unsigned f2bf(float f) { unsigned u = __builtin_bit_cast(unsigned, f); return (u + 0x7fffu + ((u >> 16) & 1u)) >> 16; }
__device__ __forceinline__ unsigned pk2(float lo, float hi) { return pg8::cvt_pk_bf16(lo, hi); }
__device__ __forceinline__ float bflo(unsigned u) { return __uint_as_float(u << 16); }
__device__ __forceinline__ float bfhi(unsigned u) { return __uint_as_float(u & 0xffff0000u); }
__device__ __forceinline__ float wave_sum(float v) { for (int o = 32; o > 0; o >>= 1) v += __shfl_xor(v, o); return v; }
__device__ __forceinline__ float wave_max(float v) { for (int o = 32; o > 0; o >>= 1) v = fmaxf(v, __shfl_xor(v, o)); return v; }
__device__ __forceinline__ float gelu_t(float x) { const float u = 1.5957691216057308f * (x + 0.044715f * x * x * x); return x / (1.f + __expf(-u)); }
__device__ __forceinline__ float silu_f(float x) { return x / (1.f + __expf(-x)); }
__device__ __forceinline__ float sigm_f(float x) { return 1.f / (1.f + __expf(-x)); }
__device__ __forceinline__ float logsig_f(float x) { const float e = __expf(-fabsf(x)); const float l = e < 0.03f ? e * (1.f - e * (0.5f - e * (0.33333334f - 0.25f * e))) : __logf(1.f + e); return fminf(x, 0.f) - l; }

using pg8::Unit; using pg8::HALF; using pg8::BM;
struct EpiGmlpIn {
    static constexpr bool PERM = true, AFTER_DRAIN = false;
    bf16_t* U; bf16_t* VT; bf16_t* ZS; float* stat;
    __device__ __forceinline__ void operator()(const pg8::f32x4 (&acc)[2][2][4][2], const Unit& u, int wr, int wc, int fr_, int fq_) const {
        const int lane_ = otid() & 63, fr = lane_ & 15, fq = lane_ >> 4; (void)fr_; (void)fq_;
        const int row0 = u.pm * BM + wr * 64 + fr, colt = u.pn * BM, region = colt >> 11, cb = (colt & 2047) + wc * 32 + 8 * fq;
#pragma unroll
        for (int ai = 0; ai < 2; ++ai)
#pragma unroll
            for (int m = 0; m < 4; ++m) {
                const int row = row0 + ai * HALF + m * 16; float s = 0.f, q = 0.f;
#pragma unroll
                for (int bj = 0; bj < 2; ++bj) {
                    const int col = cb + bj * HALF; const pg8::f32x4 v0 = acc[ai][bj][m][0], v1 = acc[ai][bj][m][1];
                    float x[8] = {v0[0], v0[1], v0[2], v0[3], v1[0], v1[1], v1[2], v1[3]};
                    if (region == 2) {
#pragma unroll
                        for (int e = 0; e < 8; ++e) x[e] = silu_f(x[e]);
                    } else {
#pragma unroll
                        for (int e = 0; e < 8; ++e) x[e] = gelu_t(x[e]);
                    }
                    u32x4 w; w.x = pk2(x[0], x[1]); w.y = pk2(x[2], x[3]); w.z = pk2(x[4], x[5]); w.w = pk2(x[6], x[7]);
                    if (region == 1) {
                        bf16_t* vp = VT + ((size_t)(row >> 7) * 2048 + col) * 128 + (row & 127);
                        const unsigned ww[4] = {w.x, w.y, w.z, w.w};
#pragma unroll
                        for (int e = 0; e < 4; ++e) { vp[(2 * e) * 128] = (bf16_t)(ww[e] & 0xffffu); vp[(2 * e + 1) * 128] = (bf16_t)(ww[e] >> 16);
                            const float a = bflo(ww[e]), b = bfhi(ww[e]); s += a + b; q += a * a + b * b; }
                    } else {
                        bf16_t* dst = (region == 0 ? U : ZS) + (size_t)row * 2048 + col;
                        *(u32x4*)dst = w;
                    }
                }
                if (region == 1) {
                    s += __shfl_xor(s, 16); s += __shfl_xor(s, 32); q += __shfl_xor(q, 16); q += __shfl_xor(q, 32);
                    if (fq == 0) { const int slot = ((colt & 2047) >> 6) + wc; stat[(size_t)row * 64 + slot] = s; stat[(size_t)row * 64 + 32 + slot] = q; }
                }
            }
    }
};
struct EpiFoxIn {
    static constexpr bool PERM = true, AFTER_DRAIN = false;
    bf16_t* QB; bf16_t* KB; bf16_t* VB; bf16_t* ZS; float* okp; float* ovp; float* olp; float* oks; float* ovs; float* ols; const float* bf;
    __device__ __forceinline__ void operator()(const pg8::f32x4 (&acc)[2][2][4][2], const Unit& u, int wr, int wc, int fr_, int fq_) const {
        const int lane_ = otid() & 63, fr = lane_ & 15, fq = lane_ >> 4; (void)fr_; (void)fq_;
        const int row0 = u.pm * BM + wr * 64 + fr, colt = u.pn * BM, region = colt >> 11, cb = (colt & 2047) + wc * 32 + 8 * fq;
        if (region == 4) {
            if (wc != 0 || fq >= 2) return;
#pragma unroll
            for (int ai = 0; ai < 2; ++ai)
#pragma unroll
                for (int m = 0; m < 4; ++m) {
                    const int row = row0 + ai * HALF + m * 16; if (row >= MV) continue;
                    const pg8::f32x4 v0 = acc[ai][0][m][0], v1 = acc[ai][0][m][1];
                    const f32x4 b0 = *(const f32x4*)(bf + 8 * fq), b1 = *(const f32x4*)(bf + 8 * fq + 4);
                    f32x4 r0, r1;
#pragma unroll
                    for (int e = 0; e < 4; ++e) { r0[e] = logsig_f(v0[e] + b0[e]); r1[e] = logsig_f(v1[e] + b1[e]); }
                    float* dst = row < MP ? olp + (size_t)row * 16 + 8 * fq : ols + (size_t)(row - MP) * 16 + 8 * fq;
                    *(f32x4*)dst = r0; *(f32x4*)(dst + 4) = r1;
                }
            return;
        }
        bf16_t* B = region == 0 ? QB : region == 1 ? KB : region == 2 ? VB : ZS;
#pragma unroll
        for (int ai = 0; ai < 2; ++ai)
#pragma unroll
            for (int m = 0; m < 4; ++m) {
                const int row = row0 + ai * HALF + m * 16;
#pragma unroll
                for (int bj = 0; bj < 2; ++bj) {
                    const int col = cb + bj * HALF; pg8::f32x4 v0 = acc[ai][bj][m][0], v1 = acc[ai][bj][m][1];
                    if (region == 3) {
#pragma unroll
                        for (int e = 0; e < 4; ++e) { v0[e] = silu_f(v0[e]); v1[e] = silu_f(v1[e]); }
                    }
                    u32x4 w; w.x = pk2(v0[0], v0[1]); w.y = pk2(v0[2], v0[3]); w.z = pk2(v1[0], v1[1]); w.w = pk2(v1[2], v1[3]);
                    *(u32x4*)(B + (size_t)row * 2048 + col) = w;
                    if ((region == 1 || region == 2) && row < MV) {
                        float* o = region == 1 ? (row < MP ? okp + (size_t)row * 2048 : oks + (size_t)(row - MP) * 2048) : (row < MP ? ovp + (size_t)row * 2048 : ovs + (size_t)(row - MP) * 2048);
                        *(pg8::f32x4*)(o + col) = v0; *(pg8::f32x4*)(o + col + 4) = v1;
                    }
                }
            }
    }
};
struct EpiT {
    static constexpr bool PERM = true, AFTER_DRAIN = false;
    bf16_t* O; int ldc;
    __device__ __forceinline__ void operator()(const pg8::f32x4 (&acc)[2][2][4][2], const Unit& u, int wr, int wc, int fr_, int fq_) const {
        const int lane_ = otid() & 63, fr = lane_ & 15, fq = lane_ >> 4; (void)fr_; (void)fq_;
        const int row0 = u.pm * BM + wr * 64 + fr, col0 = u.pn * BM + wc * 32 + 8 * fq;
#pragma unroll
        for (int ai = 0; ai < 2; ++ai)
#pragma unroll
            for (int m = 0; m < 4; ++m) { bf16_t* rp = O + (size_t)(row0 + ai * HALF + m * 16) * ldc + col0;
#pragma unroll
                for (int bj = 0; bj < 2; ++bj) { const pg8::f32x4 v0 = acc[ai][bj][m][0], v1 = acc[ai][bj][m][1];
                    u32x4 w; w.x = pk2(v0[0], v0[1]); w.y = pk2(v0[2], v0[3]); w.z = pk2(v1[0], v1[1]); w.w = pk2(v1[2], v1[3]);
                    *(u32x4*)(rp + bj * HALF) = w; } }
    }
};
struct EpiF32 {
    static constexpr bool PERM = true, AFTER_DRAIN = false;
    float* O; int ldc;
    __device__ __forceinline__ void operator()(const pg8::f32x4 (&acc)[2][2][4][2], const Unit& u, int wr, int wc, int fr_, int fq_) const {
        const int lane_ = otid() & 63, fr = lane_ & 15, fq = lane_ >> 4; (void)fr_; (void)fq_;
        const int row0 = u.pm * BM + wr * 64 + fr, col0 = u.pn * BM + wc * 32 + 8 * fq;
#pragma unroll
        for (int ai = 0; ai < 2; ++ai)
#pragma unroll
            for (int m = 0; m < 4; ++m) { float* rp = O + (size_t)(row0 + ai * HALF + m * 16) * ldc + col0;
#pragma unroll
                for (int bj = 0; bj < 2; ++bj) { *(pg8::f32x4*)(rp + bj * HALF) = acc[ai][bj][m][0]; *(pg8::f32x4*)(rp + bj * HALF + 4) = acc[ai][bj][m][1]; } }
    }
};
struct EpiPart {
    static constexpr bool PERM = true, AFTER_DRAIN = false;
    float* P;
    __device__ __forceinline__ void operator()(const pg8::f32x4 (&acc)[2][2][4][2], const Unit& u, int wr, int wc, int fr_, int fq_) const {
        const int lane_ = otid() & 63, fr = lane_ & 15, fq = lane_ >> 4; (void)fr_; (void)fq_;
        const int row0 = wr * 64 + fr, col0 = u.pn * BM + wc * 32 + 8 * fq; float* base = P + (size_t)(u.ko >> 8) * 256 * 1024;
#pragma unroll
        for (int ai = 0; ai < 2; ++ai)
#pragma unroll
            for (int m = 0; m < 4; ++m) { float* rp = base + (size_t)(row0 + ai * HALF + m * 16) * 1024 + col0;
#pragma unroll
                for (int bj = 0; bj < 2; ++bj) { *(pg8::f32x4*)(rp + bj * HALF) = acc[ai][bj][m][0]; *(pg8::f32x4*)(rp + bj * HALF + 4) = acc[ai][bj][m][1]; } }
    }
};
struct SplitOrder {
    int nsplit, c;
    __device__ bool next(int i, Unit& u) const { if (i != 0 || c >= 4 * nsplit) return false; u.pm = 128; u.pn = c & 3; u.ko = (c >> 2) * 256; return true; }
    __device__ __forceinline__ void a_ready(const Unit&) const {}
    __device__ __forceinline__ void done(const Unit&) const {}
};
struct EpiGate {
    static constexpr bool PERM = true, AFTER_DRAIN = false;
    const bf16_t* XB; float* Xo; const bf16_t* T; int f32out;
    __device__ __forceinline__ void operator()(const pg8::f32x4 (&acc)[2][2][4][2], const Unit& u, int wr, int wc, int fr_, int fq_) const {
        const int lane_ = otid() & 63, fr = lane_ & 15, fq = lane_ >> 4; (void)fr_; (void)fq_;
        const int row0 = u.pm * BM + wr * 64 + fr, col0 = u.pn * BM + wc * 32 + 8 * fq;
#pragma unroll
        for (int ai = 0; ai < 2; ++ai)
#pragma unroll
            for (int m = 0; m < 4; ++m) { const int row = row0 + ai * HALF + m * 16; if (row >= MV) continue;
#pragma unroll
                for (int bj = 0; bj < 2; ++bj) { const size_t off = (size_t)row * DM + col0 + bj * HALF;
                    const u32x4 t = *(const u32x4*)(T + off); const u32x4 xb = *(const u32x4*)(XB + off);
                    pg8::f32x4 x0 = {bflo(xb.x), bfhi(xb.x), bflo(xb.y), bfhi(xb.y)}, x1 = {bflo(xb.z), bfhi(xb.z), bflo(xb.w), bfhi(xb.w)};
                    const pg8::f32x4 a0 = acc[ai][bj][m][0], a1 = acc[ai][bj][m][1];
                    x0[0] += sigm_f(a0[0]) * bflo(t.x); x0[1] += sigm_f(a0[1]) * bfhi(t.x); x0[2] += sigm_f(a0[2]) * bflo(t.y); x0[3] += sigm_f(a0[3]) * bfhi(t.y);
                    x1[0] += sigm_f(a1[0]) * bflo(t.z); x1[1] += sigm_f(a1[1]) * bfhi(t.z); x1[2] += sigm_f(a1[2]) * bflo(t.w); x1[3] += sigm_f(a1[3]) * bfhi(t.w);
                    if (f32out) { *(pg8::f32x4*)(Xo + off) = x0; *(pg8::f32x4*)(Xo + off + 4) = x1; }
                    else { u32x4 w; w.x = pk2(x0[0], x0[1]); w.y = pk2(x0[2], x0[3]); w.z = pk2(x1[0], x1[1]); w.w = pk2(x1[2], x1[3]); *(u32x4*)((bf16_t*)Xo + off) = w; } } }
    }
};

__device__ __forceinline__ void cvt_wt(const float* __restrict__ W, bf16_t* __restrict__ Wt, int K, int N, int Npad, float* tile  ) {
    const int tid = otid(), ntn = Npad / 64, nt = ntn * (K / 64);
    const int kk0 = tid >> 4, n4 = (tid & 15) * 4;
    int t = blockIdx.x; if (t >= nt) return;
    f32x4 pre[2];
#define CVT_LOAD(t_) do { const int n0_ = ((t_) % ntn) * 64, k0_ = ((t_) / ntn) * 64; _Pragma("unroll") for (int i = 0; i < 2; ++i) { \
        pre[i] = (f32x4){0.f, 0.f, 0.f, 0.f}; if (n0_ + n4 < N) pre[i] = *(const f32x4*)(W + (size_t)(k0_ + kk0 + 32 * i) * N + n0_ + n4); } } while (0)
    CVT_LOAD(t);
    for (;;) {
        const int n0 = (t % ntn) * 64, k0 = (t / ntn) * 64;
#pragma unroll
        for (int i = 0; i < 2; ++i) { const int kk = kk0 + 32 * i; tile[kk * 65 + n4] = pre[i][0]; tile[kk * 65 + n4 + 1] = pre[i][1]; tile[kk * 65 + n4 + 2] = pre[i][2]; tile[kk * 65 + n4 + 3] = pre[i][3]; }
        __syncthreads();
        const int tn = t + (int)gridDim.x; const bool more = tn < nt;
        if (more) CVT_LOAD(tn);
        { const int nn = tid >> 3, k8 = (tid & 7) * 8; u32x4 w;
          w.x = pk2(tile[(k8 + 0) * 65 + nn], tile[(k8 + 1) * 65 + nn]); w.y = pk2(tile[(k8 + 2) * 65 + nn], tile[(k8 + 3) * 65 + nn]);
          w.z = pk2(tile[(k8 + 4) * 65 + nn], tile[(k8 + 5) * 65 + nn]); w.w = pk2(tile[(k8 + 6) * 65 + nn], tile[(k8 + 7) * 65 + nn]);
          *(u32x4*)(Wt + (size_t)(n0 + nn) * K + k0 + k8) = w; }
        __syncthreads();
        if (!more) break;
        t = tn;
    }
#undef CVT_LOAD
}
__device__ __forceinline__ void prologue(const Args& a, float* tile) {
    unsigned char* ws = a.p->ws;
    for (int j = 0; j < 2; ++j) {
        cvt_wt(a.p->in[9] + (size_t)j * 1024 * 6144, (bf16_t*)(ws + WS_WGIN) + (size_t)j * 6144 * 1024, 1024, 6144, 6144, tile);
        cvt_wt(a.p->in[14] + (size_t)j * 2048 * 1024, (bf16_t*)(ws + WS_WGOUT) + (size_t)j * 1024 * 2048, 2048, 1024, 1024, tile);
        cvt_wt(a.p->in[15] + (size_t)j * 1024 * 8208, (bf16_t*)(ws + WS_WFIN) + (size_t)j * NFIN * 1024, 1024, 8208, NFIN, tile);
        cvt_wt(a.p->in[17] + (size_t)j * 2048 * 1024, (bf16_t*)(ws + WS_WFOUT) + (size_t)j * 1024 * 2048, 2048, 1024, 1024, tile);
    }
    for (int i = 0; i < 4; ++i) {
        cvt_wt(a.p->in[18] + (size_t)i * 256 * 1024, (bf16_t*)(ws + WS_WPP) + (size_t)i * 1024 * 256, 256, 1024, 1024, tile);
        cvt_wt(a.p->in[19] + (size_t)i * 1024 * 1024, (bf16_t*)(ws + WS_WPG) + (size_t)i * 1024 * 1024, 1024, 1024, 1024, tile);
    }
    const float* wsrc = a.p->in[12]; bf16_t* wm = (bf16_t*)(ws + WS_WM); bf16_t* wms = (bf16_t*)(ws + WS_WMS);
    for (int idx = blockIdx.x * 512 + otid(); idx < 2 * 16 * 128 * 128; idx += gridDim.x * 512) {
        const int jj = idx & 127, i = (idx >> 7) & 127, lg = idx >> 14;
        const float w = wsrc[idx]; wm[idx] = (bf16_t)f2bf((jj >> 6) <= (i >> 6) ? w : 0.f);
        const float w2 = wsrc[((size_t)lg * 128 + (i & 15)) * 128 + (jj & 15)]; wms[idx] = (bf16_t)f2bf((i >> 4) == (jj >> 4) ? w2 : 0.f);
    }
}

__device__ __forceinline__ void phase_e1(const Args& a, int layer) {
    const int tid = otid(), lane = tid & 63, gw = blockIdx.x * 8 + (tid >> 6), nw = gridDim.x * 8;
    float* X = a.p->out; bf16_t* X16 = (bf16_t*)a.p->out; bf16_t* HX = (bf16_t*)(a.p->ws + WS_HX); bf16_t* PB = (bf16_t*)(a.p->ws + WS_PB);
    const float* g = a.p->in[7] + (layer & 3) * DM;
    f32x4 gv[4];
#pragma unroll
    for (int q = 0; q < 4; ++q) gv[q] = *(const f32x4*)(g + q * 256 + lane * 4);
#define E1_LOAD(v, r) do { if (layer == 0) { _Pragma("unroll") for (int q = 0; q < 4; ++q) v[q] = *(const f32x4*)(a.p->in[0] + (size_t)(r) * DM + q * 256 + lane * 4); } \
        else { _Pragma("unroll") for (int q = 0; q < 4; ++q) { const u32x2 xb = *(const u32x2*)(X16 + (size_t)(r) * DM + q * 256 + lane * 4); v[q] = (f32x4){bflo(xb.x), bfhi(xb.x), bflo(xb.y), bfhi(xb.y)}; } } } while (0)
#define E1_FIN(v, r, p) do { float ss = 0.f; _Pragma("unroll") for (int q = 0; q < 4; ++q) ss += v[q][0] * v[q][0] + v[q][1] * v[q][1] + v[q][2] * v[q][2] + v[q][3] * v[q][3]; \
        ss = wave_sum(ss); const float rr = rsqrtf(ss * (1.f / DM) + RMS_EPS); \
        _Pragma("unroll") for (int q = 0; q < 4; ++q) { u32x2 hw; hw.x = pk2(v[q][0] * rr * gv[q][0], v[q][1] * rr * gv[q][1]); hw.y = pk2(v[q][2] * rr * gv[q][2], v[q][3] * rr * gv[q][3]); \
            *(u32x2*)(HX + (size_t)(r) * DM + q * 256 + lane * 4) = hw; } \
        u32x2 pw; pw.x = pk2(p[0], p[1]); pw.y = pk2(p[2], p[3]); *(u32x2*)(PB + (size_t)(r) * 256 + lane * 4) = pw; } while (0)
    if (layer < 4) {
        const float* pp = a.p->in[5] + (size_t)layer * MP * 256;
        for (int row = gw; row < MP; row += 4 * nw) {
            const int r1 = row + nw, r2 = row + 2 * nw, r3 = row + 3 * nw; const bool has1 = r1 < MP, has2 = r2 < MP, has3 = r3 < MP;
            f32x4 v0[4], v1[4], v2[4], v3[4]; f32x4 p0, p1 = {0.f, 0.f, 0.f, 0.f}, p2 = p1, p3 = p1;
            E1_LOAD(v0, row); p0 = *(const f32x4*)(pp + (size_t)row * 256 + lane * 4);
            if (has1) { E1_LOAD(v1, r1); p1 = *(const f32x4*)(pp + (size_t)r1 * 256 + lane * 4); }
            if (has2) { E1_LOAD(v2, r2); p2 = *(const f32x4*)(pp + (size_t)r2 * 256 + lane * 4); }
            if (has3) { E1_LOAD(v3, r3); p3 = *(const f32x4*)(pp + (size_t)r3 * 256 + lane * 4); }
            E1_FIN(v0, row, p0);
            if (has1) E1_FIN(v1, r1, p1);
            if (has2) E1_FIN(v2, r2, p2);
            if (has3) E1_FIN(v3, r3, p3);
        }
    }
    for (int row = MP + gw; row < (layer == 4 ? MV : MA); row += nw) {
        if (row < MV) {
            f32x4 v[4];
            if (layer > 0) {
                const bf16_t* TBp = (const bf16_t*)(a.p->ws + WS_TB);
#pragma unroll
                for (int q = 0; q < 4; ++q) { const size_t off = (size_t)row * DM + q * 256 + lane * 4; const float* pq = (const float*)(a.p->ws + WS_PART) + (size_t)(row - MP) * 1024 + q * 256 + lane * 4;
                    f32x4 g4 = *(const f32x4*)pq;
#pragma unroll
                    for (int ks = 1; ks < 4; ++ks) g4 += *(const f32x4*)(pq + (size_t)ks * 256 * 1024);
                    const u32x2 xb = *(const u32x2*)(HX + off), tb = *(const u32x2*)(TBp + off);
                    v[q] = (f32x4){bflo(xb.x) + sigm_f(g4[0]) * bflo(tb.x), bfhi(xb.x) + sigm_f(g4[1]) * bfhi(tb.x), bflo(xb.y) + sigm_f(g4[2]) * bflo(tb.y), bfhi(xb.y) + sigm_f(g4[3]) * bfhi(tb.y)};
                    if (layer == 4) *(f32x4*)(X + off) = v[q]; else { u32x2 w; w.x = pk2(v[q][0], v[q][1]); w.y = pk2(v[q][2], v[q][3]); *(u32x2*)(X16 + off) = w; } }
                if (layer == 4) continue;
            } else {
#pragma unroll
                for (int q = 0; q < 4; ++q) v[q] = *(const f32x4*)(a.p->in[1] + (size_t)(row - MP) * DM + q * 256 + lane * 4);
            }
            const f32x4 p = *(const f32x4*)(a.p->in[6] + ((size_t)layer * MS + (row - MP)) * 256 + lane * 4);
            E1_FIN(v, row, p);
        } else {
#pragma unroll
            for (int q = 0; q < 4; ++q) *(u32x2*)(HX + (size_t)row * DM + q * 256 + lane * 4) = (u32x2){0u, 0u};
            *(u32x2*)(PB + (size_t)row * 256 + lane * 4) = (u32x2){0u, 0u};
        }
    }
#undef E1_LOAD
#undef E1_FIN
}
__device__ __forceinline__ void phase_e3(const Args& a, int layer, bool dummy = false) {
    const int tid = otid(), lane = tid & 63, gw = blockIdx.x * 8 + (tid >> 6), nw = gridDim.x * 8;
    const bf16_t* X16 = (const bf16_t*)a.p->out; bf16_t* HX = (bf16_t*)(a.p->ws + (dummy ? WS_DUMMY + 136 * MiB : WS_HX)); const bf16_t* OP = (const bf16_t*)(a.p->ws + WS_R0 + RSZ);
    const float* g = a.p->in[8] + layer * DM;
    f32x4 gv[4];
#pragma unroll
    for (int q = 0; q < 4; ++q) gv[q] = *(const f32x4*)(g + q * 256 + lane * 4);
#define E3_LOADX(XX, r, src0) do { if (layer == 0) { _Pragma("unroll") for (int q = 0; q < 4; ++q) XX[q] = *(const f32x4*)((src0) + q * 256 + lane * 4); } \
        else { _Pragma("unroll") for (int q = 0; q < 4; ++q) { const u32x2 xb = *(const u32x2*)(X16 + (size_t)(r) * DM + q * 256 + lane * 4); XX[q] = (f32x4){bflo(xb.x), bfhi(xb.x), bflo(xb.y), bfhi(xb.y)}; } } } while (0)
#define E3_FIN(v, XX, r) do { float ss = 0.f; _Pragma("unroll") for (int q = 0; q < 4; ++q) ss += v[q][0] * v[q][0] + v[q][1] * v[q][1] + v[q][2] * v[q][2] + v[q][3] * v[q][3]; \
        ss = wave_sum(ss); const float rr = rsqrtf(ss * (1.f / DM) + RMS_EPS); \
        _Pragma("unroll") for (int q = 0; q < 4; ++q) { u32x2 hw; hw.x = pk2(XX[q][0] + v[q][0] * rr * gv[q][0], XX[q][1] + v[q][1] * rr * gv[q][1]); hw.y = pk2(XX[q][2] + v[q][2] * rr * gv[q][2], XX[q][3] + v[q][3] * rr * gv[q][3]); \
            *(u32x2*)(HX + (size_t)(r) * DM + q * 256 + lane * 4) = hw; } } while (0)
#define E3_LOADOP(v, r) do { _Pragma("unroll") for (int q = 0; q < 4; ++q) { const u32x2 ob = *(const u32x2*)(OP + (size_t)(r) * DM + q * 256 + lane * 4); v[q] = (f32x4){bflo(ob.x), bfhi(ob.x), bflo(ob.y), bfhi(ob.y)}; } } while (0)
    for (int row = gw; row < MP; row += 4 * nw) {
        const int r1 = row + nw, r2 = row + 2 * nw, r3 = row + 3 * nw; const bool has1 = r1 < MP, has2 = r2 < MP, has3 = r3 < MP;
        f32x4 v0[4], x0[4], v1[4], x1[4], v2[4], x2[4], v3[4], x3[4];
        E3_LOADOP(v0, row); E3_LOADX(x0, row, a.p->in[0] + (size_t)row * DM);
        if (has1) { E3_LOADOP(v1, r1); E3_LOADX(x1, r1, a.p->in[0] + (size_t)r1 * DM); }
        if (has2) { E3_LOADOP(v2, r2); E3_LOADX(x2, r2, a.p->in[0] + (size_t)r2 * DM); }
        if (has3) { E3_LOADOP(v3, r3); E3_LOADX(x3, r3, a.p->in[0] + (size_t)r3 * DM); }
        E3_FIN(v0, x0, row);
        if (has1) E3_FIN(v1, x1, r1);
        if (has2) E3_FIN(v2, x2, r2);
        if (has3) E3_FIN(v3, x3, r3);
    }
    for (int row = MP + gw; row < MA; row += nw) {
        if (row < MV) {
            f32x4 v[4], x[4];
#pragma unroll
            for (int q = 0; q < 4; ++q) { const float* pq = (const float*)(a.p->ws + WS_PART) + (size_t)(row - MP) * 1024 + q * 256 + lane * 4; v[q] = *(const f32x4*)pq;
#pragma unroll
                for (int ks = 1; ks < 8; ++ks) v[q] += *(const f32x4*)(pq + (size_t)ks * 256 * 1024); }
            E3_LOADX(x, row, a.p->in[1] + (size_t)(row - MP) * DM);
            E3_FIN(v, x, row);
        } else {
#pragma unroll
            for (int q = 0; q < 4; ++q) *(u32x2*)(HX + (size_t)row * DM + q * 256 + lane * 4) = (u32x2){0u, 0u};
        }
    }
#undef E3_LOADX
#undef E3_FIN
#undef E3_LOADOP
}

__device__ __forceinline__ void phase_s1(const Args& a, int j, unsigned char* lds, bool dummy = false) {
    constexpr int LP = 136;
    bf16_t* As = (bf16_t*)lds; bf16_t* Bs = As + 128 * LP; float* fl = (float*)(Bs + 128 * LP);
    float* mu = fl, * rs = fl + 128, * t1 = fl + 256, * t2 = fl + 384;
    const int tid = otid(), lane = tid & 63, wid = tid >> 6, fr = lane & 15, fq = lane >> 4;
    const bf16_t* U = (const bf16_t*)(a.p->ws + WS_R0); bf16_t* Uo = (bf16_t*)(a.p->ws + (dummy ? WS_DUMMY : WS_R0)); const bf16_t* VT = (const bf16_t*)(a.p->ws + WS_R0 + RSZ); const bf16_t* ZS = (const bf16_t*)(a.p->ws + WS_R0 + 2 * RSZ);
    const float* stat = (const float*)(a.p->ws + WS_STAT);
    const float* lng = a.p->in[10] + j * EB; const float* lnb = a.p->in[11] + j * EB; const float* bsv = a.p->in[13] + j * 16 * 128;
    float* gvs = a.p->out + O_GV + (size_t)j * MS * EB;
    constexpr int NU = 257 * 16;
    const int G_ = gridDim.x, w_ = blockIdx.x;
#define S1_UNIT(k) ((G_ == 256) ? ((k) < 16 ? w_ * 16 + (((k) + w_) & 15) :     ((k) == 16 && w_ < 16 ? 4096 + w_ : NU)) : (w_ + (k) * G_))
#define S1_LOAD_AB(u_) do { const int blk_ = (u_) >> 4, g_ = (u_) & 15; \
        const bf16_t* wsrc_ = (const bf16_t*)(a.p->ws + (blk_ == 256 ? WS_WMS : WS_WM)) + ((size_t)(j * 16 + g_) * 128) * 128; const bf16_t* vsrc_ = VT + ((size_t)blk_ * 2048 + g_ * 128) * 128; \
        const size_t eo_ = ((size_t)blk_ * 128 + (tid >> 2)) * EB + g_ * 128 + (tid & 3) * 32; \
        _Pragma("unroll") for (int q = 0; q < 4; ++q) { ar[q] = *(const u32x4*)(wsrc_ + (tid >> 2) * 128 + (tid & 3) * 32 + q * 8); br[q] = *(const u32x4*)(vsrc_ + (tid >> 2) * 128 + (tid & 3) * 32 + q * 8); \
            un_[q] = *(const u32x4*)(U + eo_ + q * 8); zn_[q] = *(const u32x4*)(ZS + eo_ + q * 8); } } while (0)
    int un = S1_UNIT(0);
    if (un >= NU) return;
    u32x4 ar[4], br[4], un_[4], zn_[4];
    S1_LOAD_AB(un);
    int prev_blk = -1;
    for (int k = 0;; ++k) {
        const int blk = un >> 4, g = un & 15, issamp = blk == 256;
        if (blk != prev_blk) {
          { const int r_ = tid >> 2, p_ = tid & 3; const float* sp = stat + (size_t)(blk * 128 + r_) * 64 + p_ * 8;
          const f32x4 s0 = *(const f32x4*)sp, s1 = *(const f32x4*)(sp + 4), q0 = *(const f32x4*)(sp + 32), q1 = *(const f32x4*)(sp + 36);
          float s = ((s0[0] + s0[1]) + (s0[2] + s0[3])) + ((s1[0] + s1[1]) + (s1[2] + s1[3])), q = ((q0[0] + q0[1]) + (q0[2] + q0[3])) + ((q1[0] + q1[1]) + (q1[2] + q1[3]));
          s += __shfl_xor(s, 1); s += __shfl_xor(s, 2); q += __shfl_xor(q, 1); q += __shfl_xor(q, 2);
          if (p_ == 0) { const float m = s * (1.f / EB); const float var = fmaxf(q * (1.f / EB) - m * m, 0.f); mu[r_] = m; rs[r_] = rsqrtf(var + LN_EPS); } }
          __syncthreads(); prev_blk = blk;
        }
        { const int i = tid >> 2, part = tid & 3; float a1 = 0.f, a2 = 0.f;
#pragma unroll
          for (int q = 0; q < 4; ++q) { const int j0 = part * 32 + q * 8; const u32x4 w = ar[q]; const unsigned ww[4] = {w.x, w.y, w.z, w.w}; float o[8];
#pragma unroll
              for (int e = 0; e < 4; ++e) { const float w0 = bflo(ww[e]), w1 = bfhi(ww[e]); const float r0 = rs[j0 + 2 * e], r1 = rs[j0 + 2 * e + 1];
                  o[2 * e] = w0 * r0; o[2 * e + 1] = w1 * r1; a1 += w0 * r0 * mu[j0 + 2 * e] + w1 * r1 * mu[j0 + 2 * e + 1]; a2 += w0 + w1; }
              u32x4 ow; ow.x = pk2(o[0], o[1]); ow.y = pk2(o[2], o[3]); ow.z = pk2(o[4], o[5]); ow.w = pk2(o[6], o[7]);
              *(u32x4*)(As + i * LP + j0) = ow; *(u32x4*)(Bs + i * LP + j0) = br[q]; }
          a1 += __shfl_xor(a1, 1); a1 += __shfl_xor(a1, 2); a2 += __shfl_xor(a2, 1); a2 += __shfl_xor(a2, 2);
          if (part == 0) { t1[i] = a1; t2[i] = a2; }
        }
        __syncthreads();
        u32x4 uu[4], zz[4];
#pragma unroll
        for (int q = 0; q < 4; ++q) { uu[q] = un_[q]; zz[q] = zn_[q]; }
        const int un_next = S1_UNIT(k + 1); const bool has_next = un_next < NU;
        if (has_next) S1_LOAD_AB(un_next);
        const int i0 = (wid >> 1) * 32, c0 = (wid & 1) * 64;
        f32x4 acc[2][4];
#pragma unroll
        for (int mt = 0; mt < 2; ++mt)
#pragma unroll
            for (int nt = 0; nt < 4; ++nt) acc[mt][nt] = (f32x4){0.f, 0.f, 0.f, 0.f};
#pragma unroll
        for (int kk = 0; kk < 4; ++kk) {
            bf16x8 af[2], bfr[4];
#pragma unroll
            for (int mt = 0; mt < 2; ++mt) af[mt] = *(const bf16x8*)(As + (i0 + mt * 16 + fr) * LP + kk * 32 + fq * 8);
#pragma unroll
            for (int nt = 0; nt < 4; ++nt) bfr[nt] = *(const bf16x8*)(Bs + (c0 + nt * 16 + fr) * LP + kk * 32 + fq * 8);
#pragma unroll
            for (int mt = 0; mt < 2; ++mt)
#pragma unroll
                for (int nt = 0; nt < 4; ++nt) acc[mt][nt] = __builtin_amdgcn_mfma_f32_16x16x32_bf16(bfr[nt], af[mt], acc[mt][nt], 0, 0, 0);
        }
        const int ei = tid >> 2, ec = (tid & 3) * 32; const size_t erow = (size_t)blk * 128 + ei;
        if (issamp) {
            for (int idx = tid; idx < 128 * 128; idx += 512) { const int c = idx & 127, i = idx >> 7; const float v = __uint_as_float((unsigned)Bs[c * LP + i] << 16);
                gvs[(size_t)i * EB + g * 128 + c] = (v - mu[i]) * rs[i] * lng[g * 128 + c] + lnb[g * 128 + c]; }
        }
        __syncthreads();
        float* S32 = (float*)lds; constexpr int SP = 132;
#pragma unroll
        for (int mt = 0; mt < 2; ++mt)
#pragma unroll
            for (int nt = 0; nt < 4; ++nt) *(f32x4*)(S32 + (i0 + mt * 16 + fr) * SP + c0 + nt * 16 + fq * 4) = acc[mt][nt];
        __syncthreads();
        { const float t1i = t1[ei], t2i = t2[ei], bi = bsv[g * 128 + (issamp ? (ei & 15) : ei)];
#pragma unroll
          for (int q = 0; q < 4; ++q) { const int cg = g * 128 + ec + q * 8;
              const f32x4 sa = *(const f32x4*)(S32 + ei * SP + ec + q * 8), sb = *(const f32x4*)(S32 + ei * SP + ec + q * 8 + 4);
              const f32x4 lga = *(const f32x4*)(lng + cg), lgb = *(const f32x4*)(lng + cg + 4), lba = *(const f32x4*)(lnb + cg), lbb = *(const f32x4*)(lnb + cg + 4);
              float s[8];
#pragma unroll
              for (int e = 0; e < 4; ++e) { s[e] = lga[e] * (sa[e] - t1i) + lba[e] * t2i + bi; s[4 + e] = lgb[e] * (sb[e] - t1i) + lbb[e] * t2i + bi; }
              const unsigned u4[4] = {uu[q].x, uu[q].y, uu[q].z, uu[q].w}, z4[4] = {zz[q].x, zz[q].y, zz[q].z, zz[q].w}; unsigned y4[4];
#pragma unroll
              for (int e = 0; e < 4; ++e) y4[e] = pk2(bflo(u4[e]) * s[2 * e] * bflo(z4[e]), bfhi(u4[e]) * s[2 * e + 1] * bfhi(z4[e]));
              *(u32x4*)(Uo + erow * EB + cg) = (u32x4){y4[0], y4[1], y4[2], y4[3]}; } }
        __syncthreads();
        if (!has_next) break;
        un = un_next;
    }
#undef S1_UNIT
#undef S1_LOAD_AB
}

__device__ __forceinline__ void phase_c1(const Args& a, int j) {
    const int tid = otid(); if ((tid >> 6) != 0) return;
    const int lane = tid & 63;
    for (int sq = blockIdx.x; sq < 256; sq += gridDim.x) {
        if (sq < 128) {
            const int b = sq >> 4, h = sq & 15; const float* src = a.p->out + O_FLP + ((size_t)j * MP + (size_t)b * SEQ) * 16 + h; float* dst = (float*)(a.p->ws + WS_CBP) + (size_t)sq * SEQ;
            float tot = 0.f; for (int s = 0; s < 64; ++s) tot += src[(size_t)(lane * 64 + s) * 16];
            float inc = tot; for (int o = 1; o < 64; o <<= 1) { const float t = __shfl_up(inc, o); if (lane >= o) inc += t; }
            float run = inc - tot;
            for (int s = 0; s < 64; ++s) { run += src[(size_t)(lane * 64 + s) * 16];
                dst[lane * 64 + (((s >> 2) & 1) * 32 + ((s >> 3) & 3) * 4 + (s & 3) + 16 * (s >> 5))] = -run * 11.313708498984761f; }
        } else {
            const int bh = sq - 128, b = bh >> 4, h = bh & 15; const float* c0 = a.p->in[4] + ((size_t)(j * 8 + b) * PAST) * 16 + h; const float* c1 = a.p->out + O_FLS + ((size_t)j * MS + b * TS) * 16 + h;
            float* dst = (float*)(a.p->ws + WS_CBS) + (size_t)bh * SKS;
            float tot = 0.f; for (int s = 0; s < 33; ++s) { const int k = lane * 33 + s; const float v = k < PAST ? c0[(size_t)k * 16] : (k < PAST + TS ? c1[(size_t)(k - PAST) * 16] : 0.f); tot += v; }
            float inc = tot; for (int o = 1; o < 64; o <<= 1) { const float t = __shfl_up(inc, o); if (lane >= o) inc += t; }
            float run = inc - tot;
            for (int s = 0; s < 33; ++s) { const int k = lane * 33 + s; const float v = k < PAST ? c0[(size_t)k * 16] : (k < PAST + TS ? c1[(size_t)(k - PAST) * 16] : 0.f); run += v; dst[k] = -run; }
        }
    }
}

__device__ __forceinline__ void sample_attn(const Args& a, int j, int bh, unsigned char* ldsb, bool dummy = false) {
    constexpr int PP = 136;
    float* wmx = (float*)ldsb;
    bf16_t* Pb = (bf16_t*)(ldsb + 1024);
    float* lfin = (float*)(ldsb + 1024 + 2 * 16 * PP * 2);
    const int tid = otid(), lane = tid & 63, wid = __builtin_amdgcn_readfirstlane(tid >> 6), fr = lane & 15, fq = lane >> 4, b = bh >> 4, h = bh & 15;
    const bf16_t* Qb = (const bf16_t*)(a.p->ws + WS_R0); const bf16_t* ZS = (const bf16_t*)(a.p->ws + WS_R0 + 3 * RSZ); bf16_t* O = (bf16_t*)(a.p->ws + (dummy ? WS_DUMMY : WS_R0));
    const float* ck = a.p->in[2] + (size_t)(j * 8 + b) * PAST * EB + h * 128; const float* cv = a.p->in[3] + (size_t)(j * 8 + b) * PAST * EB + h * 128;
    const float* nk = a.p->out + O_FKS + ((size_t)j * MS + b * TS) * EB + h * 128; const float* nv = a.p->out + O_FVS + ((size_t)j * MS + b * TS) * EB + h * 128;
    const float* cb = (const float*)(a.p->ws + WS_CBS) + (size_t)bh * SKS;
    bf16x8 qf[4];
#pragma unroll
    for (int kk = 0; kk < 4; ++kk) qf[kk] = *(const bf16x8*)(Qb + (size_t)(MP + b * TS + fr) * EB + h * 128 + kk * 32 + fq * 8);
    const int kl = 16 * wid + fr;
    float m[4], ls[4]; f32x4 oacc = {0.f, 0.f, 0.f, 0.f};
#pragma unroll
    for (int r = 0; r < 4; ++r) { m[r] = -1e30f; ls[r] = 0.f; }
    f32x4 kr[8];
#pragma unroll
    for (int q = 0; q < 8; ++q) kr[q] = *(const f32x4*)(ck + (size_t)kl * EB + (q >> 1) * 32 + fq * 8 + (q & 1) * 4);
    int buf = 0;
    for (int c = 0; c < 17; ++c) {
        float vr[32];
        if (c < 16) {
#pragma unroll
            for (int q = 0; q < 32; ++q) vr[q] = cv[(size_t)(c * 128 + (q >> 3) * 32 + fq * 8 + (q & 7)) * EB + 16 * wid + fr];
        } else {
#pragma unroll
            for (int q = 0; q < 32; ++q) { const int key = (q >> 3) * 32 + fq * 8 + (q & 7); vr[q] = key < TS ? nv[(size_t)key * EB + 16 * wid + fr] : 0.f; }
        }
        const float bias = c < 16 ? cb[c * 128 + kl] : (kl < TS ? cb[PAST + kl] : 0.f);
        f32x4 sacc = {0.f, 0.f, 0.f, 0.f};
#pragma unroll
        for (int kk = 0; kk < 4; ++kk) { const f32x4 x0 = kr[2 * kk], x1 = kr[2 * kk + 1];
            u32x4 w; w.x = pk2(x0[0], x0[1]); w.y = pk2(x0[2], x0[3]); w.z = pk2(x1[0], x1[1]); w.w = pk2(x1[2], x1[3]);
            sacc = __builtin_amdgcn_mfma_f32_16x16x32_bf16(qf[kk], __builtin_bit_cast(bf16x8, w), sacc, 0, 0, 0); }
        if (c + 1 < 16) {
#pragma unroll
            for (int q = 0; q < 8; ++q) kr[q] = *(const f32x4*)(ck + (size_t)((c + 1) * 128 + kl) * EB + (q >> 1) * 32 + fq * 8 + (q & 1) * 4);
        } else if (c + 1 == 16) {
#pragma unroll
            for (int q = 0; q < 8; ++q) kr[q] = kl < TS ? *(const f32x4*)(nk + (size_t)kl * EB + (q >> 1) * 32 + fq * 8 + (q & 1) * 4) : (f32x4){0.f, 0.f, 0.f, 0.f};
        }
        float s[4], mw[4];
#pragma unroll
        for (int r = 0; r < 4; ++r) { s[r] = sacc[r] * att::SCALE + bias; if (c == 16 && (kl >= TS || kl > 4 * fq + r)) s[r] = -__builtin_inff(); mw[r] = s[r]; }
#pragma unroll
        for (int o = 1; o < 16; o <<= 1) {
#pragma unroll
            for (int r = 0; r < 4; ++r) mw[r] = fmaxf(mw[r], __shfl_xor(mw[r], o)); }
        if (fr == 0) {
#pragma unroll
            for (int r = 0; r < 4; ++r) wmx[buf * 128 + (4 * fq + r) * 8 + wid] = mw[r]; }
        __syncthreads();
        float p[4];
#pragma unroll
        for (int r = 0; r < 4; ++r) { const f32x4 w0 = *(const f32x4*)(wmx + buf * 128 + (4 * fq + r) * 8), w1 = *(const f32x4*)(wmx + buf * 128 + (4 * fq + r) * 8 + 4);
            const float mc = fmaxf(fmaxf(fmaxf(w0[0], w0[1]), fmaxf(w0[2], w0[3])), fmaxf(fmaxf(w1[0], w1[1]), fmaxf(w1[2], w1[3])));
            const float mn = fmaxf(m[r], mc), al = __expf(m[r] - mn); m[r] = mn; p[r] = __expf(s[r] - mn); ls[r] = ls[r] * al + p[r]; oacc[r] *= al;
            Pb[buf * 16 * PP + (4 * fq + r) * PP + kl] = (bf16_t)f2bf(p[r]); }
        __syncthreads();
#pragma unroll
        for (int kk = 0; kk < 4; ++kk) { const bf16x8 pa = *(const bf16x8*)(Pb + buf * 16 * PP + fr * PP + kk * 32 + fq * 8);
            u32x4 w; w.x = pk2(vr[kk * 8 + 0], vr[kk * 8 + 1]); w.y = pk2(vr[kk * 8 + 2], vr[kk * 8 + 3]); w.z = pk2(vr[kk * 8 + 4], vr[kk * 8 + 5]); w.w = pk2(vr[kk * 8 + 6], vr[kk * 8 + 7]);
            oacc = __builtin_amdgcn_mfma_f32_16x16x32_bf16(pa, __builtin_bit_cast(bf16x8, w), oacc, 0, 0, 0); }
        buf ^= 1;
    }
#pragma unroll
    for (int o = 1; o < 16; o <<= 1) {
#pragma unroll
        for (int r = 0; r < 4; ++r) ls[r] += __shfl_xor(ls[r], o); }
    if (fr == 0) {
#pragma unroll
        for (int r = 0; r < 4; ++r) lfin[wid * 16 + 4 * fq + r] = ls[r]; }
    __syncthreads();
#pragma unroll
    for (int r = 0; r < 4; ++r) { const int i = 4 * fq + r; float l = 0.f;
#pragma unroll
        for (int w = 0; w < 8; ++w) l += lfin[w * 16 + i];
        const size_t off = (size_t)(MP + b * TS + i) * EB + h * 128 + 16 * wid + fr;
        const float z = __uint_as_float((unsigned)ZS[off] << 16); O[off] = (bf16_t)f2bf(oacc[r] / l * z); }
    __syncthreads();
}

__device__ __forceinline__ void phase_attn(const Args& a, int j, unsigned char* ldsb, int mode = 0) {
    using namespace att;
    typedef __hip_bfloat16 T;
    const T* Q = (const T*)(a.p->ws + WS_R0); const T* K = (const T*)(a.p->ws + WS_R0 + RSZ); const T* V = (const T*)(a.p->ws + WS_R0 + 2 * RSZ); const T* Z = (const T*)(a.p->ws + WS_R0 + 3 * RSZ); T* O = (T*)(a.p->ws + (mode == 1 ? WS_DUMMY : WS_R0));
    const float* CB = (const float*)(a.p->ws + WS_CBP);
    char* lds = (char*)ldsb;
    constexpr int nqb = SEQ / QB, nx = nqb / 2, total = nx * NBH;
    const int stride = gridDim.x;
    int L = (gridDim.x == 256) ? (int)((blockIdx.x & 7) * 32 + (blockIdx.x >> 3)) : (int)blockIdx.x;
    if (mode == 2) L = total;
    if (L < total) {
#define MKREF(r, L_, pass_) do { const int bh_ = (L_) / nx, x_ = (L_) - bh_ * nx, qb_ = (pass_) ? x_ : nqb - 1 - x_,     b_ = bh_ >> 4, h_ = bh_ & 15; \
        const size_t ro_ = ((size_t)b_ * SEQ + (size_t)qb_ * QB) * PITCH + h_ * 128, ko_ = ((size_t)b_ * SEQ) * PITCH + h_ * 128; \
        (r).Q = Q + ro_; (r).O = O + ro_; (r).Z = Z + ro_; (r).K = K + ko_; (r).V = V + ko_; (r).CB = CB + (size_t)bh_ * SEQ; (r).P0 = qb_ * QB; } while (0)
        BlockRef<T, T> cur, nxt; int pass = 0;
        MKREF(cur, L, 0);
        Seam<T> S;
        causal_swa_prime<T, T>(cur, SEQ, lds, S);
        for (;;) {
            const bool more_pass = pass == 0, more_item = L + stride < total, last = !more_pass && !more_item;
            int passn = pass + 1, Ln = L;
            if (!more_pass) { passn = 0; Ln = more_item ? L + stride : L; }
            if (last) nxt = cur; else MKREF(nxt, Ln, passn);
            causal_swa_block<T, T>(cur, nxt, SEQ, SEQ, lds, S);
            if (last) break;
            cur = nxt; pass = passn; L = Ln;
        }
#undef MKREF
    }
    __syncthreads();
    if (mode != 1) for (int bh = (int)gridDim.x - 1 - (int)blockIdx.x; bh < NBH; bh += gridDim.x) sample_attn(a, j, bh, ldsb, mode == 2);
}

#define XB_TMO      128
#define XB_XCNT(j)  (256  + 64 * (j))
#define XB_XSUB(j)  (1280 + 64 * (j))
#define XB_XGEN(j)  (2304 + 64 * (j))
#define XB_TOP      3328
#define XB_TOPGEN   3392
#define XCD_BAR_WORDS 3456
#define XB_SPIN_CAP (1u << 18)

__device__ __forceinline__ unsigned xb_ld(unsigned* p)              { return __hip_atomic_load(p, __ATOMIC_RELAXED, __HIP_MEMORY_SCOPE_AGENT); }
__device__ __forceinline__ unsigned xb_add(unsigned* p, unsigned v) { return __hip_atomic_fetch_add(p, v, __ATOMIC_RELAXED, __HIP_MEMORY_SCOPE_AGENT); }
__device__ __forceinline__ unsigned xb_xcc_id() { return (unsigned)__builtin_amdgcn_s_getreg((3 << 11) | 20) & 0xFu; }
#define XB_SPIN(cond, bar) do { unsigned _sp = 0; while (cond) { __builtin_amdgcn_s_sleep(1); \
    if ((++_sp & 255u) == 0u) { if (xb_ld(&(bar)[XB_TMO])) break; if (_sp > XB_SPIN_CAP) { atomicAdd(&(bar)[XB_TMO], 1u); break; } } } } while (0)

struct XcdBarrier {
    unsigned* bar; unsigned x;
    volatile LAS unsigned* st;
};

__device__ __forceinline__ XcdBarrier xcd_barrier_post(unsigned* bar, volatile LAS unsigned* st) {
    XcdBarrier b; b.bar = bar; b.x = xb_xcc_id(); b.st = st;
    if (otid() == 0) (void)xb_add(&bar[XB_XCNT(b.x)], 1u);
    return b;
}
__device__ __forceinline__ void xcd_barrier_complete(unsigned* bar, unsigned x, unsigned& nloc, unsigned& nx) {
    const unsigned G = gridDim.x * gridDim.y * gridDim.z;
    unsigned sum, cnt, mine, sp = 0u;
    for (;;) {
        sum = 0u; cnt = 0u; mine = 0u;
#pragma unroll
        for (unsigned j = 0; j < 16; ++j) { const unsigned c = xb_ld(&bar[XB_XCNT(j)]); sum += c; cnt += (c > 0u) ? 1u : 0u; mine = (j == x) ? c : mine; }
        if (sum == G) break;
        __builtin_amdgcn_s_sleep(1);
        if ((++sp & 255u) == 0u) { if (xb_ld(&bar[XB_TMO])) break; if (sp > XB_SPIN_CAP) { atomicAdd(&bar[XB_TMO], 1u); break; } }
    }
    nloc = mine > 0u ? mine : 1u; nx = cnt > 0u ? cnt : 1u;
}

__device__ __forceinline__ void xcd_barrier(const XcdBarrier& b) {
    asm volatile("s_waitcnt vmcnt(0)" ::: "memory");
    __syncthreads();
    if (otid() == 0) {
        unsigned* bar = b.bar;
        __builtin_amdgcn_s_waitcnt(0);
        unsigned nloc = b.st[0], nx = b.st[1];
        if (nloc == 0u) { xcd_barrier_complete(bar, b.x, nloc, nx); b.st[0] = nloc; b.st[1] = nx; }
        const unsigned old = xb_add(&bar[XB_XSUB(b.x)], 1u);
        const unsigned gen = old / nloc;
        if (old + 1u == (gen + 1u) * nloc) {
            __builtin_amdgcn_fence(__ATOMIC_RELEASE, "agent");
            asm volatile("s_waitcnt vmcnt(0)" ::: "memory");
            const unsigned og = xb_add(&bar[XB_TOP], 1u);
            const unsigned tg = og / nx;
            if (og + 1u == (tg + 1u) * nx) xb_add(&bar[XB_TOPGEN], 1u);
            else XB_SPIN(xb_ld(&bar[XB_TOPGEN]) == tg, bar);
            __builtin_amdgcn_fence(__ATOMIC_ACQUIRE, "agent");
            xb_add(&bar[XB_XGEN(b.x)], 1u);
            asm volatile("s_waitcnt vmcnt(0)" ::: "memory");
        } else {
            XB_SPIN(xb_ld(&bar[XB_XGEN(b.x)]) == gen, bar);
            __builtin_amdgcn_fence(__ATOMIC_ACQUIRE, "agent");
            asm volatile("s_waitcnt vmcnt(0)" ::: "memory");
        }
    }
    __syncthreads();
}
#define WSPTRS() const Args a = getargs(); unsigned char* ws = a.p->ws; (void)ws; \
    bf16_t* HX = (bf16_t*)(ws + WS_HX); bf16_t* TB = (bf16_t*)(ws + WS_TB); bf16_t* PB = (bf16_t*)(ws + WS_PB); (void)HX; (void)TB; (void)PB; \
    bf16_t* R0 = (bf16_t*)(ws + WS_R0); bf16_t* R1 = (bf16_t*)(ws + WS_R0 + RSZ); bf16_t* R2 = (bf16_t*)(ws + WS_R0 + 2 * RSZ); bf16_t* R3 = (bf16_t*)(ws + WS_R0 + 3 * RSZ); (void)R0; (void)R1; (void)R2; (void)R3;
#define XBAR_MK() XcdBarrier xb_; xb_.bar = (unsigned*)(getargs().p->ws) + 1024; xb_.x = xb_xcc_id(); xb_.st = (volatile LAS unsigned*)((LAS unsigned char*)lds + (LDS_BYTES - 64))
#if PROBE_DUP == 7
#define GSYNC() do { XBAR_MK(); xcd_barrier(xb_); xcd_barrier(xb_); } while (0)
#else
#define GSYNC() do { XBAR_MK(); xcd_barrier(xb_); } while (0)
#endif
__global__ void __launch_bounds__(512, 2) fwd_megakernel(ArgsS args_unused) {
    extern __shared__ __attribute__((aligned(16))) unsigned char lds[];
    cg::grid_group grid = cg::this_grid();
    PG8_LAS unsigned char* gl = (PG8_LAS unsigned char*)lds;
    const int G = gridDim.x, c = blockIdx.x;
    { const unsigned hw = (unsigned)__builtin_amdgcn_s_getreg((5 << 11) | 4) & 63u;
      if ((threadIdx.x & 63) == 0) ((LAS int*)((LAS unsigned char*)lds + LDS_WIDTAB))[hw] = (int)(threadIdx.x >> 6);
      if (threadIdx.x < 16) ((LAS unsigned*)((LAS unsigned char*)lds + (LDS_BYTES - 64)))[threadIdx.x] = 0u; }
    __syncthreads();
    { XBAR_MK(); (void)xcd_barrier_post(xb_.bar, xb_.st); }
#ifndef SKIP_PRO
    { const Args a = getargs(); prologue(a, (float*)lds); }
#endif
    grid.sync();
    for (int layer = 0; layer < 4; ++layer) {
        const int j = layer >> 1;
#ifndef SKIP_E1
        for (int rp_ = (PROBE_DUP == 4 ? 0 : 1); rp_ < 2; ++rp_) { const Args a = getargs(); phase_e1(a, layer); if (!rp_) GSYNC(); }
#endif
        GSYNC();
        if ((layer & 1) == 0) {
#ifndef SKIP_G1G
            { WSPTRS(); pg8::Gemm g{HX, (const bf16_t*)(ws + WS_WGIN) + (size_t)j * 6144 * 1024, MA, 6144, 1024}; pg8::StaticOrder S; S.init(MA, 6144, G, c);
              EpiGmlpIn E{R0, R1, R2, (float*)(ws + WS_STAT)};
              for (int rp_ = 0; rp_ < (PROBE_DUP == 5 ? 2 : 1); ++rp_) pg8::gemm_phase<EpiGmlpIn, pg8::StaticOrder, true, true>(gl, g, S, E); }
#endif
        } else {
#ifndef SKIP_G1F
            { WSPTRS(); pg8::Gemm g{HX, (const bf16_t*)(ws + WS_WFIN) + (size_t)j * NFIN * 1024, MA, NFIN, 1024}; pg8::StaticOrder S; S.init(MA, NFIN, G, c);
              float* out = a.p->out;
              EpiFoxIn E{R0, R1, R2, R3, out + O_FKP + (size_t)j * MP * EB, out + O_FVP + (size_t)j * MP * EB, out + O_FLP + (size_t)j * MP * 16,
                         out + O_FKS + (size_t)j * MS * EB, out + O_FVS + (size_t)j * MS * EB, out + O_FLS + (size_t)j * MS * 16, a.p->in[16] + j * 16};
              for (int rp_ = 0; rp_ < (PROBE_DUP == 5 ? 2 : 1); ++rp_) pg8::gemm_phase<EpiFoxIn, pg8::StaticOrder, true, true>(gl, g, S, E); }
#endif
        }
#ifndef SKIP_GT
        { WSPTRS(); pg8::Gemm g{PB, (const bf16_t*)(ws + WS_WPP) + (size_t)layer * 1024 * 256, MA, 1024, 256}; const int nb_ = (layer & 1) ? 0 : 24;
          pg8::StaticOrder S; S.init(MA, 1024, G - nb_, c >= nb_ ? G - 1 - c : (1 << 24));
          EpiT E{TB, 1024};
          for (int rp_ = 0; rp_ < (PROBE_DUP == 6 ? 2 : 1); ++rp_) pg8::gemm_phase<EpiT, pg8::StaticOrder, true, true>(gl, g, S, E); }
#endif
        GSYNC();
        if ((layer & 1) == 0) {
#ifndef SKIP_S1
            for (int rp_ = (PROBE_DUP == 3 ? 0 : 1); rp_ < 2; ++rp_) { const Args a = getargs(); phase_s1(a, j, lds, !rp_); if (!rp_) GSYNC(); }
#endif
        } else {
#ifndef SKIP_C1
            { const Args a = getargs(); phase_c1(a, j); }
#endif
            GSYNC();
#ifndef SKIP_ATTN
            for (int rp_ = ((PROBE_DUP == 1 || PROBE_DUP == 2) ? 0 : 1); rp_ < 2; ++rp_) { const Args a = getargs(); phase_attn(a, j, lds, rp_ ? 0 : PROBE_DUP); if (!rp_) GSYNC(); }
#endif
        }
        GSYNC();
#ifndef SKIP_G2
        { WSPTRS(); pg8::Gemm g{R0, (const bf16_t*)(ws + ((layer & 1) ? WS_WFOUT : WS_WGOUT)) + (size_t)j * 1024 * 2048, MP, 1024, 2048}; pg8::StaticOrder S; S.init(MP, 1024, G, c);
          EpiT E{R1, 1024};
          for (int rp_ = 0; rp_ < (PROBE_DUP == 6 ? 2 : 1); ++rp_) pg8::gemm_phase<EpiT, pg8::StaticOrder, true, true>(gl, g, S, E); }
#endif
        { WSPTRS(); int ksl = 256; asm volatile("" : "+s"(ksl)); pg8::Gemm g{R0, (const bf16_t*)(ws + ((layer & 1) ? WS_WFOUT : WS_WGOUT)) + (size_t)j * 1024 * 2048, MA, 1024, ksl, 2048}; SplitOrder S{8, c};
          EpiPart E{(float*)(ws + WS_PART)};
          pg8::gemm_phase<EpiPart, SplitOrder, true, true>(gl, g, S, E); }
        GSYNC();
#ifndef SKIP_E3
        for (int rp_ = (PROBE_DUP == 4 ? 0 : 1); rp_ < 2; ++rp_) { const Args a = getargs(); phase_e3(a, layer, !rp_); if (!rp_) GSYNC(); }
#endif
        GSYNC();
#ifndef SKIP_G3
        { WSPTRS(); pg8::Gemm g{HX, (const bf16_t*)(ws + WS_WPG) + (size_t)layer * 1024 * 1024, MP, 1024, 1024}; pg8::StaticOrder S; S.init(MP, 1024, G, c);
          for (int rp_ = (PROBE_DUP == 6 ? 0 : 1); rp_ < 2; ++rp_) { EpiGate E{HX, rp_ ? a.p->out : (float*)(ws + WS_DUMMY), TB, layer == 3}; pg8::gemm_phase<EpiGate, pg8::StaticOrder, true, true>(gl, g, S, E); } }
#endif
        { WSPTRS(); int ksl = 256; asm volatile("" : "+s"(ksl)); pg8::Gemm g{HX, (const bf16_t*)(ws + WS_WPG) + (size_t)layer * 1024 * 1024, MA, 1024, ksl, 1024}; SplitOrder S{4, c};
          EpiPart E{(float*)(ws + WS_PART)};
          pg8::gemm_phase<EpiPart, SplitOrder, true, true>(gl, g, S, E); }
        GSYNC();
    }
    { const Args a = getargs(); phase_e1(a, 4); }
}

extern "C" void kernel_launch(void* const* d_in, const int* in_sizes, int n_in, void* d_out, int out_size, void* d_ws, size_t ws_size, hipStream_t stream) {
    static int grid = 0;
    if (grid == 0) {
        if (n_in != 20 || ws_size < WS_END) { fprintf(stderr, "kernel_launch: need 20 inputs and >= %zu bytes of workspace; got %d, %zu\n", (size_t)WS_END, n_in, ws_size); grid = -1; return; }
        int dev = 0, cus = 0, per_cu = 0;
        (void)hipGetDevice(&dev); (void)hipDeviceGetAttribute(&cus, hipDeviceAttributeMultiprocessorCount, dev);
        if (hipFuncSetAttribute((const void*)fwd_megakernel, hipFuncAttributeMaxDynamicSharedMemorySize, LDS_BYTES) != hipSuccess) { fprintf(stderr, "kernel_launch: hipFuncSetAttribute failed\n"); grid = -1; return; }
        if (hipOccupancyMaxActiveBlocksPerMultiprocessor(&per_cu, (const void*)fwd_megakernel, 512, LDS_BYTES) != hipSuccess || per_cu < 1) { fprintf(stderr, "kernel_launch: occupancy query says %d\n", per_cu); per_cu = 1; }
        (void)hipGetLastError();
        grid = cus > 0 ? cus : 256;
    }
    if (grid < 0) return;
    if (hipMemsetAsync(d_ws, 0, 65536, stream) != hipSuccess) { fprintf(stderr, "kernel_launch: memset of the barrier words failed\n"); return; }
    ArgsS a{};
    for (int i = 0; i < 20; ++i) a.in[i] = (const float*)d_in[i];
    a.out = (float*)d_out; a.ws = (unsigned char*)d_ws;
    void* args[] = {&a};
    hipError_t e = hipLaunchCooperativeKernel((const void*)fwd_megakernel, dim3(grid), dim3(512), args, LDS_BYTES, stream);
    if (e != hipSuccess) fprintf(stderr, "cooperative launch failed: %s (grid %d)\n", hipGetErrorString(e), grid);
}
```

```cpp
#include <hip/hip_runtime.h>
#include <hip/hip_bf16.h>
#include <hip/hip_cooperative_groups.h>
#include <cstdio>
#include <cstdint>
extern __shared__ __attribute__((aligned(16))) unsigned char g_lds[];
constexpr int LDS_TOTAL = 147456, LDS_WIDTAB = LDS_TOTAL - 512;
__device__ __forceinline__ int otid() {
    const unsigned hw = (unsigned)__builtin_amdgcn_s_getreg((5 << 11) | 4) & 63u;
    int w = ((volatile __attribute__((address_space(3))) int*)((__attribute__((address_space(3))) unsigned char*)g_lds + LDS_WIDTAB))[hw];
    w = __builtin_amdgcn_readfirstlane(w);
    int l; asm volatile("v_mbcnt_lo_u32_b32 %0, -1, 0" : "=v"(l)); asm volatile("v_mbcnt_hi_u32_b32 %0, -1, %0" : "+v"(l));
    return w * 64 + l;
}
namespace pg8 {
#define PG8_LAS __attribute__((address_space(3)))
typedef unsigned short bf16_t;
typedef short bf16x8 __attribute__((ext_vector_type(8)));
typedef float f32x4 __attribute__((ext_vector_type(4)));
typedef unsigned u32x4 __attribute__((ext_vector_type(4)));
constexpr int BM = 256, BK = 64, HALF = 128, HTB = HALF * BK * 2  , STAGE_BYTES = 8 * HTB, NXCD = 8, WGM = 8;

__host__ __device__ __forceinline__ int lds_byte(int r, int c) { const int st = (r >> 4) * 2 + (c >> 5), rr = r & 15, cc = c & 31, ob = rr * 64 + cc * 2; return st * 1024 + (ob ^ (((ob >> 9) & 1) << 5)); }
__host__ __device__ __forceinline__ void stage_rc(int b, int& R, int& C) { const int st = b / 1024, sb = b % 1024, swz = sb ^ (((sb >> 9) & 1) << 5); R = (st >> 1) * 16 + swz / 64; C = (st & 1) * 32 + (swz % 64) / 2; }
__host__ __device__ __forceinline__ int perm32(int rho) { const int n = rho >> 4, i = rho & 15; return 8 * (i >> 2) + 4 * n + (i & 3); }

struct Unit { int pm, pn, ko; };
struct Gemm { const bf16_t* A; const bf16_t* Bt; int M, N, K, ldk; };

struct StaticOrder {
    int nM, nN, nwg, G, c;
    __host__ __device__ void init(int M, int N, int G_, int c_) { nM = M / BM; nN = N / BM; nwg = nM * nN; G = G_; c = c_; }
    __host__ __device__ bool next(int i, Unit& u) const {
        const long L = (long)i * G + c; if (L >= nwg) return false;
        int wgid = (int)L; { const int q = nwg / NXCD, r = nwg % NXCD, xcd = wgid % NXCD, off = wgid / NXCD; wgid = (xcd < r ? xcd * (q + 1) : r * (q + 1) + (xcd - r) * q) + off; }
        const int nig = WGM * nN, gid = wgid / nig, fm = gid * WGM, gsz = (nM - fm) < WGM ? (nM - fm) : WGM;
        u.pm = fm + ((wgid % nig) % gsz); u.pn = (wgid % nig) / gsz; u.ko = 0; return true;
    }
    __device__ __forceinline__ void a_ready(const Unit&) const {}
    __device__ __forceinline__ void done(const Unit&) const {}
};

__device__ __forceinline__ unsigned cvt_pk_bf16(float lo, float hi) { unsigned r; asm volatile("v_cvt_pk_bf16_f32 %0, %1, %2" : "=v"(r) : "v"(lo), "v"(hi)); return r; }
typedef float f32x2 __attribute__((ext_vector_type(2)));
__device__ __forceinline__ f32x2 gelu_pk(f32x2 v) {
    const f32x2 av = __builtin_elementwise_abs(v), d = av * 0.2316418882f + 1.0f;
    f32x2 t; t.x = __builtin_amdgcn_rcpf(d.x); t.y = __builtin_amdgcn_rcpf(d.y);
    f32x2 q = t * 0.5307027145f + (-0.7265760135f); q = q * t + 0.7107068705f; q = q * t + (-0.142248368f); q = q * t + 0.127414796f; q = q * t;
    const f32x2 s = (v * v) * (-0.72134752044f);
    f32x2 e; e.x = __builtin_amdgcn_exp2f(s.x); e.y = __builtin_amdgcn_exp2f(s.y);
    const f32x2 m = v * (q * e), r = v - m;
    f32x2 o; o.x = v.x < 0.f ? m.x : r.x; o.y = v.y < 0.f ? m.y : r.y; return o;
}

template <int ACT  > struct EpiBf16 {
    static constexpr bool PERM = true, AFTER_DRAIN = false; static_assert(ACT == 0 || ACT == 1, "EpiBf16: ACT is 0 (none) or 1 (gelu_pk)");
    bf16_t* O; int ldc; const float* bias; int split_cols; size_t split_stride; float scale0;
    __device__ __forceinline__ void operator()(const f32x4 (&acc)[2][2][4][2], const Unit& u, int wr, int wc, int fr, int fq) const {
        const int row0 = u.pm * BM + wr * 64 + fr; int colt = u.pn * BM; bf16_t* base = O;
        float sc = 1.f; if (split_cols) { const int t = colt / split_cols; base += (size_t)t * split_stride; colt -= t * split_cols; if (t == 0) sc = scale0; }
        const int col0 = colt + wc * 32 + 8 * fq, bcol0 = u.pn * BM + wc * 32 + 8 * fq;
        f32x4 bv[2][2];
#pragma unroll
        for (int bj = 0; bj < 2; ++bj)
#pragma unroll
            for (int n = 0; n < 2; ++n) bv[bj][n] = bias ? *(const f32x4*)(bias + bcol0 + bj * HALF + 4 * n) : (f32x4){0.f, 0.f, 0.f, 0.f};
#pragma unroll
        for (int ai = 0; ai < 2; ++ai)
#pragma unroll
            for (int m = 0; m < 4; ++m) { bf16_t* rowp = base + (size_t)(row0 + ai * HALF + m * 16) * ldc + col0;
#pragma unroll
                for (int bj = 0; bj < 2; ++bj) { f32x4 v0 = acc[ai][bj][m][0] + bv[bj][0], v1 = acc[ai][bj][m][1] + bv[bj][1];
                    if (ACT == 1) { f32x2 a = gelu_pk((f32x2){v0[0], v0[1]}), b = gelu_pk((f32x2){v0[2], v0[3]}), c = gelu_pk((f32x2){v1[0], v1[1]}), d = gelu_pk((f32x2){v1[2], v1[3]});
                        v0 = (f32x4){a.x, a.y, b.x, b.y}; v1 = (f32x4){c.x, c.y, d.x, d.y}; }
                    v0 = v0 * sc; v1 = v1 * sc; u32x4 w; w.x = cvt_pk_bf16(v0[0], v0[1]); w.y = cvt_pk_bf16(v0[2], v0[3]); w.z = cvt_pk_bf16(v1[0], v1[1]); w.w = cvt_pk_bf16(v1[2], v1[3]);
                    *(u32x4*)(rowp + bj * HALF) = w; } }
    }
};


template <class Epi, class Sched, bool ALIGN_EPI = false, bool SP2 = false>
__device__ __forceinline__ void gemm_phase(PG8_LAS unsigned char* lds, const Gemm g, const Sched& S, const Epi& E) {
    const int tid = otid(), wid = __builtin_amdgcn_readfirstlane(tid >> 6), lane = tid & 63, wr = wid >> 2, wc = wid & 3, fr = lane & 15, fq = lane >> 4;
    const int K = g.K, nt = K / BK, LDK = g.ldk ? g.ldk : g.K;
    unsigned voffA[2], voffB[2];
#pragma unroll
    for (int i = 0; i < 2; ++i) { int R, C; stage_rc(tid * 16 + i * 8192, R, C); const int Rb = Epi::PERM ? ((R & ~31) + perm32(R & 31)) : R;
        voffA[i] = (unsigned)(R * LDK + C) * 2u; voffB[i] = (unsigned)(Rb * LDK + C) * 2u; }
    const size_t kstep = (size_t)(BK * 2);
    const size_t hstep = (size_t)HALF * LDK * 2;
    const size_t tstep = 2 * hstep;
    const unsigned ldsw = (unsigned)wid * 1024u;
    const int aoff = lds_byte(wr * 64 + fr, fq * 8), boff = lds_byte(wc * 32 + fr, fq * 8);
#define PG8_SA(b, h) (((b) * 2 + (h)) * HTB)
#define PG8_SB(b, h) ((4 + (b) * 2 + (h)) * HTB)
#define PG8_STAGE(bufoff, gbase, voff) do { _Pragma("unroll") for (int _i = 0; _i < 2; ++_i) \
        __builtin_amdgcn_global_load_lds((const unsigned*)((const char*)(gbase) + (voff)[_i]), (PG8_LAS unsigned*)(lds + (bufoff) + ldsw + _i * 8192), 16, 0, 0); } while (0)
#define PG8_LDA(dst, b, h) do { _Pragma("unroll") for (int m = 0; m < 4; ++m) _Pragma("unroll") for (int k = 0; k < 2; ++k) dst[m][k] = *(const PG8_LAS bf16x8*)(lds + PG8_SA(b, h) + aoff + m * 2048 + k * 1024); } while (0)
#define PG8_LDB(dst, b, h) do { _Pragma("unroll") for (int n = 0; n < 2; ++n) _Pragma("unroll") for (int k = 0; k < 2; ++k) dst[n][k] = *(const PG8_LAS bf16x8*)(lds + PG8_SB(b, h) + boff + n * 2048 + k * 1024); } while (0)
#define PG8_MMA(ai, bj, At, Bt) do { __builtin_amdgcn_s_setprio(1); _Pragma("unroll") for (int m = 0; m < 4; ++m) _Pragma("unroll") for (int n = 0; n < 2; ++n) _Pragma("unroll") for (int k = 0; k < 2; ++k) \
        acc[ai][bj][m][n] = __builtin_amdgcn_mfma_f32_16x16x32_bf16(Bt[n][k], At[m][k], acc[ai][bj][m][n], 0, 0, 0); __builtin_amdgcn_s_setprio(0); } while (0)
#define PG8_WAIT_V(n) asm volatile("s_waitcnt vmcnt(" #n ")" ::: "memory")
#define PG8_WAIT_L(n) asm volatile("s_waitcnt lgkmcnt(" #n ")" ::: "memory")
#define PG8_BAR __builtin_amdgcn_s_barrier()
#define PG8_SCHED __builtin_amdgcn_sched_barrier(0)
    Unit cur, nxt; int ui = 0;
    if (!S.next(0, cur)) return;
    f32x4 acc[2][2][4][2];
#pragma unroll
    for (int a = 0; a < 2; ++a)
#pragma unroll
        for (int b = 0; b < 2; ++b)
#pragma unroll
            for (int m = 0; m < 4; ++m)
#pragma unroll
                for (int n = 0; n < 2; ++n) acc[a][b][m][n] = (f32x4){0.f, 0.f, 0.f, 0.f};
    bf16x8 At[4][2], B0[2][2], B1[2][2];
    const char* cA = (const char*)g.A + (size_t)cur.pm * tstep + (size_t)cur.ko * 2; const char* cB = (const char*)g.Bt + (size_t)cur.pn * tstep + (size_t)cur.ko * 2;
    S.a_ready(cur);
    if constexpr (SP2) {
        PG8_STAGE(PG8_SB(0, 0), cB, voffB); PG8_STAGE(PG8_SB(0, 1), cB + hstep, voffB); PG8_STAGE(PG8_SA(0, 0), cA, voffA); PG8_STAGE(PG8_SA(0, 1), cA + hstep, voffA);
        if (wr == 1) PG8_BAR;
        PG8_WAIT_V(2); PG8_BAR;
        PG8_STAGE(PG8_SB(1, 0), cB + kstep, voffB); PG8_STAGE(PG8_SA(1, 0), cA + kstep, voffA); PG8_STAGE(PG8_SB(1, 1), cB + hstep + kstep, voffB);
        PG8_WAIT_V(6); PG8_BAR;
    } else {
        PG8_STAGE(PG8_SB(0, 0), cB, voffB); PG8_STAGE(PG8_SA(0, 0), cA, voffA); PG8_STAGE(PG8_SB(0, 1), cB + hstep, voffB); PG8_STAGE(PG8_SA(0, 1), cA + hstep, voffA);
        if (wr == 1) PG8_BAR;
        PG8_WAIT_V(4); PG8_BAR;
        PG8_STAGE(PG8_SB(1, 0), cB + kstep, voffB); PG8_STAGE(PG8_SA(1, 0), cA + kstep, voffA); PG8_STAGE(PG8_SB(1, 1), cB + hstep + kstep, voffB);
        PG8_WAIT_V(6); PG8_BAR;
    }
    for (;;) {
        const bool has_next = S.next(ui + 1, nxt);
        const char* nA = has_next ? (const char*)g.A + (size_t)nxt.pm * tstep + (size_t)nxt.ko * 2 : cA; const char* nB = has_next ? (const char*)g.Bt + (size_t)nxt.pn * tstep + (size_t)nxt.ko * 2 : cB;
        for (int t = 0; t < nt; t += 2) {
            const bool last = (t == nt - 2);
            const char* a1 = cA + (size_t)(t + 1) * kstep;
            const char* a2 = last ? nA : cA + (size_t)(t + 2) * kstep; const char* b2 = last ? nB : cB + (size_t)(t + 2) * kstep;
            const char* a3 = a2 + kstep; const char* b3 = b2 + kstep;
            if (last && has_next) S.a_ready(nxt);
            if constexpr (SP2) {
            PG8_LDB(B0, 0, 0); PG8_LDB(B1, 0, 1); PG8_SCHED; PG8_LDA(At, 0, 0); PG8_STAGE(PG8_SA(1, 1), a1 + hstep, voffA);
            PG8_WAIT_V(8); PG8_WAIT_L(0); PG8_BAR; PG8_MMA(0, 0, At, B0); PG8_MMA(0, 1, At, B1); PG8_BAR; PG8_SCHED;
            PG8_LDA(At, 0, 1); PG8_STAGE(PG8_SB(0, 0), b2, voffB); PG8_STAGE(PG8_SB(0, 1), b2 + hstep, voffB); PG8_STAGE(PG8_SA(0, 0), a2, voffA);
            PG8_WAIT_V(8); PG8_WAIT_L(0); PG8_BAR; PG8_MMA(1, 0, At, B0); PG8_MMA(1, 1, At, B1); PG8_BAR; PG8_SCHED;
            PG8_LDB(B0, 1, 0); PG8_LDB(B1, 1, 1); PG8_SCHED; PG8_LDA(At, 1, 0); PG8_STAGE(PG8_SA(0, 1), a2 + hstep, voffA);
            PG8_WAIT_V(8); PG8_WAIT_L(0); PG8_BAR; PG8_MMA(0, 0, At, B0); PG8_MMA(0, 1, At, B1); PG8_BAR; PG8_SCHED;
            PG8_LDA(At, 1, 1); PG8_STAGE(PG8_SB(1, 0), b3, voffB); PG8_STAGE(PG8_SB(1, 1), b3 + hstep, voffB); PG8_STAGE(PG8_SA(1, 0), a3, voffA);
            PG8_WAIT_V(8); PG8_WAIT_L(0); PG8_BAR; PG8_MMA(1, 0, At, B0); PG8_MMA(1, 1, At, B1); PG8_BAR; PG8_SCHED;
            } else {
            PG8_LDB(B0, 0, 0); PG8_SCHED; PG8_LDA(At, 0, 0); PG8_STAGE(PG8_SA(1, 1), a1 + hstep, voffA);
            PG8_WAIT_L(8); PG8_BAR; PG8_WAIT_L(0); PG8_MMA(0, 0, At, B0); PG8_BAR; PG8_SCHED;
            PG8_LDB(B1, 0, 1); PG8_STAGE(PG8_SB(0, 0), b2, voffB);
            PG8_BAR; PG8_WAIT_L(0); PG8_MMA(0, 1, At, B1); PG8_BAR;
            PG8_LDA(At, 0, 1); PG8_STAGE(PG8_SA(0, 0), a2, voffA);
            PG8_BAR; PG8_WAIT_L(0); PG8_MMA(1, 0, At, B0); PG8_BAR; PG8_SCHED;
            PG8_STAGE(PG8_SB(0, 1), b2 + hstep, voffB);
            PG8_WAIT_V(6); PG8_BAR; PG8_MMA(1, 1, At, B1); PG8_BAR;
            PG8_LDB(B0, 1, 0); PG8_SCHED; PG8_LDA(At, 1, 0); PG8_STAGE(PG8_SA(0, 1), a2 + hstep, voffA);
            PG8_WAIT_L(8); PG8_BAR; PG8_WAIT_L(0); PG8_MMA(0, 0, At, B0); PG8_BAR; PG8_SCHED;
            PG8_LDB(B1, 1, 1); PG8_STAGE(PG8_SB(1, 0), b3, voffB);
            PG8_BAR; PG8_WAIT_L(0); PG8_MMA(0, 1, At, B1); PG8_BAR;
            PG8_LDA(At, 1, 1); PG8_STAGE(PG8_SA(1, 0), a3, voffA);
            PG8_BAR; PG8_WAIT_L(0); PG8_MMA(1, 0, At, B0); PG8_BAR; PG8_SCHED;
            PG8_STAGE(PG8_SB(1, 1), b3 + hstep, voffB);
            PG8_WAIT_V(6); PG8_BAR; PG8_MMA(1, 1, At, B1); PG8_BAR;
            }
        }
        if constexpr (ALIGN_EPI) { if (wr == 0) PG8_BAR; }
        if constexpr (!Epi::AFTER_DRAIN) { E(acc, cur, wr, wc, fr, fq); S.done(cur); }
        if (!has_next) break;
#pragma unroll
        for (int a = 0; a < 2; ++a)
#pragma unroll
            for (int b = 0; b < 2; ++b)
#pragma unroll
                for (int m = 0; m < 4; ++m)
#pragma unroll
                    for (int n = 0; n < 2; ++n) acc[a][b][m][n] = (f32x4){0.f, 0.f, 0.f, 0.f};
        cur = nxt; cA = nA; cB = nB; ++ui;
        if constexpr (ALIGN_EPI) { if (wr == 1) PG8_BAR; }
    }
    PG8_WAIT_V(0);
    if constexpr (!ALIGN_EPI) { if (wr == 0) PG8_BAR; }
    PG8_BAR;
    if constexpr (Epi::AFTER_DRAIN) { E.fused(acc, cur, wr, wc, fr, fq, lds, wid, lane); S.done(cur); }
#undef PG8_SA
#undef PG8_SB
#undef PG8_STAGE
#undef PG8_LDA
#undef PG8_LDB
#undef PG8_MMA
#undef PG8_WAIT_V
#undef PG8_WAIT_L
#undef PG8_BAR
#undef PG8_SCHED
}
}
namespace att {
constexpr int D = 128, PITCH = 2048;
constexpr float THR = 8.f;
constexpr bool WSKIP = false;
constexpr float SCALE = 0.08838834764831845f;
constexpr int NW = 8, QBLK = 32, KVBLK = 64, QB = NW * QBLK;
constexpr int SHM_V = KVBLK * D * 2, SHM_K = KVBLK * D * 2;
constexpr int LDS_BYTES = 2 * SHM_V + 2 * SHM_K + NW * 64 * 4 + 512;
using bf16 = __hip_bfloat16;
typedef short bf16x8 __attribute__((ext_vector_type(8)));
typedef short s16x4 __attribute__((ext_vector_type(4)));
typedef float f32x16 __attribute__((ext_vector_type(16)));
typedef float f32x4 __attribute__((ext_vector_type(4)));
typedef unsigned u32x4 __attribute__((ext_vector_type(4)));
template <class A, class Bt> struct same_t { static constexpr bool v = false; };
template <class A> struct same_t<A, A> { static constexpr bool v = true; };

#define BPERM(k) ((((k) >> 2) & 1) * 32 + (((k) >> 3) & 3) * 4 + ((k) & 3))
#define KSWZ(row, colB) ((row) * 256 + ((colB) ^ (((row) & 7) << 4)))
#define SBAR() __builtin_amdgcn_sched_barrier(0)
__device__ __forceinline__ int v_st(int k, int c) { const int kk = (k & ~0xC) | ((k & 4) << 1) | ((k & 8) >> 1); return ((kk >> 3) * 4 + (c >> 5)) * 512 + ((kk & 7) * 32 + (c & 31)) * 2; }
__device__ __forceinline__ int v_rd_base(int lane) { return ((lane & 3) << 3) | (((lane >> 2) & 3) << 6) | (((lane >> 4) & 1) << 5) | (((lane >> 5) & 1) << 8); }
constexpr int v_rd_off(int d0, int ks, int half) { return d0 * 512 + ks * 4096 + half * 2048; }
__device__ __forceinline__ int crow(int r, int hi) { return (r & 3) + 8 * (r >> 2) + 4 * hi; }
__device__ __forceinline__ unsigned cvtpk(float lo, float hi) {
    unsigned r; asm volatile("v_cvt_pk_bf16_f32 %0, %1, %2" : "=v"(r) : "v"(lo), "v"(hi)); return r;
}
__device__ __forceinline__ bf16x8 pack8(f32x4 a, f32x4 b) {
    u32x4 w = {cvtpk(a[0], a[1]), cvtpk(a[2], a[3]), cvtpk(b[0], b[1]), cvtpk(b[2], b[3])};
    return *reinterpret_cast<bf16x8*>(&w);
}
template <class T> __device__ __forceinline__ bf16x8 load8(const T* p) {
    if constexpr (same_t<T, float>::v) { return pack8(*(const f32x4*)p, *(const f32x4*)(p + 4)); }
    else { return *reinterpret_cast<const bf16x8*>(p); }
}
__device__ __forceinline__ void mask_tile(f32x16& p0, f32x16& p1, int dq, unsigned W) {
    const float NEG = -__builtin_inff();
#pragma unroll
    for (int r = 0; r < 16; ++r) {
        const int c = (r & 3) + 8 * (r >> 2);
        if ((unsigned)(dq - c) >= W) p0[r] = NEG;
        if ((unsigned)(dq - c - 32) >= W) p1[r] = NEG;
    }
}
__device__ __forceinline__ void partialSM(f32x16& p0, f32x16& p1, float& m_reg, float& mn, float& alpha) {
    float pmax = p0[0]; for (int r = 1; r < 16; ++r) pmax = fmaxf(pmax, p0[r]); for (int r = 0; r < 16; ++r) pmax = fmaxf(pmax, p1[r]);
    { auto rr = __builtin_amdgcn_permlane32_swap(__float_as_uint(pmax), __float_as_uint(pmax), false, false);
      pmax = fmaxf(__uint_as_float(rr[0]), __uint_as_float(rr[1])); }
    constexpr float C2 = 1.4426950408889634f * SCALE;
    if (__builtin_expect(__all((pmax - m_reg) * SCALE <= THR), 1)) { mn = m_reg; alpha = 1.f; }
    else { mn = fmaxf(m_reg, pmax); alpha = __builtin_amdgcn_exp2f((m_reg - mn) * C2); m_reg = mn; }
    const float mnL = -mn * C2;
    for (int r = 0; r < 16; ++r) p0[r] = fmaf(p0[r], C2, mnL); for (int r = 0; r < 16; ++r) p1[r] = fmaf(p1[r], C2, mnL);
    for (int r = 0; r < 16; ++r) p0[r] = __builtin_amdgcn_exp2f(p0[r]);
}
__device__ __forceinline__ void finishSM(f32x16& p0, f32x16& p1, float alpha, float& l_reg, bf16x8& pa0, bf16x8& pa1, bf16x8& pa2, bf16x8& pa3) {
    for (int r = 0; r < 16; ++r) p1[r] = __builtin_amdgcn_exp2f(p1[r]);
    float ps = 0; for (int r = 0; r < 16; ++r) ps += p0[r]; for (int r = 0; r < 16; ++r) ps += p1[r];
    { auto rr = __builtin_amdgcn_permlane32_swap(__float_as_uint(ps), __float_as_uint(ps), false, false);
      ps = __uint_as_float(rr[0]) + __uint_as_float(rr[1]); }
    l_reg = l_reg * alpha + ps;
#define PK4(P, B_, OUT) do { unsigned a0 = cvtpk(P[B_+0], P[B_+1]), a1 = cvtpk(P[B_+2], P[B_+3]);                          \
        unsigned b0 = cvtpk(P[B_+4], P[B_+5]), b1 = cvtpk(P[B_+6], P[B_+7]);                                             \
        auto r0 = __builtin_amdgcn_permlane32_swap(a0, b0, false, false); auto r1 = __builtin_amdgcn_permlane32_swap(a1, b1, false, false); \
        u32x4 w = {r0[0], r1[0], r0[1], r1[1]}; OUT = *reinterpret_cast<bf16x8*>(&w); } while (0)
    PK4(p0, 0, pa0); PK4(p0, 8, pa1); PK4(p1, 0, pa2); PK4(p1, 8, pa3);
#undef PK4
}
template <int KB, bool SK>
__device__ __forceinline__ void qkt(f32x16& p0, f32x16& p1, const char* K_lds, const float* B_lds, int r32, int hi, const bf16x8* qr, bool act) {
    if (SK && !act) { const float NEG = -__builtin_inff();
#pragma unroll
        for (int r = 0; r < 16; ++r) { p0[r] = NEG; p1[r] = NEG; } return; }
#ifdef ATT_NOBIAS
    p0 = f32x16{}; p1 = f32x16{};
#else
    p0 = *(const f32x16*)(B_lds + KB * 64 + hi * 32); p1 = *(const f32x16*)(B_lds + KB * 64 + hi * 32 + 16);
#endif
    const char* kb[4];
#pragma unroll
    for (int dd = 0; dd < 4; ++dd) kb[dd] = K_lds + KB * SHM_K + KSWZ(r32, (dd * 16 + hi * 8) * 2);
#pragma unroll
    for (int d0 = 0; d0 < 8; ++d0) { const char* a = kb[d0 & 3] + (d0 >> 2) * 128;
        bf16x8 b0 = *reinterpret_cast<const bf16x8*>(a);
        bf16x8 b1 = *reinterpret_cast<const bf16x8*>(a + 32 * 256);
        p0 = __builtin_amdgcn_mfma_f32_32x32x16_bf16(b0, qr[d0], p0, 0, 0, 0);
        p1 = __builtin_amdgcn_mfma_f32_32x32x16_bf16(b1, qr[d0], p1, 0, 0, 0); }
}
template <int VB, bool SK>
__device__ __forceinline__ void pv_tile(f32x16* o, int vb0, bf16x8 pa0, bf16x8 pa1, bf16x8 pa2, bf16x8 pa3, bool act) {
    if (SK && !act) return;
#define TRRD(dst, off) asm volatile("ds_read_b64_tr_b16 %0, %1 offset:%2" : "=&v"(dst) : "v"(vb0), "i"(off) : "memory")
#define PV_D0(d0) do { s16x4 l0, l1, l2, l3, h0, h1, h2, h3; constexpr int b_ = VB * SHM_V + v_rd_off(d0, 0, 0);     \
        TRRD(l0, b_); TRRD(h0, b_ + 2048); TRRD(l1, b_ + 4096); TRRD(h1, b_ + 6144); TRRD(l2, b_ + 8192); TRRD(h2, b_ + 10240); TRRD(l3, b_ + 12288); TRRD(h3, b_ + 14336); \
        asm volatile("s_waitcnt lgkmcnt(0)" ::: "memory"); SBAR();                 \
        o[d0] = __builtin_amdgcn_mfma_f32_32x32x16_bf16(pa0, (bf16x8){l0[0], l0[1], l0[2], l0[3], h0[0], h0[1], h0[2], h0[3]}, o[d0], 0, 0, 0);   \
        o[d0] = __builtin_amdgcn_mfma_f32_32x32x16_bf16(pa1, (bf16x8){l1[0], l1[1], l1[2], l1[3], h1[0], h1[1], h1[2], h1[3]}, o[d0], 0, 0, 0);   \
        o[d0] = __builtin_amdgcn_mfma_f32_32x32x16_bf16(pa2, (bf16x8){l2[0], l2[1], l2[2], l2[3], h2[0], h2[1], h2[2], h2[3]}, o[d0], 0, 0, 0);   \
        o[d0] = __builtin_amdgcn_mfma_f32_32x32x16_bf16(pa3, (bf16x8){l3[0], l3[1], l3[2], l3[3], h3[0], h3[1], h3[2], h3[3]}, o[d0], 0, 0, 0); } while (0)
    PV_D0(0); PV_D0(1); PV_D0(2); PV_D0(3);
#undef PV_D0
#undef TRRD
}

template <class TIn, class TOut> struct BlockRef { const TIn* Q; const TIn* K; const TIn* V; TOut* O; const float* CB; const TIn* Z; int P0; };
template <class TIn> struct Seam {
    bf16x8 qr[8];
    bf16x8 st_v0, st_v1, st_k0, st_k1; float st_b0; f32x4 sf0, sf1, sf2, sf3;
    f32x4 tq[16];
};
__device__ __forceinline__ int swa_jlo(int P0, int W) { const int lowk = P0 - W + 1; return lowk > 0 ? lowk / KVBLK : 0; }
#define ROW(p, k0, rr) ((p) + (unsigned)(((k0) + (rr)) * PITCH + sc))
#define VMW() asm volatile("s_waitcnt vmcnt(0)" ::: "memory")
#define VMWN(n) asm volatile("s_waitcnt vmcnt(%0)" :: "i"(n) : "memory")
#define SLOAD_H(Kp, Vp, Cp, k0) do { S.st_b0 = (Cp)[(unsigned)((k0) + sr + 32 * (tid & 1))]; S.st_v0 = load8<TIn>(ROW(Vp, k0, sr)); S.st_v1 = load8<TIn>(ROW(Vp, k0, 32 + sr));              \
                         S.st_k0 = load8<TIn>(ROW(Kp, k0, sr)); S.st_k1 = load8<TIn>(ROW(Kp, k0, 32 + sr)); } while (0)
#define SWRITE_HK(bf) do { B_lds[(bf) * 64 + sr + 32 * (tid & 1)] = S.st_b0; *(bf16x8*)(K_lds + (bf) * SHM_K + kws) = S.st_k0; *(bf16x8*)(K_lds + (bf) * SHM_K + kws + 32 * 256) = S.st_k1; } while (0)
#define SWRITE_HV(bf) do { *(bf16x8*)(V_lds + (bf) * SHM_V + vst0) = S.st_v0; *(bf16x8*)(V_lds + (bf) * SHM_V + vst1) = S.st_v1; } while (0)
#define SWRITE_H(bf) do { SWRITE_HV(bf); SWRITE_HK(bf); } while (0)
#define SLOAD_F(p, k0) do { S.sf0 = *(const f32x4*)ROW(p, k0, sr); S.sf1 = *(const f32x4*)(ROW(p, k0, sr) + 4);                \
                            S.sf2 = *(const f32x4*)ROW(p, k0, 32 + sr); S.sf3 = *(const f32x4*)(ROW(p, k0, 32 + sr) + 4); } while (0)
#define SWRITE_KF(bf) do { *(bf16x8*)(K_lds + (bf) * SHM_K + kws) = pack8(S.sf0, S.sf1); *(bf16x8*)(K_lds + (bf) * SHM_K + kws + 32 * 256) = pack8(S.sf2, S.sf3); } while (0)
#define SWRITE_VF(bf) do { *(bf16x8*)(V_lds + (bf) * SHM_V + vst0) = pack8(S.sf0, S.sf1); *(bf16x8*)(V_lds + (bf) * SHM_V + vst1) = pack8(S.sf2, S.sf3); } while (0)
template <class TIn, class TOut>
__device__ __forceinline__ void causal_swa_prime(const BlockRef<TIn, TOut>& cur, int W, char* lds, Seam<TIn>& S) {
    constexpr bool F32 = same_t<TIn, float>::v;
    const int tid = otid(), wid = __builtin_amdgcn_readfirstlane(tid >> 6), lane = tid & 63, r32 = lane & 31, hi = lane >> 5;
    const int sr = tid >> 4, sc = (tid & 15) * 8, kws = KSWZ(sr, sc * 2); char* K_lds = lds + 2 * SHM_V; float* B_lds = (float*)(lds + 2 * SHM_V + 2 * SHM_K + NW * 64 * 4);
    const int kb0 = swa_jlo(cur.P0, W) * KVBLK;
    for (int d0 = 0; d0 < 8; ++d0) S.qr[d0] = load8<TIn>(cur.Q + (unsigned)((wid * QBLK + r32) * PITCH + d0 * 16 + hi * 8));
    if constexpr (F32) { SLOAD_F((const float*)cur.K, kb0); VMW(); SWRITE_KF(0); SBAR(); SLOAD_F((const float*)cur.V, kb0); }
    else { SLOAD_H(cur.K, cur.V, cur.CB, kb0); VMW(); SWRITE_HK(0); }
    __syncthreads();
}
template <class TIn, class TOut>
__device__ __forceinline__ void causal_swa_block(const BlockRef<TIn, TOut>& cur, const BlockRef<TIn, TOut>& nxt, int skv, int W, char* lds, Seam<TIn>& S) {
    constexpr bool F32 = same_t<TIn, float>::v;
    const int tid = otid(), wid = __builtin_amdgcn_readfirstlane(tid >> 6), lane = tid & 63, r32 = lane & 31, hi = lane >> 5;
    const int j_lo = swa_jlo(cur.P0, W);
    int j_hi = (cur.P0 + QB - 1) / KVBLK + 1; if (j_hi > skv / KVBLK) j_hi = skv / KVBLK;
    const int NT = j_hi - j_lo;
    const int kbn = swa_jlo(nxt.P0, W) * KVBLK;
    const int qlo = cur.P0 + wid * QBLK, qm = qlo + r32 - 4 * hi;
    char* V_lds = lds; char* K_lds = lds + 2 * SHM_V; float* B_lds = (float*)(lds + 2 * SHM_V + 2 * SHM_K + NW * 64 * 4);
    float* ws = (float*)(lds + 2 * SHM_V + 2 * SHM_K) + wid * 64; float* li_l = ws, * al_l = ws + 32;
    float m_reg = -1e30f, l_reg = 0; f32x16 o[4] = {};
    const int sr = tid >> 4, sc = (tid & 15) * 8, vst0 = v_st(sr, sc), vst1 = v_st(32 + sr, sc), kws = KSWZ(sr, sc * 2);
    const int vb0 = (int)(uintptr_t)V_lds + v_rd_base(lane);
    const TIn* Kh = cur.K; const TIn* Vh = cur.V; const float* Ch = cur.CB;
#define RESC(a) do { if (__any((a) < 1.f)) { if (hi == 0) al_l[r32] = (a); asm volatile("s_waitcnt lgkmcnt(0)" ::: "memory");              \
                     for (int d_ = 0; d_ < 4; ++d_) for (int r = 0; r < 16; ++r) o[d_][r] *= al_l[crow(r, hi)]; } } while (0)
#define KBASE(t) ((j_lo + (t)) * KVBLK)
#define ACT(t) (KBASE(t) <= qlo + QBLK - 1 && KBASE(t) + KVBLK - 1 >= qlo - W + 1)
#define MASKT(P0_, P1_, t) do { const int kb_ = KBASE(t); if ((!SK || ACT(t)) && (kb_ + KVBLK - 1 > qlo || kb_ <= qlo + QBLK - 1 - W)) mask_tile(P0_, P1_, qm - kb_, (unsigned)W); } while (0)
    constexpr int NQL = F32 ? 16 : 8;
    constexpr bool SK = WSKIP && !F32;
#define SEAM_K0() do { VMWN(NQL); if constexpr (F32) { SWRITE_KF(0); SBAR(); SLOAD_F((const float*)nxt.V, kbn); } else { SWRITE_HK(0); } SBAR(); } while (0)
    f32x16 pA0, pA1, pB0, pB1; float mnA, mnB, alA, alB; bf16x8 pa0, pa1, pa2, pa3;
    if constexpr (F32) { VMW(); SWRITE_VF(0); SBAR(); } else { SWRITE_HV(0); SBAR(); }
    if (NT > 1) { if constexpr (F32) SLOAD_F((const float*)Kh, KBASE(1)); else SLOAD_H(Kh, Vh, Ch, KBASE(1)); }
    SBAR(); qkt<0, SK>(pA0, pA1, K_lds, B_lds, r32, hi, S.qr, ACT(0));
    if constexpr (F32) { if (NT > 1) { VMW(); SWRITE_KF(1); SBAR(); SLOAD_F((const float*)Vh, KBASE(1)); } }
    MASKT(pA0, pA1, 0); partialSM(pA0, pA1, m_reg, mnA, alA);
    if (NT > 1) { VMW(); if constexpr (F32) { SWRITE_VF(1); SBAR(); if (NT > 2) SLOAD_F((const float*)Kh, KBASE(2)); } else SWRITE_H(1); }
    __syncthreads();
#define HALF_STEP(PX0, PX1, mnX, alX, PY0, PY1, alY, t, KB, VB, SB) do {                                                      \
        SBAR(); qkt<KB, SK>(PX0, PX1, K_lds, B_lds, r32, hi, S.qr, ACT(t));                                             \
        finishSM(PY0, PY1, alY, l_reg, pa0, pa1, pa2, pa3); SBAR();                                                           \
        if ((t) + 1 < NT) { if constexpr (F32) { VMW(); SWRITE_KF(SB); SBAR(); SLOAD_F((const float*)Vh, KBASE((t) + 1)); }  \
                            else { SLOAD_H(Kh, Vh, Ch, KBASE((t) + 1)); } SBAR(); }                                               \
        pv_tile<VB, SK>(o, vb0, pa0, pa1, pa2, pa3, ACT((t) - 1)); MASKT(PX0, PX1, (t)); partialSM(PX0, PX1, m_reg, mnX, alX);                                        \
        __syncthreads();                                                                                                      \
        if ((t) + 1 < NT) { VMW(); if constexpr (F32) { SWRITE_VF(SB); SBAR(); if ((t) + 2 < NT) SLOAD_F((const float*)Kh, KBASE((t) + 2)); } \
                            else { SWRITE_H(SB); } }                                                                          \
        RESC(alX); __syncthreads(); } while (0)
    for (int t = 1; t + 1 < NT; t += 2) {
        HALF_STEP(pB0, pB1, mnB, alB, pA0, pA1, alA, t, 1, 0, 0);
        HALF_STEP(pA0, pA1, mnA, alA, pB0, pB1, alB, t + 1, 0, 1, 1);
    }
    const bool even = (NT & 1) == 0;
    if (even) { SBAR(); qkt<1, SK>(pB0, pB1, K_lds, B_lds, r32, hi, S.qr, ACT(NT - 1)); SBAR(); }
#define QROW(e) (nxt.Q + (size_t)(wid * QBLK + r32) * PITCH + ((e) >> 1) * 16 + hi * 8 + ((e) & 1) * 4)
    if constexpr (F32) { SLOAD_F((const float*)nxt.K, kbn); SBAR();
#pragma unroll
        for (int e = 0; e < 8; ++e) S.tq[e] = *(const f32x4*)QROW(e); }
    else { SLOAD_H(nxt.K, nxt.V, nxt.CB, kbn); SBAR();
#pragma unroll
        for (int d0 = 0; d0 < 8; ++d0) S.qr[d0] = load8<TIn>(nxt.Q + (unsigned)((wid * QBLK + r32) * PITCH + d0 * 16 + hi * 8)); }
    SBAR();
    finishSM(pA0, pA1, alA, l_reg, pa0, pa1, pa2, pa3); SBAR();
    if constexpr (F32) {
#pragma unroll
        for (int e = 8; e < 16; ++e) S.tq[e] = *(const f32x4*)QROW(e); SBAR(); }
#undef QROW
    pv_tile<0, SK>(o, vb0, pa0, pa1, pa2, pa3, ACT(even ? NT - 2 : NT - 1));
    if (even) { MASKT(pB0, pB1, NT - 1); partialSM(pB0, pB1, m_reg, mnB, alB); __syncthreads(); RESC(alB);
        finishSM(pB0, pB1, alB, l_reg, pa0, pa1, pa2, pa3); SBAR(); pv_tile<1, SK>(o, vb0, pa0, pa1, pa2, pa3, ACT(NT - 1)); }
    SBAR(); SEAM_K0();
    if (hi == 0) li_l[r32] = l_reg; asm volatile("s_waitcnt lgkmcnt(0)" ::: "memory");
    float rli[16];
#pragma unroll
    for (int r = 0; r < 16; ++r) rli[r] = __builtin_amdgcn_rcpf(li_l[crow(r, hi)]);
    TOut* Ow = cur.O + (size_t)(wid * QBLK) * PITCH; const TIn* Zw = cur.Z + (size_t)(wid * QBLK) * PITCH; unsigned lo_ = (unsigned)(4 * hi) * PITCH + r32; asm volatile("" : "+v"(lo_));
#pragma unroll
    for (int r = 0; r < 16; ++r) { const int orow = crow(r, hi);
#pragma unroll
        for (int d0 = 0; d0 < 4; ++d0) { const float v = o[d0][r] * rli[r];
            if constexpr (same_t<TOut, float>::v) { Ow[(size_t)orow * PITCH + d0 * 32 + r32] = v; }
            else { const float vn = __shfl_xor(v, 1);
                   if ((r32 & 1) == 0) { const unsigned of_ = lo_ + (unsigned)(orow - 4 * hi) * PITCH + d0 * 32; const unsigned zz = *(const unsigned*)(Zw + of_);
                       *(unsigned*)(Ow + of_) = cvtpk(v * __uint_as_float(zz << 16), vn * __uint_as_float(zz & 0xffff0000u)); } } } }
    if constexpr (F32) {
#pragma unroll
        for (int d0 = 0; d0 < 8; ++d0) S.qr[d0] = pack8(S.tq[2 * d0], S.tq[2 * d0 + 1]); }
    __syncthreads();
#undef RESC
#undef KBASE
#undef ACT
#undef MASKT
#undef SEAM_K0
#undef HALF_STEP
}
#undef ROW
#undef VMW
#undef VMWN
#undef SLOAD_H
#undef SWRITE_HK
#undef SWRITE_HV
#undef SWRITE_H
#undef SLOAD_F
#undef SWRITE_KF
#undef SWRITE_VF
}

namespace cg = cooperative_groups;
#define LAS __attribute__((address_space(3)))
typedef unsigned short bf16_t;
typedef float f32x4 __attribute__((ext_vector_type(4)));
typedef float f32x2 __attribute__((ext_vector_type(2)));
typedef unsigned u32x4 __attribute__((ext_vector_type(4)));
typedef unsigned u32x2 __attribute__((ext_vector_type(2)));
typedef short bf16x8 __attribute__((ext_vector_type(8)));

constexpr int DM = 1024, EB = 2048, MP = 32768, MS = 128, MV = MP + MS  , MA = 33024  ;
constexpr int SEQ = 4096, NBH = 128, PAST = 2048, TS = 16, SKS = 2112  ;
constexpr int NFIN = 8448;
constexpr float RMS_EPS = 1e-6f, LN_EPS = 1e-5f;
constexpr size_t O_YP = 0, O_YS = 33554432, O_GV = 33685504, O_FKP = 34209792, O_FVP = 168427520, O_FLP = 302645248, O_FKS = 303693824, O_FVS = 304218112, O_FLS = 304742400;
constexpr size_t MiB = 1u << 20;
constexpr size_t WS_WGIN = 1 * MiB;
constexpr size_t WS_WGOUT = 25 * MiB;
constexpr size_t WS_WFIN = 33 * MiB;
constexpr size_t WS_WFOUT = 66 * MiB;
constexpr size_t WS_WPP = 74 * MiB;
constexpr size_t WS_WPG = 76 * MiB;
constexpr size_t WS_WM = 84 * MiB;
constexpr size_t WS_WMS = 85 * MiB;
constexpr size_t WS_PB = 88 * MiB;
constexpr size_t WS_HX = 105 * MiB;
constexpr size_t WS_TB = 170 * MiB;
constexpr size_t WS_STAT = 756 * MiB;
constexpr size_t WS_CBP = 236 * MiB;
constexpr size_t WS_CBS = 238 * MiB + 512 * 1024;
constexpr size_t WS_R0 = 240 * MiB, RSZ = 129 * MiB;
constexpr size_t WS_END = 775 * MiB;
constexpr size_t WS_PART = 766 * MiB;
constexpr size_t WS_DUMMY = 776 * MiB;
constexpr int LDS_BYTES = LDS_TOTAL;
#ifndef PROBE_DUP
#define PROBE_DUP 0
#endif

struct ArgsS { const float* in[20]; float* out; unsigned char* ws; };
typedef const __attribute__((address_space(4))) ArgsS* ArgsP;
struct Args { ArgsP p; };
__device__ __forceinline__ Args getargs() { ArgsP p = (ArgsP)__builtin_amdgcn_kernarg_segment_ptr(); asm volatile("" : "+s"(p)); Args a; a.p = p; return a; }

__device__ __forceinline__ unsigned f2bf(float f) { unsigned u = __builtin_bit_cast(unsigned, f); return (u + 0x7fffu + ((u >> 16) & 1u)) >> 16; }
__device__ __forceinline__ unsigned pk2(float lo, float hi) { return pg8::cvt_pk_bf16(lo, hi); }
__device__ __forceinline__ float bflo(unsigned u) { return __uint_as_float(u << 16); }
__device__ __forceinline__ float bfhi(unsigned u) { return __uint_as_float(u & 0xffff0000u); }
__device__ __forceinline__ float wave_sum(float v) { for (int o = 32; o > 0; o >>= 1) v += __shfl_xor(v, o); return v; }
__device__ __forceinline__ float wave_max(float v) { for (int o = 32; o > 0; o >>= 1) v = fmaxf(v, __shfl_xor(v, o)); return v; }
__device__ __forceinline__ float gelu_t(float x) { const float u = 1.5957691216057308f * (x + 0.044715f * x * x * x); return x / (1.f + __expf(-u)); }
__device__ __forceinline__ float silu_f(float x) { return x / (1.f + __expf(-x)); }
__device__ __forceinline__ float sigm_f(float x) { return 1.f / (1.f + __expf(-x)); }
__device__ __forceinline__ float logsig_f(float x) { const float e = __expf(-fabsf(x)); const float l = e < 0.03f ? e * (1.f - e * (0.5f - e * (0.33333334f - 0.25f * e))) : __logf(1.f + e); return fminf(x, 0.f) - l; }

using pg8::Unit; using pg8::HALF; using pg8::BM;
struct EpiGmlpIn {
    static constexpr bool PERM = true, AFTER_DRAIN = false;
    bf16_t* U; bf16_t* VT; bf16_t* ZS; float* stat;
    __device__ __forceinline__ void operator()(const pg8::f32x4 (&acc)[2][2][4][2], const Unit& u, int wr, int wc, int fr_, int fq_) const {
        const int lane_ = otid() & 63, fr = lane_ & 15, fq = lane_ >> 4; (void)fr_; (void)fq_;
        const int row0 = u.pm * BM + wr * 64 + fr, colt = u.pn * BM, region = colt >> 11, cb = (colt & 2047) + wc * 32 + 8 * fq;
#pragma unroll
        for (int ai = 0; ai < 2; ++ai)
#pragma unroll
            for (int m = 0; m < 4; ++m) {
                const int row = row0 + ai * HALF + m * 16; float s = 0.f, q = 0.f;
#pragma unroll
                for (int bj = 0; bj < 2; ++bj) {
                    const int col = cb + bj * HALF; const pg8::f32x4 v0 = acc[ai][bj][m][0], v1 = acc[ai][bj][m][1];
                    float x[8] = {v0[0], v0[1], v0[2], v0[3], v1[0], v1[1], v1[2], v1[3]};
                    if (region == 2) {
#pragma unroll
                        for (int e = 0; e < 8; ++e) x[e] = silu_f(x[e]);
                    } else {
#pragma unroll
                        for (int e = 0; e < 8; ++e) x[e] = gelu_t(x[e]);
                    }
                    u32x4 w; w.x = pk2(x[0], x[1]); w.y = pk2(x[2], x[3]); w.z = pk2(x[4], x[5]); w.w = pk2(x[6], x[7]);
                    if (region == 1) {
                        bf16_t* vp = VT + ((size_t)(row >> 7) * 2048 + col) * 128 + (row & 127);
                        const unsigned ww[4] = {w.x, w.y, w.z, w.w};
#pragma unroll
                        for (int e = 0; e < 4; ++e) { vp[(2 * e) * 128] = (bf16_t)(ww[e] & 0xffffu); vp[(2 * e + 1) * 128] = (bf16_t)(ww[e] >> 16);
                            const float a = bflo(ww[e]), b = bfhi(ww[e]); s += a + b; q += a * a + b * b; }
                    } else {
                        bf16_t* dst = (region == 0 ? U : ZS) + (size_t)row * 2048 + col;
                        *(u32x4*)dst = w;
                    }
                }
                if (region == 1) {
                    s += __shfl_xor(s, 16); s += __shfl_xor(s, 32); q += __shfl_xor(q, 16); q += __shfl_xor(q, 32);
                    if (fq == 0) { const int slot = ((colt & 2047) >> 6) + wc; stat[(size_t)row * 64 + slot] = s; stat[(size_t)row * 64 + 32 + slot] = q; }
                }
            }
    }
};
struct EpiFoxIn {
    static constexpr bool PERM = true, AFTER_DRAIN = false;
    bf16_t* QB; bf16_t* KB; bf16_t* VB; bf16_t* ZS; float* okp; float* ovp; float* olp; float* oks; float* ovs; float* ols; const float* bf;
    __device__ __forceinline__ void operator()(const pg8::f32x4 (&acc)[2][2][4][2], const Unit& u, int wr, int wc, int fr_, int fq_) const {
        const int lane_ = otid() & 63, fr = lane_ & 15, fq = lane_ >> 4; (void)fr_; (void)fq_;
        const int row0 = u.pm * BM + wr * 64 + fr, colt = u.pn * BM, region = colt >> 11, cb = (colt & 2047) + wc * 32 + 8 * fq;
        if (region == 4) {
            if (wc != 0 || fq >= 2) return;
#pragma unroll
            for (int ai = 0; ai < 2; ++ai)
#pragma unroll
                for (int m = 0; m < 4; ++m) {
                    const int row = row0 + ai * HALF + m * 16; if (row >= MV) continue;
                    const pg8::f32x4 v0 = acc[ai][0][m][0], v1 = acc[ai][0][m][1];
                    const f32x4 b0 = *(const f32x4*)(bf + 8 * fq), b1 = *(const f32x4*)(bf + 8 * fq + 4);
                    f32x4 r0, r1;
#pragma unroll
                    for (int e = 0; e < 4; ++e) { r0[e] = logsig_f(v0[e] + b0[e]); r1[e] = logsig_f(v1[e] + b1[e]); }
                    float* dst = row < MP ? olp + (size_t)row * 16 + 8 * fq : ols + (size_t)(row - MP) * 16 + 8 * fq;
                    *(f32x4*)dst = r0; *(f32x4*)(dst + 4) = r1;
                }
            return;
        }
        bf16_t* B = region == 0 ? QB : region == 1 ? KB : region == 2 ? VB : ZS;
#pragma unroll
        for (int ai = 0; ai < 2; ++ai)
#pragma unroll
            for (int m = 0; m < 4; ++m) {
                const int row = row0 + ai * HALF + m * 16;
#pragma unroll
                for (int bj = 0; bj < 2; ++bj) {
                    const int col = cb + bj * HALF; pg8::f32x4 v0 = acc[ai][bj][m][0], v1 = acc[ai][bj][m][1];
                    if (region == 3) {
#pragma unroll
                        for (int e = 0; e < 4; ++e) { v0[e] = silu_f(v0[e]); v1[e] = silu_f(v1[e]); }
                    }
                    u32x4 w; w.x = pk2(v0[0], v0[1]); w.y = pk2(v0[2], v0[3]); w.z = pk2(v1[0], v1[1]); w.w = pk2(v1[2], v1[3]);
                    *(u32x4*)(B + (size_t)row * 2048 + col) = w;
                    if ((region == 1 || region == 2) && row < MV) {
                        float* o = region == 1 ? (row < MP ? okp + (size_t)row * 2048 : oks + (size_t)(row - MP) * 2048) : (row < MP ? ovp + (size_t)row * 2048 : ovs + (size_t)(row - MP) * 2048);
                        *(pg8::f32x4*)(o + col) = v0; *(pg8::f32x4*)(o + col + 4) = v1;
                    }
                }
            }
    }
};
struct EpiT {
    static constexpr bool PERM = true, AFTER_DRAIN = false;
    bf16_t* O; int ldc;
    __device__ __forceinline__ void operator()(const pg8::f32x4 (&acc)[2][2][4][2], const Unit& u, int wr, int wc, int fr_, int fq_) const {
        const int lane_ = otid() & 63, fr = lane_ & 15, fq = lane_ >> 4; (void)fr_; (void)fq_;
        const int row0 = u.pm * BM + wr * 64 + fr, col0 = u.pn * BM + wc * 32 + 8 * fq;
#pragma unroll
        for (int ai = 0; ai < 2; ++ai)
#pragma unroll
            for (int m = 0; m < 4; ++m) { bf16_t* rp = O + (size_t)(row0 + ai * HALF + m * 16) * ldc + col0;
#pragma unroll
                for (int bj = 0; bj < 2; ++bj) { const pg8::f32x4 v0 = acc[ai][bj][m][0], v1 = acc[ai][bj][m][1];
                    u32x4 w; w.x = pk2(v0[0], v0[1]); w.y = pk2(v0[2], v0[3]); w.z = pk2(v1[0], v1[1]); w.w = pk2(v1[2], v1[3]);
                    *(u32x4*)(rp + bj * HALF) = w; } }
    }
};
struct EpiF32 {
    static constexpr bool PERM = true, AFTER_DRAIN = false;
    float* O; int ldc;
    __device__ __forceinline__ void operator()(const pg8::f32x4 (&acc)[2][2][4][2], const Unit& u, int wr, int wc, int fr_, int fq_) const {
        const int lane_ = otid() & 63, fr = lane_ & 15, fq = lane_ >> 4; (void)fr_; (void)fq_;
        const int row0 = u.pm * BM + wr * 64 + fr, col0 = u.pn * BM + wc * 32 + 8 * fq;
#pragma unroll
        for (int ai = 0; ai < 2; ++ai)
#pragma unroll
            for (int m = 0; m < 4; ++m) { float* rp = O + (size_t)(row0 + ai * HALF + m * 16) * ldc + col0;
#pragma unroll
                for (int bj = 0; bj < 2; ++bj) { *(pg8::f32x4*)(rp + bj * HALF) = acc[ai][bj][m][0]; *(pg8::f32x4*)(rp + bj * HALF + 4) = acc[ai][bj][m][1]; } }
    }
};
struct EpiPart {
    static constexpr bool PERM = true, AFTER_DRAIN = false;
    float* P;
    __device__ __forceinline__ void operator()(const pg8::f32x4 (&acc)[2][2][4][2], const Unit& u, int wr, int wc, int fr_, int fq_) const {
        const int lane_ = otid() & 63, fr = lane_ & 15, fq = lane_ >> 4; (void)fr_; (void)fq_;
        const int row0 = wr * 64 + fr, col0 = u.pn * BM + wc * 32 + 8 * fq; float* base = P + (size_t)(u.ko >> 8) * 256 * 1024;
#pragma unroll
        for (int ai = 0; ai < 2; ++ai)
#pragma unroll
            for (int m = 0; m < 4; ++m) { float* rp = base + (size_t)(row0 + ai * HALF + m * 16) * 1024 + col0;
#pragma unroll
                for (int bj = 0; bj < 2; ++bj) { *(pg8::f32x4*)(rp + bj * HALF) = acc[ai][bj][m][0]; *(pg8::f32x4*)(rp + bj * HALF + 4) = acc[ai][bj][m][1]; } }
    }
};
struct SplitOrder {
    int nsplit, c;
    __device__ bool next(int i, Unit& u) const { if (i != 0 || c >= 4 * nsplit) return false; u.pm = 128; u.pn = c & 3; u.ko = (c >> 2) * 256; return true; }
    __device__ __forceinline__ void a_ready(const Unit&) const {}
    __device__ __forceinline__ void done(const Unit&) const {}
};
struct EpiGate {
    static constexpr bool PERM = true, AFTER_DRAIN = false;
    const bf16_t* XB; float* Xo; const bf16_t* T; int f32out;
    __device__ __forceinline__ void operator()(const pg8::f32x4 (&acc)[2][2][4][2], const Unit& u, int wr, int wc, int fr_, int fq_) const {
        const int lane_ = otid() & 63, fr = lane_ & 15, fq = lane_ >> 4; (void)fr_; (void)fq_;
        const int row0 = u.pm * BM + wr * 64 + fr, col0 = u.pn * BM + wc * 32 + 8 * fq;
#pragma unroll
        for (int ai = 0; ai < 2; ++ai)
#pragma unroll
            for (int m = 0; m < 4; ++m) { const int row = row0 + ai * HALF + m * 16; if (row >= MV) continue;
#pragma unroll
                for (int bj = 0; bj < 2; ++bj) { const size_t off = (size_t)row * DM + col0 + bj * HALF;
                    const u32x4 t = *(const u32x4*)(T + off); const u32x4 xb = *(const u32x4*)(XB + off);
                    pg8::f32x4 x0 = {bflo(xb.x), bfhi(xb.x), bflo(xb.y), bfhi(xb.y)}, x1 = {bflo(xb.z), bfhi(xb.z), bflo(xb.w), bfhi(xb.w)};
                    const pg8::f32x4 a0 = acc[ai][bj][m][0], a1 = acc[ai][bj][m][1];
                    x0[0] += sigm_f(a0[0]) * bflo(t.x); x0[1] += sigm_f(a0[1]) * bfhi(t.x); x0[2] += sigm_f(a0[2]) * bflo(t.y); x0[3] += sigm_f(a0[3]) * bfhi(t.y);
                    x1[0] += sigm_f(a1[0]) * bflo(t.z); x1[1] += sigm_f(a1[1]) * bfhi(t.z); x1[2] += sigm_f(a1[2]) * bflo(t.w); x1[3] += sigm_f(a1[3]) * bfhi(t.w);
                    if (f32out) { *(pg8::f32x4*)(Xo + off) = x0; *(pg8::f32x4*)(Xo + off + 4) = x1; }
                    else { u32x4 w; w.x = pk2(x0[0], x0[1]); w.y = pk2(x0[2], x0[3]); w.z = pk2(x1[0], x1[1]); w.w = pk2(x1[2], x1[3]); *(u32x4*)((bf16_t*)Xo + off) = w; } } }
    }
};

__device__ __forceinline__ void cvt_wt(const float* __restrict__ W, bf16_t* __restrict__ Wt, int K, int N, int Npad, float* tile  ) {
    const int tid = otid(), ntn = Npad / 64, nt = ntn * (K / 64);
    const int kk0 = tid >> 4, n4 = (tid & 15) * 4;
    int t = blockIdx.x; if (t >= nt) return;
    f32x4 pre[2];
#define CVT_LOAD(t_) do { const int n0_ = ((t_) % ntn) * 64, k0_ = ((t_) / ntn) * 64; _Pragma("unroll") for (int i = 0; i < 2; ++i) { \
        pre[i] = (f32x4){0.f, 0.f, 0.f, 0.f}; if (n0_ + n4 < N) pre[i] = *(const f32x4*)(W + (size_t)(k0_ + kk0 + 32 * i) * N + n0_ + n4); } } while (0)
    CVT_LOAD(t);
    for (;;) {
        const int n0 = (t % ntn) * 64, k0 = (t / ntn) * 64;
#pragma unroll
        for (int i = 0; i < 2; ++i) { const int kk = kk0 + 32 * i; tile[kk * 65 + n4] = pre[i][0]; tile[kk * 65 + n4 + 1] = pre[i][1]; tile[kk * 65 + n4 + 2] = pre[i][2]; tile[kk * 65 + n4 + 3] = pre[i][3]; }
        __syncthreads();
        const int tn = t + (int)gridDim.x; const bool more = tn < nt;
        if (more) CVT_LOAD(tn);
        { const int nn = tid >> 3, k8 = (tid & 7) * 8; u32x4 w;
          w.x = pk2(tile[(k8 + 0) * 65 + nn], tile[(k8 + 1) * 65 + nn]); w.y = pk2(tile[(k8 + 2) * 65 + nn], tile[(k8 + 3) * 65 + nn]);
          w.z = pk2(tile[(k8 + 4) * 65 + nn], tile[(k8 + 5) * 65 + nn]); w.w = pk2(tile[(k8 + 6) * 65 + nn], tile[(k8 + 7) * 65 + nn]);
          *(u32x4*)(Wt + (size_t)(n0 + nn) * K + k0 + k8) = w; }
        __syncthreads();
        if (!more) break;
        t = tn;
    }
#undef CVT_LOAD
}
__device__ __forceinline__ void prologue(const Args& a, float* tile) {
    unsigned char* ws = a.p->ws;
    for (int j = 0; j < 2; ++j) {
        cvt_wt(a.p->in[9] + (size_t)j * 1024 * 6144, (bf16_t*)(ws + WS_WGIN) + (size_t)j * 6144 * 1024, 1024, 6144, 6144, tile);
        cvt_wt(a.p->in[14] + (size_t)j * 2048 * 1024, (bf16_t*)(ws + WS_WGOUT) + (size_t)j * 1024 * 2048, 2048, 1024, 1024, tile);
        cvt_wt(a.p->in[15] + (size_t)j * 1024 * 8208, (bf16_t*)(ws + WS_WFIN) + (size_t)j * NFIN * 1024, 1024, 8208, NFIN, tile);
        cvt_wt(a.p->in[17] + (size_t)j * 2048 * 1024, (bf16_t*)(ws + WS_WFOUT) + (size_t)j * 1024 * 2048, 2048, 1024, 1024, tile);
    }
    for (int i = 0; i < 4; ++i) {
        cvt_wt(a.p->in[18] + (size_t)i * 256 * 1024, (bf16_t*)(ws + WS_WPP) + (size_t)i * 1024 * 256, 256, 1024, 1024, tile);
        cvt_wt(a.p->in[19] + (size_t)i * 1024 * 1024, (bf16_t*)(ws + WS_WPG) + (size_t)i * 1024 * 1024, 1024, 1024, 1024, tile);
    }
    const float* wsrc = a.p->in[12]; bf16_t* wm = (bf16_t*)(ws + WS_WM); bf16_t* wms = (bf16_t*)(ws + WS_WMS);
    for (int idx = blockIdx.x * 512 + otid(); idx < 2 * 16 * 128 * 128; idx += gridDim.x * 512) {
        const int jj = idx & 127, i = (idx >> 7) & 127, lg = idx >> 14;
        const float w = wsrc[idx]; wm[idx] = (bf16_t)f2bf((jj >> 6) <= (i >> 6) ? w : 0.f);
        const float w2 = wsrc[((size_t)lg * 128 + (i & 15)) * 128 + (jj & 15)]; wms[idx] = (bf16_t)f2bf((i >> 4) == (jj >> 4) ? w2 : 0.f);
    }
}

__device__ __forceinline__ void phase_e1(const Args& a, int layer) {
    const int tid = otid(), lane = tid & 63, gw = blockIdx.x * 8 + (tid >> 6), nw = gridDim.x * 8;
    float* X = a.p->out; bf16_t* X16 = (bf16_t*)a.p->out; bf16_t* HX = (bf16_t*)(a.p->ws + WS_HX); bf16_t* PB = (bf16_t*)(a.p->ws + WS_PB);
    const float* g = a.p->in[7] + (layer & 3) * DM;
    f32x4 gv[4];
#pragma unroll
    for (int q = 0; q < 4; ++q) gv[q] = *(const f32x4*)(g + q * 256 + lane * 4);
#define E1_LOAD(v, r) do { if (layer == 0) { _Pragma("unroll") for (int q = 0; q < 4; ++q) v[q] = *(const f32x4*)(a.p->in[0] + (size_t)(r) * DM + q * 256 + lane * 4); } \
        else { _Pragma("unroll") for (int q = 0; q < 4; ++q) { const u32x2 xb = *(const u32x2*)(X16 + (size_t)(r) * DM + q * 256 + lane * 4); v[q] = (f32x4){bflo(xb.x), bfhi(xb.x), bflo(xb.y), bfhi(xb.y)}; } } } while (0)
#define E1_FIN(v, r, p) do { float ss = 0.f; _Pragma("unroll") for (int q = 0; q < 4; ++q) ss += v[q][0] * v[q][0] + v[q][1] * v[q][1] + v[q][2] * v[q][2] + v[q][3] * v[q][3]; \
        ss = wave_sum(ss); const float rr = rsqrtf(ss * (1.f / DM) + RMS_EPS); \
        _Pragma("unroll") for (int q = 0; q < 4; ++q) { u32x2 hw; hw.x = pk2(v[q][0] * rr * gv[q][0], v[q][1] * rr * gv[q][1]); hw.y = pk2(v[q][2] * rr * gv[q][2], v[q][3] * rr * gv[q][3]); \
            *(u32x2*)(HX + (size_t)(r) * DM + q * 256 + lane * 4) = hw; } \
        u32x2 pw; pw.x = pk2(p[0], p[1]); pw.y = pk2(p[2], p[3]); *(u32x2*)(PB + (size_t)(r) * 256 + lane * 4) = pw; } while (0)
    if (layer < 4) {
        const float* pp = a.p->in[5] + (size_t)layer * MP * 256;
        for (int row = gw; row < MP; row += 2 * nw) {
            const int r1 = row + nw; const bool has1 = r1 < MP;
            f32x4 v0[4], v1[4]; f32x4 p0, p1 = {0.f, 0.f, 0.f, 0.f};
            E1_LOAD(v0, row); p0 = *(const f32x4*)(pp + (size_t)row * 256 + lane * 4);
            if (has1) { E1_LOAD(v1, r1); p1 = *(const f32x4*)(pp + (size_t)r1 * 256 + lane * 4); }
            E1_FIN(v0, row, p0);
            if (has1) E1_FIN(v1, r1, p1);
        }
    }
    for (int row = MP + gw; row < (layer == 4 ? MV : MA); row += nw) {
        if (row < MV) {
            f32x4 v[4];
            if (layer > 0) {
                const bf16_t* TBp = (const bf16_t*)(a.p->ws + WS_TB);
#pragma unroll
                for (int q = 0; q < 4; ++q) { const size_t off = (size_t)row * DM + q * 256 + lane * 4; const float* pq = (const float*)(a.p->ws + WS_PART) + (size_t)(row - MP) * 1024 + q * 256 + lane * 4;
                    f32x4 g4 = *(const f32x4*)pq;
#pragma unroll
                    for (int ks = 1; ks < 4; ++ks) g4 += *(const f32x4*)(pq + (size_t)ks * 256 * 1024);
                    const u32x2 xb = *(const u32x2*)(HX + off), tb = *(const u32x2*)(TBp + off);
                    v[q] = (f32x4){bflo(xb.x) + sigm_f(g4[0]) * bflo(tb.x), bfhi(xb.x) + sigm_f(g4[1]) * bfhi(tb.x), bflo(xb.y) + sigm_f(g4[2]) * bflo(tb.y), bfhi(xb.y) + sigm_f(g4[3]) * bfhi(tb.y)};
                    if (layer == 4) *(f32x4*)(X + off) = v[q]; else { u32x2 w; w.x = pk2(v[q][0], v[q][1]); w.y = pk2(v[q][2], v[q][3]); *(u32x2*)(X16 + off) = w; } }
                if (layer == 4) continue;
            } else {
#pragma unroll
                for (int q = 0; q < 4; ++q) v[q] = *(const f32x4*)(a.p->in[1] + (size_t)(row - MP) * DM + q * 256 + lane * 4);
            }
            const f32x4 p = *(const f32x4*)(a.p->in[6] + ((size_t)layer * MS + (row - MP)) * 256 + lane * 4);
            E1_FIN(v, row, p);
        } else {
#pragma unroll
            for (int q = 0; q < 4; ++q) *(u32x2*)(HX + (size_t)row * DM + q * 256 + lane * 4) = (u32x2){0u, 0u};
            *(u32x2*)(PB + (size_t)row * 256 + lane * 4) = (u32x2){0u, 0u};
        }
    }
#undef E1_LOAD
#undef E1_FIN
}
__device__ __forceinline__ void phase_e3(const Args& a, int layer, bool dummy = false) {
    const int tid = otid(), lane = tid & 63, gw = blockIdx.x * 8 + (tid >> 6), nw = gridDim.x * 8;
    const bf16_t* X16 = (const bf16_t*)a.p->out; bf16_t* HX = (bf16_t*)(a.p->ws + (dummy ? WS_DUMMY + 136 * MiB : WS_HX)); const bf16_t* OP = (const bf16_t*)(a.p->ws + WS_R0 + RSZ);
    const float* g = a.p->in[8] + layer * DM;
    f32x4 gv[4];
#pragma unroll
    for (int q = 0; q < 4; ++q) gv[q] = *(const f32x4*)(g + q * 256 + lane * 4);
#define E3_LOADX(XX, r, src0) do { if (layer == 0) { _Pragma("unroll") for (int q = 0; q < 4; ++q) XX[q] = *(const f32x4*)((src0) + q * 256 + lane * 4); } \
        else { _Pragma("unroll") for (int q = 0; q < 4; ++q) { const u32x2 xb = *(const u32x2*)(X16 + (size_t)(r) * DM + q * 256 + lane * 4); XX[q] = (f32x4){bflo(xb.x), bfhi(xb.x), bflo(xb.y), bfhi(xb.y)}; } } } while (0)
#define E3_FIN(v, XX, r) do { float ss = 0.f; _Pragma("unroll") for (int q = 0; q < 4; ++q) ss += v[q][0] * v[q][0] + v[q][1] * v[q][1] + v[q][2] * v[q][2] + v[q][3] * v[q][3]; \
        ss = wave_sum(ss); const float rr = rsqrtf(ss * (1.f / DM) + RMS_EPS); \
        _Pragma("unroll") for (int q = 0; q < 4; ++q) { u32x2 hw; hw.x = pk2(XX[q][0] + v[q][0] * rr * gv[q][0], XX[q][1] + v[q][1] * rr * gv[q][1]); hw.y = pk2(XX[q][2] + v[q][2] * rr * gv[q][2], XX[q][3] + v[q][3] * rr * gv[q][3]); \
            *(u32x2*)(HX + (size_t)(r) * DM + q * 256 + lane * 4) = hw; } } while (0)
#define E3_LOADOP(v, r) do { _Pragma("unroll") for (int q = 0; q < 4; ++q) { const u32x2 ob = *(const u32x2*)(OP + (size_t)(r) * DM + q * 256 + lane * 4); v[q] = (f32x4){bflo(ob.x), bfhi(ob.x), bflo(ob.y), bfhi(ob.y)}; } } while (0)
    for (int row = gw; row < MP; row += 2 * nw) {
        const int r1 = row + nw; const bool has1 = r1 < MP;
        f32x4 v0[4], x0[4], v1[4], x1[4];
        E3_LOADOP(v0, row); E3_LOADX(x0, row, a.p->in[0] + (size_t)row * DM);
        if (has1) { E3_LOADOP(v1, r1); E3_LOADX(x1, r1, a.p->in[0] + (size_t)r1 * DM); }
        E3_FIN(v0, x0, row);
        if (has1) E3_FIN(v1, x1, r1);
    }
    for (int row = MP + gw; row < MA; row += nw) {
        if (row < MV) {
            f32x4 v[4], x[4];
#pragma unroll
            for (int q = 0; q < 4; ++q) { const float* pq = (const float*)(a.p->ws + WS_PART) + (size_t)(row - MP) * 1024 + q * 256 + lane * 4; v[q] = *(const f32x4*)pq;
#pragma unroll
                for (int ks = 1; ks < 8; ++ks) v[q] += *(const f32x4*)(pq + (size_t)ks * 256 * 1024); }
            E3_LOADX(x, row, a.p->in[1] + (size_t)(row - MP) * DM);
            E3_FIN(v, x, row);
        } else {
#pragma unroll
            for (int q = 0; q < 4; ++q) *(u32x2*)(HX + (size_t)row * DM + q * 256 + lane * 4) = (u32x2){0u, 0u};
        }
    }
#undef E3_LOADX
#undef E3_FIN
#undef E3_LOADOP
}

__device__ __forceinline__ void phase_s1(const Args& a, int j, unsigned char* lds, bool dummy = false) {
    constexpr int LP = 136;
    bf16_t* As = (bf16_t*)lds; bf16_t* Bs = As + 128 * LP; float* fl = (float*)(Bs + 128 * LP);
    float* mu = fl, * rs = fl + 128, * t1 = fl + 256, * t2 = fl + 384;
    const int tid = otid(), lane = tid & 63, wid = tid >> 6, fr = lane & 15, fq = lane >> 4;
    const bf16_t* U = (const bf16_t*)(a.p->ws + WS_R0); bf16_t* Uo = (bf16_t*)(a.p->ws + (dummy ? WS_DUMMY : WS_R0)); const bf16_t* VT = (const bf16_t*)(a.p->ws + WS_R0 + RSZ); const bf16_t* ZS = (const bf16_t*)(a.p->ws + WS_R0 + 2 * RSZ);
    const float* stat = (const float*)(a.p->ws + WS_STAT);
    const float* lng = a.p->in[10] + j * EB; const float* lnb = a.p->in[11] + j * EB; const float* bsv = a.p->in[13] + j * 16 * 128;
    float* gvs = a.p->out + O_GV + (size_t)j * MS * EB;
    constexpr int NU = 257 * 16;
    const int G_ = gridDim.x, w_ = blockIdx.x;
#define S1_UNIT(k) ((G_ == 256) ? ((k) < 16 ? w_ * 16 + (((k) + w_) & 15) :     ((k) == 16 && w_ < 16 ? 4096 + w_ : NU)) : (w_ + (k) * G_))
#define S1_LOAD_AB(u_) do { const int blk_ = (u_) >> 4, g_ = (u_) & 15; \
        const bf16_t* wsrc_ = (const bf16_t*)(a.p->ws + (blk_ == 256 ? WS_WMS : WS_WM)) + ((size_t)(j * 16 + g_) * 128) * 128; const bf16_t* vsrc_ = VT + ((size_t)blk_ * 2048 + g_ * 128) * 128; \
        _Pragma("unroll") for (int q = 0; q < 4; ++q) { ar[q] = *(const u32x4*)(wsrc_ + (tid >> 2) * 128 + (tid & 3) * 32 + q * 8); br[q] = *(const u32x4*)(vsrc_ + (tid >> 2) * 128 + (tid & 3) * 32 + q * 8); } } while (0)
    int un = S1_UNIT(0);
    if (un >= NU) return;
    u32x4 ar[4], br[4];
    S1_LOAD_AB(un);
    int prev_blk = -1;
    for (int k = 0;; ++k) {
        const int blk = un >> 4, g = un & 15, issamp = blk == 256;
        if (blk != prev_blk) {
          { const int r_ = tid >> 2, p_ = tid & 3; const float* sp = stat + (size_t)(blk * 128 + r_) * 64 + p_ * 8;
          const f32x4 s0 = *(const f32x4*)sp, s1 = *(const f32x4*)(sp + 4), q0 = *(const f32x4*)(sp + 32), q1 = *(const f32x4*)(sp + 36);
          float s = ((s0[0] + s0[1]) + (s0[2] + s0[3])) + ((s1[0] + s1[1]) + (s1[2] + s1[3])), q = ((q0[0] + q0[1]) + (q0[2] + q0[3])) + ((q1[0] + q1[1]) + (q1[2] + q1[3]));
          s += __shfl_xor(s, 1); s += __shfl_xor(s, 2); q += __shfl_xor(q, 1); q += __shfl_xor(q, 2);
          if (p_ == 0) { const float m = s * (1.f / EB); const float var = fmaxf(q * (1.f / EB) - m * m, 0.f); mu[r_] = m; rs[r_] = rsqrtf(var + LN_EPS); } }
          __syncthreads(); prev_blk = blk;
        }
        { const int i = tid >> 2, part = tid & 3; float a1 = 0.f, a2 = 0.f;
#pragma unroll
          for (int q = 0; q < 4; ++q) { const int j0 = part * 32 + q * 8; const u32x4 w = ar[q]; const unsigned ww[4] = {w.x, w.y, w.z, w.w}; float o[8];
#pragma unroll
              for (int e = 0; e < 4; ++e) { const float w0 = bflo(ww[e]), w1 = bfhi(ww[e]); const float r0 = rs[j0 + 2 * e], r1 = rs[j0 + 2 * e + 1];
                  o[2 * e] = w0 * r0; o[2 * e + 1] = w1 * r1; a1 += w0 * r0 * mu[j0 + 2 * e] + w1 * r1 * mu[j0 + 2 * e + 1]; a2 += w0 + w1; }
              u32x4 ow; ow.x = pk2(o[0], o[1]); ow.y = pk2(o[2], o[3]); ow.z = pk2(o[4], o[5]); ow.w = pk2(o[6], o[7]);
              *(u32x4*)(As + i * LP + j0) = ow; *(u32x4*)(Bs + i * LP + j0) = br[q]; }
          a1 += __shfl_xor(a1, 1); a1 += __shfl_xor(a1, 2); a2 += __shfl_xor(a2, 1); a2 += __shfl_xor(a2, 2);
          if (part == 0) { t1[i] = a1; t2[i] = a2; }
        }
        __syncthreads();
        const int un_next = S1_UNIT(k + 1); const bool has_next = un_next < NU;
        if (has_next) S1_LOAD_AB(un_next);
        const int i0 = (wid >> 1) * 32, c0 = (wid & 1) * 64;
        f32x4 acc[2][4];
#pragma unroll
        for (int mt = 0; mt < 2; ++mt)
#pragma unroll
            for (int nt = 0; nt < 4; ++nt) acc[mt][nt] = (f32x4){0.f, 0.f, 0.f, 0.f};
#pragma unroll
        for (int kk = 0; kk < 4; ++kk) {
            bf16x8 af[2], bfr[4];
#pragma unroll
            for (int mt = 0; mt < 2; ++mt) af[mt] = *(const bf16x8*)(As + (i0 + mt * 16 + fr) * LP + kk * 32 + fq * 8);
#pragma unroll
            for (int nt = 0; nt < 4; ++nt) bfr[nt] = *(const bf16x8*)(Bs + (c0 + nt * 16 + fr) * LP + kk * 32 + fq * 8);
#pragma unroll
            for (int mt = 0; mt < 2; ++mt)
#pragma unroll
                for (int nt = 0; nt < 4; ++nt) acc[mt][nt] = __builtin_amdgcn_mfma_f32_16x16x32_bf16(bfr[nt], af[mt], acc[mt][nt], 0, 0, 0);
        }
        const int ei = tid >> 2, ec = (tid & 3) * 32; const size_t erow = (size_t)blk * 128 + ei;
        u32x4 uu[4], zz[4];
#pragma unroll
        for (int q = 0; q < 4; ++q) { uu[q] = *(const u32x4*)(U + erow * EB + g * 128 + ec + q * 8); zz[q] = *(const u32x4*)(ZS + erow * EB + g * 128 + ec + q * 8); }
        if (issamp) {
            for (int idx = tid; idx < 128 * 128; idx += 512) { const int c = idx & 127, i = idx >> 7; const float v = __uint_as_float((unsigned)Bs[c * LP + i] << 16);
                gvs[(size_t)i * EB + g * 128 + c] = (v - mu[i]) * rs[i] * lng[g * 128 + c] + lnb[g * 128 + c]; }
        }
        __syncthreads();
        float* S32 = (float*)lds; constexpr int SP = 132;
#pragma unroll
        for (int mt = 0; mt < 2; ++mt)
#pragma unroll
            for (int nt = 0; nt < 4; ++nt) *(f32x4*)(S32 + (i0 + mt * 16 + fr) * SP + c0 + nt * 16 + fq * 4) = acc[mt][nt];
        __syncthreads();
        { const float t1i = t1[ei], t2i = t2[ei], bi = bsv[g * 128 + (issamp ? (ei & 15) : ei)];
#pragma unroll
          for (int q = 0; q < 4; ++q) { const int cg = g * 128 + ec + q * 8;
              const f32x4 sa = *(const f32x4*)(S32 + ei * SP + ec + q * 8), sb = *(const f32x4*)(S32 + ei * SP + ec + q * 8 + 4);
              const f32x4 lga = *(const f32x4*)(lng + cg), lgb = *(const f32x4*)(lng + cg + 4), lba = *(const f32x4*)(lnb + cg), lbb = *(const f32x4*)(lnb + cg + 4);
              float s[8];
#pragma unroll
              for (int e = 0; e < 4; ++e) { s[e] = lga[e] * (sa[e] - t1i) + lba[e] * t2i + bi; s[4 + e] = lgb[e] * (sb[e] - t1i) + lbb[e] * t2i + bi; }
              const unsigned u4[4] = {uu[q].x, uu[q].y, uu[q].z, uu[q].w}, z4[4] = {zz[q].x, zz[q].y, zz[q].z, zz[q].w}; unsigned y4[4];
#pragma unroll
              for (int e = 0; e < 4; ++e) y4[e] = pk2(bflo(u4[e]) * s[2 * e] * bflo(z4[e]), bfhi(u4[e]) * s[2 * e + 1] * bfhi(z4[e]));
              *(u32x4*)(Uo + erow * EB + cg) = (u32x4){y4[0], y4[1], y4[2], y4[3]}; } }
        __syncthreads();
        if (!has_next) break;
        un = un_next;
    }
#undef S1_UNIT
#undef S1_LOAD_AB
}

__device__ __forceinline__ void phase_c1(const Args& a, int j) {
    const int tid = otid(); if ((tid >> 6) != 0) return;
    const int lane = tid & 63;
    for (int sq = blockIdx.x; sq < 256; sq += gridDim.x) {
        if (sq < 128) {
            const int b = sq >> 4, h = sq & 15; const float* src = a.p->out + O_FLP + ((size_t)j * MP + (size_t)b * SEQ) * 16 + h; float* dst = (float*)(a.p->ws + WS_CBP) + (size_t)sq * SEQ;
            float tot = 0.f; for (int s = 0; s < 64; ++s) tot += src[(size_t)(lane * 64 + s) * 16];
            float inc = tot; for (int o = 1; o < 64; o <<= 1) { const float t = __shfl_up(inc, o); if (lane >= o) inc += t; }
            float run = inc - tot;
            for (int s = 0; s < 64; ++s) { run += src[(size_t)(lane * 64 + s) * 16];
                dst[lane * 64 + (((s >> 2) & 1) * 32 + ((s >> 3) & 3) * 4 + (s & 3) + 16 * (s >> 5))] = -run * 11.313708498984761f; }
        } else {
            const int bh = sq - 128, b = bh >> 4, h = bh & 15; const float* c0 = a.p->in[4] + ((size_t)(j * 8 + b) * PAST) * 16 + h; const float* c1 = a.p->out + O_FLS + ((size_t)j * MS + b * TS) * 16 + h;
            float* dst = (float*)(a.p->ws + WS_CBS) + (size_t)bh * SKS;
            float tot = 0.f; for (int s = 0; s < 33; ++s) { const int k = lane * 33 + s; const float v = k < PAST ? c0[(size_t)k * 16] : (k < PAST + TS ? c1[(size_t)(k - PAST) * 16] : 0.f); tot += v; }
            float inc = tot; for (int o = 1; o < 64; o <<= 1) { const float t = __shfl_up(inc, o); if (lane >= o) inc += t; }
            float run = inc - tot;
            for (int s = 0; s < 33; ++s) { const int k = lane * 33 + s; const float v = k < PAST ? c0[(size_t)k * 16] : (k < PAST + TS ? c1[(size_t)(k - PAST) * 16] : 0.f); run += v; dst[k] = -run; }
        }
    }
}

__device__ __forceinline__ void sample_attn(const Args& a, int j, int bh, unsigned char* ldsb, bool dummy = false) {
    constexpr int PP = 136;
    float* wmx = (float*)ldsb;
    bf16_t* Pb = (bf16_t*)(ldsb + 1024);
    float* lfin = (float*)(ldsb + 1024 + 2 * 16 * PP * 2);
    const int tid = otid(), lane = tid & 63, wid = __builtin_amdgcn_readfirstlane(tid >> 6), fr = lane & 15, fq = lane >> 4, b = bh >> 4, h = bh & 15;
    const bf16_t* Qb = (const bf16_t*)(a.p->ws + WS_R0); const bf16_t* ZS = (const bf16_t*)(a.p->ws + WS_R0 + 3 * RSZ); bf16_t* O = (bf16_t*)(a.p->ws + (dummy ? WS_DUMMY : WS_R0));
    const float* ck = a.p->in[2] + (size_t)(j * 8 + b) * PAST * EB + h * 128; const float* cv = a.p->in[3] + (size_t)(j * 8 + b) * PAST * EB + h * 128;
    const float* nk = a.p->out + O_FKS + ((size_t)j * MS + b * TS) * EB + h * 128; const float* nv = a.p->out + O_FVS + ((size_t)j * MS + b * TS) * EB + h * 128;
    const float* cb = (const float*)(a.p->ws + WS_CBS) + (size_t)bh * SKS;
    bf16x8 qf[4];
#pragma unroll
    for (int kk = 0; kk < 4; ++kk) qf[kk] = *(const bf16x8*)(Qb + (size_t)(MP + b * TS + fr) * EB + h * 128 + kk * 32 + fq * 8);
    const int kl = 16 * wid + fr;
    float m[4], ls[4]; f32x4 oacc = {0.f, 0.f, 0.f, 0.f};
#pragma unroll
    for (int r = 0; r < 4; ++r) { m[r] = -1e30f; ls[r] = 0.f; }
    f32x4 kr[8];
#pragma unroll
    for (int q = 0; q < 8; ++q) kr[q] = *(const f32x4*)(ck + (size_t)kl * EB + (q >> 1) * 32 + fq * 8 + (q & 1) * 4);
    int buf = 0;
    for (int c = 0; c < 17; ++c) {
        float vr[32];
        if (c < 16) {
#pragma unroll
            for (int q = 0; q < 32; ++q) vr[q] = cv[(size_t)(c * 128 + (q >> 3) * 32 + fq * 8 + (q & 7)) * EB + 16 * wid + fr];
        } else {
#pragma unroll
            for (int q = 0; q < 32; ++q) { const int key = (q >> 3) * 32 + fq * 8 + (q & 7); vr[q] = key < TS ? nv[(size_t)key * EB + 16 * wid + fr] : 0.f; }
        }
        const float bias = c < 16 ? cb[c * 128 + kl] : (kl < TS ? cb[PAST + kl] : 0.f);
        f32x4 sacc = {0.f, 0.f, 0.f, 0.f};
#pragma unroll
        for (int kk = 0; kk < 4; ++kk) { const f32x4 x0 = kr[2 * kk], x1 = kr[2 * kk + 1];
            u32x4 w; w.x = pk2(x0[0], x0[1]); w.y = pk2(x0[2], x0[3]); w.z = pk2(x1[0], x1[1]); w.w = pk2(x1[2], x1[3]);
            sacc = __builtin_amdgcn_mfma_f32_16x16x32_bf16(qf[kk], __builtin_bit_cast(bf16x8, w), sacc, 0, 0, 0); }
        if (c + 1 < 16) {
#pragma unroll
            for (int q = 0; q < 8; ++q) kr[q] = *(const f32x4*)(ck + (size_t)((c + 1) * 128 + kl) * EB + (q >> 1) * 32 + fq * 8 + (q & 1) * 4);
        } else if (c + 1 == 16) {
#pragma unroll
            for (int q = 0; q < 8; ++q) kr[q] = kl < TS ? *(const f32x4*)(nk + (size_t)kl * EB + (q >> 1) * 32 + fq * 8 + (q & 1) * 4) : (f32x4){0.f, 0.f, 0.f, 0.f};
        }
        float s[4], mw[4];
#pragma unroll
        for (int r = 0; r < 4; ++r) { s[r] = sacc[r] * att::SCALE + bias; if (c == 16 && (kl >= TS || kl > 4 * fq + r)) s[r] = -__builtin_inff(); mw[r] = s[r]; }
#pragma unroll
        for (int o = 1; o < 16; o <<= 1) {
#pragma unroll
            for (int r = 0; r < 4; ++r) mw[r] = fmaxf(mw[r], __shfl_xor(mw[r], o)); }
        if (fr == 0) {
#pragma unroll
            for (int r = 0; r < 4; ++r) wmx[buf * 128 + (4 * fq + r) * 8 + wid] = mw[r]; }
        __syncthreads();
        float p[4];
#pragma unroll
        for (int r = 0; r < 4; ++r) { const f32x4 w0 = *(const f32x4*)(wmx + buf * 128 + (4 * fq + r) * 8), w1 = *(const f32x4*)(wmx + buf * 128 + (4 * fq + r) * 8 + 4);
            const float mc = fmaxf(fmaxf(fmaxf(w0[0], w0[1]), fmaxf(w0[2], w0[3])), fmaxf(fmaxf(w1[0], w1[1]), fmaxf(w1[2], w1[3])));
            const float mn = fmaxf(m[r], mc), al = __expf(m[r] - mn); m[r] = mn; p[r] = __expf(s[r] - mn); ls[r] = ls[r] * al + p[r]; oacc[r] *= al;
            Pb[buf * 16 * PP + (4 * fq + r) * PP + kl] = (bf16_t)f2bf(p[r]); }
        __syncthreads();
#pragma unroll
        for (int kk = 0; kk < 4; ++kk) { const bf16x8 pa = *(const bf16x8*)(Pb + buf * 16 * PP + fr * PP + kk * 32 + fq * 8);
            u32x4 w; w.x = pk2(vr[kk * 8 + 0], vr[kk * 8 + 1]); w.y = pk2(vr[kk * 8 + 2], vr[kk * 8 + 3]); w.z = pk2(vr[kk * 8 + 4], vr[kk * 8 + 5]); w.w = pk2(vr[kk * 8 + 6], vr[kk * 8 + 7]);
            oacc = __builtin_amdgcn_mfma_f32_16x16x32_bf16(pa, __builtin_bit_cast(bf16x8, w), oacc, 0, 0, 0); }
        buf ^= 1;
    }
#pragma unroll
    for (int o = 1; o < 16; o <<= 1) {
#pragma unroll
        for (int r = 0; r < 4; ++r) ls[r] += __shfl_xor(ls[r], o); }
    if (fr == 0) {
#pragma unroll
        for (int r = 0; r < 4; ++r) lfin[wid * 16 + 4 * fq + r] = ls[r]; }
    __syncthreads();
#pragma unroll
    for (int r = 0; r < 4; ++r) { const int i = 4 * fq + r; float l = 0.f;
#pragma unroll
        for (int w = 0; w < 8; ++w) l += lfin[w * 16 + i];
        const size_t off = (size_t)(MP + b * TS + i) * EB + h * 128 + 16 * wid + fr;
        const float z = __uint_as_float((unsigned)ZS[off] << 16); O[off] = (bf16_t)f2bf(oacc[r] / l * z); }
    __syncthreads();
}

__device__ __forceinline__ void phase_attn(const Args& a, int j, unsigned char* ldsb, int mode = 0) {
    using namespace att;
    typedef __hip_bfloat16 T;
    const T* Q = (const T*)(a.p->ws + WS_R0); const T* K = (const T*)(a.p->ws + WS_R0 + RSZ); const T* V = (const T*)(a.p->ws + WS_R0 + 2 * RSZ); const T* Z = (const T*)(a.p->ws + WS_R0 + 3 * RSZ); T* O = (T*)(a.p->ws + (mode == 1 ? WS_DUMMY : WS_R0));
    const float* CB = (const float*)(a.p->ws + WS_CBP);
    char* lds = (char*)ldsb;
    constexpr int nqb = SEQ / QB, nx = nqb / 2, total = nx * NBH;
    const int stride = gridDim.x;
    int L = (gridDim.x == 256) ? (int)((blockIdx.x & 7) * 32 + (blockIdx.x >> 3)) : (int)blockIdx.x;
    if (mode == 2) L = total;
    if (L < total) {
#define MKREF(r, L_, pass_) do { const int bh_ = (L_) / nx, x_ = (L_) - bh_ * nx, qb_ = (pass_) ? x_ : nqb - 1 - x_,     b_ = bh_ >> 4, h_ = bh_ & 15; \
        const size_t ro_ = ((size_t)b_ * SEQ + (size_t)qb_ * QB) * PITCH + h_ * 128, ko_ = ((size_t)b_ * SEQ) * PITCH + h_ * 128; \
        (r).Q = Q + ro_; (r).O = O + ro_; (r).Z = Z + ro_; (r).K = K + ko_; (r).V = V + ko_; (r).CB = CB + (size_t)bh_ * SEQ; (r).P0 = qb_ * QB; } while (0)
        BlockRef<T, T> cur, nxt; int pass = 0;
        MKREF(cur, L, 0);
        Seam<T> S;
        causal_swa_prime<T, T>(cur, SEQ, lds, S);
        for (;;) {
            const bool more_pass = pass == 0, more_item = L + stride < total, last = !more_pass && !more_item;
            int passn = pass + 1, Ln = L;
            if (!more_pass) { passn = 0; Ln = more_item ? L + stride : L; }
            if (last) nxt = cur; else MKREF(nxt, Ln, passn);
            causal_swa_block<T, T>(cur, nxt, SEQ, SEQ, lds, S);
            if (last) break;
            cur = nxt; pass = passn; L = Ln;
        }
#undef MKREF
    }
    __syncthreads();
    if (mode != 1) for (int bh = (int)gridDim.x - 1 - (int)blockIdx.x; bh < NBH; bh += gridDim.x) sample_attn(a, j, bh, ldsb, mode == 2);
}

#define XB_TMO      128
#define XB_XCNT(j)  (256  + 64 * (j))
#define XB_XSUB(j)  (1280 + 64 * (j))
#define XB_XGEN(j)  (2304 + 64 * (j))
#define XB_TOP      3328
#define XB_TOPGEN   3392
#define XCD_BAR_WORDS 3456
#define XB_SPIN_CAP (1u << 18)

__device__ __forceinline__ unsigned xb_ld(unsigned* p)              { return __hip_atomic_load(p, __ATOMIC_RELAXED, __HIP_MEMORY_SCOPE_AGENT); }
__device__ __forceinline__ unsigned xb_add(unsigned* p, unsigned v) { return __hip_atomic_fetch_add(p, v, __ATOMIC_RELAXED, __HIP_MEMORY_SCOPE_AGENT); }
__device__ __forceinline__ unsigned xb_xcc_id() { return (unsigned)__builtin_amdgcn_s_getreg((3 << 11) | 20) & 0xFu; }
#define XB_SPIN(cond, bar) do { unsigned _sp = 0; while (cond) { __builtin_amdgcn_s_sleep(1); \
    if ((++_sp & 255u) == 0u) { if (xb_ld(&(bar)[XB_TMO])) break; if (_sp > XB_SPIN_CAP) { atomicAdd(&(bar)[XB_TMO], 1u); break; } } } } while (0)

struct XcdBarrier {
    unsigned* bar; unsigned x;
    volatile LAS unsigned* st;
};

__device__ __forceinline__ XcdBarrier xcd_barrier_post(unsigned* bar, volatile LAS unsigned* st) {
    XcdBarrier b; b.bar = bar; b.x = xb_xcc_id(); b.st = st;
    if (otid() == 0) (void)xb_add(&bar[XB_XCNT(b.x)], 1u);
    return b;
}
__device__ __forceinline__ void xcd_barrier_complete(unsigned* bar, unsigned x, unsigned& nloc, unsigned& nx) {
    const unsigned G = gridDim.x * gridDim.y * gridDim.z;
    unsigned sum, cnt, mine, sp = 0u;
    for (;;) {
        sum = 0u; cnt = 0u; mine = 0u;
#pragma unroll
        for (unsigned j = 0; j < 16; ++j) { const unsigned c = xb_ld(&bar[XB_XCNT(j)]); sum += c; cnt += (c > 0u) ? 1u : 0u; mine = (j == x) ? c : mine; }
        if (sum == G) break;
        __builtin_amdgcn_s_sleep(1);
        if ((++sp & 255u) == 0u) { if (xb_ld(&bar[XB_TMO])) break; if (sp > XB_SPIN_CAP) { atomicAdd(&bar[XB_TMO], 1u); break; } }
    }
    nloc = mine > 0u ? mine : 1u; nx = cnt > 0u ? cnt : 1u;
}

__device__ __forceinline__ void xcd_barrier(const XcdBarrier& b) {
    asm volatile("s_waitcnt vmcnt(0)" ::: "memory");
    __syncthreads();
    if (otid() == 0) {
        unsigned* bar = b.bar;
        __builtin_amdgcn_s_waitcnt(0);
        unsigned nloc = b.st[0], nx = b.st[1];
        if (nloc == 0u) { xcd_barrier_complete(bar, b.x, nloc, nx); b.st[0] = nloc; b.st[1] = nx; }
        const unsigned old = xb_add(&bar[XB_XSUB(b.x)], 1u);
        const unsigned gen = old / nloc;
        if (old + 1u == (gen + 1u) * nloc) {
            __builtin_amdgcn_fence(__ATOMIC_RELEASE, "agent");
            asm volatile("s_waitcnt vmcnt(0)" ::: "memory");
            const unsigned og = xb_add(&bar[XB_TOP], 1u);
            const unsigned tg = og / nx;
            if (og + 1u == (tg + 1u) * nx) xb_add(&bar[XB_TOPGEN], 1u);
            else XB_SPIN(xb_ld(&bar[XB_TOPGEN]) == tg, bar);
            __builtin_amdgcn_fence(__ATOMIC_ACQUIRE, "agent");
            xb_add(&bar[XB_XGEN(b.x)], 1u);
            asm volatile("s_waitcnt vmcnt(0)" ::: "memory");
        } else {
            XB_SPIN(xb_ld(&bar[XB_XGEN(b.x)]) == gen, bar);
            __builtin_amdgcn_fence(__ATOMIC_ACQUIRE, "agent");
            asm volatile("s_waitcnt vmcnt(0)" ::: "memory");
        }
    }
    __syncthreads();
}
#define WSPTRS() const Args a = getargs(); unsigned char* ws = a.p->ws; (void)ws; \
    bf16_t* HX = (bf16_t*)(ws + WS_HX); bf16_t* TB = (bf16_t*)(ws + WS_TB); bf16_t* PB = (bf16_t*)(ws + WS_PB); (void)HX; (void)TB; (void)PB; \
    bf16_t* R0 = (bf16_t*)(ws + WS_R0); bf16_t* R1 = (bf16_t*)(ws + WS_R0 + RSZ); bf16_t* R2 = (bf16_t*)(ws + WS_R0 + 2 * RSZ); bf16_t* R3 = (bf16_t*)(ws + WS_R0 + 3 * RSZ); (void)R0; (void)R1; (void)R2; (void)R3;
#define XBAR_MK() XcdBarrier xb_; xb_.bar = (unsigned*)(getargs().p->ws) + 1024; xb_.x = xb_xcc_id(); xb_.st = (volatile LAS unsigned*)((LAS unsigned char*)lds + (LDS_BYTES - 64))
#if PROBE_DUP == 7
#define GSYNC() do { XBAR_MK(); xcd_barrier(xb_); xcd_barrier(xb_); } while (0)
#else
#define GSYNC() do { XBAR_MK(); xcd_barrier(xb_); } while (0)
#endif
__global__ void __launch_bounds__(512, 2) fwd_megakernel(ArgsS args_unused) {
    extern __shared__ __attribute__((aligned(16))) unsigned char lds[];
    cg::grid_group grid = cg::this_grid();
    PG8_LAS unsigned char* gl = (PG8_LAS unsigned char*)lds;
    const int G = gridDim.x, c = blockIdx.x;
    { const unsigned hw = (unsigned)__builtin_amdgcn_s_getreg((5 << 11) | 4) & 63u;
      if ((threadIdx.x & 63) == 0) ((LAS int*)((LAS unsigned char*)lds + LDS_WIDTAB))[hw] = (int)(threadIdx.x >> 6);
      if (threadIdx.x < 16) ((LAS unsigned*)((LAS unsigned char*)lds + (LDS_BYTES - 64)))[threadIdx.x] = 0u; }
    __syncthreads();
    { XBAR_MK(); (void)xcd_barrier_post(xb_.bar, xb_.st); }
#ifndef SKIP_PRO
    { const Args a = getargs(); prologue(a, (float*)lds); }
#endif
    grid.sync();
    for (int layer = 0; layer < 4; ++layer) {
        const int j = layer >> 1;
#ifndef SKIP_E1
        for (int rp_ = (PROBE_DUP == 4 ? 0 : 1); rp_ < 2; ++rp_) { const Args a = getargs(); phase_e1(a, layer); if (!rp_) GSYNC(); }
#endif
        GSYNC();
        if ((layer & 1) == 0) {
#ifndef SKIP_G1G
            { WSPTRS(); pg8::Gemm g{HX, (const bf16_t*)(ws + WS_WGIN) + (size_t)j * 6144 * 1024, MA, 6144, 1024}; pg8::StaticOrder S; S.init(MA, 6144, G, c);
              EpiGmlpIn E{R0, R1, R2, (float*)(ws + WS_STAT)};
              for (int rp_ = 0; rp_ < (PROBE_DUP == 5 ? 2 : 1); ++rp_) pg8::gemm_phase<EpiGmlpIn, pg8::StaticOrder, true, true>(gl, g, S, E); }
#endif
        } else {
#ifndef SKIP_G1F
            { WSPTRS(); pg8::Gemm g{HX, (const bf16_t*)(ws + WS_WFIN) + (size_t)j * NFIN * 1024, MA, NFIN, 1024}; pg8::StaticOrder S; S.init(MA, NFIN, G, c);
              float* out = a.p->out;
              EpiFoxIn E{R0, R1, R2, R3, out + O_FKP + (size_t)j * MP * EB, out + O_FVP + (size_t)j * MP * EB, out + O_FLP + (size_t)j * MP * 16,
                         out + O_FKS + (size_t)j * MS * EB, out + O_FVS + (size_t)j * MS * EB, out + O_FLS + (size_t)j * MS * 16, a.p->in[16] + j * 16};
              for (int rp_ = 0; rp_ < (PROBE_DUP == 5 ? 2 : 1); ++rp_) pg8::gemm_phase<EpiFoxIn, pg8::StaticOrder, true, true>(gl, g, S, E); }
#endif
        }
#ifndef SKIP_GT
        { WSPTRS(); pg8::Gemm g{PB, (const bf16_t*)(ws + WS_WPP) + (size_t)layer * 1024 * 256, MA, 1024, 256}; const int nb_ = (layer & 1) ? 0 : 24;
          pg8::StaticOrder S; S.init(MA, 1024, G - nb_, c >= nb_ ? G - 1 - c : (1 << 24));
          EpiT E{TB, 1024};
          for (int rp_ = 0; rp_ < (PROBE_DUP == 6 ? 2 : 1); ++rp_) pg8::gemm_phase<EpiT, pg8::StaticOrder, true, true>(gl, g, S, E); }
#endif
        GSYNC();
        if ((layer & 1) == 0) {
#ifndef SKIP_S1
            for (int rp_ = (PROBE_DUP == 3 ? 0 : 1); rp_ < 2; ++rp_) { const Args a = getargs(); phase_s1(a, j, lds, !rp_); if (!rp_) GSYNC(); }
#endif
        } else {
#ifndef SKIP_C1
            { const Args a = getargs(); phase_c1(a, j); }
#endif
            GSYNC();
#ifndef SKIP_ATTN
            for (int rp_ = ((PROBE_DUP == 1 || PROBE_DUP == 2) ? 0 : 1); rp_ < 2; ++rp_) { const Args a = getargs(); phase_attn(a, j, lds, rp_ ? 0 : PROBE_DUP); if (!rp_) GSYNC(); }
#endif
        }
        GSYNC();
#ifndef SKIP_G2
        { WSPTRS(); pg8::Gemm g{R0, (const bf16_t*)(ws + ((layer & 1) ? WS_WFOUT : WS_WGOUT)) + (size_t)j * 1024 * 2048, MP, 1024, 2048}; pg8::StaticOrder S; S.init(MP, 1024, G, c);
          EpiT E{R1, 1024};
          for (int rp_ = 0; rp_ < (PROBE_DUP == 6 ? 2 : 1); ++rp_) pg8::gemm_phase<EpiT, pg8::StaticOrder, true, true>(gl, g, S, E); }
#endif
        { WSPTRS(); int ksl = 256; asm volatile("" : "+s"(ksl)); pg8::Gemm g{R0, (const bf16_t*)(ws + ((layer & 1) ? WS_WFOUT : WS_WGOUT)) + (size_t)j * 1024 * 2048, MA, 1024, ksl, 2048}; SplitOrder S{8, c};
          EpiPart E{(float*)(ws + WS_PART)};
          pg8::gemm_phase<EpiPart, SplitOrder, true, true>(gl, g, S, E); }
        GSYNC();
#ifndef SKIP_E3
        for (int rp_ = (PROBE_DUP == 4 ? 0 : 1); rp_ < 2; ++rp_) { const Args a = getargs(); phase_e3(a, layer, !rp_); if (!rp_) GSYNC(); }
#endif
        GSYNC();
#ifndef SKIP_G3
        { WSPTRS(); pg8::Gemm g{HX, (const bf16_t*)(ws + WS_WPG) + (size_t)layer * 1024 * 1024, MP, 1024, 1024}; pg8::StaticOrder S; S.init(MP, 1024, G, c);
          for (int rp_ = (PROBE_DUP == 6 ? 0 : 1); rp_ < 2; ++rp_) { EpiGate E{HX, rp_ ? a.p->out : (float*)(ws + WS_DUMMY), TB, layer == 3}; pg8::gemm_phase<EpiGate, pg8::StaticOrder, true, true>(gl, g, S, E); } }
#endif
        { WSPTRS(); int ksl = 256; asm volatile("" : "+s"(ksl)); pg8::Gemm g{HX, (const bf16_t*)(ws + WS_WPG) + (size_t)layer * 1024 * 1024, MA, 1024, ksl, 1024}; SplitOrder S{4, c};
          EpiPart E{(float*)(ws + WS_PART)};
          pg8::gemm_phase<EpiPart, SplitOrder, true, true>(gl, g, S, E); }
        GSYNC();
    }
    { const Args a = getargs(); phase_e1(a, 4); }
}

extern "C" void kernel_launch(void* const* d_in, const int* in_sizes, int n_in, void* d_out, int out_size, void* d_ws, size_t ws_size, hipStream_t stream) {
    static int grid = 0;
    if (grid == 0) {
        if (n_in != 20 || ws_size < WS_END) { fprintf(stderr, "kernel_launch: need 20 inputs and >= %zu bytes of workspace; got %d, %zu\n", (size_t)WS_END, n_in, ws_size); grid = -1; return; }
        int dev = 0, cus = 0, per_cu = 0;
        (void)hipGetDevice(&dev); (void)hipDeviceGetAttribute(&cus, hipDeviceAttributeMultiprocessorCount, dev);
        if (hipFuncSetAttribute((const void*)fwd_megakernel, hipFuncAttributeMaxDynamicSharedMemorySize, LDS_BYTES) != hipSuccess) { fprintf(stderr, "kernel_launch: hipFuncSetAttribute failed\n"); grid = -1; return; }
        if (hipOccupancyMaxActiveBlocksPerMultiprocessor(&per_cu, (const void*)fwd_megakernel, 512, LDS_BYTES) != hipSuccess || per_cu < 1) { fprintf(stderr, "kernel_launch: occupancy query says %d\n", per_cu); per_cu = 1; }
        (void)hipGetLastError();
        grid = cus > 0 ? cus : 256;
    }
    if (grid < 0) return;
    if (hipMemsetAsync(d_ws, 0, 65536, stream) != hipSuccess) { fprintf(stderr, "kernel_launch: memset of the barrier words failed\n"); return; }
    ArgsS a{};
    for (int i = 0; i < 20; ++i) a.in[i] = (const float*)d_in[i];
    a.out = (float*)d_out; a.ws = (unsigned char*)d_ws;
    void* args[] = {&a};
    hipError_t e = hipLaunchCooperativeKernel((const void*)fwd_megakernel, dim3(grid), dim3(512), args, LDS_BYTES, stream);
    if (e != hipSuccess) fprintf(stderr, "cooperative launch failed: %s (grid %d)\n", hipGetErrorString(e), grid);
}
```

```cpp
#include <hip/hip_runtime.h>
#include <hip/hip_bf16.h>
#include <hip/hip_cooperative_groups.h>
#include <cstdio>
#include <cstdint>
extern __shared__ __attribute__((aligned(16))) unsigned char g_lds[];
constexpr int LDS_TOTAL = 147456, LDS_WIDTAB = LDS_TOTAL - 512;
__device__ __forceinline__ int otid() {
    const unsigned hw = (unsigned)__builtin_amdgcn_s_getreg((5 << 11) | 4) & 63u;
    int w = ((volatile __attribute__((address_space(3))) int*)((__attribute__((address_space(3))) unsigned char*)g_lds + LDS_WIDTAB))[hw];
    w = __builtin_amdgcn_readfirstlane(w);
    int l; asm volatile("v_mbcnt_lo_u32_b32 %0, -1, 0" : "=v"(l)); asm volatile("v_mbcnt_hi_u32_b32 %0, -1, %0" : "+v"(l));
    return w * 64 + l;
}
namespace pg8 {
#define PG8_LAS __attribute__((address_space(3)))
typedef unsigned short bf16_t;
typedef short bf16x8 __attribute__((ext_vector_type(8)));
typedef float f32x4 __attribute__((ext_vector_type(4)));
typedef unsigned u32x4 __attribute__((ext_vector_type(4)));
constexpr int BM = 256, BK = 64, HALF = 128, HTB = HALF * BK * 2  , STAGE_BYTES = 8 * HTB, NXCD = 8, WGM = 8;

__host__ __device__ __forceinline__ int lds_byte(int r, int c) { const int st = (r >> 4) * 2 + (c >> 5), rr = r & 15, cc = c & 31, ob = rr * 64 + cc * 2; return st * 1024 + (ob ^ (((ob >> 9) & 1) << 5)); }
__host__ __device__ __forceinline__ void stage_rc(int b, int& R, int& C) { const int st = b / 1024, sb = b % 1024, swz = sb ^ (((sb >> 9) & 1) << 5); R = (st >> 1) * 16 + swz / 64; C = (st & 1) * 32 + (swz % 64) / 2; }
__host__ __device__ __forceinline__ int perm32(int rho) { const int n = rho >> 4, i = rho & 15; return 8 * (i >> 2) + 4 * n + (i & 3); }

struct Unit { int pm, pn, ko; };
struct Gemm { const bf16_t* A; const bf16_t* Bt; int M, N, K, ldk; };

struct StaticOrder {
    int nM, nN, nwg, G, c;
    __host__ __device__ void init(int M, int N, int G_, int c_) { nM = M / BM; nN = N / BM; nwg = nM * nN; G = G_; c = c_; }
    __host__ __device__ bool next(int i, Unit& u) const {
        const long L = (long)i * G + c; if (L >= nwg) return false;
        int wgid = (int)L; { const int q = nwg / NXCD, r = nwg % NXCD, xcd = wgid % NXCD, off = wgid / NXCD; wgid = (xcd < r ? xcd * (q + 1) : r * (q + 1) + (xcd - r) * q) + off; }
        const int nig = WGM * nN, gid = wgid / nig, fm = gid * WGM, gsz = (nM - fm) < WGM ? (nM - fm) : WGM;
        u.pm = fm + ((wgid % nig) % gsz); u.pn = (wgid % nig) / gsz; u.ko = 0; return true;
    }
    __device__ __forceinline__ void a_ready(const Unit&) const {}
    __device__ __forceinline__ void done(const Unit&) const {}
};

__device__ __forceinline__ unsigned cvt_pk_bf16(float lo, float hi) { unsigned r; asm volatile("v_cvt_pk_bf16_f32 %0, %1, %2" : "=v"(r) : "v"(lo), "v"(hi)); return r; }
typedef float f32x2 __attribute__((ext_vector_type(2)));
__device__ __forceinline__ f32x2 gelu_pk(f32x2 v) {
    const f32x2 av = __builtin_elementwise_abs(v), d = av * 0.2316418882f + 1.0f;
    f32x2 t; t.x = __builtin_amdgcn_rcpf(d.x); t.y = __builtin_amdgcn_rcpf(d.y);
    f32x2 q = t * 0.5307027145f + (-0.7265760135f); q = q * t + 0.7107068705f; q = q * t + (-0.142248368f); q = q * t + 0.127414796f; q = q * t;
    const f32x2 s = (v * v) * (-0.72134752044f);
    f32x2 e; e.x = __builtin_amdgcn_exp2f(s.x); e.y = __builtin_amdgcn_exp2f(s.y);
    const f32x2 m = v * (q * e), r = v - m;
    f32x2 o; o.x = v.x < 0.f ? m.x : r.x; o.y = v.y < 0.f ? m.y : r.y; return o;
}

template <int ACT  > struct EpiBf16 {
    static constexpr bool PERM = true, AFTER_DRAIN = false; static_assert(ACT == 0 || ACT == 1, "EpiBf16: ACT is 0 (none) or 1 (gelu_pk)");
    bf16_t* O; int ldc; const float* bias; int split_cols; size_t split_stride; float scale0;
    __device__ __forceinline__ void operator()(const f32x4 (&acc)[2][2][4][2], const Unit& u, int wr, int wc, int fr, int fq) const {
        const int row0 = u.pm * BM + wr * 64 + fr; int colt = u.pn * BM; bf16_t* base = O;
        float sc = 1.f; if (split_cols) { const int t = colt / split_cols; base += (size_t)t * split_stride; colt -= t * split_cols; if (t == 0) sc = scale0; }
        const int col0 = colt + wc * 32 + 8 * fq, bcol0 = u.pn * BM + wc * 32 + 8 * fq;
        f32x4 bv[2][2];
#pragma unroll
        for (int bj = 0; bj < 2; ++bj)
#pragma unroll
            for (int n = 0; n < 2; ++n) bv[bj][n] = bias ? *(const f32x4*)(bias + bcol0 + bj * HALF + 4 * n) : (f32x4){0.f, 0.f, 0.f, 0.f};
#pragma unroll
        for (int ai = 0; ai < 2; ++ai)
#pragma unroll
            for (int m = 0; m < 4; ++m) { bf16_t* rowp = base + (size_t)(row0 + ai * HALF + m * 16) * ldc + col0;
#pragma unroll
                for (int bj = 0; bj < 2; ++bj) { f32x4 v0 = acc[ai][bj][m][0] + bv[bj][0], v1 = acc[ai][bj][m][1] + bv[bj][1];
                    if (ACT == 1) { f32x2 a = gelu_pk((f32x2){v0[0], v0[1]}), b = gelu_pk((f32x2){v0[2], v0[3]}), c = gelu_pk((f32x2){v1[0], v1[1]}), d = gelu_pk((f32x2){v1[2], v1[3]});
                        v0 = (f32x4){a.x, a.y, b.x, b.y}; v1 = (f32x4){c.x, c.y, d.x, d.y}; }
                    v0 = v0 * sc; v1 = v1 * sc; u32x4 w; w.x = cvt_pk_bf16(v0[0], v0[1]); w.y = cvt_pk_bf16(v0[2], v0[3]); w.z = cvt_pk_bf16(v1[0], v1[1]); w.w = cvt_pk_bf16(v1[2], v1[3]);
                    *(u32x4*)(rowp + bj * HALF) = w; } }
    }
};


template <class Epi, class Sched, bool ALIGN_EPI = false, bool SP2 = false>
__device__ __forceinline__ void gemm_phase(PG8_LAS unsigned char* lds, const Gemm g, const Sched& S, const Epi& E) {
    const int tid = otid(), wid = __builtin_amdgcn_readfirstlane(tid >> 6), lane = tid & 63, wr = wid >> 2, wc = wid & 3, fr = lane & 15, fq = lane >> 4;
    const int K = g.K, nt = K / BK, LDK = g.ldk ? g.ldk : g.K;
    unsigned voffA[2], voffB[2];
#pragma unroll
    for (int i = 0; i < 2; ++i) { int R, C; stage_rc(tid * 16 + i * 8192, R, C); const int Rb = Epi::PERM ? ((R & ~31) + perm32(R & 31)) : R;
        voffA[i] = (unsigned)(R * LDK + C) * 2u; voffB[i] = (unsigned)(Rb * LDK + C) * 2u; }
    const size_t kstep = (size_t)(BK * 2);
    const size_t hstep = (size_t)HALF * LDK * 2;
    const size_t tstep = 2 * hstep;
    const unsigned ldsw = (unsigned)wid * 1024u;
    const int aoff = lds_byte(wr * 64 + fr, fq * 8), boff = lds_byte(wc * 32 + fr, fq * 8);
#define PG8_SA(b, h) (((b) * 2 + (h)) * HTB)
#define PG8_SB(b, h) ((4 + (b) * 2 + (h)) * HTB)
#define PG8_STAGE(bufoff, gbase, voff) do { _Pragma("unroll") for (int _i = 0; _i < 2; ++_i) \
        __builtin_amdgcn_global_load_lds((const unsigned*)((const char*)(gbase) + (voff)[_i]), (PG8_LAS unsigned*)(lds + (bufoff) + ldsw + _i * 8192), 16, 0, 0); } while (0)
#define PG8_LDA(dst, b, h) do { _Pragma("unroll") for (int m = 0; m < 4; ++m) _Pragma("unroll") for (int k = 0; k < 2; ++k) dst[m][k] = *(const PG8_LAS bf16x8*)(lds + PG8_SA(b, h) + aoff + m * 2048 + k * 1024); } while (0)
#define PG8_LDB(dst, b, h) do { _Pragma("unroll") for (int n = 0; n < 2; ++n) _Pragma("unroll") for (int k = 0; k < 2; ++k) dst[n][k] = *(const PG8_LAS bf16x8*)(lds + PG8_SB(b, h) + boff + n * 2048 + k * 1024); } while (0)
#define PG8_MMA(ai, bj, At, Bt) do { __builtin_amdgcn_s_setprio(1); _Pragma("unroll") for (int m = 0; m < 4; ++m) _Pragma("unroll") for (int n = 0; n < 2; ++n) _Pragma("unroll") for (int k = 0; k < 2; ++k) \
        acc[ai][bj][m][n] = __builtin_amdgcn_mfma_f32_16x16x32_bf16(Bt[n][k], At[m][k], acc[ai][bj][m][n], 0, 0, 0); __builtin_amdgcn_s_setprio(0); } while (0)
#define PG8_WAIT_V(n) asm volatile("s_waitcnt vmcnt(" #n ")" ::: "memory")
#define PG8_WAIT_L(n) asm volatile("s_waitcnt lgkmcnt(" #n ")" ::: "memory")
#define PG8_BAR __builtin_amdgcn_s_barrier()
#define PG8_SCHED __builtin_amdgcn_sched_barrier(0)
    Unit cur, nxt; int ui = 0;
    if (!S.next(0, cur)) return;
    f32x4 acc[2][2][4][2];
#pragma unroll
    for (int a = 0; a < 2; ++a)
#pragma unroll
        for (int b = 0; b < 2; ++b)
#pragma unroll
            for (int m = 0; m < 4; ++m)
#pragma unroll
                for (int n = 0; n < 2; ++n) acc[a][b][m][n] = (f32x4){0.f, 0.f, 0.f, 0.f};
    bf16x8 At[4][2], B0[2][2], B1[2][2];
    const char* cA = (const char*)g.A + (size_t)cur.pm * tstep + (size_t)cur.ko * 2; const char* cB = (const char*)g.Bt + (size_t)cur.pn * tstep + (size_t)cur.ko * 2;
    S.a_ready(cur);
    if constexpr (SP2) {
        PG8_STAGE(PG8_SB(0, 0), cB, voffB); PG8_STAGE(PG8_SB(0, 1), cB + hstep, voffB); PG8_STAGE(PG8_SA(0, 0), cA, voffA); PG8_STAGE(PG8_SA(0, 1), cA + hstep, voffA);
        if (wr == 1) PG8_BAR;
        PG8_WAIT_V(2); PG8_BAR;
        PG8_STAGE(PG8_SB(1, 0), cB + kstep, voffB); PG8_STAGE(PG8_SA(1, 0), cA + kstep, voffA); PG8_STAGE(PG8_SB(1, 1), cB + hstep + kstep, voffB);
        PG8_WAIT_V(6); PG8_BAR;
    } else {
        PG8_STAGE(PG8_SB(0, 0), cB, voffB); PG8_STAGE(PG8_SA(0, 0), cA, voffA); PG8_STAGE(PG8_SB(0, 1), cB + hstep, voffB); PG8_STAGE(PG8_SA(0, 1), cA + hstep, voffA);
        if (wr == 1) PG8_BAR;
        PG8_WAIT_V(4); PG8_BAR;
        PG8_STAGE(PG8_SB(1, 0), cB + kstep, voffB); PG8_STAGE(PG8_SA(1, 0), cA + kstep, voffA); PG8_STAGE(PG8_SB(1, 1), cB + hstep + kstep, voffB);
        PG8_WAIT_V(6); PG8_BAR;
    }
    for (;;) {
        const bool has_next = S.next(ui + 1, nxt);
        const char* nA = has_next ? (const char*)g.A + (size_t)nxt.pm * tstep + (size_t)nxt.ko * 2 : cA; const char* nB = has_next ? (const char*)g.Bt + (size_t)nxt.pn * tstep + (size_t)nxt.ko * 2 : cB;
        for (int t = 0; t < nt; t += 2) {
            const bool last = (t == nt - 2);
            const char* a1 = cA + (size_t)(t + 1) * kstep;
            const char* a2 = last ? nA : cA + (size_t)(t + 2) * kstep; const char* b2 = last ? nB : cB + (size_t)(t + 2) * kstep;
            const char* a3 = a2 + kstep; const char* b3 = b2 + kstep;
            if (last && has_next) S.a_ready(nxt);
            if constexpr (SP2) {
            PG8_LDB(B0, 0, 0); PG8_LDB(B1, 0, 1); PG8_SCHED; PG8_LDA(At, 0, 0); PG8_STAGE(PG8_SA(1, 1), a1 + hstep, voffA);
            PG8_WAIT_V(8); PG8_WAIT_L(0); PG8_BAR; PG8_MMA(0, 0, At, B0); PG8_MMA(0, 1, At, B1); PG8_BAR; PG8_SCHED;
            PG8_LDA(At, 0, 1); PG8_STAGE(PG8_SB(0, 0), b2, voffB); PG8_STAGE(PG8_SB(0, 1), b2 + hstep, voffB); PG8_STAGE(PG8_SA(0, 0), a2, voffA);
            PG8_WAIT_V(8); PG8_WAIT_L(0); PG8_BAR; PG8_MMA(1, 0, At, B0); PG8_MMA(1, 1, At, B1); PG8_BAR; PG8_SCHED;
            PG8_LDB(B0, 1, 0); PG8_LDB(B1, 1, 1); PG8_SCHED; PG8_LDA(At, 1, 0); PG8_STAGE(PG8_SA(0, 1), a2 + hstep, voffA);
            PG8_WAIT_V(8); PG8_WAIT_L(0); PG8_BAR; PG8_MMA(0, 0, At, B0); PG8_MMA(0, 1, At, B1); PG8_BAR; PG8_SCHED;
            PG8_LDA(At, 1, 1); PG8_STAGE(PG8_SB(1, 0), b3, voffB); PG8_STAGE(PG8_SB(1, 1), b3 + hstep, voffB); PG8_STAGE(PG8_SA(1, 0), a3, voffA);
            PG8_WAIT_V(8); PG8_WAIT_L(0); PG8_BAR; PG8_MMA(1, 0, At, B0); PG8_MMA(1, 1, At, B1); PG8_BAR; PG8_SCHED;
            } else {
            PG8_LDB(B0, 0, 0); PG8_SCHED; PG8_LDA(At, 0, 0); PG8_STAGE(PG8_SA(1, 1), a1 + hstep, voffA);
            PG8_WAIT_L(8); PG8_BAR; PG8_WAIT_L(0); PG8_MMA(0, 0, At, B0); PG8_BAR; PG8_SCHED;
            PG8_LDB(B1, 0, 1); PG8_STAGE(PG8_SB(0, 0), b2, voffB);
            PG8_BAR; PG8_WAIT_L(0); PG8_MMA(0, 1, At, B1); PG8_BAR;
            PG8_LDA(At, 0, 1); PG8_STAGE(PG8_SA(0, 0), a2, voffA);
            PG8_BAR; PG8_WAIT_L(0); PG8_MMA(1, 0, At, B0); PG8_BAR; PG8_SCHED;
            PG8_STAGE(PG8_SB(0, 1), b2 + hstep, voffB);
            PG8_WAIT_V(6); PG8_BAR; PG8_MMA(1, 1, At, B1); PG8_BAR;
            PG8_LDB(B0, 1, 0); PG8_SCHED; PG8_LDA(At, 1, 0); PG8_STAGE(PG8_SA(0, 1), a2 + hstep, voffA);
            PG8_WAIT_L(8); PG8_BAR; PG8_WAIT_L(0); PG8_MMA(0, 0, At, B0); PG8_BAR; PG8_SCHED;
            PG8_LDB(B1, 1, 1); PG8_STAGE(PG8_SB(1, 0), b3, voffB);
            PG8_BAR; PG8_WAIT_L(0); PG8_MMA(0, 1, At, B1); PG8_BAR;
            PG8_LDA(At, 1, 1); PG8_STAGE(PG8_SA(1, 0), a3, voffA);
            PG8_BAR; PG8_WAIT_L(0); PG8_MMA(1, 0, At, B0); PG8_BAR; PG8_SCHED;
            PG8_STAGE(PG8_SB(1, 1), b3 + hstep, voffB);
            PG8_WAIT_V(6); PG8_BAR; PG8_MMA(1, 1, At, B1); PG8_BAR;
            }
        }
        if constexpr (ALIGN_EPI) { if (wr == 0) PG8_BAR; }
        if constexpr (!Epi::AFTER_DRAIN) { E(acc, cur, wr, wc, fr, fq); S.done(cur); }
        if (!has_next) break;
#pragma unroll
        for (int a = 0; a < 2; ++a)
#pragma unroll
            for (int b = 0; b < 2; ++b)
#pragma unroll
                for (int m = 0; m < 4; ++m)
#pragma unroll
                    for (int n = 0; n < 2; ++n) acc[a][b][m][n] = (f32x4){0.f, 0.f, 0.f, 0.f};
        cur = nxt; cA = nA; cB = nB; ++ui;
        if constexpr (ALIGN_EPI) { if (wr == 1) PG8_BAR; }
    }
    PG8_WAIT_V(0);
    if constexpr (!ALIGN_EPI) { if (wr == 0) PG8_BAR; }
    PG8_BAR;
    if constexpr (Epi::AFTER_DRAIN) { E.fused(acc, cur, wr, wc, fr, fq, lds, wid, lane); S.done(cur); }
#undef PG8_SA
#undef PG8_SB
#undef PG8_STAGE
#undef PG8_LDA
#undef PG8_LDB
#undef PG8_MMA
#undef PG8_WAIT_V
#undef PG8_WAIT_L
#undef PG8_BAR
#undef PG8_SCHED
}
}
namespace att {
constexpr int D = 128, PITCH = 2048;
constexpr float THR = 8.f;
constexpr bool WSKIP = false;
constexpr float SCALE = 0.08838834764831845f;
constexpr int NW = 8, QBLK = 32, KVBLK = 64, QB = NW * QBLK;
constexpr int SHM_V = KVBLK * D * 2, SHM_K = KVBLK * D * 2;
constexpr int LDS_BYTES = 2 * SHM_V + 2 * SHM_K + NW * 64 * 4 + 512;
using bf16 = __hip_bfloat16;
typedef short bf16x8 __attribute__((ext_vector_type(8)));
typedef short s16x4 __attribute__((ext_vector_type(4)));
typedef float f32x16 __attribute__((ext_vector_type(16)));
typedef float f32x4 __attribute__((ext_vector_type(4)));
typedef unsigned u32x4 __attribute__((ext_vector_type(4)));
template <class A, class Bt> struct same_t { static constexpr bool v = false; };
template <class A> struct same_t<A, A> { static constexpr bool v = true; };

#define BPERM(k) ((((k) >> 2) & 1) * 32 + (((k) >> 3) & 3) * 4 + ((k) & 3))
#define KSWZ(row, colB) ((row) * 256 + ((colB) ^ (((row) & 7) << 4)))
#define SBAR() __builtin_amdgcn_sched_barrier(0)
__device__ __forceinline__ int v_st(int k, int c) { const int kk = (k & ~0xC) | ((k & 4) << 1) | ((k & 8) >> 1); return ((kk >> 3) * 4 + (c >> 5)) * 512 + ((kk & 7) * 32 + (c & 31)) * 2; }
__device__ __forceinline__ int v_rd_base(int lane) { return ((lane & 3) << 3) | (((lane >> 2) & 3) << 6) | (((lane >> 4) & 1) << 5) | (((lane >> 5) & 1) << 8); }
constexpr int v_rd_off(int d0, int ks, int half) { return d0 * 512 + ks * 4096 + half * 2048; }
__device__ __forceinline__ int crow(int r, int hi) { return (r & 3) + 8 * (r >> 2) + 4 * hi; }
__device__ __forceinline__ unsigned cvtpk(float lo, float hi) {
    unsigned r; asm volatile("v_cvt_pk_bf16_f32 %0, %1, %2" : "=v"(r) : "v"(lo), "v"(hi)); return r;
}
__device__ __forceinline__ bf16x8 pack8(f32x4 a, f32x4 b) {
    u32x4 w = {cvtpk(a[0], a[1]), cvtpk(a[2], a[3]), cvtpk(b[0], b[1]), cvtpk(b[2], b[3])};
    return *reinterpret_cast<bf16x8*>(&w);
}
template <class T> __device__ __forceinline__ bf16x8 load8(const T* p) {
    if constexpr (same_t<T, float>::v) { return pack8(*(const f32x4*)p, *(const f32x4*)(p + 4)); }
    else { return *reinterpret_cast<const bf16x8*>(p); }
}
__device__ __forceinline__ void mask_tile(f32x16& p0, f32x16& p1, int dq, unsigned W) {
    const float NEG = -__builtin_inff();
#pragma unroll
    for (int r = 0; r < 16; ++r) {
        const int c = (r & 3) + 8 * (r >> 2);
        if ((unsigned)(dq - c) >= W) p0[r] = NEG;
        if ((unsigned)(dq - c - 32) >= W) p1[r] = NEG;
    }
}
__device__ __forceinline__ void partialSM(f32x16& p0, f32x16& p1, float& m_reg, float& mn, float& alpha) {
    float pmax = p0[0]; for (int r = 1; r < 16; ++r) pmax = fmaxf(pmax, p0[r]); for (int r = 0; r < 16; ++r) pmax = fmaxf(pmax, p1[r]);
    { auto rr = __builtin_amdgcn_permlane32_swap(__float_as_uint(pmax), __float_as_uint(pmax), false, false);
      pmax = fmaxf(__uint_as_float(rr[0]), __uint_as_float(rr[1])); }
    constexpr float C2 = 1.4426950408889634f * SCALE;
    if (__builtin_expect(__all((pmax - m_reg) * SCALE <= THR), 1)) { mn = m_reg; alpha = 1.f; }
    else { mn = fmaxf(m_reg, pmax); alpha = __builtin_amdgcn_exp2f((m_reg - mn) * C2); m_reg = mn; }
    const float mnL = -mn * C2;
    for (int r = 0; r < 16; ++r) p0[r] = fmaf(p0[r], C2, mnL); for (int r = 0; r < 16; ++r) p1[r] = fmaf(p1[r], C2, mnL);
    for (int r = 0; r < 16; ++r) p0[r] = __builtin_amdgcn_exp2f(p0[r]);
}
__device__ __forceinline__ void finishSM(f32x16& p0, f32x16& p1, float alpha, float& l_reg, bf16x8& pa0, bf16x8& pa1, bf16x8& pa2, bf16x8& pa3) {
    for (int r = 0; r < 16; ++r) p1[r] = __builtin_amdgcn_exp2f(p1[r]);
    float ps = 0; for (int r = 0; r < 16; ++r) ps += p0[r]; for (int r = 0; r < 16; ++r) ps += p1[r];
    { auto rr = __builtin_amdgcn_permlane32_swap(__float_as_uint(ps), __float_as_uint(ps), false, false);
      ps = __uint_as_float(rr[0]) + __uint_as_float(rr[1]); }
    l_reg = l_reg * alpha + ps;
#define PK4(P, B_, OUT) do { unsigned a0 = cvtpk(P[B_+0], P[B_+1]), a1 = cvtpk(P[B_+2], P[B_+3]);                          \
        unsigned b0 = cvtpk(P[B_+4], P[B_+5]), b1 = cvtpk(P[B_+6], P[B_+7]);                                             \
        auto r0 = __builtin_amdgcn_permlane32_swap(a0, b0, false, false); auto r1 = __builtin_amdgcn_permlane32_swap(a1, b1, false, false); \
        u32x4 w = {r0[0], r1[0], r0[1], r1[1]}; OUT = *reinterpret_cast<bf16x8*>(&w); } while (0)
    PK4(p0, 0, pa0); PK4(p0, 8, pa1); PK4(p1, 0, pa2); PK4(p1, 8, pa3);
#undef PK4
}
template <int KB, bool SK>
__device__ __forceinline__ void qkt(f32x16& p0, f32x16& p1, const char* K_lds, const float* B_lds, int r32, int hi, const bf16x8* qr, bool act) {
    if (SK && !act) { const float NEG = -__builtin_inff();
#pragma unroll
        for (int r = 0; r < 16; ++r) { p0[r] = NEG; p1[r] = NEG; } return; }
#ifdef ATT_NOBIAS
    p0 = f32x16{}; p1 = f32x16{};
#else
    p0 = *(const f32x16*)(B_lds + KB * 64 + hi * 32); p1 = *(const f32x16*)(B_lds + KB * 64 + hi * 32 + 16);
#endif
    const char* kb[4];
#pragma unroll
    for (int dd = 0; dd < 4; ++dd) kb[dd] = K_lds + KB * SHM_K + KSWZ(r32, (dd * 16 + hi * 8) * 2);
#pragma unroll
    for (int d0 = 0; d0 < 8; ++d0) { const char* a = kb[d0 & 3] + (d0 >> 2) * 128;
        bf16x8 b0 = *reinterpret_cast<const bf16x8*>(a);
        bf16x8 b1 = *reinterpret_cast<const bf16x8*>(a + 32 * 256);
        p0 = __builtin_amdgcn_mfma_f32_32x32x16_bf16(b0, qr[d0], p0, 0, 0, 0);
        p1 = __builtin_amdgcn_mfma_f32_32x32x16_bf16(b1, qr[d0], p1, 0, 0, 0); }
}
template <int VB, bool SK>
__device__ __forceinline__ void pv_tile(f32x16* o, int vb0, bf16x8 pa0, bf16x8 pa1, bf16x8 pa2, bf16x8 pa3, bool act) {
    if (SK && !act) return;
#define TRRD(dst, off) asm volatile("ds_read_b64_tr_b16 %0, %1 offset:%2" : "=&v"(dst) : "v"(vb0), "i"(off) : "memory")
#define PV_D0(d0) do { s16x4 l0, l1, l2, l3, h0, h1, h2, h3; constexpr int b_ = VB * SHM_V + v_rd_off(d0, 0, 0);     \
        TRRD(l0, b_); TRRD(h0, b_ + 2048); TRRD(l1, b_ + 4096); TRRD(h1, b_ + 6144); TRRD(l2, b_ + 8192); TRRD(h2, b_ + 10240); TRRD(l3, b_ + 12288); TRRD(h3, b_ + 14336); \
        asm volatile("s_waitcnt lgkmcnt(0)" ::: "memory"); SBAR();                 \
        o[d0] = __builtin_amdgcn_mfma_f32_32x32x16_bf16(pa0, (bf16x8){l0[0], l0[1], l0[2], l0[3], h0[0], h0[1], h0[2], h0[3]}, o[d0], 0, 0, 0);   \
        o[d0] = __builtin_amdgcn_mfma_f32_32x32x16_bf16(pa1, (bf16x8){l1[0], l1[1], l1[2], l1[3], h1[0], h1[1], h1[2], h1[3]}, o[d0], 0, 0, 0);   \
        o[d0] = __builtin_amdgcn_mfma_f32_32x32x16_bf16(pa2, (bf16x8){l2[0], l2[1], l2[2], l2[3], h2[0], h2[1], h2[2], h2[3]}, o[d0], 0, 0, 0);   \
        o[d0] = __builtin_amdgcn_mfma_f32_32x32x16_bf16(pa3, (bf16x8){l3[0], l3[1], l3[2], l3[3], h3[0], h3[1], h3[2], h3[3]}, o[d0], 0, 0, 0); } while (0)
    PV_D0(0); PV_D0(1); PV_D0(2); PV_D0(3);
#undef PV_D0
#undef TRRD
}

template <class TIn, class TOut> struct BlockRef { const TIn* Q; const TIn* K; const TIn* V; TOut* O; const float* CB; const TIn* Z; int P0; };
template <class TIn> struct Seam {
    bf16x8 qr[8];
    bf16x8 st_v0, st_v1, st_k0, st_k1; float st_b0; f32x4 sf0, sf1, sf2, sf3;
    f32x4 tq[16];
};
__device__ __forceinline__ int swa_jlo(int P0, int W) { const int lowk = P0 - W + 1; return lowk > 0 ? lowk / KVBLK : 0; }
#define ROW(p, k0, rr) ((p) + (unsigned)(((k0) + (rr)) * PITCH + sc))
#define VMW() asm volatile("s_waitcnt vmcnt(0)" ::: "memory")
#define VMWN(n) asm volatile("s_waitcnt vmcnt(%0)" :: "i"(n) : "memory")
#define SLOAD_H(Kp, Vp, Cp, k0) do { S.st_b0 = (Cp)[(unsigned)((k0) + sr + 32 * (tid & 1))]; S.st_v0 = load8<TIn>(ROW(Vp, k0, sr)); S.st_v1 = load8<TIn>(ROW(Vp, k0, 32 + sr));              \
                         S.st_k0 = load8<TIn>(ROW(Kp, k0, sr)); S.st_k1 = load8<TIn>(ROW(Kp, k0, 32 + sr)); } while (0)
#define SWRITE_HK(bf) do { B_lds[(bf) * 64 + sr + 32 * (tid & 1)] = S.st_b0; *(bf16x8*)(K_lds + (bf) * SHM_K + kws) = S.st_k0; *(bf16x8*)(K_lds + (bf) * SHM_K + kws + 32 * 256) = S.st_k1; } while (0)
#define SWRITE_HV(bf) do { *(bf16x8*)(V_lds + (bf) * SHM_V + vst0) = S.st_v0; *(bf16x8*)(V_lds + (bf) * SHM_V + vst1) = S.st_v1; } while (0)
#define SWRITE_H(bf) do { SWRITE_HV(bf); SWRITE_HK(bf); } while (0)
#define SLOAD_F(p, k0) do { S.sf0 = *(const f32x4*)ROW(p, k0, sr); S.sf1 = *(const f32x4*)(ROW(p, k0, sr) + 4);                \
                            S.sf2 = *(const f32x4*)ROW(p, k0, 32 + sr); S.sf3 = *(const f32x4*)(ROW(p, k0, 32 + sr) + 4); } while (0)
#define SWRITE_KF(bf) do { *(bf16x8*)(K_lds + (bf) * SHM_K + kws) = pack8(S.sf0, S.sf1); *(bf16x8*)(K_lds + (bf) * SHM_K + kws + 32 * 256) = pack8(S.sf2, S.sf3); } while (0)
#define SWRITE_VF(bf) do { *(bf16x8*)(V_lds + (bf) * SHM_V + vst0) = pack8(S.sf0, S.sf1); *(bf16x8*)(V_lds + (bf) * SHM_V + vst1) = pack8(S.sf2, S.sf3); } while (0)
template <class TIn, class TOut>
__device__ __forceinline__ void causal_swa_prime(const BlockRef<TIn, TOut>& cur, int W, char* lds, Seam<TIn>& S) {
    constexpr bool F32 = same_t<TIn, float>::v;
    const int tid = otid(), wid = __builtin_amdgcn_readfirstlane(tid >> 6), lane = tid & 63, r32 = lane & 31, hi = lane >> 5;
    const int sr = tid >> 4, sc = (tid & 15) * 8, kws = KSWZ(sr, sc * 2); char* K_lds = lds + 2 * SHM_V; float* B_lds = (float*)(lds + 2 * SHM_V + 2 * SHM_K + NW * 64 * 4);
    const int kb0 = swa_jlo(cur.P0, W) * KVBLK;
    for (int d0 = 0; d0 < 8; ++d0) S.qr[d0] = load8<TIn>(cur.Q + (unsigned)((wid * QBLK + r32) * PITCH + d0 * 16 + hi * 8));
    if constexpr (F32) { SLOAD_F((const float*)cur.K, kb0); VMW(); SWRITE_KF(0); SBAR(); SLOAD_F((const float*)cur.V, kb0); }
    else { SLOAD_H(cur.K, cur.V, cur.CB, kb0); VMW(); SWRITE_HK(0); }
    __syncthreads();
}
template <class TIn, class TOut>
__device__ __forceinline__ void causal_swa_block(const BlockRef<TIn, TOut>& cur, const BlockRef<TIn, TOut>& nxt, int skv, int W, char* lds, Seam<TIn>& S) {
    constexpr bool F32 = same_t<TIn, float>::v;
    const int tid = otid(), wid = __builtin_amdgcn_readfirstlane(tid >> 6), lane = tid & 63, r32 = lane & 31, hi = lane >> 5;
    const int j_lo = swa_jlo(cur.P0, W);
    int j_hi = (cur.P0 + QB - 1) / KVBLK + 1; if (j_hi > skv / KVBLK) j_hi = skv / KVBLK;
    const int NT = j_hi - j_lo;
    const int kbn = swa_jlo(nxt.P0, W) * KVBLK;
    const int qlo = cur.P0 + wid * QBLK, qm = qlo + r32 - 4 * hi;
    char* V_lds = lds; char* K_lds = lds + 2 * SHM_V; float* B_lds = (float*)(lds + 2 * SHM_V + 2 * SHM_K + NW * 64 * 4);
    float* ws = (float*)(lds + 2 * SHM_V + 2 * SHM_K) + wid * 64; float* li_l = ws, * al_l = ws + 32;
    float m_reg = -1e30f, l_reg = 0; f32x16 o[4] = {};
    const int sr = tid >> 4, sc = (tid & 15) * 8, vst0 = v_st(sr, sc), vst1 = v_st(32 + sr, sc), kws = KSWZ(sr, sc * 2);
    const int vb0 = (int)(uintptr_t)V_lds + v_rd_base(lane);
    const TIn* Kh = cur.K; const TIn* Vh = cur.V; const float* Ch = cur.CB;
#define RESC(a) do { if (__any((a) < 1.f)) { if (hi == 0) al_l[r32] = (a); asm volatile("s_waitcnt lgkmcnt(0)" ::: "memory");              \
                     for (int d_ = 0; d_ < 4; ++d_) for (int r = 0; r < 16; ++r) o[d_][r] *= al_l[crow(r, hi)]; } } while (0)
#define KBASE(t) ((j_lo + (t)) * KVBLK)
#define ACT(t) (KBASE(t) <= qlo + QBLK - 1 && KBASE(t) + KVBLK - 1 >= qlo - W + 1)
#define MASKT(P0_, P1_, t) do { const int kb_ = KBASE(t); if ((!SK || ACT(t)) && (kb_ + KVBLK - 1 > qlo || kb_ <= qlo + QBLK - 1 - W)) mask_tile(P0_, P1_, qm - kb_, (unsigned)W); } while (0)
    constexpr int NQL = F32 ? 16 : 8;
    constexpr bool SK = WSKIP && !F32;
#define SEAM_K0() do { VMWN(NQL); if constexpr (F32) { SWRITE_KF(0); SBAR(); SLOAD_F((const float*)nxt.V, kbn); } else { SWRITE_HK(0); } SBAR(); } while (0)
    f32x16 pA0, pA1, pB0, pB1; float mnA, mnB, alA, alB; bf16x8 pa0, pa1, pa2, pa3;
    if constexpr (F32) { VMW(); SWRITE_VF(0); SBAR(); } else { SWRITE_HV(0); SBAR(); }
    if (NT > 1) { if constexpr (F32) SLOAD_F((const float*)Kh, KBASE(1)); else SLOAD_H(Kh, Vh, Ch, KBASE(1)); }
    SBAR(); qkt<0, SK>(pA0, pA1, K_lds, B_lds, r32, hi, S.qr, ACT(0));
    if constexpr (F32) { if (NT > 1) { VMW(); SWRITE_KF(1); SBAR(); SLOAD_F((const float*)Vh, KBASE(1)); } }
    MASKT(pA0, pA1, 0); partialSM(pA0, pA1, m_reg, mnA, alA);
    if (NT > 1) { VMW(); if constexpr (F32) { SWRITE_VF(1); SBAR(); if (NT > 2) SLOAD_F((const float*)Kh, KBASE(2)); } else SWRITE_H(1); }
    __syncthreads();
#define HALF_STEP(PX0, PX1, mnX, alX, PY0, PY1, alY, t, KB, VB, SB) do {                                                      \
        SBAR(); qkt<KB, SK>(PX0, PX1, K_lds, B_lds, r32, hi, S.qr, ACT(t));                                             \
        finishSM(PY0, PY1, alY, l_reg, pa0, pa1, pa2, pa3); SBAR();                                                           \
        if ((t) + 1 < NT) { if constexpr (F32) { VMW(); SWRITE_KF(SB); SBAR(); SLOAD_F((const float*)Vh, KBASE((t) + 1)); }  \
                            else { SLOAD_H(Kh, Vh, Ch, KBASE((t) + 1)); } SBAR(); }                                               \
        pv_tile<VB, SK>(o, vb0, pa0, pa1, pa2, pa3, ACT((t) - 1)); MASKT(PX0, PX1, (t)); partialSM(PX0, PX1, m_reg, mnX, alX);                                        \
        __syncthreads();                                                                                                      \
        if ((t) + 1 < NT) { VMW(); if constexpr (F32) { SWRITE_VF(SB); SBAR(); if ((t) + 2 < NT) SLOAD_F((const float*)Kh, KBASE((t) + 2)); } \
                            else { SWRITE_H(SB); } }                                                                          \
        RESC(alX); __syncthreads(); } while (0)
    for (int t = 1; t + 1 < NT; t += 2) {
        HALF_STEP(pB0, pB1, mnB, alB, pA0, pA1, alA, t, 1, 0, 0);
        HALF_STEP(pA0, pA1, mnA, alA, pB0, pB1, alB, t + 1, 0, 1, 1);
    }
    const bool even = (NT & 1) == 0;
    if (even) { SBAR(); qkt<1, SK>(pB0, pB1, K_lds, B_lds, r32, hi, S.qr, ACT(NT - 1)); SBAR(); }
#define QROW(e) (nxt.Q + (size_t)(wid * QBLK + r32) * PITCH + ((e) >> 1) * 16 + hi * 8 + ((e) & 1) * 4)
    if constexpr (F32) { SLOAD_F((const float*)nxt.K, kbn); SBAR();
#pragma unroll
        for (int e = 0; e < 8; ++e) S.tq[e] = *(const f32x4*)QROW(e); }
    else { SLOAD_H(nxt.K, nxt.V, nxt.CB, kbn); SBAR();
#pragma unroll
        for (int d0 = 0; d0 < 8; ++d0) S.qr[d0] = load8<TIn>(nxt.Q + (unsigned)((wid * QBLK + r32) * PITCH + d0 * 16 + hi * 8)); }
    SBAR();
    finishSM(pA0, pA1, alA, l_reg, pa0, pa1, pa2, pa3); SBAR();
    if constexpr (F32) {
#pragma unroll
        for (int e = 8; e < 16; ++e) S.tq[e] = *(const f32x4*)QROW(e); SBAR(); }
#undef QROW
    pv_tile<0, SK>(o, vb0, pa0, pa1, pa2, pa3, ACT(even ? NT - 2 : NT - 1));
    if (even) { MASKT(pB0, pB1, NT - 1); partialSM(pB0, pB1, m_reg, mnB, alB); __syncthreads(); RESC(alB);
        finishSM(pB0, pB1, alB, l_reg, pa0, pa1, pa2, pa3); SBAR(); pv_tile<1, SK>(o, vb0, pa0, pa1, pa2, pa3, ACT(NT - 1)); }
    SBAR(); SEAM_K0();
    if (hi == 0) li_l[r32] = l_reg; asm volatile("s_waitcnt lgkmcnt(0)" ::: "memory");
    float rli[16];
#pragma unroll
    for (int r = 0; r < 16; ++r) rli[r] = __builtin_amdgcn_rcpf(li_l[crow(r, hi)]);
    TOut* Ow = cur.O + (size_t)(wid * QBLK) * PITCH; const TIn* Zw = cur.Z + (size_t)(wid * QBLK) * PITCH; unsigned lo_ = (unsigned)(4 * hi) * PITCH + r32; asm volatile("" : "+v"(lo_));
#pragma unroll
    for (int r = 0; r < 16; ++r) { const int orow = crow(r, hi);
#pragma unroll
        for (int d0 = 0; d0 < 4; ++d0) { const float v = o[d0][r] * rli[r];
            if constexpr (same_t<TOut, float>::v) { Ow[(size_t)orow * PITCH + d0 * 32 + r32] = v; }
            else { const float vn = __shfl_xor(v, 1);
                   if ((r32 & 1) == 0) { const unsigned of_ = lo_ + (unsigned)(orow - 4 * hi) * PITCH + d0 * 32; const unsigned zz = *(const unsigned*)(Zw + of_);
                       *(unsigned*)(Ow + of_) = cvtpk(v * __uint_as_float(zz << 16), vn * __uint_as_float(zz & 0xffff0000u)); } } } }
    if constexpr (F32) {
#pragma unroll
        for (int d0 = 0; d0 < 8; ++d0) S.qr[d0] = pack8(S.tq[2 * d0], S.tq[2 * d0 + 1]); }
    __syncthreads();
#undef RESC
#undef KBASE
#undef ACT
#undef MASKT
#undef SEAM_K0
#undef HALF_STEP
}
#undef ROW
#undef VMW
#undef VMWN
#undef SLOAD_H
#undef SWRITE_HK
#undef SWRITE_HV
#undef SWRITE_H
#undef SLOAD_F
#undef SWRITE_KF
#undef SWRITE_VF
}

namespace cg = cooperative_groups;
#define LAS __attribute__((address_space(3)))
typedef unsigned short bf16_t;
typedef float f32x4 __attribute__((ext_vector_type(4)));
typedef float f32x2 __attribute__((ext_vector_type(2)));
typedef unsigned u32x4 __attribute__((ext_vector_type(4)));
typedef unsigned u32x2 __attribute__((ext_vector_type(2)));
typedef short bf16x8 __attribute__((ext_vector_type(8)));

constexpr int DM = 1024, EB = 2048, MP = 32768, MS = 128, MV = MP + MS  , MA = 33024  ;
constexpr int SEQ = 4096, NBH = 128, PAST = 2048, TS = 16, SKS = 2112  ;
constexpr int NFIN = 8448;
constexpr float RMS_EPS = 1e-6f, LN_EPS = 1e-5f;
constexpr size_t O_YP = 0, O_YS = 33554432, O_GV = 33685504, O_FKP = 34209792, O_FVP = 168427520, O_FLP = 302645248, O_FKS = 303693824, O_FVS = 304218112, O_FLS = 304742400;
constexpr size_t MiB = 1u << 20;
constexpr size_t WS_WGIN = 1 * MiB;
constexpr size_t WS_WGOUT = 25 * MiB;
constexpr size_t WS_WFIN = 33 * MiB;
constexpr size_t WS_WFOUT = 66 * MiB;
constexpr size_t WS_WPP = 74 * MiB;
constexpr size_t WS_WPG = 76 * MiB;
constexpr size_t WS_WM = 84 * MiB;
constexpr size_t WS_WMS = 85 * MiB;
constexpr size_t WS_PB = 88 * MiB;
constexpr size_t WS_HX = 105 * MiB;
constexpr size_t WS_TB = 170 * MiB;
constexpr size_t WS_STAT = 756 * MiB;
constexpr size_t WS_CBP = 236 * MiB;
constexpr size_t WS_CBS = 238 * MiB + 512 * 1024;
constexpr size_t WS_R0 = 240 * MiB, RSZ = 129 * MiB;
constexpr size_t WS_END = 775 * MiB;
constexpr size_t WS_PART = 766 * MiB;
constexpr size_t WS_DUMMY = 776 * MiB;
constexpr int LDS_BYTES = LDS_TOTAL;
#ifndef PROBE_DUP
#define PROBE_DUP 0
#endif

struct ArgsS { const float* in[20]; float* out; unsigned char* ws; };
typedef const __attribute__((address_space(4))) ArgsS* ArgsP;
struct Args { ArgsP p; };
__device__ __forceinline__ Args getargs() { ArgsP p = (ArgsP)__builtin_amdgcn_kernarg_segment_ptr(); asm volatile("" : "+s"(p)); Args a; a.p = p; return a; }

__device__ __forceinline__ unsigned f2bf(float f) { unsigned u = __builtin_bit_cast(unsigned, f); return (u + 0x7fffu + ((u >> 16) & 1u)) >> 16; }
__device__ __forceinline__ unsigned pk2(float lo, float hi) { return pg8::cvt_pk_bf16(lo, hi); }
__device__ __forceinline__ float bflo(unsigned u) { return __uint_as_float(u << 16); }
__device__ __forceinline__ float bfhi(unsigned u) { return __uint_as_float(u & 0xffff0000u); }
__device__ __forceinline__ float wave_sum(float v) { for (int o = 32; o > 0; o >>= 1) v += __shfl_xor(v, o); return v; }
__device__ __forceinline__ float wave_max(float v) { for (int o = 32; o > 0; o >>= 1) v = fmaxf(v, __shfl_xor(v, o)); return v; }
__device__ __forceinline__ float gelu_t(float x) { const float t = x * x; const float e = __builtin_amdgcn_exp2f((-2.3022082f * x) * (1.f + 0.044715f * t)); return x * __builtin_amdgcn_rcpf(1.f + e); }
__device__ __forceinline__ float silu_f(float x) { return x * __builtin_amdgcn_rcpf(1.f + __builtin_amdgcn_exp2f(-1.4426950408889634f * x)); }
__device__ __forceinline__ float sigm_f(float x) { return __builtin_amdgcn_rcpf(1.f + __builtin_amdgcn_exp2f(-1.4426950408889634f * x)); }
__device__ __forceinline__ float logsig_f(float x) { const float e = __expf(-fabsf(x)); const float l = e < 0.03f ? e * (1.f - e * (0.5f - e * (0.33333334f - 0.25f * e))) : __logf(1.f + e); return fminf(x, 0.f) - l; }

using pg8::Unit; using pg8::HALF; using pg8::BM;
struct EpiGmlpIn {
    static constexpr bool PERM = true, AFTER_DRAIN = false;
    bf16_t* U; bf16_t* VT; bf16_t* ZS; float* stat;
    __device__ __forceinline__ void operator()(const pg8::f32x4 (&acc)[2][2][4][2], const Unit& u, int wr, int wc, int fr_, int fq_) const {
        const int lane_ = otid() & 63, fr = lane_ & 15, fq = lane_ >> 4; (void)fr_; (void)fq_;
        const int row0 = u.pm * BM + wr * 64 + fr, colt = u.pn * BM, region = colt >> 11, cb = (colt & 2047) + wc * 32 + 8 * fq;
#pragma unroll
        for (int ai = 0; ai < 2; ++ai)
#pragma unroll
            for (int m = 0; m < 4; ++m) {
                const int row = row0 + ai * HALF + m * 16; float s = 0.f, q = 0.f;
#pragma unroll
                for (int bj = 0; bj < 2; ++bj) {
                    const int col = cb + bj * HALF; const pg8::f32x4 v0 = acc[ai][bj][m][0], v1 = acc[ai][bj][m][1];
                    float x[8] = {v0[0], v0[1], v0[2], v0[3], v1[0], v1[1], v1[2], v1[3]};
                    if (region == 2) {
#pragma unroll
                        for (int e = 0; e < 8; ++e) x[e] = silu_f(x[e]);
                    } else {
#pragma unroll
                        for (int e = 0; e < 8; ++e) x[e] = gelu_t(x[e]);
                    }
                    u32x4 w; w.x = pk2(x[0], x[1]); w.y = pk2(x[2], x[3]); w.z = pk2(x[4], x[5]); w.w = pk2(x[6], x[7]);
                    if (region == 1) {
                        bf16_t* vp = VT + ((size_t)(row >> 7) * 2048 + col) * 128 + (row & 127);
                        const unsigned ww[4] = {w.x, w.y, w.z, w.w};
#pragma unroll
                        for (int e = 0; e < 4; ++e) { vp[(2 * e) * 128] = (bf16_t)(ww[e] & 0xffffu); vp[(2 * e + 1) * 128] = (bf16_t)(ww[e] >> 16);
                            const float a = bflo(ww[e]), b = bfhi(ww[e]); s += a + b; q += a * a + b * b; }
                    } else {
                        bf16_t* dst = (region == 0 ? U : ZS) + (size_t)row * 2048 + col;
                        *(u32x4*)dst = w;
                    }
                }
                if (region == 1) {
                    s += __shfl_xor(s, 16); s += __shfl_xor(s, 32); q += __shfl_xor(q, 16); q += __shfl_xor(q, 32);
                    if (fq == 0) { const int slot = ((colt & 2047) >> 6) + wc; stat[(size_t)row * 64 + slot] = s; stat[(size_t)row * 64 + 32 + slot] = q; }
                }
            }
    }
};
struct EpiFoxIn {
    static constexpr bool PERM = true, AFTER_DRAIN = false;
    bf16_t* QB; bf16_t* KB; bf16_t* VB; bf16_t* ZS; float* okp; float* ovp; float* olp; float* oks; float* ovs; float* ols; const float* bf;
    __device__ __forceinline__ void operator()(const pg8::f32x4 (&acc)[2][2][4][2], const Unit& u, int wr, int wc, int fr_, int fq_) const {
        const int lane_ = otid() & 63, fr = lane_ & 15, fq = lane_ >> 4; (void)fr_; (void)fq_;
        const int row0 = u.pm * BM + wr * 64 + fr, colt = u.pn * BM, region = colt >> 11, cb = (colt & 2047) + wc * 32 + 8 * fq;
        if (region == 4) {
            if (wc != 0 || fq >= 2) return;
#pragma unroll
            for (int ai = 0; ai < 2; ++ai)
#pragma unroll
                for (int m = 0; m < 4; ++m) {
                    const int row = row0 + ai * HALF + m * 16; if (row >= MV) continue;
                    const pg8::f32x4 v0 = acc[ai][0][m][0], v1 = acc[ai][0][m][1];
                    const f32x4 b0 = *(const f32x4*)(bf + 8 * fq), b1 = *(const f32x4*)(bf + 8 * fq + 4);
                    f32x4 r0, r1;
#pragma unroll
                    for (int e = 0; e < 4; ++e) { r0[e] = logsig_f(v0[e] + b0[e]); r1[e] = logsig_f(v1[e] + b1[e]); }
                    float* dst = row < MP ? olp + (size_t)row * 16 + 8 * fq : ols + (size_t)(row - MP) * 16 + 8 * fq;
                    *(f32x4*)dst = r0; *(f32x4*)(dst + 4) = r1;
                }
            return;
        }
        bf16_t* B = region == 0 ? QB : region == 1 ? KB : region == 2 ? VB : ZS;
#pragma unroll
        for (int ai = 0; ai < 2; ++ai)
#pragma unroll
            for (int m = 0; m < 4; ++m) {
                const int row = row0 + ai * HALF + m * 16;
#pragma unroll
                for (int bj = 0; bj < 2; ++bj) {
                    const int col = cb + bj * HALF; pg8::f32x4 v0 = acc[ai][bj][m][0], v1 = acc[ai][bj][m][1];
                    if (region == 3) {
#pragma unroll
                        for (int e = 0; e < 4; ++e) { v0[e] = silu_f(v0[e]); v1[e] = silu_f(v1[e]); }
                    }
                    u32x4 w; w.x = pk2(v0[0], v0[1]); w.y = pk2(v0[2], v0[3]); w.z = pk2(v1[0], v1[1]); w.w = pk2(v1[2], v1[3]);
                    *(u32x4*)(B + (size_t)row * 2048 + col) = w;
                    if ((region == 1 || region == 2) && row < MV) {
                        float* o = region == 1 ? (row < MP ? okp + (size_t)row * 2048 : oks + (size_t)(row - MP) * 2048) : (row < MP ? ovp + (size_t)row * 2048 : ovs + (size_t)(row - MP) * 2048);
                        *(pg8::f32x4*)(o + col) = v0; *(pg8::f32x4*)(o + col + 4) = v1;
                    }
                }
            }
    }
};
struct EpiT {
    static constexpr bool PERM = true, AFTER_DRAIN = false;
    bf16_t* O; int ldc;
    __device__ __forceinline__ void operator()(const pg8::f32x4 (&acc)[2][2][4][2], const Unit& u, int wr, int wc, int fr_, int fq_) const {
        const int lane_ = otid() & 63, fr = lane_ & 15, fq = lane_ >> 4; (void)fr_; (void)fq_;
        const int row0 = u.pm * BM + wr * 64 + fr, col0 = u.pn * BM + wc * 32 + 8 * fq;
#pragma unroll
        for (int ai = 0; ai < 2; ++ai)
#pragma unroll
            for (int m = 0; m < 4; ++m) { bf16_t* rp = O + (size_t)(row0 + ai * HALF + m * 16) * ldc + col0;
#pragma unroll
                for (int bj = 0; bj < 2; ++bj) { const pg8::f32x4 v0 = acc[ai][bj][m][0], v1 = acc[ai][bj][m][1];
                    u32x4 w; w.x = pk2(v0[0], v0[1]); w.y = pk2(v0[2], v0[3]); w.z = pk2(v1[0], v1[1]); w.w = pk2(v1[2], v1[3]);
                    *(u32x4*)(rp + bj * HALF) = w; } }
    }
};
struct EpiF32 {
    static constexpr bool PERM = true, AFTER_DRAIN = false;
    float* O; int ldc;
    __device__ __forceinline__ void operator()(const pg8::f32x4 (&acc)[2][2][4][2], const Unit& u, int wr, int wc, int fr_, int fq_) const {
        const int lane_ = otid() & 63, fr = lane_ & 15, fq = lane_ >> 4; (void)fr_; (void)fq_;
        const int row0 = u.pm * BM + wr * 64 + fr, col0 = u.pn * BM + wc * 32 + 8 * fq;
#pragma unroll
        for (int ai = 0; ai < 2; ++ai)
#pragma unroll
            for (int m = 0; m < 4; ++m) { float* rp = O + (size_t)(row0 + ai * HALF + m * 16) * ldc + col0;
#pragma unroll
                for (int bj = 0; bj < 2; ++bj) { *(pg8::f32x4*)(rp + bj * HALF) = acc[ai][bj][m][0]; *(pg8::f32x4*)(rp + bj * HALF + 4) = acc[ai][bj][m][1]; } }
    }
};
struct EpiPart {
    static constexpr bool PERM = true, AFTER_DRAIN = false;
    float* P;
    __device__ __forceinline__ void operator()(const pg8::f32x4 (&acc)[2][2][4][2], const Unit& u, int wr, int wc, int fr_, int fq_) const {
        const int lane_ = otid() & 63, fr = lane_ & 15, fq = lane_ >> 4; (void)fr_; (void)fq_;
        const int row0 = wr * 64 + fr, col0 = u.pn * BM + wc * 32 + 8 * fq; float* base = P + (size_t)(u.ko >> 8) * 256 * 1024;
#pragma unroll
        for (int ai = 0; ai < 2; ++ai)
#pragma unroll
            for (int m = 0; m < 4; ++m) { float* rp = base + (size_t)(row0 + ai * HALF + m * 16) * 1024 + col0;
#pragma unroll
                for (int bj = 0; bj < 2; ++bj) { *(pg8::f32x4*)(rp + bj * HALF) = acc[ai][bj][m][0]; *(pg8::f32x4*)(rp + bj * HALF + 4) = acc[ai][bj][m][1]; } }
    }
};
struct SplitOrder {
    int nsplit, c;
    __device__ bool next(int i, Unit& u) const { if (i != 0 || c >= 4 * nsplit) return false; u.pm = 128; u.pn = c & 3; u.ko = (c >> 2) * 256; return true; }
    __device__ __forceinline__ void a_ready(const Unit&) const {}
    __device__ __forceinline__ void done(const Unit&) const {}
};
struct EpiGate {
    static constexpr bool PERM = true, AFTER_DRAIN = false;
    const bf16_t* XB; float* Xo; const bf16_t* T; int f32out;
    __device__ __forceinline__ void operator()(const pg8::f32x4 (&acc)[2][2][4][2], const Unit& u, int wr, int wc, int fr_, int fq_) const {
        const int lane_ = otid() & 63, fr = lane_ & 15, fq = lane_ >> 4; (void)fr_; (void)fq_;
        const int row0 = u.pm * BM + wr * 64 + fr, col0 = u.pn * BM + wc * 32 + 8 * fq;
#pragma unroll
        for (int ai = 0; ai < 2; ++ai)
#pragma unroll
            for (int m = 0; m < 4; ++m) { const int row = row0 + ai * HALF + m * 16; if (row >= MV) continue;
#pragma unroll
                for (int bj = 0; bj < 2; ++bj) { const size_t off = (size_t)row * DM + col0 + bj * HALF;
                    const u32x4 t = *(const u32x4*)(T + off); const u32x4 xb = *(const u32x4*)(XB + off);
                    pg8::f32x4 x0 = {bflo(xb.x), bfhi(xb.x), bflo(xb.y), bfhi(xb.y)}, x1 = {bflo(xb.z), bfhi(xb.z), bflo(xb.w), bfhi(xb.w)};
                    const pg8::f32x4 a0 = acc[ai][bj][m][0], a1 = acc[ai][bj][m][1];
                    x0[0] += sigm_f(a0[0]) * bflo(t.x); x0[1] += sigm_f(a0[1]) * bfhi(t.x); x0[2] += sigm_f(a0[2]) * bflo(t.y); x0[3] += sigm_f(a0[3]) * bfhi(t.y);
                    x1[0] += sigm_f(a1[0]) * bflo(t.z); x1[1] += sigm_f(a1[1]) * bfhi(t.z); x1[2] += sigm_f(a1[2]) * bflo(t.w); x1[3] += sigm_f(a1[3]) * bfhi(t.w);
                    if (f32out) { *(pg8::f32x4*)(Xo + off) = x0; *(pg8::f32x4*)(Xo + off + 4) = x1; }
                    else { u32x4 w; w.x = pk2(x0[0], x0[1]); w.y = pk2(x0[2], x0[3]); w.z = pk2(x1[0], x1[1]); w.w = pk2(x1[2], x1[3]); *(u32x4*)((bf16_t*)Xo + off) = w; } } }
    }
};

__device__ __forceinline__ void cvt_wt(const float* __restrict__ W, bf16_t* __restrict__ Wt, int K, int N, int Npad, float* tile  ) {
    const int tid = otid(), ntn = Npad / 64, nt = ntn * (K / 64);
    for (int t = blockIdx.x; t < nt; t += gridDim.x) {
        const int n0 = (t % ntn) * 64, k0 = (t / ntn) * 64;
#pragma unroll
        for (int i = 0; i < 2; ++i) { const int kk = (tid >> 4) + 32 * i, n4 = (tid & 15) * 4;
            f32x4 v = {0.f, 0.f, 0.f, 0.f}; if (n0 + n4 < N) v = *(const f32x4*)(W + (size_t)(k0 + kk) * N + n0 + n4);
            tile[kk * 65 + n4] = v[0]; tile[kk * 65 + n4 + 1] = v[1]; tile[kk * 65 + n4 + 2] = v[2]; tile[kk * 65 + n4 + 3] = v[3]; }
        __syncthreads();
        { const int nn = tid >> 3, k8 = (tid & 7) * 8; u32x4 w;
          w.x = pk2(tile[(k8 + 0) * 65 + nn], tile[(k8 + 1) * 65 + nn]); w.y = pk2(tile[(k8 + 2) * 65 + nn], tile[(k8 + 3) * 65 + nn]);
          w.z = pk2(tile[(k8 + 4) * 65 + nn], tile[(k8 + 5) * 65 + nn]); w.w = pk2(tile[(k8 + 6) * 65 + nn], tile[(k8 + 7) * 65 + nn]);
          *(u32x4*)(Wt + (size_t)(n0 + nn) * K + k0 + k8) = w; }
        __syncthreads();
    }
}
__device__ __forceinline__ void prologue(const Args& a, float* tile) {
    unsigned char* ws = a.p->ws;
    for (int j = 0; j < 2; ++j) {
        cvt_wt(a.p->in[9] + (size_t)j * 1024 * 6144, (bf16_t*)(ws + WS_WGIN) + (size_t)j * 6144 * 1024, 1024, 6144, 6144, tile);
        cvt_wt(a.p->in[14] + (size_t)j * 2048 * 1024, (bf16_t*)(ws + WS_WGOUT) + (size_t)j * 1024 * 2048, 2048, 1024, 1024, tile);
        cvt_wt(a.p->in[15] + (size_t)j * 1024 * 8208, (bf16_t*)(ws + WS_WFIN) + (size_t)j * NFIN * 1024, 1024, 8208, NFIN, tile);
        cvt_wt(a.p->in[17] + (size_t)j * 2048 * 1024, (bf16_t*)(ws + WS_WFOUT) + (size_t)j * 1024 * 2048, 2048, 1024, 1024, tile);
    }
    for (int i = 0; i < 4; ++i) {
        cvt_wt(a.p->in[18] + (size_t)i * 256 * 1024, (bf16_t*)(ws + WS_WPP) + (size_t)i * 1024 * 256, 256, 1024, 1024, tile);
        cvt_wt(a.p->in[19] + (size_t)i * 1024 * 1024, (bf16_t*)(ws + WS_WPG) + (size_t)i * 1024 * 1024, 1024, 1024, 1024, tile);
    }
    const float* wsrc = a.p->in[12]; bf16_t* wm = (bf16_t*)(ws + WS_WM); bf16_t* wms = (bf16_t*)(ws + WS_WMS);
    for (int idx = blockIdx.x * 512 + otid(); idx < 2 * 16 * 128 * 128; idx += gridDim.x * 512) {
        const int jj = idx & 127, i = (idx >> 7) & 127, lg = idx >> 14;
        const float w = wsrc[idx]; wm[idx] = (bf16_t)f2bf((jj >> 6) <= (i >> 6) ? w : 0.f);
        const float w2 = wsrc[((size_t)lg * 128 + (i & 15)) * 128 + (jj & 15)]; wms[idx] = (bf16_t)f2bf((i >> 4) == (jj >> 4) ? w2 : 0.f);
    }
}

__device__ __forceinline__ void phase_e1(const Args& a, int layer) {
    const int tid = otid(), lane = tid & 63, gw = blockIdx.x * 8 + (tid >> 6), nw = gridDim.x * 8;
    float* X = a.p->out; bf16_t* X16 = (bf16_t*)a.p->out; bf16_t* HX = (bf16_t*)(a.p->ws + WS_HX); bf16_t* PB = (bf16_t*)(a.p->ws + WS_PB);
    const float* g = a.p->in[7] + (layer & 3) * DM;
    f32x4 gv[4];
#pragma unroll
    for (int q = 0; q < 4; ++q) gv[q] = *(const f32x4*)(g + q * 256 + lane * 4);
#define E1_LOAD(v, r) do { if (layer == 0) { _Pragma("unroll") for (int q = 0; q < 4; ++q) v[q] = *(const f32x4*)(a.p->in[0] + (size_t)(r) * DM + q * 256 + lane * 4); } \
        else { _Pragma("unroll") for (int q = 0; q < 4; ++q) { const u32x2 xb = *(const u32x2*)(X16 + (size_t)(r) * DM + q * 256 + lane * 4); v[q] = (f32x4){bflo(xb.x), bfhi(xb.x), bflo(xb.y), bfhi(xb.y)}; } } } while (0)
#define E1_FIN(v, r, p) do { float ss = 0.f; _Pragma("unroll") for (int q = 0; q < 4; ++q) ss += v[q][0] * v[q][0] + v[q][1] * v[q][1] + v[q][2] * v[q][2] + v[q][3] * v[q][3]; \
        ss = wave_sum(ss); const float rr = rsqrtf(ss * (1.f / DM) + RMS_EPS); \
        _Pragma("unroll") for (int q = 0; q < 4; ++q) { u32x2 hw; hw.x = pk2(v[q][0] * rr * gv[q][0], v[q][1] * rr * gv[q][1]); hw.y = pk2(v[q][2] * rr * gv[q][2], v[q][3] * rr * gv[q][3]); \
            *(u32x2*)(HX + (size_t)(r) * DM + q * 256 + lane * 4) = hw; } \
        u32x2 pw; pw.x = pk2(p[0], p[1]); pw.y = pk2(p[2], p[3]); *(u32x2*)(PB + (size_t)(r) * 256 + lane * 4) = pw; } while (0)
    if (layer < 4) {
        const float* pp = a.p->in[5] + (size_t)layer * MP * 256;
        for (int row = gw; row < MP; row += 2 * nw) {
            const int r1 = row + nw; const bool has1 = r1 < MP;
            f32x4 v0[4], v1[4]; f32x4 p0, p1 = {0.f, 0.f, 0.f, 0.f};
            E1_LOAD(v0, row); p0 = *(const f32x4*)(pp + (size_t)row * 256 + lane * 4);
            if (has1) { E1_LOAD(v1, r1); p1 = *(const f32x4*)(pp + (size_t)r1 * 256 + lane * 4); }
            E1_FIN(v0, row, p0);
            if (has1) E1_FIN(v1, r1, p1);
        }
    }
    for (int row = MP + gw; row < (layer == 4 ? MV : MA); row += nw) {
        if (row < MV) {
            f32x4 v[4];
            if (layer > 0) {
                const bf16_t* TBp = (const bf16_t*)(a.p->ws + WS_TB);
#pragma unroll
                for (int q = 0; q < 4; ++q) { const size_t off = (size_t)row * DM + q * 256 + lane * 4; const float* pq = (const float*)(a.p->ws + WS_PART) + (size_t)(row - MP) * 1024 + q * 256 + lane * 4;
                    f32x4 g4 = *(const f32x4*)pq;
#pragma unroll
                    for (int ks = 1; ks < 4; ++ks) g4 += *(const f32x4*)(pq + (size_t)ks * 256 * 1024);
                    const u32x2 xb = *(const u32x2*)(HX + off), tb = *(const u32x2*)(TBp + off);
                    v[q] = (f32x4){bflo(xb.x) + sigm_f(g4[0]) * bflo(tb.x), bfhi(xb.x) + sigm_f(g4[1]) * bfhi(tb.x), bflo(xb.y) + sigm_f(g4[2]) * bflo(tb.y), bfhi(xb.y) + sigm_f(g4[3]) * bfhi(tb.y)};
                    if (layer == 4) *(f32x4*)(X + off) = v[q]; else { u32x2 w; w.x = pk2(v[q][0], v[q][1]); w.y = pk2(v[q][2], v[q][3]); *(u32x2*)(X16 + off) = w; } }
                if (layer == 4) continue;
            } else {
#pragma unroll
                for (int q = 0; q < 4; ++q) v[q] = *(const f32x4*)(a.p->in[1] + (size_t)(row - MP) * DM + q * 256 + lane * 4);
            }
            const f32x4 p = *(const f32x4*)(a.p->in[6] + ((size_t)layer * MS + (row - MP)) * 256 + lane * 4);
            E1_FIN(v, row, p);
        } else {
#pragma unroll
            for (int q = 0; q < 4; ++q) *(u32x2*)(HX + (size_t)row * DM + q * 256 + lane * 4) = (u32x2){0u, 0u};
            *(u32x2*)(PB + (size_t)row * 256 + lane * 4) = (u32x2){0u, 0u};
        }
    }
#undef E1_LOAD
#undef E1_FIN
}
__device__ __forceinline__ void phase_e3(const Args& a, int layer, bool dummy = false) {
    const int tid = otid(), lane = tid & 63, gw = blockIdx.x * 8 + (tid >> 6), nw = gridDim.x * 8;
    const bf16_t* X16 = (const bf16_t*)a.p->out; bf16_t* HX = (bf16_t*)(a.p->ws + (dummy ? WS_DUMMY + 136 * MiB : WS_HX)); const bf16_t* OP = (const bf16_t*)(a.p->ws + WS_R0 + RSZ);
    const float* g = a.p->in[8] + layer * DM;
    f32x4 gv[4];
#pragma unroll
    for (int q = 0; q < 4; ++q) gv[q] = *(const f32x4*)(g + q * 256 + lane * 4);
#define E3_LOADX(XX, r, src0) do { if (layer == 0) { _Pragma("unroll") for (int q = 0; q < 4; ++q) XX[q] = *(const f32x4*)((src0) + q * 256 + lane * 4); } \
        else { _Pragma("unroll") for (int q = 0; q < 4; ++q) { const u32x2 xb = *(const u32x2*)(X16 + (size_t)(r) * DM + q * 256 + lane * 4); XX[q] = (f32x4){bflo(xb.x), bfhi(xb.x), bflo(xb.y), bfhi(xb.y)}; } } } while (0)
#define E3_FIN(v, XX, r) do { float ss = 0.f; _Pragma("unroll") for (int q = 0; q < 4; ++q) ss += v[q][0] * v[q][0] + v[q][1] * v[q][1] + v[q][2] * v[q][2] + v[q][3] * v[q][3]; \
        ss = wave_sum(ss); const float rr = rsqrtf(ss * (1.f / DM) + RMS_EPS); \
        _Pragma("unroll") for (int q = 0; q < 4; ++q) { u32x2 hw; hw.x = pk2(XX[q][0] + v[q][0] * rr * gv[q][0], XX[q][1] + v[q][1] * rr * gv[q][1]); hw.y = pk2(XX[q][2] + v[q][2] * rr * gv[q][2], XX[q][3] + v[q][3] * rr * gv[q][3]); \
            *(u32x2*)(HX + (size_t)(r) * DM + q * 256 + lane * 4) = hw; } } while (0)
#define E3_LOADOP(v, r) do { _Pragma("unroll") for (int q = 0; q < 4; ++q) { const u32x2 ob = *(const u32x2*)(OP + (size_t)(r) * DM + q * 256 + lane * 4); v[q] = (f32x4){bflo(ob.x), bfhi(ob.x), bflo(ob.y), bfhi(ob.y)}; } } while (0)
    for (int row = gw; row < MP; row += 2 * nw) {
        const int r1 = row + nw; const bool has1 = r1 < MP;
        f32x4 v0[4], x0[4], v1[4], x1[4];
        E3_LOADOP(v0, row); E3_LOADX(x0, row, a.p->in[0] + (size_t)row * DM);
        if (has1) { E3_LOADOP(v1, r1); E3_LOADX(x1, r1, a.p->in[0] + (size_t)r1 * DM); }
        E3_FIN(v0, x0, row);
        if (has1) E3_FIN(v1, x1, r1);
    }
    for (int row = MP + gw; row < MA; row += nw) {
        if (row < MV) {
            f32x4 v[4], x[4];
#pragma unroll
            for (int q = 0; q < 4; ++q) { const float* pq = (const float*)(a.p->ws + WS_PART) + (size_t)(row - MP) * 1024 + q * 256 + lane * 4; v[q] = *(const f32x4*)pq;
#pragma unroll
                for (int ks = 1; ks < 8; ++ks) v[q] += *(const f32x4*)(pq + (size_t)ks * 256 * 1024); }
            E3_LOADX(x, row, a.p->in[1] + (size_t)(row - MP) * DM);
            E3_FIN(v, x, row);
        } else {
#pragma unroll
            for (int q = 0; q < 4; ++q) *(u32x2*)(HX + (size_t)row * DM + q * 256 + lane * 4) = (u32x2){0u, 0u};
        }
    }
#undef E3_LOADX
#undef E3_FIN
#undef E3_LOADOP
}

__device__ __forceinline__ void phase_s1(const Args& a, int j, unsigned char* lds, bool dummy = false) {
    constexpr int LP = 136;
    bf16_t* As = (bf16_t*)lds; bf16_t* Bs = As + 128 * LP; float* fl = (float*)(Bs + 128 * LP);
    float* mu = fl, * rs = fl + 128, * t1 = fl + 256, * t2 = fl + 384;
    const int tid = otid(), lane = tid & 63, wid = tid >> 6, fr = lane & 15, fq = lane >> 4;
    const bf16_t* U = (const bf16_t*)(a.p->ws + WS_R0); bf16_t* Uo = (bf16_t*)(a.p->ws + (dummy ? WS_DUMMY : WS_R0)); const bf16_t* VT = (const bf16_t*)(a.p->ws + WS_R0 + RSZ); const bf16_t* ZS = (const bf16_t*)(a.p->ws + WS_R0 + 2 * RSZ);
    const float* stat = (const float*)(a.p->ws + WS_STAT);
    const float* lng = a.p->in[10] + j * EB; const float* lnb = a.p->in[11] + j * EB; const float* bsv = a.p->in[13] + j * 16 * 128;
    float* gvs = a.p->out + O_GV + (size_t)j * MS * EB;
    constexpr int NU = 257 * 16;
    const int G_ = gridDim.x, w_ = blockIdx.x;
#define S1_UNIT(k) ((G_ == 256) ? ((k) < 16 ? w_ * 16 + (((k) + w_) & 15) :     ((k) == 16 && w_ < 16 ? 4096 + w_ : NU)) : (w_ + (k) * G_))
#define S1_LOAD_AB(u_) do { const int blk_ = (u_) >> 4, g_ = (u_) & 15; \
        const bf16_t* wsrc_ = (const bf16_t*)(a.p->ws + (blk_ == 256 ? WS_WMS : WS_WM)) + ((size_t)(j * 16 + g_) * 128) * 128; const bf16_t* vsrc_ = VT + ((size_t)blk_ * 2048 + g_ * 128) * 128; \
        _Pragma("unroll") for (int q = 0; q < 4; ++q) { ar[q] = *(const u32x4*)(wsrc_ + (tid >> 2) * 128 + (tid & 3) * 32 + q * 8); br[q] = *(const u32x4*)(vsrc_ + (tid >> 2) * 128 + (tid & 3) * 32 + q * 8); } } while (0)
    int un = S1_UNIT(0);
    if (un >= NU) return;
    u32x4 ar[4], br[4];
    S1_LOAD_AB(un);
    int prev_blk = -1;
    for (int k = 0;; ++k) {
        const int blk = un >> 4, g = un & 15, issamp = blk == 256;
        if (blk != prev_blk) {
          { const int r_ = tid >> 2, p_ = tid & 3; const float* sp = stat + (size_t)(blk * 128 + r_) * 64 + p_ * 8;
          const f32x4 s0 = *(const f32x4*)sp, s1 = *(const f32x4*)(sp + 4), q0 = *(const f32x4*)(sp + 32), q1 = *(const f32x4*)(sp + 36);
          float s = ((s0[0] + s0[1]) + (s0[2] + s0[3])) + ((s1[0] + s1[1]) + (s1[2] + s1[3])), q = ((q0[0] + q0[1]) + (q0[2] + q0[3])) + ((q1[0] + q1[1]) + (q1[2] + q1[3]));
          s += __shfl_xor(s, 1); s += __shfl_xor(s, 2); q += __shfl_xor(q, 1); q += __shfl_xor(q, 2);
          if (p_ == 0) { const float m = s * (1.f / EB); const float var = fmaxf(q * (1.f / EB) - m * m, 0.f); mu[r_] = m; rs[r_] = rsqrtf(var + LN_EPS); } }
          __syncthreads(); prev_blk = blk;
        }
        { const int i = tid >> 2, part = tid & 3; float a1 = 0.f, a2 = 0.f;
#pragma unroll
          for (int q = 0; q < 4; ++q) { const int j0 = part * 32 + q * 8; const u32x4 w = ar[q]; const unsigned ww[4] = {w.x, w.y, w.z, w.w}; float o[8];
#pragma unroll
              for (int e = 0; e < 4; ++e) { const float w0 = bflo(ww[e]), w1 = bfhi(ww[e]); const float r0 = rs[j0 + 2 * e], r1 = rs[j0 + 2 * e + 1];
                  o[2 * e] = w0 * r0; o[2 * e + 1] = w1 * r1; a1 += w0 * r0 * mu[j0 + 2 * e] + w1 * r1 * mu[j0 + 2 * e + 1]; a2 += w0 + w1; }
              u32x4 ow; ow.x = pk2(o[0], o[1]); ow.y = pk2(o[2], o[3]); ow.z = pk2(o[4], o[5]); ow.w = pk2(o[6], o[7]);
              *(u32x4*)(As + i * LP + j0) = ow; *(u32x4*)(Bs + i * LP + j0) = br[q]; }
          a1 += __shfl_xor(a1, 1); a1 += __shfl_xor(a1, 2); a2 += __shfl_xor(a2, 1); a2 += __shfl_xor(a2, 2);
          if (part == 0) { t1[i] = a1; t2[i] = a2; }
        }
        __syncthreads();
        const int un_next = S1_UNIT(k + 1); const bool has_next = un_next < NU;
        if (has_next) S1_LOAD_AB(un_next);
        const int i0 = (wid >> 1) * 32, c0 = (wid & 1) * 64;
        f32x4 acc[2][4];
#pragma unroll
        for (int mt = 0; mt < 2; ++mt)
#pragma unroll
            for (int nt = 0; nt < 4; ++nt) acc[mt][nt] = (f32x4){0.f, 0.f, 0.f, 0.f};
#pragma unroll
        for (int kk = 0; kk < 4; ++kk) {
            bf16x8 af[2], bfr[4];
#pragma unroll
            for (int mt = 0; mt < 2; ++mt) af[mt] = *(const bf16x8*)(As + (i0 + mt * 16 + fr) * LP + kk * 32 + fq * 8);
#pragma unroll
            for (int nt = 0; nt < 4; ++nt) bfr[nt] = *(const bf16x8*)(Bs + (c0 + nt * 16 + fr) * LP + kk * 32 + fq * 8);
#pragma unroll
            for (int mt = 0; mt < 2; ++mt)
#pragma unroll
                for (int nt = 0; nt < 4; ++nt) acc[mt][nt] = __builtin_amdgcn_mfma_f32_16x16x32_bf16(bfr[nt], af[mt], acc[mt][nt], 0, 0, 0);
        }
        const int ei = tid >> 2, ec = (tid & 3) * 32; const size_t erow = (size_t)blk * 128 + ei;
        u32x4 uu[4], zz[4];
#pragma unroll
        for (int q = 0; q < 4; ++q) { uu[q] = *(const u32x4*)(U + erow * EB + g * 128 + ec + q * 8); zz[q] = *(const u32x4*)(ZS + erow * EB + g * 128 + ec + q * 8); }
        if (issamp) {
            for (int idx = tid; idx < 128 * 128; idx += 512) { const int c = idx & 127, i = idx >> 7; const float v = __uint_as_float((unsigned)Bs[c * LP + i] << 16);
                gvs[(size_t)i * EB + g * 128 + c] = (v - mu[i]) * rs[i] * lng[g * 128 + c] + lnb[g * 128 + c]; }
        }
        __syncthreads();
        float* S32 = (float*)lds; constexpr int SP = 132;
#pragma unroll
        for (int mt = 0; mt < 2; ++mt)
#pragma unroll
            for (int nt = 0; nt < 4; ++nt) *(f32x4*)(S32 + (i0 + mt * 16 + fr) * SP + c0 + nt * 16 + fq * 4) = acc[mt][nt];
        __syncthreads();
        { const float t1i = t1[ei], t2i = t2[ei], bi = bsv[g * 128 + (issamp ? (ei & 15) : ei)];
#pragma unroll
          for (int q = 0; q < 4; ++q) { const int cg = g * 128 + ec + q * 8;
              const f32x4 sa = *(const f32x4*)(S32 + ei * SP + ec + q * 8), sb = *(const f32x4*)(S32 + ei * SP + ec + q * 8 + 4);
              const f32x4 lga = *(const f32x4*)(lng + cg), lgb = *(const f32x4*)(lng + cg + 4), lba = *(const f32x4*)(lnb + cg), lbb = *(const f32x4*)(lnb + cg + 4);
              float s[8];
#pragma unroll
              for (int e = 0; e < 4; ++e) { s[e] = lga[e] * (sa[e] - t1i) + lba[e] * t2i + bi; s[4 + e] = lgb[e] * (sb[e] - t1i) + lbb[e] * t2i + bi; }
              const unsigned u4[4] = {uu[q].x, uu[q].y, uu[q].z, uu[q].w}, z4[4] = {zz[q].x, zz[q].y, zz[q].z, zz[q].w}; unsigned y4[4];
#pragma unroll
              for (int e = 0; e < 4; ++e) y4[e] = pk2(bflo(u4[e]) * s[2 * e] * bflo(z4[e]), bfhi(u4[e]) * s[2 * e + 1] * bfhi(z4[e]));
              *(u32x4*)(Uo + erow * EB + cg) = (u32x4){y4[0], y4[1], y4[2], y4[3]}; } }
        __syncthreads();
        if (!has_next) break;
        un = un_next;
    }
#undef S1_UNIT
#undef S1_LOAD_AB
}

__device__ __forceinline__ void phase_c1(const Args& a, int j) {
    const int tid = otid(); if ((tid >> 6) != 0) return;
    const int lane = tid & 63;
    for (int sq = blockIdx.x; sq < 256; sq += gridDim.x) {
        if (sq < 128) {
            const int b = sq >> 4, h = sq & 15; const float* src = a.p->out + O_FLP + ((size_t)j * MP + (size_t)b * SEQ) * 16 + h; float* dst = (float*)(a.p->ws + WS_CBP) + (size_t)sq * SEQ;
            float tot = 0.f; for (int s = 0; s < 64; ++s) tot += src[(size_t)(lane * 64 + s) * 16];
            float inc = tot; for (int o = 1; o < 64; o <<= 1) { const float t = __shfl_up(inc, o); if (lane >= o) inc += t; }
            float run = inc - tot;
            for (int s = 0; s < 64; ++s) { run += src[(size_t)(lane * 64 + s) * 16];
                dst[lane * 64 + (((s >> 2) & 1) * 32 + ((s >> 3) & 3) * 4 + (s & 3) + 16 * (s >> 5))] = -run * 11.313708498984761f; }
        } else {
            const int bh = sq - 128, b = bh >> 4, h = bh & 15; const float* c0 = a.p->in[4] + ((size_t)(j * 8 + b) * PAST) * 16 + h; const float* c1 = a.p->out + O_FLS + ((size_t)j * MS + b * TS) * 16 + h;
            float* dst = (float*)(a.p->ws + WS_CBS) + (size_t)bh * SKS;
            float tot = 0.f; for (int s = 0; s < 33; ++s) { const int k = lane * 33 + s; const float v = k < PAST ? c0[(size_t)k * 16] : (k < PAST + TS ? c1[(size_t)(k - PAST) * 16] : 0.f); tot += v; }
            float inc = tot; for (int o = 1; o < 64; o <<= 1) { const float t = __shfl_up(inc, o); if (lane >= o) inc += t; }
            float run = inc - tot;
            for (int s = 0; s < 33; ++s) { const int k = lane * 33 + s; const float v = k < PAST ? c0[(size_t)k * 16] : (k < PAST + TS ? c1[(size_t)(k - PAST) * 16] : 0.f); run += v; dst[k] = -run; }
        }
    }
}

__device__ __forceinline__ void sample_attn(const Args& a, int j, int bh, unsigned char* ldsb, bool dummy = false) {
    constexpr int PP = 136;
    float* wmx = (float*)ldsb;
    bf16_t* Pb = (bf16_t*)(ldsb + 1024);
    float* lfin = (float*)(ldsb + 1024 + 2 * 16 * PP * 2);
    const int tid = otid(), lane = tid & 63, wid = __builtin_amdgcn_readfirstlane(tid >> 6), fr = lane & 15, fq = lane >> 4, b = bh >> 4, h = bh & 15;
    const bf16_t* Qb = (const bf16_t*)(a.p->ws + WS_R0); const bf16_t* ZS = (const bf16_t*)(a.p->ws + WS_R0 + 3 * RSZ); bf16_t* O = (bf16_t*)(a.p->ws + (dummy ? WS_DUMMY : WS_R0));
    const float* ck = a.p->in[2] + (size_t)(j * 8 + b) * PAST * EB + h * 128; const float* cv = a.p->in[3] + (size_t)(j * 8 + b) * PAST * EB + h * 128;
    const float* nk = a.p->out + O_FKS + ((size_t)j * MS + b * TS) * EB + h * 128; const float* nv = a.p->out + O_FVS + ((size_t)j * MS + b * TS) * EB + h * 128;
    const float* cb = (const float*)(a.p->ws + WS_CBS) + (size_t)bh * SKS;
    bf16x8 qf[4];
#pragma unroll
    for (int kk = 0; kk < 4; ++kk) qf[kk] = *(const bf16x8*)(Qb + (size_t)(MP + b * TS + fr) * EB + h * 128 + kk * 32 + fq * 8);
    const int kl = 16 * wid + fr;
    float m[4], ls[4]; f32x4 oacc = {0.f, 0.f, 0.f, 0.f};
#pragma unroll
    for (int r = 0; r < 4; ++r) { m[r] = -1e30f; ls[r] = 0.f; }
    f32x4 kr[8];
#pragma unroll
    for (int q = 0; q < 8; ++q) kr[q] = *(const f32x4*)(ck + (size_t)kl * EB + (q >> 1) * 32 + fq * 8 + (q & 1) * 4);
    int buf = 0;
    for (int c = 0; c < 17; ++c) {
        float vr[32];
        if (c < 16) {
#pragma unroll
            for (int q = 0; q < 32; ++q) vr[q] = cv[(size_t)(c * 128 + (q >> 3) * 32 + fq * 8 + (q & 7)) * EB + 16 * wid + fr];
        } else {
#pragma unroll
            for (int q = 0; q < 32; ++q) { const int key = (q >> 3) * 32 + fq * 8 + (q & 7); vr[q] = key < TS ? nv[(size_t)key * EB + 16 * wid + fr] : 0.f; }
        }
        const float bias = c < 16 ? cb[c * 128 + kl] : (kl < TS ? cb[PAST + kl] : 0.f);
        f32x4 sacc = {0.f, 0.f, 0.f, 0.f};
#pragma unroll
        for (int kk = 0; kk < 4; ++kk) { const f32x4 x0 = kr[2 * kk], x1 = kr[2 * kk + 1];
            u32x4 w; w.x = pk2(x0[0], x0[1]); w.y = pk2(x0[2], x0[3]); w.z = pk2(x1[0], x1[1]); w.w = pk2(x1[2], x1[3]);
            sacc = __builtin_amdgcn_mfma_f32_16x16x32_bf16(qf[kk], __builtin_bit_cast(bf16x8, w), sacc, 0, 0, 0); }
        if (c + 1 < 16) {
#pragma unroll
            for (int q = 0; q < 8; ++q) kr[q] = *(const f32x4*)(ck + (size_t)((c + 1) * 128 + kl) * EB + (q >> 1) * 32 + fq * 8 + (q & 1) * 4);
        } else if (c + 1 == 16) {
#pragma unroll
            for (int q = 0; q < 8; ++q) kr[q] = kl < TS ? *(const f32x4*)(nk + (size_t)kl * EB + (q >> 1) * 32 + fq * 8 + (q & 1) * 4) : (f32x4){0.f, 0.f, 0.f, 0.f};
        }
        float s[4], mw[4];
#pragma unroll
        for (int r = 0; r < 4; ++r) { s[r] = sacc[r] * att::SCALE + bias; if (c == 16 && (kl >= TS || kl > 4 * fq + r)) s[r] = -__builtin_inff(); mw[r] = s[r]; }
#pragma unroll
        for (int o = 1; o < 16; o <<= 1) {
#pragma unroll
            for (int r = 0; r < 4; ++r) mw[r] = fmaxf(mw[r], __shfl_xor(mw[r], o)); }
        if (fr == 0) {
#pragma unroll
            for (int r = 0; r < 4; ++r) wmx[buf * 128 + (4 * fq + r) * 8 + wid] = mw[r]; }
        __syncthreads();
        float p[4];
#pragma unroll
        for (int r = 0; r < 4; ++r) { const f32x4 w0 = *(const f32x4*)(wmx + buf * 128 + (4 * fq + r) * 8), w1 = *(const f32x4*)(wmx + buf * 128 + (4 * fq + r) * 8 + 4);
            const float mc = fmaxf(fmaxf(fmaxf(w0[0], w0[1]), fmaxf(w0[2], w0[3])), fmaxf(fmaxf(w1[0], w1[1]), fmaxf(w1[2], w1[3])));
            const float mn = fmaxf(m[r], mc), al = __expf(m[r] - mn); m[r] = mn; p[r] = __expf(s[r] - mn); ls[r] = ls[r] * al + p[r]; oacc[r] *= al;
            Pb[buf * 16 * PP + (4 * fq + r) * PP + kl] = (bf16_t)f2bf(p[r]); }
        __syncthreads();
#pragma unroll
        for (int kk = 0; kk < 4; ++kk) { const bf16x8 pa = *(const bf16x8*)(Pb + buf * 16 * PP + fr * PP + kk * 32 + fq * 8);
            u32x4 w; w.x = pk2(vr[kk * 8 + 0], vr[kk * 8 + 1]); w.y = pk2(vr[kk * 8 + 2], vr[kk * 8 + 3]); w.z = pk2(vr[kk * 8 + 4], vr[kk * 8 + 5]); w.w = pk2(vr[kk * 8 + 6], vr[kk * 8 + 7]);
            oacc = __builtin_amdgcn_mfma_f32_16x16x32_bf16(pa, __builtin_bit_cast(bf16x8, w), oacc, 0, 0, 0); }
        buf ^= 1;
    }
#pragma unroll
    for (int o = 1; o < 16; o <<= 1) {
#pragma unroll
        for (int r = 0; r < 4; ++r) ls[r] += __shfl_xor(ls[r], o); }
    if (fr == 0) {
#pragma unroll
        for (int r = 0; r < 4; ++r) lfin[wid * 16 + 4 * fq + r] = ls[r]; }
    __syncthreads();
#pragma unroll
    for (int r = 0; r < 4; ++r) { const int i = 4 * fq + r; float l = 0.f;
#pragma unroll
        for (int w = 0; w < 8; ++w) l += lfin[w * 16 + i];
        const size_t off = (size_t)(MP + b * TS + i) * EB + h * 128 + 16 * wid + fr;
        const float z = __uint_as_float((unsigned)ZS[off] << 16); O[off] = (bf16_t)f2bf(oacc[r] / l * z); }
    __syncthreads();
}

__device__ __forceinline__ void phase_attn(const Args& a, int j, unsigned char* ldsb, int mode = 0) {
    using namespace att;
    typedef __hip_bfloat16 T;
    const T* Q = (const T*)(a.p->ws + WS_R0); const T* K = (const T*)(a.p->ws + WS_R0 + RSZ); const T* V = (const T*)(a.p->ws + WS_R0 + 2 * RSZ); const T* Z = (const T*)(a.p->ws + WS_R0 + 3 * RSZ); T* O = (T*)(a.p->ws + (mode == 1 ? WS_DUMMY : WS_R0));
    const float* CB = (const float*)(a.p->ws + WS_CBP);
    char* lds = (char*)ldsb;
    constexpr int nqb = SEQ / QB, nx = nqb / 2, total = nx * NBH;
    const int stride = gridDim.x;
    int L = (gridDim.x == 256) ? (int)((blockIdx.x & 7) * 32 + (blockIdx.x >> 3)) : (int)blockIdx.x;
    if (mode == 2) L = total;
    if (L < total) {
#define MKREF(r, L_, pass_) do { const int bh_ = (L_) / nx, x_ = (L_) - bh_ * nx, qb_ = (pass_) ? x_ : nqb - 1 - x_,     b_ = bh_ >> 4, h_ = bh_ & 15; \
        const size_t ro_ = ((size_t)b_ * SEQ + (size_t)qb_ * QB) * PITCH + h_ * 128, ko_ = ((size_t)b_ * SEQ) * PITCH + h_ * 128; \
        (r).Q = Q + ro_; (r).O = O + ro_; (r).Z = Z + ro_; (r).K = K + ko_; (r).V = V + ko_; (r).CB = CB + (size_t)bh_ * SEQ; (r).P0 = qb_ * QB; } while (0)
        BlockRef<T, T> cur, nxt; int pass = 0;
        MKREF(cur, L, 0);
        Seam<T> S;
        causal_swa_prime<T, T>(cur, SEQ, lds, S);
        for (;;) {
            const bool more_pass = pass == 0, more_item = L + stride < total, last = !more_pass && !more_item;
            int passn = pass + 1, Ln = L;
            if (!more_pass) { passn = 0; Ln = more_item ? L + stride : L; }
            if (last) nxt = cur; else MKREF(nxt, Ln, passn);
            causal_swa_block<T, T>(cur, nxt, SEQ, SEQ, lds, S);
            if (last) break;
            cur = nxt; pass = passn; L = Ln;
        }
#undef MKREF
    }
    __syncthreads();
    if (mode != 1) for (int bh = (int)gridDim.x - 1 - (int)blockIdx.x; bh < NBH; bh += gridDim.x) sample_attn(a, j, bh, ldsb, mode == 2);
}

#define XB_TMO      128
#define XB_XCNT(j)  (256  + 64 * (j))
#define XB_XSUB(j)  (1280 + 64 * (j))
#define XB_XGEN(j)  (2304 + 64 * (j))
#define XB_TOP      3328
#define XB_TOPGEN   3392
#define XCD_BAR_WORDS 3456
#define XB_SPIN_CAP (1u << 18)

__device__ __forceinline__ unsigned xb_ld(unsigned* p)              { return __hip_atomic_load(p, __ATOMIC_RELAXED, __HIP_MEMORY_SCOPE_AGENT); }
__device__ __forceinline__ unsigned xb_add(unsigned* p, unsigned v) { return __hip_atomic_fetch_add(p, v, __ATOMIC_RELAXED, __HIP_MEMORY_SCOPE_AGENT); }
__device__ __forceinline__ unsigned xb_xcc_id() { return (unsigned)__builtin_amdgcn_s_getreg((3 << 11) | 20) & 0xFu; }
#define XB_SPIN(cond, bar) do { unsigned _sp = 0; while (cond) { __builtin_amdgcn_s_sleep(1); \
    if ((++_sp & 255u) == 0u) { if (xb_ld(&(bar)[XB_TMO])) break; if (_sp > XB_SPIN_CAP) { atomicAdd(&(bar)[XB_TMO], 1u); break; } } } } while (0)

struct XcdBarrier {
    unsigned* bar; unsigned x;
    volatile LAS unsigned* st;
};

__device__ __forceinline__ XcdBarrier xcd_barrier_post(unsigned* bar, volatile LAS unsigned* st) {
    XcdBarrier b; b.bar = bar; b.x = xb_xcc_id(); b.st = st;
    if (otid() == 0) (void)xb_add(&bar[XB_XCNT(b.x)], 1u);
    return b;
}
__device__ __forceinline__ void xcd_barrier_complete(unsigned* bar, unsigned x, unsigned& nloc, unsigned& nx) {
    const unsigned G = gridDim.x * gridDim.y * gridDim.z;
    unsigned sum, cnt, mine, sp = 0u;
    for (;;) {
        sum = 0u; cnt = 0u; mine = 0u;
#pragma unroll
        for (unsigned j = 0; j < 16; ++j) { const unsigned c = xb_ld(&bar[XB_XCNT(j)]); sum += c; cnt += (c > 0u) ? 1u : 0u; mine = (j == x) ? c : mine; }
        if (sum == G) break;
        __builtin_amdgcn_s_sleep(1);
        if ((++sp & 255u) == 0u) { if (xb_ld(&bar[XB_TMO])) break; if (sp > XB_SPIN_CAP) { atomicAdd(&bar[XB_TMO], 1u); break; } }
    }
    nloc = mine > 0u ? mine : 1u; nx = cnt > 0u ? cnt : 1u;
}

__device__ __forceinline__ void xcd_barrier(const XcdBarrier& b) {
    asm volatile("s_waitcnt vmcnt(0)" ::: "memory");
    __syncthreads();
    if (otid() == 0) {
        unsigned* bar = b.bar;
        __builtin_amdgcn_s_waitcnt(0);
        unsigned nloc = b.st[0], nx = b.st[1];
        if (nloc == 0u) { xcd_barrier_complete(bar, b.x, nloc, nx); b.st[0] = nloc; b.st[1] = nx; }
        const unsigned old = xb_add(&bar[XB_XSUB(b.x)], 1u);
        const unsigned gen = old / nloc;
        if (old + 1u == (gen + 1u) * nloc) {
            __builtin_amdgcn_fence(__ATOMIC_RELEASE, "agent");
            asm volatile("s_waitcnt vmcnt(0)" ::: "memory");
            const unsigned og = xb_add(&bar[XB_TOP], 1u);
            const unsigned tg = og / nx;
            if (og + 1u == (tg + 1u) * nx) xb_add(&bar[XB_TOPGEN], 1u);
            else XB_SPIN(xb_ld(&bar[XB_TOPGEN]) == tg, bar);
            __builtin_amdgcn_fence(__ATOMIC_ACQUIRE, "agent");
            xb_add(&bar[XB_XGEN(b.x)], 1u);
            asm volatile("s_waitcnt vmcnt(0)" ::: "memory");
        } else {
            XB_SPIN(xb_ld(&bar[XB_XGEN(b.x)]) == gen, bar);
            __builtin_amdgcn_fence(__ATOMIC_ACQUIRE, "agent");
            asm volatile("s_waitcnt vmcnt(0)" ::: "memory");
        }
    }
    __syncthreads();
}
#define WSPTRS() const Args a = getargs(); unsigned char* ws = a.p->ws; (void)ws; \
    bf16_t* HX = (bf16_t*)(ws + WS_HX); bf16_t* TB = (bf16_t*)(ws + WS_TB); bf16_t* PB = (bf16_t*)(ws + WS_PB); (void)HX; (void)TB; (void)PB; \
    bf16_t* R0 = (bf16_t*)(ws + WS_R0); bf16_t* R1 = (bf16_t*)(ws + WS_R0 + RSZ); bf16_t* R2 = (bf16_t*)(ws + WS_R0 + 2 * RSZ); bf16_t* R3 = (bf16_t*)(ws + WS_R0 + 3 * RSZ); (void)R0; (void)R1; (void)R2; (void)R3;
#define XBAR_MK() XcdBarrier xb_; xb_.bar = (unsigned*)(getargs().p->ws) + 1024; xb_.x = xb_xcc_id(); xb_.st = (volatile LAS unsigned*)((LAS unsigned char*)lds + (LDS_BYTES - 64))
#if PROBE_DUP == 7
#define GSYNC() do { XBAR_MK(); xcd_barrier(xb_); xcd_barrier(xb_); } while (0)
#else
#define GSYNC() do { XBAR_MK(); xcd_barrier(xb_); } while (0)
#endif
__global__ void __launch_bounds__(512, 2) fwd_megakernel(ArgsS args_unused) {
    extern __shared__ __attribute__((aligned(16))) unsigned char lds[];
    cg::grid_group grid = cg::this_grid();
    PG8_LAS unsigned char* gl = (PG8_LAS unsigned char*)lds;
    const int G = gridDim.x, c = blockIdx.x;
    { const unsigned hw = (unsigned)__builtin_amdgcn_s_getreg((5 << 11) | 4) & 63u;
      if ((threadIdx.x & 63) == 0) ((LAS int*)((LAS unsigned char*)lds + LDS_WIDTAB))[hw] = (int)(threadIdx.x >> 6);
      if (threadIdx.x < 16) ((LAS unsigned*)((LAS unsigned char*)lds + (LDS_BYTES - 64)))[threadIdx.x] = 0u; }
    __syncthreads();
    { XBAR_MK(); (void)xcd_barrier_post(xb_.bar, xb_.st); }
#ifndef SKIP_PRO
    { const Args a = getargs(); prologue(a, (float*)lds); }
#endif
    grid.sync();
    for (int layer = 0; layer < 4; ++layer) {
        const int j = layer >> 1;
#ifndef SKIP_E1
        for (int rp_ = (PROBE_DUP == 4 ? 0 : 1); rp_ < 2; ++rp_) { const Args a = getargs(); phase_e1(a, layer); if (!rp_) GSYNC(); }
#endif
        GSYNC();
        if ((layer & 1) == 0) {
#ifndef SKIP_G1G
            { WSPTRS(); pg8::Gemm g{HX, (const bf16_t*)(ws + WS_WGIN) + (size_t)j * 6144 * 1024, MA, 6144, 1024}; pg8::StaticOrder S; S.init(MA, 6144, G, c);
              EpiGmlpIn E{R0, R1, R2, (float*)(ws + WS_STAT)};
              for (int rp_ = 0; rp_ < (PROBE_DUP == 5 ? 2 : 1); ++rp_) pg8::gemm_phase<EpiGmlpIn, pg8::StaticOrder, true, true>(gl, g, S, E); }
#endif
        } else {
#ifndef SKIP_G1F
            { WSPTRS(); pg8::Gemm g{HX, (const bf16_t*)(ws + WS_WFIN) + (size_t)j * NFIN * 1024, MA, NFIN, 1024}; pg8::StaticOrder S; S.init(MA, NFIN, G, c);
              float* out = a.p->out;
              EpiFoxIn E{R0, R1, R2, R3, out + O_FKP + (size_t)j * MP * EB, out + O_FVP + (size_t)j * MP * EB, out + O_FLP + (size_t)j * MP * 16,
                         out + O_FKS + (size_t)j * MS * EB, out + O_FVS + (size_t)j * MS * EB, out + O_FLS + (size_t)j * MS * 16, a.p->in[16] + j * 16};
              for (int rp_ = 0; rp_ < (PROBE_DUP == 5 ? 2 : 1); ++rp_) pg8::gemm_phase<EpiFoxIn, pg8::StaticOrder, true, true>(gl, g, S, E); }
#endif
        }
#ifndef SKIP_GT
        { WSPTRS(); pg8::Gemm g{PB, (const bf16_t*)(ws + WS_WPP) + (size_t)layer * 1024 * 256, MA, 1024, 256}; const int nb_ = (layer & 1) ? 0 : 24;
          pg8::StaticOrder S; S.init(MA, 1024, G - nb_, c >= nb_ ? G - 1 - c : (1 << 24));
          EpiT E{TB, 1024};
          for (int rp_ = 0; rp_ < (PROBE_DUP == 6 ? 2 : 1); ++rp_) pg8::gemm_phase<EpiT, pg8::StaticOrder, true, true>(gl, g, S, E); }
#endif
        GSYNC();
        if ((layer & 1) == 0) {
#ifndef SKIP_S1
            for (int rp_ = (PROBE_DUP == 3 ? 0 : 1); rp_ < 2; ++rp_) { const Args a = getargs(); phase_s1(a, j, lds, !rp_); if (!rp_) GSYNC(); }
#endif
        } else {
#ifndef SKIP_C1
            { const Args a = getargs(); phase_c1(a, j); }
#endif
            GSYNC();
#ifndef SKIP_ATTN
            for (int rp_ = ((PROBE_DUP == 1 || PROBE_DUP == 2) ? 0 : 1); rp_ < 2; ++rp_) { const Args a = getargs(); phase_attn(a, j, lds, rp_ ? 0 : PROBE_DUP); if (!rp_) GSYNC(); }
#endif
        }
        GSYNC();
#ifndef SKIP_G2
        { WSPTRS(); pg8::Gemm g{R0, (const bf16_t*)(ws + ((layer & 1) ? WS_WFOUT : WS_WGOUT)) + (size_t)j * 1024 * 2048, MP, 1024, 2048}; pg8::StaticOrder S; S.init(MP, 1024, G, c);
          EpiT E{R1, 1024};
          for (int rp_ = 0; rp_ < (PROBE_DUP == 6 ? 2 : 1); ++rp_) pg8::gemm_phase<EpiT, pg8::StaticOrder, true, true>(gl, g, S, E); }
#endif
        { WSPTRS(); int ksl = 256; asm volatile("" : "+s"(ksl)); pg8::Gemm g{R0, (const bf16_t*)(ws + ((layer & 1) ? WS_WFOUT : WS_WGOUT)) + (size_t)j * 1024 * 2048, MA, 1024, ksl, 2048}; SplitOrder S{8, c};
          EpiPart E{(float*)(ws + WS_PART)};
          pg8::gemm_phase<EpiPart, SplitOrder, true, true>(gl, g, S, E); }
        GSYNC();
#ifndef SKIP_E3
        for (int rp_ = (PROBE_DUP == 4 ? 0 : 1); rp_ < 2; ++rp_) { const Args a = getargs(); phase_e3(a, layer, !rp_); if (!rp_) GSYNC(); }
#endif
        GSYNC();
#ifndef SKIP_G3
        { WSPTRS(); pg8::Gemm g{HX, (const bf16_t*)(ws + WS_WPG) + (size_t)layer * 1024 * 1024, MP, 1024, 1024}; pg8::StaticOrder S; S.init(MP, 1024, G, c);
          for (int rp_ = (PROBE_DUP == 6 ? 0 : 1); rp_ < 2; ++rp_) { EpiGate E{HX, rp_ ? a.p->out : (float*)(ws + WS_DUMMY), TB, layer == 3}; pg8::gemm_phase<EpiGate, pg8::StaticOrder, true, true>(gl, g, S, E); } }
#endif
        { WSPTRS(); int ksl = 256; asm volatile("" : "+s"(ksl)); pg8::Gemm g{HX, (const bf16_t*)(ws + WS_WPG) + (size_t)layer * 1024 * 1024, MA, 1024, ksl, 1024}; SplitOrder S{4, c};
          EpiPart E{(float*)(ws + WS_PART)};
          pg8::gemm_phase<EpiPart, SplitOrder, true, true>(gl, g, S, E); }
        GSYNC();
    }
    { const Args a = getargs(); phase_e1(a, 4); }
}

extern "C" void kernel_launch(void* const* d_in, const int* in_sizes, int n_in, void* d_out, int out_size, void* d_ws, size_t ws_size, hipStream_t stream) {
    static int grid = 0;
    if (grid == 0) {
        if (n_in != 20 || ws_size < WS_END) { fprintf(stderr, "kernel_launch: need 20 inputs and >= %zu bytes of workspace; got %d, %zu\n", (size_t)WS_END, n_in, ws_size); grid = -1; return; }
        int dev = 0, cus = 0, per_cu = 0;
        (void)hipGetDevice(&dev); (void)hipDeviceGetAttribute(&cus, hipDeviceAttributeMultiprocessorCount, dev);
        if (hipFuncSetAttribute((const void*)fwd_megakernel, hipFuncAttributeMaxDynamicSharedMemorySize, LDS_BYTES) != hipSuccess) { fprintf(stderr, "kernel_launch: hipFuncSetAttribute failed\n"); grid = -1; return; }
        if (hipOccupancyMaxActiveBlocksPerMultiprocessor(&per_cu, (const void*)fwd_megakernel, 512, LDS_BYTES) != hipSuccess || per_cu < 1) { fprintf(stderr, "kernel_launch: occupancy query says %d\n", per_cu); per_cu = 1; }
        (void)hipGetLastError();
        grid = cus > 0 ? cus : 256;
    }
    if (grid < 0) return;
    if (hipMemsetAsync(d_ws, 0, 65536, stream) != hipSuccess) { fprintf(stderr, "kernel_launch: memset of the barrier words failed\n"); return; }
    ArgsS a{};
    for (int i = 0; i < 20; ++i) a.in[i] = (const float*)d_in[i];
    a.out = (float*)d_out; a.ws = (unsigned char*)d_ws;
    void* args[] = {&a};
    hipError_t e = hipLaunchCooperativeKernel((const void*)fwd_megakernel, dim3(grid), dim3(512), args, LDS_BYTES, stream);
    if (e != hipSuccess) fprintf(stderr, "cooperative launch failed: %s (grid %d)\n", hipGetErrorString(e), grid);
}
```

```cpp
#include <hip/hip_runtime.h>
#include <hip/hip_bf16.h>
#include <hip/hip_cooperative_groups.h>
#include <cstdio>
#include <cstdint>
extern __shared__ __attribute__((aligned(16))) unsigned char g_lds[];
constexpr int LDS_TOTAL = 147456, LDS_WIDTAB = LDS_TOTAL - 512;
__device__ __forceinline__ int otid() {
    const unsigned hw = (unsigned)__builtin_amdgcn_s_getreg((5 << 11) | 4) & 63u;
    int w = ((volatile __attribute__((address_space(3))) int*)((__attribute__((address_space(3))) unsigned char*)g_lds + LDS_WIDTAB))[hw];
    w = __builtin_amdgcn_readfirstlane(w);
    int l; asm volatile("v_mbcnt_lo_u32_b32 %0, -1, 0" : "=v"(l)); asm volatile("v_mbcnt_hi_u32_b32 %0, -1, %0" : "+v"(l));
    return w * 64 + l;
}
namespace pg8 {
#define PG8_LAS __attribute__((address_space(3)))
typedef unsigned short bf16_t;
typedef short bf16x8 __attribute__((ext_vector_type(8)));
typedef float f32x4 __attribute__((ext_vector_type(4)));
typedef unsigned u32x4 __attribute__((ext_vector_type(4)));
constexpr int BM = 256, BK = 64, HALF = 128, HTB = HALF * BK * 2  , STAGE_BYTES = 8 * HTB, NXCD = 8, WGM = 8;

__host__ __device__ __forceinline__ int lds_byte(int r, int c) { const int st = (r >> 4) * 2 + (c >> 5), rr = r & 15, cc = c & 31, ob = rr * 64 + cc * 2; return st * 1024 + (ob ^ (((ob >> 9) & 1) << 5)); }
__host__ __device__ __forceinline__ void stage_rc(int b, int& R, int& C) { const int st = b / 1024, sb = b % 1024, swz = sb ^ (((sb >> 9) & 1) << 5); R = (st >> 1) * 16 + swz / 64; C = (st & 1) * 32 + (swz % 64) / 2; }
__host__ __device__ __forceinline__ int perm32(int rho) { const int n = rho >> 4, i = rho & 15; return 8 * (i >> 2) + 4 * n + (i & 3); }

struct Unit { int pm, pn, ko; };
struct Gemm { const bf16_t* A; const bf16_t* Bt; int M, N, K, ldk; };

struct StaticOrder {
    int nM, nN, nwg, G, c;
    __host__ __device__ void init(int M, int N, int G_, int c_) { nM = M / BM; nN = N / BM; nwg = nM * nN; G = G_; c = c_; }
    __host__ __device__ bool next(int i, Unit& u) const {
        const long L = (long)i * G + c; if (L >= nwg) return false;
        int wgid = (int)L; { const int q = nwg / NXCD, r = nwg % NXCD, xcd = wgid % NXCD, off = wgid / NXCD; wgid = (xcd < r ? xcd * (q + 1) : r * (q + 1) + (xcd - r) * q) + off; }
        const int nig = WGM * nN, gid = wgid / nig, fm = gid * WGM, gsz = (nM - fm) < WGM ? (nM - fm) : WGM;
        u.pm = fm + ((wgid % nig) % gsz); u.pn = (wgid % nig) / gsz; u.ko = 0; return true;
    }
    __device__ __forceinline__ void a_ready(const Unit&) const {}
    __device__ __forceinline__ void done(const Unit&) const {}
};

__device__ __forceinline__ unsigned cvt_pk_bf16(float lo, float hi) { unsigned r; asm volatile("v_cvt_pk_bf16_f32 %0, %1, %2" : "=v"(r) : "v"(lo), "v"(hi)); return r; }
typedef float f32x2 __attribute__((ext_vector_type(2)));
__device__ __forceinline__ f32x2 gelu_pk(f32x2 v) {
    const f32x2 av = __builtin_elementwise_abs(v), d = av * 0.2316418882f + 1.0f;
    f32x2 t; t.x = __builtin_amdgcn_rcpf(d.x); t.y = __builtin_amdgcn_rcpf(d.y);
    f32x2 q = t * 0.5307027145f + (-0.7265760135f); q = q * t + 0.7107068705f; q = q * t + (-0.142248368f); q = q * t + 0.127414796f; q = q * t;
    const f32x2 s = (v * v) * (-0.72134752044f);
    f32x2 e; e.x = __builtin_amdgcn_exp2f(s.x); e.y = __builtin_amdgcn_exp2f(s.y);
    const f32x2 m = v * (q * e), r = v - m;
    f32x2 o; o.x = v.x < 0.f ? m.x : r.x; o.y = v.y < 0.f ? m.y : r.y; return o;
}

template <int ACT  > struct EpiBf16 {
    static constexpr bool PERM = true, AFTER_DRAIN = false; static_assert(ACT == 0 || ACT == 1, "EpiBf16: ACT is 0 (none) or 1 (gelu_pk)");
    bf16_t* O; int ldc; const float* bias; int split_cols; size_t split_stride; float scale0;
    __device__ __forceinline__ void operator()(const f32x4 (&acc)[2][2][4][2], const Unit& u, int wr, int wc, int fr, int fq) const {
        const int row0 = u.pm * BM + wr * 64 + fr; int colt = u.pn * BM; bf16_t* base = O;
        float sc = 1.f; if (split_cols) { const int t = colt / split_cols; base += (size_t)t * split_stride; colt -= t * split_cols; if (t == 0) sc = scale0; }
        const int col0 = colt + wc * 32 + 8 * fq, bcol0 = u.pn * BM + wc * 32 + 8 * fq;
        f32x4 bv[2][2];
#pragma unroll
        for (int bj = 0; bj < 2; ++bj)
#pragma unroll
            for (int n = 0; n < 2; ++n) bv[bj][n] = bias ? *(const f32x4*)(bias + bcol0 + bj * HALF + 4 * n) : (f32x4){0.f, 0.f, 0.f, 0.f};
#pragma unroll
        for (int ai = 0; ai < 2; ++ai)
#pragma unroll
            for (int m = 0; m < 4; ++m) { bf16_t* rowp = base + (size_t)(row0 + ai * HALF + m * 16) * ldc + col0;
#pragma unroll
                for (int bj = 0; bj < 2; ++bj) { f32x4 v0 = acc[ai][bj][m][0] + bv[bj][0], v1 = acc[ai][bj][m][1] + bv[bj][1];
                    if (ACT == 1) { f32x2 a = gelu_pk((f32x2){v0[0], v0[1]}), b = gelu_pk((f32x2){v0[2], v0[3]}), c = gelu_pk((f32x2){v1[0], v1[1]}), d = gelu_pk((f32x2){v1[2], v1[3]});
                        v0 = (f32x4){a.x, a.y, b.x, b.y}; v1 = (f32x4){c.x, c.y, d.x, d.y}; }
                    v0 = v0 * sc; v1 = v1 * sc; u32x4 w; w.x = cvt_pk_bf16(v0[0], v0[1]); w.y = cvt_pk_bf16(v0[2], v0[3]); w.z = cvt_pk_bf16(v1[0], v1[1]); w.w = cvt_pk_bf16(v1[2], v1[3]);
                    *(u32x4*)(rowp + bj * HALF) = w; } }
    }
};


template <class Epi, class Sched, bool ALIGN_EPI = false, bool SP2 = false>
__device__ __forceinline__ void gemm_phase(PG8_LAS unsigned char* lds, const Gemm g, const Sched& S, const Epi& E) {
    const int tid = otid(), wid = __builtin_amdgcn_readfirstlane(tid >> 6), lane = tid & 63, wr = wid >> 2, wc = wid & 3, fr = lane & 15, fq = lane >> 4;
    const int K = g.K, nt = K / BK, LDK = g.ldk ? g.ldk : g.K;
    unsigned voffA[2], voffB[2];
#pragma unroll
    for (int i = 0; i < 2; ++i) { int R, C; stage_rc(tid * 16 + i * 8192, R, C); const int Rb = Epi::PERM ? ((R & ~31) + perm32(R & 31)) : R;
        voffA[i] = (unsigned)(R * LDK + C) * 2u; voffB[i] = (unsigned)(Rb * LDK + C) * 2u; }
    const size_t kstep = (size_t)(BK * 2);
    const size_t hstep = (size_t)HALF * LDK * 2;
    const size_t tstep = 2 * hstep;
    const unsigned ldsw = (unsigned)wid * 1024u;
    const int aoff = lds_byte(wr * 64 + fr, fq * 8), boff = lds_byte(wc * 32 + fr, fq * 8);
#define PG8_SA(b, h) (((b) * 2 + (h)) * HTB)
#define PG8_SB(b, h) ((4 + (b) * 2 + (h)) * HTB)
#define PG8_STAGE(bufoff, gbase, voff) do { _Pragma("unroll") for (int _i = 0; _i < 2; ++_i) \
        __builtin_amdgcn_global_load_lds((const unsigned*)((const char*)(gbase) + (voff)[_i]), (PG8_LAS unsigned*)(lds + (bufoff) + ldsw + _i * 8192), 16, 0, 0); } while (0)
#define PG8_LDA(dst, b, h) do { _Pragma("unroll") for (int m = 0; m < 4; ++m) _Pragma("unroll") for (int k = 0; k < 2; ++k) dst[m][k] = *(const PG8_LAS bf16x8*)(lds + PG8_SA(b, h) + aoff + m * 2048 + k * 1024); } while (0)
#define PG8_LDB(dst, b, h) do { _Pragma("unroll") for (int n = 0; n < 2; ++n) _Pragma("unroll") for (int k = 0; k < 2; ++k) dst[n][k] = *(const PG8_LAS bf16x8*)(lds + PG8_SB(b, h) + boff + n * 2048 + k * 1024); } while (0)
#define PG8_MMA(ai, bj, At, Bt) do { __builtin_amdgcn_s_setprio(1); _Pragma("unroll") for (int m = 0; m < 4; ++m) _Pragma("unroll") for (int n = 0; n < 2; ++n) _Pragma("unroll") for (int k = 0; k < 2; ++k) \
        acc[ai][bj][m][n] = __builtin_amdgcn_mfma_f32_16x16x32_bf16(Bt[n][k], At[m][k], acc[ai][bj][m][n], 0, 0, 0); __builtin_amdgcn_s_setprio(0); } while (0)
#define PG8_WAIT_V(n) asm volatile("s_waitcnt vmcnt(" #n ")" ::: "memory")
#define PG8_WAIT_L(n) asm volatile("s_waitcnt lgkmcnt(" #n ")" ::: "memory")
#define PG8_BAR __builtin_amdgcn_s_barrier()
#define PG8_SCHED __builtin_amdgcn_sched_barrier(0)
    Unit cur, nxt; int ui = 0;
    if (!S.next(0, cur)) return;
    f32x4 acc[2][2][4][2];
#pragma unroll
    for (int a = 0; a < 2; ++a)
#pragma unroll
        for (int b = 0; b < 2; ++b)
#pragma unroll
            for (int m = 0; m < 4; ++m)
#pragma unroll
                for (int n = 0; n < 2; ++n) acc[a][b][m][n] = (f32x4){0.f, 0.f, 0.f, 0.f};
    bf16x8 At[4][2], B0[2][2], B1[2][2];
    const char* cA = (const char*)g.A + (size_t)cur.pm * tstep + (size_t)cur.ko * 2; const char* cB = (const char*)g.Bt + (size_t)cur.pn * tstep + (size_t)cur.ko * 2;
    S.a_ready(cur);
    if constexpr (SP2) {
        PG8_STAGE(PG8_SB(0, 0), cB, voffB); PG8_STAGE(PG8_SB(0, 1), cB + hstep, voffB); PG8_STAGE(PG8_SA(0, 0), cA, voffA); PG8_STAGE(PG8_SA(0, 1), cA + hstep, voffA);
        if (wr == 1) PG8_BAR;
        PG8_WAIT_V(2); PG8_BAR;
        PG8_STAGE(PG8_SB(1, 0), cB + kstep, voffB); PG8_STAGE(PG8_SA(1, 0), cA + kstep, voffA); PG8_STAGE(PG8_SB(1, 1), cB + hstep + kstep, voffB);
        PG8_WAIT_V(6); PG8_BAR;
    } else {
        PG8_STAGE(PG8_SB(0, 0), cB, voffB); PG8_STAGE(PG8_SA(0, 0), cA, voffA); PG8_STAGE(PG8_SB(0, 1), cB + hstep, voffB); PG8_STAGE(PG8_SA(0, 1), cA + hstep, voffA);
        if (wr == 1) PG8_BAR;
        PG8_WAIT_V(4); PG8_BAR;
        PG8_STAGE(PG8_SB(1, 0), cB + kstep, voffB); PG8_STAGE(PG8_SA(1, 0), cA + kstep, voffA); PG8_STAGE(PG8_SB(1, 1), cB + hstep + kstep, voffB);
        PG8_WAIT_V(6); PG8_BAR;
    }
    for (;;) {
        const bool has_next = S.next(ui + 1, nxt);
        const char* nA = has_next ? (const char*)g.A + (size_t)nxt.pm * tstep + (size_t)nxt.ko * 2 : cA; const char* nB = has_next ? (const char*)g.Bt + (size_t)nxt.pn * tstep + (size_t)nxt.ko * 2 : cB;
        for (int t = 0; t < nt; t += 2) {
            const bool last = (t == nt - 2);
            const char* a1 = cA + (size_t)(t + 1) * kstep;
            const char* a2 = last ? nA : cA + (size_t)(t + 2) * kstep; const char* b2 = last ? nB : cB + (size_t)(t + 2) * kstep;
            const char* a3 = a2 + kstep; const char* b3 = b2 + kstep;
            if (last && has_next) S.a_ready(nxt);
            if constexpr (SP2) {
            PG8_LDB(B0, 0, 0); PG8_LDB(B1, 0, 1); PG8_SCHED; PG8_LDA(At, 0, 0); PG8_STAGE(PG8_SA(1, 1), a1 + hstep, voffA);
            PG8_WAIT_V(8); PG8_WAIT_L(0); PG8_BAR; PG8_MMA(0, 0, At, B0); PG8_MMA(0, 1, At, B1); PG8_BAR; PG8_SCHED;
            PG8_LDA(At, 0, 1); PG8_STAGE(PG8_SB(0, 0), b2, voffB); PG8_STAGE(PG8_SB(0, 1), b2 + hstep, voffB); PG8_STAGE(PG8_SA(0, 0), a2, voffA);
            PG8_WAIT_V(8); PG8_WAIT_L(0); PG8_BAR; PG8_MMA(1, 0, At, B0); PG8_MMA(1, 1, At, B1); PG8_BAR; PG8_SCHED;
            PG8_LDB(B0, 1, 0); PG8_LDB(B1, 1, 1); PG8_SCHED; PG8_LDA(At, 1, 0); PG8_STAGE(PG8_SA(0, 1), a2 + hstep, voffA);
            PG8_WAIT_V(8); PG8_WAIT_L(0); PG8_BAR; PG8_MMA(0, 0, At, B0); PG8_MMA(0, 1, At, B1); PG8_BAR; PG8_SCHED;
            PG8_LDA(At, 1, 1); PG8_STAGE(PG8_SB(1, 0), b3, voffB); PG8_STAGE(PG8_SB(1, 1), b3 + hstep, voffB); PG8_STAGE(PG8_SA(1, 0), a3, voffA);
            PG8_WAIT_V(8); PG8_WAIT_L(0); PG8_BAR; PG8_MMA(1, 0, At, B0); PG8_MMA(1, 1, At, B1); PG8_BAR; PG8_SCHED;
            } else {
            PG8_LDB(B0, 0, 0); PG8_SCHED; PG8_LDA(At, 0, 0); PG8_STAGE(PG8_SA(1, 1), a1 + hstep, voffA);
            PG8_WAIT_L(8); PG8_BAR; PG8_WAIT_L(0); PG8_MMA(0, 0, At, B0); PG8_BAR; PG8_SCHED;
            PG8_LDB(B1, 0, 1); PG8_STAGE(PG8_SB(0, 0), b2, voffB);
            PG8_BAR; PG8_WAIT_L(0); PG8_MMA(0, 1, At, B1); PG8_BAR;
            PG8_LDA(At, 0, 1); PG8_STAGE(PG8_SA(0, 0), a2, voffA);
            PG8_BAR; PG8_WAIT_L(0); PG8_MMA(1, 0, At, B0); PG8_BAR; PG8_SCHED;
            PG8_STAGE(PG8_SB(0, 1), b2 + hstep, voffB);
            PG8_WAIT_V(6); PG8_BAR; PG8_MMA(1, 1, At, B1); PG8_BAR;
            PG8_LDB(B0, 1, 0); PG8_SCHED; PG8_LDA(At, 1, 0); PG8_STAGE(PG8_SA(0, 1), a2 + hstep, voffA);
            PG8_WAIT_L(8); PG8_BAR; PG8_WAIT_L(0); PG8_MMA(0, 0, At, B0); PG8_BAR; PG8_SCHED;
            PG8_LDB(B1, 1, 1); PG8_STAGE(PG8_SB(1, 0), b3, voffB);
            PG8_BAR; PG8_WAIT_L(0); PG8_MMA(0, 1, At, B1); PG8_BAR;
            PG8_LDA(At, 1, 1); PG8_STAGE(PG8_SA(1, 0), a3, voffA);
            PG8_BAR; PG8_WAIT_L(0); PG8_MMA(1, 0, At, B0); PG8_BAR; PG8_SCHED;
            PG8_STAGE(PG8_SB(1, 1), b3 + hstep, voffB);
            PG8_WAIT_V(6); PG8_BAR; PG8_MMA(1, 1, At, B1); PG8_BAR;
            }
        }
        if constexpr (ALIGN_EPI) { if (wr == 0) PG8_BAR; }
        if constexpr (!Epi::AFTER_DRAIN) { E(acc, cur, wr, wc, fr, fq); S.done(cur); }
        if (!has_next) break;
#pragma unroll
        for (int a = 0; a < 2; ++a)
#pragma unroll
            for (int b = 0; b < 2; ++b)
#pragma unroll
                for (int m = 0; m < 4; ++m)
#pragma unroll
                    for (int n = 0; n < 2; ++n) acc[a][b][m][n] = (f32x4){0.f, 0.f, 0.f, 0.f};
        cur = nxt; cA = nA; cB = nB; ++ui;
        if constexpr (ALIGN_EPI) { if (wr == 1) PG8_BAR; }
    }
    PG8_WAIT_V(0);
    if constexpr (!ALIGN_EPI) { if (wr == 0) PG8_BAR; }
    PG8_BAR;
    if constexpr (Epi::AFTER_DRAIN) { E.fused(acc, cur, wr, wc, fr, fq, lds, wid, lane); S.done(cur); }
#undef PG8_SA
#undef PG8_SB
#undef PG8_STAGE
#undef PG8_LDA
#undef PG8_LDB
#undef PG8_MMA
#undef PG8_WAIT_V
#undef PG8_WAIT_L
#undef PG8_BAR
#undef PG8_SCHED
}
}
namespace att {
constexpr int D = 128, PITCH = 2048;
constexpr float THR = 8.f;
constexpr bool WSKIP = false;
constexpr float SCALE = 0.08838834764831845f;
constexpr int NW = 8, QBLK = 32, KVBLK = 64, QB = NW * QBLK;
constexpr int SHM_V = KVBLK * D * 2, SHM_K = KVBLK * D * 2;
constexpr int LDS_BYTES = 2 * SHM_V + 2 * SHM_K + NW * 64 * 4 + 512;
using bf16 = __hip_bfloat16;
typedef short bf16x8 __attribute__((ext_vector_type(8)));
typedef short s16x4 __attribute__((ext_vector_type(4)));
typedef float f32x16 __attribute__((ext_vector_type(16)));
typedef float f32x4 __attribute__((ext_vector_type(4)));
typedef unsigned u32x4 __attribute__((ext_vector_type(4)));
template <class A, class Bt> struct same_t { static constexpr bool v = false; };
template <class A> struct same_t<A, A> { static constexpr bool v = true; };

#define BPERM(k) ((((k) >> 2) & 1) * 32 + (((k) >> 3) & 3) * 4 + ((k) & 3))
#define KSWZ(row, colB) ((row) * 256 + ((colB) ^ (((row) & 7) << 4)))
#define SBAR() __builtin_amdgcn_sched_barrier(0)
__device__ __forceinline__ int v_st(int k, int c) { const int kk = (k & ~0xC) | ((k & 4) << 1) | ((k & 8) >> 1); return ((kk >> 3) * 4 + (c >> 5)) * 512 + ((kk & 7) * 32 + (c & 31)) * 2; }
__device__ __forceinline__ int v_rd_base(int lane) { return ((lane & 3) << 3) | (((lane >> 2) & 3) << 6) | (((lane >> 4) & 1) << 5) | (((lane >> 5) & 1) << 8); }
constexpr int v_rd_off(int d0, int ks, int half) { return d0 * 512 + ks * 4096 + half * 2048; }
__device__ __forceinline__ int crow(int r, int hi) { return (r & 3) + 8 * (r >> 2) + 4 * hi; }
__device__ __forceinline__ unsigned cvtpk(float lo, float hi) {
    unsigned r; asm volatile("v_cvt_pk_bf16_f32 %0, %1, %2" : "=v"(r) : "v"(lo), "v"(hi)); return r;
}
__device__ __forceinline__ bf16x8 pack8(f32x4 a, f32x4 b) {
    u32x4 w = {cvtpk(a[0], a[1]), cvtpk(a[2], a[3]), cvtpk(b[0], b[1]), cvtpk(b[2], b[3])};
    return *reinterpret_cast<bf16x8*>(&w);
}
template <class T> __device__ __forceinline__ bf16x8 load8(const T* p) {
    if constexpr (same_t<T, float>::v) { return pack8(*(const f32x4*)p, *(const f32x4*)(p + 4)); }
    else { return *reinterpret_cast<const bf16x8*>(p); }
}
__device__ __forceinline__ void mask_tile(f32x16& p0, f32x16& p1, int dq, unsigned W) {
    const float NEG = -__builtin_inff();
#pragma unroll
    for (int r = 0; r < 16; ++r) {
        const int c = (r & 3) + 8 * (r >> 2);
        if ((unsigned)(dq - c) >= W) p0[r] = NEG;
        if ((unsigned)(dq - c - 32) >= W) p1[r] = NEG;
    }
}
__device__ __forceinline__ void partialSM(f32x16& p0, f32x16& p1, float& m_reg, float& mn, float& alpha) {
    float pmax = p0[0]; for (int r = 1; r < 16; ++r) pmax = fmaxf(pmax, p0[r]); for (int r = 0; r < 16; ++r) pmax = fmaxf(pmax, p1[r]);
    { auto rr = __builtin_amdgcn_permlane32_swap(__float_as_uint(pmax), __float_as_uint(pmax), false, false);
      pmax = fmaxf(__uint_as_float(rr[0]), __uint_as_float(rr[1])); }
    constexpr float C2 = 1.4426950408889634f * SCALE;
    if (__builtin_expect(__all((pmax - m_reg) * SCALE <= THR), 1)) { mn = m_reg; alpha = 1.f; }
    else { mn = fmaxf(m_reg, pmax); alpha = __builtin_amdgcn_exp2f((m_reg - mn) * C2); m_reg = mn; }
    const float mnL = -mn * C2;
    for (int r = 0; r < 16; ++r) p0[r] = fmaf(p0[r], C2, mnL); for (int r = 0; r < 16; ++r) p1[r] = fmaf(p1[r], C2, mnL);
    for (int r = 0; r < 16; ++r) p0[r] = __builtin_amdgcn_exp2f(p0[r]);
}
__device__ __forceinline__ void finishSM(f32x16& p0, f32x16& p1, float alpha, float& l_reg, bf16x8& pa0, bf16x8& pa1, bf16x8& pa2, bf16x8& pa3) {
    for (int r = 0; r < 16; ++r) p1[r] = __builtin_amdgcn_exp2f(p1[r]);
    float ps = 0; for (int r = 0; r < 16; ++r) ps += p0[r]; for (int r = 0; r < 16; ++r) ps += p1[r];
    { auto rr = __builtin_amdgcn_permlane32_swap(__float_as_uint(ps), __float_as_uint(ps), false, false);
      ps = __uint_as_float(rr[0]) + __uint_as_float(rr[1]); }
    l_reg = l_reg * alpha + ps;
#define PK4(P, B_, OUT) do { unsigned a0 = cvtpk(P[B_+0], P[B_+1]), a1 = cvtpk(P[B_+2], P[B_+3]);                          \
        unsigned b0 = cvtpk(P[B_+4], P[B_+5]), b1 = cvtpk(P[B_+6], P[B_+7]);                                             \
        auto r0 = __builtin_amdgcn_permlane32_swap(a0, b0, false, false); auto r1 = __builtin_amdgcn_permlane32_swap(a1, b1, false, false); \
        u32x4 w = {r0[0], r1[0], r0[1], r1[1]}; OUT = *reinterpret_cast<bf16x8*>(&w); } while (0)
    PK4(p0, 0, pa0); PK4(p0, 8, pa1); PK4(p1, 0, pa2); PK4(p1, 8, pa3);
#undef PK4
}
template <int KB, bool SK>
__device__ __forceinline__ void qkt(f32x16& p0, f32x16& p1, const char* K_lds, const float* B_lds, int r32, int hi, const bf16x8* qr, bool act) {
    if (SK && !act) { const float NEG = -__builtin_inff();
#pragma unroll
        for (int r = 0; r < 16; ++r) { p0[r] = NEG; p1[r] = NEG; } return; }
#ifdef ATT_NOBIAS
    p0 = f32x16{}; p1 = f32x16{};
#else
    p0 = *(const f32x16*)(B_lds + KB * 64 + hi * 32); p1 = *(const f32x16*)(B_lds + KB * 64 + hi * 32 + 16);
#endif
    const char* kb[4];
#pragma unroll
    for (int dd = 0; dd < 4; ++dd) kb[dd] = K_lds + KB * SHM_K + KSWZ(r32, (dd * 16 + hi * 8) * 2);
#pragma unroll
    for (int d0 = 0; d0 < 8; ++d0) { const char* a = kb[d0 & 3] + (d0 >> 2) * 128;
        bf16x8 b0 = *reinterpret_cast<const bf16x8*>(a);
        bf16x8 b1 = *reinterpret_cast<const bf16x8*>(a + 32 * 256);
        p0 = __builtin_amdgcn_mfma_f32_32x32x16_bf16(b0, qr[d0], p0, 0, 0, 0);
        p1 = __builtin_amdgcn_mfma_f32_32x32x16_bf16(b1, qr[d0], p1, 0, 0, 0); }
}
template <int VB, bool SK>
__device__ __forceinline__ void pv_tile(f32x16* o, int vb0, bf16x8 pa0, bf16x8 pa1, bf16x8 pa2, bf16x8 pa3, bool act) {
    if (SK && !act) return;
#define TRRD(dst, off) asm volatile("ds_read_b64_tr_b16 %0, %1 offset:%2" : "=&v"(dst) : "v"(vb0), "i"(off) : "memory")
#define PV_D0(d0) do { s16x4 l0, l1, l2, l3, h0, h1, h2, h3; constexpr int b_ = VB * SHM_V + v_rd_off(d0, 0, 0);     \
        TRRD(l0, b_); TRRD(h0, b_ + 2048); TRRD(l1, b_ + 4096); TRRD(h1, b_ + 6144); TRRD(l2, b_ + 8192); TRRD(h2, b_ + 10240); TRRD(l3, b_ + 12288); TRRD(h3, b_ + 14336); \
        asm volatile("s_waitcnt lgkmcnt(0)" ::: "memory"); SBAR();                 \
        o[d0] = __builtin_amdgcn_mfma_f32_32x32x16_bf16(pa0, (bf16x8){l0[0], l0[1], l0[2], l0[3], h0[0], h0[1], h0[2], h0[3]}, o[d0], 0, 0, 0);   \
        o[d0] = __builtin_amdgcn_mfma_f32_32x32x16_bf16(pa1, (bf16x8){l1[0], l1[1], l1[2], l1[3], h1[0], h1[1], h1[2], h1[3]}, o[d0], 0, 0, 0);   \
        o[d0] = __builtin_amdgcn_mfma_f32_32x32x16_bf16(pa2, (bf16x8){l2[0], l2[1], l2[2], l2[3], h2[0], h2[1], h2[2], h2[3]}, o[d0], 0, 0, 0);   \
        o[d0] = __builtin_amdgcn_mfma_f32_32x32x16_bf16(pa3, (bf16x8){l3[0], l3[1], l3[2], l3[3], h3[0], h3[1], h3[2], h3[3]}, o[d0], 0, 0, 0); } while (0)
    PV_D0(0); PV_D0(1); PV_D0(2); PV_D0(3);
#undef PV_D0
#undef TRRD
}

template <class TIn, class TOut> struct BlockRef { const TIn* Q; const TIn* K; const TIn* V; TOut* O; const float* CB; const TIn* Z; int P0; };
template <class TIn> struct Seam {
    bf16x8 qr[8];
    bf16x8 st_v0, st_v1, st_k0, st_k1; float st_b0; f32x4 sf0, sf1, sf2, sf3;
    f32x4 tq[16];
};
__device__ __forceinline__ int swa_jlo(int P0, int W) { const int lowk = P0 - W + 1; return lowk > 0 ? lowk / KVBLK : 0; }
#define ROW(p, k0, rr) ((p) + (unsigned)(((k0) + (rr)) * PITCH + sc))
#define VMW() asm volatile("s_waitcnt vmcnt(0)" ::: "memory")
#define VMWN(n) asm volatile("s_waitcnt vmcnt(%0)" :: "i"(n) : "memory")
#define SLOAD_H(Kp, Vp, Cp, k0) do { S.st_b0 = (Cp)[(unsigned)((k0) + sr + 32 * (tid & 1))]; S.st_v0 = load8<TIn>(ROW(Vp, k0, sr)); S.st_v1 = load8<TIn>(ROW(Vp, k0, 32 + sr));              \
                         S.st_k0 = load8<TIn>(ROW(Kp, k0, sr)); S.st_k1 = load8<TIn>(ROW(Kp, k0, 32 + sr)); } while (0)
#define SWRITE_HK(bf) do { B_lds[(bf) * 64 + sr + 32 * (tid & 1)] = S.st_b0; *(bf16x8*)(K_lds + (bf) * SHM_K + kws) = S.st_k0; *(bf16x8*)(K_lds + (bf) * SHM_K + kws + 32 * 256) = S.st_k1; } while (0)
#define SWRITE_HV(bf) do { *(bf16x8*)(V_lds + (bf) * SHM_V + vst0) = S.st_v0; *(bf16x8*)(V_lds + (bf) * SHM_V + vst1) = S.st_v1; } while (0)
#define SWRITE_H(bf) do { SWRITE_HV(bf); SWRITE_HK(bf); } while (0)
#define SLOAD_F(p, k0) do { S.sf0 = *(const f32x4*)ROW(p, k0, sr); S.sf1 = *(const f32x4*)(ROW(p, k0, sr) + 4);                \
                            S.sf2 = *(const f32x4*)ROW(p, k0, 32 + sr); S.sf3 = *(const f32x4*)(ROW(p, k0, 32 + sr) + 4); } while (0)
#define SWRITE_KF(bf) do { *(bf16x8*)(K_lds + (bf) * SHM_K + kws) = pack8(S.sf0, S.sf1); *(bf16x8*)(K_lds + (bf) * SHM_K + kws + 32 * 256) = pack8(S.sf2, S.sf3); } while (0)
#define SWRITE_VF(bf) do { *(bf16x8*)(V_lds + (bf) * SHM_V + vst0) = pack8(S.sf0, S.sf1); *(bf16x8*)(V_lds + (bf) * SHM_V + vst1) = pack8(S.sf2, S.sf3); } while (0)
template <class TIn, class TOut>
__device__ __forceinline__ void causal_swa_prime(const BlockRef<TIn, TOut>& cur, int W, char* lds, Seam<TIn>& S) {
    constexpr bool F32 = same_t<TIn, float>::v;
    const int tid = otid(), wid = __builtin_amdgcn_readfirstlane(tid >> 6), lane = tid & 63, r32 = lane & 31, hi = lane >> 5;
    const int sr = tid >> 4, sc = (tid & 15) * 8, kws = KSWZ(sr, sc * 2); char* K_lds = lds + 2 * SHM_V; float* B_lds = (float*)(lds + 2 * SHM_V + 2 * SHM_K + NW * 64 * 4);
    const int kb0 = swa_jlo(cur.P0, W) * KVBLK;
    for (int d0 = 0; d0 < 8; ++d0) S.qr[d0] = load8<TIn>(cur.Q + (unsigned)((wid * QBLK + r32) * PITCH + d0 * 16 + hi * 8));
    if constexpr (F32) { SLOAD_F((const float*)cur.K, kb0); VMW(); SWRITE_KF(0); SBAR(); SLOAD_F((const float*)cur.V, kb0); }
    else { SLOAD_H(cur.K, cur.V, cur.CB, kb0); VMW(); SWRITE_HK(0); }
    __syncthreads();
}
template <class TIn, class TOut>
__device__ __forceinline__ void causal_swa_block(const BlockRef<TIn, TOut>& cur, const BlockRef<TIn, TOut>& nxt, int skv, int W, char* lds, Seam<TIn>& S) {
    constexpr bool F32 = same_t<TIn, float>::v;
    const int tid = otid(), wid = __builtin_amdgcn_readfirstlane(tid >> 6), lane = tid & 63, r32 = lane & 31, hi = lane >> 5;
    const int j_lo = swa_jlo(cur.P0, W);
    int j_hi = (cur.P0 + QB - 1) / KVBLK + 1; if (j_hi > skv / KVBLK) j_hi = skv / KVBLK;
    const int NT = j_hi - j_lo;
    const int kbn = swa_jlo(nxt.P0, W) * KVBLK;
    const int qlo = cur.P0 + wid * QBLK, qm = qlo + r32 - 4 * hi;
    char* V_lds = lds; char* K_lds = lds + 2 * SHM_V; float* B_lds = (float*)(lds + 2 * SHM_V + 2 * SHM_K + NW * 64 * 4);
    float* ws = (float*)(lds + 2 * SHM_V + 2 * SHM_K) + wid * 64; float* li_l = ws, * al_l = ws + 32;
    float m_reg = -1e30f, l_reg = 0; f32x16 o[4] = {};
    const int sr = tid >> 4, sc = (tid & 15) * 8, vst0 = v_st(sr, sc), vst1 = v_st(32 + sr, sc), kws = KSWZ(sr, sc * 2);
    const int vb0 = (int)(uintptr_t)V_lds + v_rd_base(lane);
    const TIn* Kh = cur.K; const TIn* Vh = cur.V; const float* Ch = cur.CB;
#define RESC(a) do { if (__any((a) < 1.f)) { if (hi == 0) al_l[r32] = (a); asm volatile("s_waitcnt lgkmcnt(0)" ::: "memory");              \
                     for (int d_ = 0; d_ < 4; ++d_) for (int r = 0; r < 16; ++r) o[d_][r] *= al_l[crow(r, hi)]; } } while (0)
#define KBASE(t) ((j_lo + (t)) * KVBLK)
#define ACT(t) (KBASE(t) <= qlo + QBLK - 1 && KBASE(t) + KVBLK - 1 >= qlo - W + 1)
#define MASKT(P0_, P1_, t) do { const int kb_ = KBASE(t); if ((!SK || ACT(t)) && (kb_ + KVBLK - 1 > qlo || kb_ <= qlo + QBLK - 1 - W)) mask_tile(P0_, P1_, qm - kb_, (unsigned)W); } while (0)
    constexpr int NQL = F32 ? 16 : 8;
    constexpr bool SK = WSKIP && !F32;
#define SEAM_K0() do { VMWN(NQL); if constexpr (F32) { SWRITE_KF(0); SBAR(); SLOAD_F((const float*)nxt.V, kbn); } else { SWRITE_HK(0); } SBAR(); } while (0)
    f32x16 pA0, pA1, pB0, pB1; float mnA, mnB, alA, alB; bf16x8 pa0, pa1, pa2, pa3;
    if constexpr (F32) { VMW(); SWRITE_VF(0); SBAR(); } else { SWRITE_HV(0); SBAR(); }
    if (NT > 1) { if constexpr (F32) SLOAD_F((const float*)Kh, KBASE(1)); else SLOAD_H(Kh, Vh, Ch, KBASE(1)); }
    SBAR(); qkt<0, SK>(pA0, pA1, K_lds, B_lds, r32, hi, S.qr, ACT(0));
    if constexpr (F32) { if (NT > 1) { VMW(); SWRITE_KF(1); SBAR(); SLOAD_F((const float*)Vh, KBASE(1)); } }
    MASKT(pA0, pA1, 0); partialSM(pA0, pA1, m_reg, mnA, alA);
    if (NT > 1) { VMW(); if constexpr (F32) { SWRITE_VF(1); SBAR(); if (NT > 2) SLOAD_F((const float*)Kh, KBASE(2)); } else SWRITE_H(1); }
    __syncthreads();
#define HALF_STEP(PX0, PX1, mnX, alX, PY0, PY1, alY, t, KB, VB, SB) do {                                                      \
        SBAR(); qkt<KB, SK>(PX0, PX1, K_lds, B_lds, r32, hi, S.qr, ACT(t));                                             \
        finishSM(PY0, PY1, alY, l_reg, pa0, pa1, pa2, pa3); SBAR();                                                           \
        if ((t) + 1 < NT) { if constexpr (F32) { VMW(); SWRITE_KF(SB); SBAR(); SLOAD_F((const float*)Vh, KBASE((t) + 1)); }  \
                            else { SLOAD_H(Kh, Vh, Ch, KBASE((t) + 1)); } SBAR(); }                                               \
        pv_tile<VB, SK>(o, vb0, pa0, pa1, pa2, pa3, ACT((t) - 1)); MASKT(PX0, PX1, (t)); partialSM(PX0, PX1, m_reg, mnX, alX);                                        \
        __syncthreads();                                                                                                      \
        if ((t) + 1 < NT) { VMW(); if constexpr (F32) { SWRITE_VF(SB); SBAR(); if ((t) + 2 < NT) SLOAD_F((const float*)Kh, KBASE((t) + 2)); } \
                            else { SWRITE_H(SB); } }                                                                          \
        RESC(alX); __syncthreads(); } while (0)
    for (int t = 1; t + 1 < NT; t += 2) {
        HALF_STEP(pB0, pB1, mnB, alB, pA0, pA1, alA, t, 1, 0, 0);
        HALF_STEP(pA0, pA1, mnA, alA, pB0, pB1, alB, t + 1, 0, 1, 1);
    }
    const bool even = (NT & 1) == 0;
    if (even) { SBAR(); qkt<1, SK>(pB0, pB1, K_lds, B_lds, r32, hi, S.qr, ACT(NT - 1)); SBAR(); }
#define QROW(e) (nxt.Q + (size_t)(wid * QBLK + r32) * PITCH + ((e) >> 1) * 16 + hi * 8 + ((e) & 1) * 4)
    if constexpr (F32) { SLOAD_F((const float*)nxt.K, kbn); SBAR();
#pragma unroll
        for (int e = 0; e < 8; ++e) S.tq[e] = *(const f32x4*)QROW(e); }
    else { SLOAD_H(nxt.K, nxt.V, nxt.CB, kbn); SBAR();
#pragma unroll
        for (int d0 = 0; d0 < 8; ++d0) S.qr[d0] = load8<TIn>(nxt.Q + (unsigned)((wid * QBLK + r32) * PITCH + d0 * 16 + hi * 8)); }
    SBAR();
    finishSM(pA0, pA1, alA, l_reg, pa0, pa1, pa2, pa3); SBAR();
    if constexpr (F32) {
#pragma unroll
        for (int e = 8; e < 16; ++e) S.tq[e] = *(const f32x4*)QROW(e); SBAR(); }
#undef QROW
    pv_tile<0, SK>(o, vb0, pa0, pa1, pa2, pa3, ACT(even ? NT - 2 : NT - 1));
    if (even) { MASKT(pB0, pB1, NT - 1); partialSM(pB0, pB1, m_reg, mnB, alB); __syncthreads(); RESC(alB);
        finishSM(pB0, pB1, alB, l_reg, pa0, pa1, pa2, pa3); SBAR(); pv_tile<1, SK>(o, vb0, pa0, pa1, pa2, pa3, ACT(NT - 1)); }
    SBAR(); SEAM_K0();
    if (hi == 0) li_l[r32] = l_reg; asm volatile("s_waitcnt lgkmcnt(0)" ::: "memory");
    float rli[16];
#pragma unroll
    for (int r = 0; r < 16; ++r) rli[r] = __builtin_amdgcn_rcpf(li_l[crow(r, hi)]);
    TOut* Ow = cur.O + (size_t)(wid * QBLK) * PITCH; const TIn* Zw = cur.Z + (size_t)(wid * QBLK) * PITCH; unsigned lo_ = (unsigned)(4 * hi) * PITCH + r32; asm volatile("" : "+v"(lo_));
#pragma unroll
    for (int r = 0; r < 16; ++r) { const int orow = crow(r, hi);
#pragma unroll
        for (int d0 = 0; d0 < 4; ++d0) { const float v = o[d0][r] * rli[r];
            if constexpr (same_t<TOut, float>::v) { Ow[(size_t)orow * PITCH + d0 * 32 + r32] = v; }
            else { const float vn = __shfl_xor(v, 1);
                   if ((r32 & 1) == 0) { const unsigned of_ = lo_ + (unsigned)(orow - 4 * hi) * PITCH + d0 * 32; const unsigned zz = *(const unsigned*)(Zw + of_);
                       *(unsigned*)(Ow + of_) = cvtpk(v * __uint_as_float(zz << 16), vn * __uint_as_float(zz & 0xffff0000u)); } } } }
    if constexpr (F32) {
#pragma unroll
        for (int d0 = 0; d0 < 8; ++d0) S.qr[d0] = pack8(S.tq[2 * d0], S.tq[2 * d0 + 1]); }
    __syncthreads();
#undef RESC
#undef KBASE
#undef ACT
#undef MASKT
#undef SEAM_K0
#undef HALF_STEP
}
#undef ROW
#undef VMW
#undef VMWN
#undef SLOAD_H
#undef SWRITE_HK
#undef SWRITE_HV
#undef SWRITE_H
#undef SLOAD_F
#undef SWRITE_KF
#undef SWRITE_VF
}

namespace cg = cooperative_groups;
#define LAS __attribute__((address_space(3)))
typedef unsigned short bf16_t;
typedef float f32x4 __attribute__((ext_vector_type(4)));
typedef float f32x2 __attribute__((ext_vector_type(2)));
typedef unsigned u32x4 __attribute__((ext_vector_type(4)));
typedef unsigned u32x2 __attribute__((ext_vector_type(2)));
typedef short bf16x8 __attribute__((ext_vector_type(8)));

constexpr int DM = 1024, EB = 2048, MP = 32768, MS = 128, MV = MP + MS  , MA = 33024  ;
constexpr int SEQ = 4096, NBH = 128, PAST = 2048, TS = 16, SKS = 2112  ;
constexpr int NFIN = 8448;
constexpr float RMS_EPS = 1e-6f, LN_EPS = 1e-5f;
constexpr size_t O_YP = 0, O_YS = 33554432, O_GV = 33685504, O_FKP = 34209792, O_FVP = 168427520, O_FLP = 302645248, O_FKS = 303693824, O_FVS = 304218112, O_FLS = 304742400;
constexpr size_t MiB = 1u << 20;
constexpr size_t WS_WGIN = 1 * MiB;
constexpr size_t WS_WGOUT = 25 * MiB;
constexpr size_t WS_WFIN = 33 * MiB;
constexpr size_t WS_WFOUT = 66 * MiB;
constexpr size_t WS_WPP = 74 * MiB;
constexpr size_t WS_WPG = 76 * MiB;
constexpr size_t WS_WM = 84 * MiB;
constexpr size_t WS_WMS = 85 * MiB;
constexpr size_t WS_PB = 88 * MiB;
constexpr size_t WS_HX = 105 * MiB;
constexpr size_t WS_TB = 170 * MiB;
constexpr size_t WS_STAT = 756 * MiB;
constexpr size_t WS_CBP = 236 * MiB;
constexpr size_t WS_CBS = 238 * MiB + 512 * 1024;
constexpr size_t WS_R0 = 240 * MiB, RSZ = 129 * MiB;
constexpr size_t WS_END = 775 * MiB;
constexpr size_t WS_PART = 766 * MiB;
constexpr size_t WS_DUMMY = 776 * MiB;
constexpr int LDS_BYTES = LDS_TOTAL;
#ifndef PROBE_DUP
#define PROBE_DUP 0
#endif

struct ArgsS { const float* in[20]; float* out; unsigned char* ws; };
typedef const __attribute__((address_space(4))) ArgsS* ArgsP;
struct Args { ArgsP p; };
__device__ __forceinline__ Args getargs() { ArgsP p = (ArgsP)__builtin_amdgcn_kernarg_segment_ptr(); asm volatile("" : "+s"(p)); Args a; a.p = p; return a; }

__device__ __forceinline__ unsigned f2bf(float f) { unsigned u = __builtin_bit_cast(unsigned, f); return (u + 0x7fffu + ((u >> 16) & 1u)) >> 16; }
__device__ __forceinline__ unsigned pk2(float lo, float hi) { return pg8::cvt_pk_bf16(lo, hi); }
__device__ __forceinline__ float bflo(unsigned u) { return __uint_as_float(u << 16); }
__device__ __forceinline__ float bfhi(unsigned u) { return __uint_as_float(u & 0xffff0000u); }
__device__ __forceinline__ float wave_sum(float v) { for (int o = 32; o > 0; o >>= 1) v += __shfl_xor(v, o); return v; }
__device__ __forceinline__ float wave_max(float v) { for (int o = 32; o > 0; o >>= 1) v = fmaxf(v, __shfl_xor(v, o)); return v; }
__device__ __forceinline__ float gelu_t(float x) { const float t = x * x; const float e = __builtin_amdgcn_exp2f((-2.3022082f * x) * (1.f + 0.044715f * t)); return x * __builtin_amdgcn_rcpf(1.f + e); }
__device__ __forceinline__ float silu_f(float x) { return x * __builtin_amdgcn_rcpf(1.f + __builtin_amdgcn_exp2f(-1.4426950408889634f * x)); }
__device__ __forceinline__ float sigm_f(float x) { return __builtin_amdgcn_rcpf(1.f + __builtin_amdgcn_exp2f(-1.4426950408889634f * x)); }
__device__ __forceinline__ f32x2 sigm2(f32x2 v) { const f32x2 a = v * -1.4426950408889634f; f32x2 e; e.x = __builtin_amdgcn_exp2f(a.x); e.y = __builtin_amdgcn_exp2f(a.y); const f32x2 d = e + 1.0f; f32x2 r; r.x = __builtin_amdgcn_rcpf(d.x); r.y = __builtin_amdgcn_rcpf(d.y); return r; }
__device__ __forceinline__ f32x2 silu2(f32x2 v) { return v * sigm2(v); }
__device__ __forceinline__ f32x2 gelu2(f32x2 v) { const f32x2 t = v * v; const f32x2 a = (v * -2.3022082f) * (t * 0.044715f + 1.0f); f32x2 e; e.x = __builtin_amdgcn_exp2f(a.x); e.y = __builtin_amdgcn_exp2f(a.y); const f32x2 d = e + 1.0f; f32x2 r; r.x = __builtin_amdgcn_rcpf(d.x); r.y = __builtin_amdgcn_rcpf(d.y); return v * r; }
__device__ __forceinline__ float logsig_f(float x) { const float e = __expf(-fabsf(x)); const float l = e < 0.03f ? e * (1.f - e * (0.5f - e * (0.33333334f - 0.25f * e))) : __logf(1.f + e); return fminf(x, 0.f) - l; }

using pg8::Unit; using pg8::HALF; using pg8::BM;
struct EpiGmlpIn {
    static constexpr bool PERM = true, AFTER_DRAIN = false;
    bf16_t* U; bf16_t* VT; bf16_t* ZS; float* stat;
    __device__ __forceinline__ void operator()(const pg8::f32x4 (&acc)[2][2][4][2], const Unit& u, int wr, int wc, int fr_, int fq_) const {
        const int lane_ = otid() & 63, fr = lane_ & 15, fq = lane_ >> 4; (void)fr_; (void)fq_;
        const int row0 = u.pm * BM + wr * 64 + fr, colt = u.pn * BM, region = colt >> 11, cb = (colt & 2047) + wc * 32 + 8 * fq;
#pragma unroll
        for (int ai = 0; ai < 2; ++ai)
#pragma unroll
            for (int m = 0; m < 4; ++m) {
                const int row = row0 + ai * HALF + m * 16; float s = 0.f, q = 0.f;
#pragma unroll
                for (int bj = 0; bj < 2; ++bj) {
                    const int col = cb + bj * HALF; const pg8::f32x4 v0 = acc[ai][bj][m][0], v1 = acc[ai][bj][m][1];
                    float x[8] = {v0[0], v0[1], v0[2], v0[3], v1[0], v1[1], v1[2], v1[3]};
                    if (region == 2) {
#pragma unroll
                        for (int e = 0; e < 8; e += 2) { const f32x2 r = silu2((f32x2){x[e], x[e + 1]}); x[e] = r.x; x[e + 1] = r.y; }
                    } else {
#pragma unroll
                        for (int e = 0; e < 8; e += 2) { const f32x2 r = gelu2((f32x2){x[e], x[e + 1]}); x[e] = r.x; x[e + 1] = r.y; }
                    }
                    u32x4 w; w.x = pk2(x[0], x[1]); w.y = pk2(x[2], x[3]); w.z = pk2(x[4], x[5]); w.w = pk2(x[6], x[7]);
                    if (region == 1) {
                        bf16_t* vp = VT + ((size_t)(row >> 7) * 2048 + col) * 128 + (row & 127);
                        const unsigned ww[4] = {w.x, w.y, w.z, w.w};
#pragma unroll
                        for (int e = 0; e < 4; ++e) { vp[(2 * e) * 128] = (bf16_t)(ww[e] & 0xffffu); vp[(2 * e + 1) * 128] = (bf16_t)(ww[e] >> 16);
                            const float a = bflo(ww[e]), b = bfhi(ww[e]); s += a + b; q += a * a + b * b; }
                    } else {
                        bf16_t* dst = (region == 0 ? U : ZS) + (size_t)row * 2048 + col;
                        *(u32x4*)dst = w;
                    }
                }
                if (region == 1) {
                    s += __shfl_xor(s, 16); s += __shfl_xor(s, 32); q += __shfl_xor(q, 16); q += __shfl_xor(q, 32);
                    if (fq == 0) { const int slot = ((colt & 2047) >> 6) + wc; stat[(size_t)row * 64 + slot] = s; stat[(size_t)row * 64 + 32 + slot] = q; }
                }
            }
    }
};
struct EpiFoxIn {
    static constexpr bool PERM = true, AFTER_DRAIN = false;
    bf16_t* QB; bf16_t* KB; bf16_t* VB; bf16_t* ZS; float* okp; float* ovp; float* olp; float* oks; float* ovs; float* ols; const float* bf;
    __device__ __forceinline__ void operator()(const pg8::f32x4 (&acc)[2][2][4][2], const Unit& u, int wr, int wc, int fr_, int fq_) const {
        const int lane_ = otid() & 63, fr = lane_ & 15, fq = lane_ >> 4; (void)fr_; (void)fq_;
        const int row0 = u.pm * BM + wr * 64 + fr, colt = u.pn * BM, region = colt >> 11, cb = (colt & 2047) + wc * 32 + 8 * fq;
        if (region == 4) {
            if (wc != 0 || fq >= 2) return;
#pragma unroll
            for (int ai = 0; ai < 2; ++ai)
#pragma unroll
                for (int m = 0; m < 4; ++m) {
                    const int row = row0 + ai * HALF + m * 16; if (row >= MV) continue;
                    const pg8::f32x4 v0 = acc[ai][0][m][0], v1 = acc[ai][0][m][1];
                    const f32x4 b0 = *(const f32x4*)(bf + 8 * fq), b1 = *(const f32x4*)(bf + 8 * fq + 4);
                    f32x4 r0, r1;
#pragma unroll
                    for (int e = 0; e < 4; ++e) { r0[e] = logsig_f(v0[e] + b0[e]); r1[e] = logsig_f(v1[e] + b1[e]); }
                    float* dst = row < MP ? olp + (size_t)row * 16 + 8 * fq : ols + (size_t)(row - MP) * 16 + 8 * fq;
                    *(f32x4*)dst = r0; *(f32x4*)(dst + 4) = r1;
                }
            return;
        }
        bf16_t* B = region == 0 ? QB : region == 1 ? KB : region == 2 ? VB : ZS;
#pragma unroll
        for (int ai = 0; ai < 2; ++ai)
#pragma unroll
            for (int m = 0; m < 4; ++m) {
                const int row = row0 + ai * HALF + m * 16;
#pragma unroll
                for (int bj = 0; bj < 2; ++bj) {
                    const int col = cb + bj * HALF; pg8::f32x4 v0 = acc[ai][bj][m][0], v1 = acc[ai][bj][m][1];
                    if (region == 3) {
#pragma unroll
                        for (int e = 0; e < 4; e += 2) { const f32x2 r0 = silu2((f32x2){v0[e], v0[e + 1]}), r1 = silu2((f32x2){v1[e], v1[e + 1]}); v0[e] = r0.x; v0[e + 1] = r0.y; v1[e] = r1.x; v1[e + 1] = r1.y; }
                    }
                    u32x4 w; w.x = pk2(v0[0], v0[1]); w.y = pk2(v0[2], v0[3]); w.z = pk2(v1[0], v1[1]); w.w = pk2(v1[2], v1[3]);
                    *(u32x4*)(B + (size_t)row * 2048 + col) = w;
                    if ((region == 1 || region == 2) && row < MV) {
                        float* o = region == 1 ? (row < MP ? okp + (size_t)row * 2048 : oks + (size_t)(row - MP) * 2048) : (row < MP ? ovp + (size_t)row * 2048 : ovs + (size_t)(row - MP) * 2048);
                        *(pg8::f32x4*)(o + col) = v0; *(pg8::f32x4*)(o + col + 4) = v1;
                    }
                }
            }
    }
};
struct EpiT {
    static constexpr bool PERM = true, AFTER_DRAIN = false;
    bf16_t* O; int ldc;
    __device__ __forceinline__ void operator()(const pg8::f32x4 (&acc)[2][2][4][2], const Unit& u, int wr, int wc, int fr_, int fq_) const {
        const int lane_ = otid() & 63, fr = lane_ & 15, fq = lane_ >> 4; (void)fr_; (void)fq_;
        const int row0 = u.pm * BM + wr * 64 + fr, col0 = u.pn * BM + wc * 32 + 8 * fq;
#pragma unroll
        for (int ai = 0; ai < 2; ++ai)
#pragma unroll
            for (int m = 0; m < 4; ++m) { bf16_t* rp = O + (size_t)(row0 + ai * HALF + m * 16) * ldc + col0;
#pragma unroll
                for (int bj = 0; bj < 2; ++bj) { const pg8::f32x4 v0 = acc[ai][bj][m][0], v1 = acc[ai][bj][m][1];
                    u32x4 w; w.x = pk2(v0[0], v0[1]); w.y = pk2(v0[2], v0[3]); w.z = pk2(v1[0], v1[1]); w.w = pk2(v1[2], v1[3]);
                    *(u32x4*)(rp + bj * HALF) = w; } }
    }
};
struct EpiF32 {
    static constexpr bool PERM = true, AFTER_DRAIN = false;
    float* O; int ldc;
    __device__ __forceinline__ void operator()(const pg8::f32x4 (&acc)[2][2][4][2], const Unit& u, int wr, int wc, int fr_, int fq_) const {
        const int lane_ = otid() & 63, fr = lane_ & 15, fq = lane_ >> 4; (void)fr_; (void)fq_;
        const int row0 = u.pm * BM + wr * 64 + fr, col0 = u.pn * BM + wc * 32 + 8 * fq;
#pragma unroll
        for (int ai = 0; ai < 2; ++ai)
#pragma unroll
            for (int m = 0; m < 4; ++m) { float* rp = O + (size_t)(row0 + ai * HALF + m * 16) * ldc + col0;
#pragma unroll
                for (int bj = 0; bj < 2; ++bj) { *(pg8::f32x4*)(rp + bj * HALF) = acc[ai][bj][m][0]; *(pg8::f32x4*)(rp + bj * HALF + 4) = acc[ai][bj][m][1]; } }
    }
};
struct EpiPart {
    static constexpr bool PERM = true, AFTER_DRAIN = false;
    float* P;
    __device__ __forceinline__ void operator()(const pg8::f32x4 (&acc)[2][2][4][2], const Unit& u, int wr, int wc, int fr_, int fq_) const {
        const int lane_ = otid() & 63, fr = lane_ & 15, fq = lane_ >> 4; (void)fr_; (void)fq_;
        const int row0 = wr * 64 + fr, col0 = u.pn * BM + wc * 32 + 8 * fq; float* base = P + (size_t)(u.ko >> 8) * 256 * 1024;
#pragma unroll
        for (int ai = 0; ai < 2; ++ai)
#pragma unroll
            for (int m = 0; m < 4; ++m) { float* rp = base + (size_t)(row0 + ai * HALF + m * 16) * 1024 + col0;
#pragma unroll
                for (int bj = 0; bj < 2; ++bj) { *(pg8::f32x4*)(rp + bj * HALF) = acc[ai][bj][m][0]; *(pg8::f32x4*)(rp + bj * HALF + 4) = acc[ai][bj][m][1]; } }
    }
};
struct SplitOrder {
    int nsplit, c;
    __device__ bool next(int i, Unit& u) const { if (i != 0 || c >= 4 * nsplit) return false; u.pm = 128; u.pn = c & 3; u.ko = (c >> 2) * 256; return true; }
    __device__ __forceinline__ void a_ready(const Unit&) const {}
    __device__ __forceinline__ void done(const Unit&) const {}
};
struct EpiGate {
    static constexpr bool PERM = true, AFTER_DRAIN = false;
    const bf16_t* XB; float* Xo; const bf16_t* T; int f32out;
    __device__ __forceinline__ void operator()(const pg8::f32x4 (&acc)[2][2][4][2], const Unit& u, int wr, int wc, int fr_, int fq_) const {
        const int lane_ = otid() & 63, fr = lane_ & 15, fq = lane_ >> 4; (void)fr_; (void)fq_;
        const int row0 = u.pm * BM + wr * 64 + fr, col0 = u.pn * BM + wc * 32 + 8 * fq;
#pragma unroll
        for (int ai = 0; ai < 2; ++ai)
#pragma unroll
            for (int m = 0; m < 4; ++m) { const int row = row0 + ai * HALF + m * 16; if (row >= MV) continue;
#pragma unroll
                for (int bj = 0; bj < 2; ++bj) { const size_t off = (size_t)row * DM + col0 + bj * HALF;
                    const u32x4 t = *(const u32x4*)(T + off); const u32x4 xb = *(const u32x4*)(XB + off);
                    pg8::f32x4 x0 = {bflo(xb.x), bfhi(xb.x), bflo(xb.y), bfhi(xb.y)}, x1 = {bflo(xb.z), bfhi(xb.z), bflo(xb.w), bfhi(xb.w)};
                    const pg8::f32x4 a0 = acc[ai][bj][m][0], a1 = acc[ai][bj][m][1];
                    { const f32x2 s0 = sigm2((f32x2){a0[0], a0[1]}), s1 = sigm2((f32x2){a0[2], a0[3]}), s2 = sigm2((f32x2){a1[0], a1[1]}), s3 = sigm2((f32x2){a1[2], a1[3]});
                      x0[0] += s0.x * bflo(t.x); x0[1] += s0.y * bfhi(t.x); x0[2] += s1.x * bflo(t.y); x0[3] += s1.y * bfhi(t.y);
                      x1[0] += s2.x * bflo(t.z); x1[1] += s2.y * bfhi(t.z); x1[2] += s3.x * bflo(t.w); x1[3] += s3.y * bfhi(t.w); }
                    if (f32out) { *(pg8::f32x4*)(Xo + off) = x0; *(pg8::f32x4*)(Xo + off + 4) = x1; }
                    else { u32x4 w; w.x = pk2(x0[0], x0[1]); w.y = pk2(x0[2], x0[3]); w.z = pk2(x1[0], x1[1]); w.w = pk2(x1[2], x1[3]); *(u32x4*)((bf16_t*)Xo + off) = w; } } }
    }
};

__device__ __forceinline__ void cvt_wt(const float* __restrict__ W, bf16_t* __restrict__ Wt, int K, int N, int Npad, float* tile  ) {
    const int tid = otid(), ntn = Npad / 64, nt = ntn * (K / 64);
    for (int t = blockIdx.x; t < nt; t += gridDim.x) {
        const int n0 = (t % ntn) * 64, k0 = (t / ntn) * 64;
#pragma unroll
        for (int i = 0; i < 2; ++i) { const int kk = (tid >> 4) + 32 * i, n4 = (tid & 15) * 4;
            f32x4 v = {0.f, 0.f, 0.f, 0.f}; if (n0 + n4 < N) v = *(const f32x4*)(W + (size_t)(k0 + kk) * N + n0 + n4);
            tile[kk * 65 + n4] = v[0]; tile[kk * 65 + n4 + 1] = v[1]; tile[kk * 65 + n4 + 2] = v[2]; tile[kk * 65 + n4 + 3] = v[3]; }
        __syncthreads();
        { const int nn = tid >> 3, k8 = (tid & 7) * 8; u32x4 w;
          w.x = pk2(tile[(k8 + 0) * 65 + nn], tile[(k8 + 1) * 65 + nn]); w.y = pk2(tile[(k8 + 2) * 65 + nn], tile[(k8 + 3) * 65 + nn]);
          w.z = pk2(tile[(k8 + 4) * 65 + nn], tile[(k8 + 5) * 65 + nn]); w.w = pk2(tile[(k8 + 6) * 65 + nn], tile[(k8 + 7) * 65 + nn]);
          *(u32x4*)(Wt + (size_t)(n0 + nn) * K + k0 + k8) = w; }
        __syncthreads();
    }
}
__device__ __forceinline__ void prologue(const Args& a, float* tile) {
    unsigned char* ws = a.p->ws;
    for (int j = 0; j < 2; ++j) {
        cvt_wt(a.p->in[9] + (size_t)j * 1024 * 6144, (bf16_t*)(ws + WS_WGIN) + (size_t)j * 6144 * 1024, 1024, 6144, 6144, tile);
        cvt_wt(a.p->in[14] + (size_t)j * 2048 * 1024, (bf16_t*)(ws + WS_WGOUT) + (size_t)j * 1024 * 2048, 2048, 1024, 1024, tile);
        cvt_wt(a.p->in[15] + (size_t)j * 1024 * 8208, (bf16_t*)(ws + WS_WFIN) + (size_t)j * NFIN * 1024, 1024, 8208, NFIN, tile);
        cvt_wt(a.p->in[17] + (size_t)j * 2048 * 1024, (bf16_t*)(ws + WS_WFOUT) + (size_t)j * 1024 * 2048, 2048, 1024, 1024, tile);
    }
    for (int i = 0; i < 4; ++i) {
        cvt_wt(a.p->in[18] + (size_t)i * 256 * 1024, (bf16_t*)(ws + WS_WPP) + (size_t)i * 1024 * 256, 256, 1024, 1024, tile);
        cvt_wt(a.p->in[19] + (size_t)i * 1024 * 1024, (bf16_t*)(ws + WS_WPG) + (size_t)i * 1024 * 1024, 1024, 1024, 1024, tile);
    }
    const float* wsrc = a.p->in[12]; bf16_t* wm = (bf16_t*)(ws + WS_WM); bf16_t* wms = (bf16_t*)(ws + WS_WMS);
    for (int idx = blockIdx.x * 512 + otid(); idx < 2 * 16 * 128 * 128; idx += gridDim.x * 512) {
        const int jj = idx & 127, i = (idx >> 7) & 127, lg = idx >> 14;
        const float w = wsrc[idx]; wm[idx] = (bf16_t)f2bf((jj >> 6) <= (i >> 6) ? w : 0.f);
        const float w2 = wsrc[((size_t)lg * 128 + (i & 15)) * 128 + (jj & 15)]; wms[idx] = (bf16_t)f2bf((i >> 4) == (jj >> 4) ? w2 : 0.f);
    }
}

__device__ __forceinline__ void phase_e1(const Args& a, int layer) {
    const int tid = otid(), lane = tid & 63, gw = blockIdx.x * 8 + (tid >> 6), nw = gridDim.x * 8;
    float* X = a.p->out; bf16_t* X16 = (bf16_t*)a.p->out; bf16_t* HX = (bf16_t*)(a.p->ws + WS_HX); bf16_t* PB = (bf16_t*)(a.p->ws + WS_PB);
    const float* g = a.p->in[7] + (layer & 3) * DM;
    f32x4 gv[4];
#pragma unroll
    for (int q = 0; q < 4; ++q) gv[q] = *(const f32x4*)(g + q * 256 + lane * 4);
#define E1_LOAD(v, r) do { if (layer == 0) { _Pragma("unroll") for (int q = 0; q < 4; ++q) v[q] = *(const f32x4*)(a.p->in[0] + (size_t)(r) * DM + q * 256 + lane * 4); } \
        else { _Pragma("unroll") for (int q = 0; q < 4; ++q) { const u32x2 xb = *(const u32x2*)(X16 + (size_t)(r) * DM + q * 256 + lane * 4); v[q] = (f32x4){bflo(xb.x), bfhi(xb.x), bflo(xb.y), bfhi(xb.y)}; } } } while (0)
#define E1_FIN(v, r, p) do { float ss = 0.f; _Pragma("unroll") for (int q = 0; q < 4; ++q) ss += v[q][0] * v[q][0] + v[q][1] * v[q][1] + v[q][2] * v[q][2] + v[q][3] * v[q][3]; \
        ss = wave_sum(ss); const float rr = rsqrtf(ss * (1.f / DM) + RMS_EPS); \
        _Pragma("unroll") for (int q = 0; q < 4; ++q) { u32x2 hw; hw.x = pk2(v[q][0] * rr * gv[q][0], v[q][1] * rr * gv[q][1]); hw.y = pk2(v[q][2] * rr * gv[q][2], v[q][3] * rr * gv[q][3]); \
            *(u32x2*)(HX + (size_t)(r) * DM + q * 256 + lane * 4) = hw; } \
        u32x2 pw; pw.x = pk2(p[0], p[1]); pw.y = pk2(p[2], p[3]); *(u32x2*)(PB + (size_t)(r) * 256 + lane * 4) = pw; } while (0)
    if (layer < 4) {
        const float* pp = a.p->in[5] + (size_t)layer * MP * 256;
        for (int row = gw; row < MP; row += 2 * nw) {
            const int r1 = row + nw; const bool has1 = r1 < MP;
            f32x4 v0[4], v1[4]; f32x4 p0, p1 = {0.f, 0.f, 0.f, 0.f};
            E1_LOAD(v0, row); p0 = *(const f32x4*)(pp + (size_t)row * 256 + lane * 4);
            if (has1) { E1_LOAD(v1, r1); p1 = *(const f32x4*)(pp + (size_t)r1 * 256 + lane * 4); }
            E1_FIN(v0, row, p0);
            if (has1) E1_FIN(v1, r1, p1);
        }
    }
    for (int row = MP + gw; row < (layer == 4 ? MV : MA); row += nw) {
        if (row < MV) {
            f32x4 v[4];
            if (layer > 0) {
                const bf16_t* TBp = (const bf16_t*)(a.p->ws + WS_TB);
#pragma unroll
                for (int q = 0; q < 4; ++q) { const size_t off = (size_t)row * DM + q * 256 + lane * 4; const float* pq = (const float*)(a.p->ws + WS_PART) + (size_t)(row - MP) * 1024 + q * 256 + lane * 4;
                    f32x4 g4 = *(const f32x4*)pq;
#pragma unroll
                    for (int ks = 1; ks < 4; ++ks) g4 += *(const f32x4*)(pq + (size_t)ks * 256 * 1024);
                    const u32x2 xb = *(const u32x2*)(HX + off), tb = *(const u32x2*)(TBp + off);
                    v[q] = (f32x4){bflo(xb.x) + sigm_f(g4[0]) * bflo(tb.x), bfhi(xb.x) + sigm_f(g4[1]) * bfhi(tb.x), bflo(xb.y) + sigm_f(g4[2]) * bflo(tb.y), bfhi(xb.y) + sigm_f(g4[3]) * bfhi(tb.y)};
                    if (layer == 4) *(f32x4*)(X + off) = v[q]; else { u32x2 w; w.x = pk2(v[q][0], v[q][1]); w.y = pk2(v[q][2], v[q][3]); *(u32x2*)(X16 + off) = w; } }
                if (layer == 4) continue;
            } else {
#pragma unroll
                for (int q = 0; q < 4; ++q) v[q] = *(const f32x4*)(a.p->in[1] + (size_t)(row - MP) * DM + q * 256 + lane * 4);
            }
            const f32x4 p = *(const f32x4*)(a.p->in[6] + ((size_t)layer * MS + (row - MP)) * 256 + lane * 4);
            E1_FIN(v, row, p);
        } else {
#pragma unroll
            for (int q = 0; q < 4; ++q) *(u32x2*)(HX + (size_t)row * DM + q * 256 + lane * 4) = (u32x2){0u, 0u};
            *(u32x2*)(PB + (size_t)row * 256 + lane * 4) = (u32x2){0u, 0u};
        }
    }
#undef E1_LOAD
#undef E1_FIN
}
__device__ __forceinline__ void phase_e3(const Args& a, int layer, bool dummy = false) {
    const int tid = otid(), lane = tid & 63, gw = blockIdx.x * 8 + (tid >> 6), nw = gridDim.x * 8;
    const bf16_t* X16 = (const bf16_t*)a.p->out; bf16_t* HX = (bf16_t*)(a.p->ws + (dummy ? WS_DUMMY + 136 * MiB : WS_HX)); const bf16_t* OP = (const bf16_t*)(a.p->ws + WS_R0 + RSZ);
    const float* g = a.p->in[8] + layer * DM;
    f32x4 gv[4];
#pragma unroll
    for (int q = 0; q < 4; ++q) gv[q] = *(const f32x4*)(g + q * 256 + lane * 4);
#define E3_LOADX(XX, r, src0) do { if (layer == 0) { _Pragma("unroll") for (int q = 0; q < 4; ++q) XX[q] = *(const f32x4*)((src0) + q * 256 + lane * 4); } \
        else { _Pragma("unroll") for (int q = 0; q < 4; ++q) { const u32x2 xb = *(const u32x2*)(X16 + (size_t)(r) * DM + q * 256 + lane * 4); XX[q] = (f32x4){bflo(xb.x), bfhi(xb.x), bflo(xb.y), bfhi(xb.y)}; } } } while (0)
#define E3_FIN(v, XX, r) do { float ss = 0.f; _Pragma("unroll") for (int q = 0; q < 4; ++q) ss += v[q][0] * v[q][0] + v[q][1] * v[q][1] + v[q][2] * v[q][2] + v[q][3] * v[q][3]; \
        ss = wave_sum(ss); const float rr = rsqrtf(ss * (1.f / DM) + RMS_EPS); \
        _Pragma("unroll") for (int q = 0; q < 4; ++q) { u32x2 hw; hw.x = pk2(XX[q][0] + v[q][0] * rr * gv[q][0], XX[q][1] + v[q][1] * rr * gv[q][1]); hw.y = pk2(XX[q][2] + v[q][2] * rr * gv[q][2], XX[q][3] + v[q][3] * rr * gv[q][3]); \
            *(u32x2*)(HX + (size_t)(r) * DM + q * 256 + lane * 4) = hw; } } while (0)
#define E3_LOADOP(v, r) do { _Pragma("unroll") for (int q = 0; q < 4; ++q) { const u32x2 ob = *(const u32x2*)(OP + (size_t)(r) * DM + q * 256 + lane * 4); v[q] = (f32x4){bflo(ob.x), bfhi(ob.x), bflo(ob.y), bfhi(ob.y)}; } } while (0)
    for (int row = gw; row < MP; row += 2 * nw) {
        const int r1 = row + nw; const bool has1 = r1 < MP;
        f32x4 v0[4], x0[4], v1[4], x1[4];
        E3_LOADOP(v0, row); E3_LOADX(x0, row, a.p->in[0] + (size_t)row * DM);
        if (has1) { E3_LOADOP(v1, r1); E3_LOADX(x1, r1, a.p->in[0] + (size_t)r1 * DM); }
        E3_FIN(v0, x0, row);
        if (has1) E3_FIN(v1, x1, r1);
    }
    for (int row = MP + gw; row < MA; row += nw) {
        if (row < MV) {
            f32x4 v[4], x[4];
#pragma unroll
            for (int q = 0; q < 4; ++q) { const float* pq = (const float*)(a.p->ws + WS_PART) + (size_t)(row - MP) * 1024 + q * 256 + lane * 4; v[q] = *(const f32x4*)pq;
#pragma unroll
                for (int ks = 1; ks < 8; ++ks) v[q] += *(const f32x4*)(pq + (size_t)ks * 256 * 1024); }
            E3_LOADX(x, row, a.p->in[1] + (size_t)(row - MP) * DM);
            E3_FIN(v, x, row);
        } else {
#pragma unroll
            for (int q = 0; q < 4; ++q) *(u32x2*)(HX + (size_t)row * DM + q * 256 + lane * 4) = (u32x2){0u, 0u};
        }
    }
#undef E3_LOADX
#undef E3_FIN
#undef E3_LOADOP
}

__device__ __forceinline__ void phase_s1(const Args& a, int j, unsigned char* lds, bool dummy = false) {
    constexpr int LP = 136;
    bf16_t* As = (bf16_t*)lds; bf16_t* Bs = As + 128 * LP; float* fl = (float*)(Bs + 128 * LP);
    float* mu = fl, * rs = fl + 128, * t1 = fl + 256, * t2 = fl + 384;
    const int tid = otid(), lane = tid & 63, wid = tid >> 6, fr = lane & 15, fq = lane >> 4;
    const bf16_t* U = (const bf16_t*)(a.p->ws + WS_R0); bf16_t* Uo = (bf16_t*)(a.p->ws + (dummy ? WS_DUMMY : WS_R0)); const bf16_t* VT = (const bf16_t*)(a.p->ws + WS_R0 + RSZ); const bf16_t* ZS = (const bf16_t*)(a.p->ws + WS_R0 + 2 * RSZ);
    const float* stat = (const float*)(a.p->ws + WS_STAT);
    const float* lng = a.p->in[10] + j * EB; const float* lnb = a.p->in[11] + j * EB; const float* bsv = a.p->in[13] + j * 16 * 128;
    float* gvs = a.p->out + O_GV + (size_t)j * MS * EB;
    constexpr int NU = 257 * 16;
    const int G_ = gridDim.x, w_ = blockIdx.x;
#define S1_UNIT(k) ((G_ == 256) ? ((k) < 16 ? w_ * 16 + (((k) + w_) & 15) :     ((k) == 16 && w_ < 16 ? 4096 + w_ : NU)) : (w_ + (k) * G_))
#define S1_LOAD_AB(u_) do { const int blk_ = (u_) >> 4, g_ = (u_) & 15; \
        const bf16_t* wsrc_ = (const bf16_t*)(a.p->ws + (blk_ == 256 ? WS_WMS : WS_WM)) + ((size_t)(j * 16 + g_) * 128) * 128; const bf16_t* vsrc_ = VT + ((size_t)blk_ * 2048 + g_ * 128) * 128; \
        _Pragma("unroll") for (int q = 0; q < 4; ++q) { ar[q] = *(const u32x4*)(wsrc_ + (tid >> 2) * 128 + (tid & 3) * 32 + q * 8); br[q] = *(const u32x4*)(vsrc_ + (tid >> 2) * 128 + (tid & 3) * 32 + q * 8); } } while (0)
    int un = S1_UNIT(0);
    if (un >= NU) return;
    u32x4 ar[4], br[4];
    S1_LOAD_AB(un);
    int prev_blk = -1;
    for (int k = 0;; ++k) {
        const int blk = un >> 4, g = un & 15, issamp = blk == 256;
        if (blk != prev_blk) {
          { const int r_ = tid >> 2, p_ = tid & 3; const float* sp = stat + (size_t)(blk * 128 + r_) * 64 + p_ * 8;
          const f32x4 s0 = *(const f32x4*)sp, s1 = *(const f32x4*)(sp + 4), q0 = *(const f32x4*)(sp + 32), q1 = *(const f32x4*)(sp + 36);
          float s = ((s0[0] + s0[1]) + (s0[2] + s0[3])) + ((s1[0] + s1[1]) + (s1[2] + s1[3])), q = ((q0[0] + q0[1]) + (q0[2] + q0[3])) + ((q1[0] + q1[1]) + (q1[2] + q1[3]));
          s += __shfl_xor(s, 1); s += __shfl_xor(s, 2); q += __shfl_xor(q, 1); q += __shfl_xor(q, 2);
          if (p_ == 0) { const float m = s * (1.f / EB); const float var = fmaxf(q * (1.f / EB) - m * m, 0.f); mu[r_] = m; rs[r_] = rsqrtf(var + LN_EPS); } }
          __syncthreads(); prev_blk = blk;
        }
        { const int i = tid >> 2, part = tid & 3; float a1 = 0.f, a2 = 0.f;
#pragma unroll
          for (int q = 0; q < 4; ++q) { const int j0 = part * 32 + q * 8; const u32x4 w = ar[q]; const unsigned ww[4] = {w.x, w.y, w.z, w.w}; float o[8];
#pragma unroll
              for (int e = 0; e < 4; ++e) { const float w0 = bflo(ww[e]), w1 = bfhi(ww[e]); const float r0 = rs[j0 + 2 * e], r1 = rs[j0 + 2 * e + 1];
                  o[2 * e] = w0 * r0; o[2 * e + 1] = w1 * r1; a1 += w0 * r0 * mu[j0 + 2 * e] + w1 * r1 * mu[j0 + 2 * e + 1]; a2 += w0 + w1; }
              u32x4 ow; ow.x = pk2(o[0], o[1]); ow.y = pk2(o[2], o[3]); ow.z = pk2(o[4], o[5]); ow.w = pk2(o[6], o[7]);
              *(u32x4*)(As + i * LP + j0) = ow; *(u32x4*)(Bs + i * LP + j0) = br[q]; }
          a1 += __shfl_xor(a1, 1); a1 += __shfl_xor(a1, 2); a2 += __shfl_xor(a2, 1); a2 += __shfl_xor(a2, 2);
          if (part == 0) { t1[i] = a1; t2[i] = a2; }
        }
        __syncthreads();
        const int un_next = S1_UNIT(k + 1); const bool has_next = un_next < NU;
        if (has_next) S1_LOAD_AB(un_next);
        const int i0 = (wid >> 1) * 32, c0 = (wid & 1) * 64;
        f32x4 acc[2][4];
#pragma unroll
        for (int mt = 0; mt < 2; ++mt)
#pragma unroll
            for (int nt = 0; nt < 4; ++nt) acc[mt][nt] = (f32x4){0.f, 0.f, 0.f, 0.f};
#pragma unroll
        for (int kk = 0; kk < 4; ++kk) {
            bf16x8 af[2], bfr[4];
#pragma unroll
            for (int mt = 0; mt < 2; ++mt) af[mt] = *(const bf16x8*)(As + (i0 + mt * 16 + fr) * LP + kk * 32 + fq * 8);
#pragma unroll
            for (int nt = 0; nt < 4; ++nt) bfr[nt] = *(const bf16x8*)(Bs + (c0 + nt * 16 + fr) * LP + kk * 32 + fq * 8);
#pragma unroll
            for (int mt = 0; mt < 2; ++mt)
#pragma unroll
                for (int nt = 0; nt < 4; ++nt) acc[mt][nt] = __builtin_amdgcn_mfma_f32_16x16x32_bf16(bfr[nt], af[mt], acc[mt][nt], 0, 0, 0);
        }
        const int ei = tid >> 2, ec = (tid & 3) * 32; const size_t erow = (size_t)blk * 128 + ei;
        u32x4 uu[4], zz[4];
#pragma unroll
        for (int q = 0; q < 4; ++q) { uu[q] = *(const u32x4*)(U + erow * EB + g * 128 + ec + q * 8); zz[q] = *(const u32x4*)(ZS + erow * EB + g * 128 + ec + q * 8); }
        if (issamp) {
            for (int idx = tid; idx < 128 * 128; idx += 512) { const int c = idx & 127, i = idx >> 7; const float v = __uint_as_float((unsigned)Bs[c * LP + i] << 16);
                gvs[(size_t)i * EB + g * 128 + c] = (v - mu[i]) * rs[i] * lng[g * 128 + c] + lnb[g * 128 + c]; }
        }
        __syncthreads();
        float* S32 = (float*)lds; constexpr int SP = 132;
#pragma unroll
        for (int mt = 0; mt < 2; ++mt)
#pragma unroll
            for (int nt = 0; nt < 4; ++nt) *(f32x4*)(S32 + (i0 + mt * 16 + fr) * SP + c0 + nt * 16 + fq * 4) = acc[mt][nt];
        __syncthreads();
        { const float t1i = t1[ei], t2i = t2[ei], bi = bsv[g * 128 + (issamp ? (ei & 15) : ei)];
#pragma unroll
          for (int q = 0; q < 4; ++q) { const int cg = g * 128 + ec + q * 8;
              const f32x4 sa = *(const f32x4*)(S32 + ei * SP + ec + q * 8), sb = *(const f32x4*)(S32 + ei * SP + ec + q * 8 + 4);
              const f32x4 lga = *(const f32x4*)(lng + cg), lgb = *(const f32x4*)(lng + cg + 4), lba = *(const f32x4*)(lnb + cg), lbb = *(const f32x4*)(lnb + cg + 4);
              float s[8];
#pragma unroll
              for (int e = 0; e < 4; ++e) { s[e] = lga[e] * (sa[e] - t1i) + lba[e] * t2i + bi; s[4 + e] = lgb[e] * (sb[e] - t1i) + lbb[e] * t2i + bi; }
              const unsigned u4[4] = {uu[q].x, uu[q].y, uu[q].z, uu[q].w}, z4[4] = {zz[q].x, zz[q].y, zz[q].z, zz[q].w}; unsigned y4[4];
#pragma unroll
              for (int e = 0; e < 4; ++e) y4[e] = pk2(bflo(u4[e]) * s[2 * e] * bflo(z4[e]), bfhi(u4[e]) * s[2 * e + 1] * bfhi(z4[e]));
              *(u32x4*)(Uo + erow * EB + cg) = (u32x4){y4[0], y4[1], y4[2], y4[3]}; } }
        __syncthreads();
        if (!has_next) break;
        un = un_next;
    }
#undef S1_UNIT
#undef S1_LOAD_AB
}

__device__ __forceinline__ void phase_c1(const Args& a, int j) {
    const int tid = otid(); if ((tid >> 6) != 0) return;
    const int lane = tid & 63;
    for (int sq = blockIdx.x; sq < 256; sq += gridDim.x) {
        if (sq < 128) {
            const int b = sq >> 4, h = sq & 15; const float* src = a.p->out + O_FLP + ((size_t)j * MP + (size_t)b * SEQ) * 16 + h; float* dst = (float*)(a.p->ws + WS_CBP) + (size_t)sq * SEQ;
            float tot = 0.f; for (int s = 0; s < 64; ++s) tot += src[(size_t)(lane * 64 + s) * 16];
            float inc = tot; for (int o = 1; o < 64; o <<= 1) { const float t = __shfl_up(inc, o); if (lane >= o) inc += t; }
            float run = inc - tot;
            for (int s = 0; s < 64; ++s) { run += src[(size_t)(lane * 64 + s) * 16];
                dst[lane * 64 + (((s >> 2) & 1) * 32 + ((s >> 3) & 3) * 4 + (s & 3) + 16 * (s >> 5))] = -run * 11.313708498984761f; }
        } else {
            const int bh = sq - 128, b = bh >> 4, h = bh & 15; const float* c0 = a.p->in[4] + ((size_t)(j * 8 + b) * PAST) * 16 + h; const float* c1 = a.p->out + O_FLS + ((size_t)j * MS + b * TS) * 16 + h;
            float* dst = (float*)(a.p->ws + WS_CBS) + (size_t)bh * SKS;
            float tot = 0.f; for (int s = 0; s < 33; ++s) { const int k = lane * 33 + s; const float v = k < PAST ? c0[(size_t)k * 16] : (k < PAST + TS ? c1[(size_t)(k - PAST) * 16] : 0.f); tot += v; }
            float inc = tot; for (int o = 1; o < 64; o <<= 1) { const float t = __shfl_up(inc, o); if (lane >= o) inc += t; }
            float run = inc - tot;
            for (int s = 0; s < 33; ++s) { const int k = lane * 33 + s; const float v = k < PAST ? c0[(size_t)k * 16] : (k < PAST + TS ? c1[(size_t)(k - PAST) * 16] : 0.f); run += v; dst[k] = -run; }
        }
    }
}

__device__ __forceinline__ void sample_attn(const Args& a, int j, int bh, unsigned char* ldsb, bool dummy = false) {
    constexpr int PP = 136;
    float* wmx = (float*)ldsb;
    bf16_t* Pb = (bf16_t*)(ldsb + 1024);
    float* lfin = (float*)(ldsb + 1024 + 2 * 16 * PP * 2);
    const int tid = otid(), lane = tid & 63, wid = __builtin_amdgcn_readfirstlane(tid >> 6), fr = lane & 15, fq = lane >> 4, b = bh >> 4, h = bh & 15;
    const bf16_t* Qb = (const bf16_t*)(a.p->ws + WS_R0); const bf16_t* ZS = (const bf16_t*)(a.p->ws + WS_R0 + 3 * RSZ); bf16_t* O = (bf16_t*)(a.p->ws + (dummy ? WS_DUMMY : WS_R0));
    const float* ck = a.p->in[2] + (size_t)(j * 8 + b) * PAST * EB + h * 128; const float* cv = a.p->in[3] + (size_t)(j * 8 + b) * PAST * EB + h * 128;
    const float* nk = a.p->out + O_FKS + ((size_t)j * MS + b * TS) * EB + h * 128; const float* nv = a.p->out + O_FVS + ((size_t)j * MS + b * TS) * EB + h * 128;
    const float* cb = (const float*)(a.p->ws + WS_CBS) + (size_t)bh * SKS;
    bf16x8 qf[4];
#pragma unroll
    for (int kk = 0; kk < 4; ++kk) qf[kk] = *(const bf16x8*)(Qb + (size_t)(MP + b * TS + fr) * EB + h * 128 + kk * 32 + fq * 8);
    const int kl = 16 * wid + fr;
    float m[4], ls[4]; f32x4 oacc = {0.f, 0.f, 0.f, 0.f};
#pragma unroll
    for (int r = 0; r < 4; ++r) { m[r] = -1e30f; ls[r] = 0.f; }
    f32x4 kr[8];
#pragma unroll
    for (int q = 0; q < 8; ++q) kr[q] = *(const f32x4*)(ck + (size_t)kl * EB + (q >> 1) * 32 + fq * 8 + (q & 1) * 4);
    int buf = 0;
    for (int c = 0; c < 17; ++c) {
        float vr[32];
        if (c < 16) {
#pragma unroll
            for (int q = 0; q < 32; ++q) vr[q] = cv[(size_t)(c * 128 + (q >> 3) * 32 + fq * 8 + (q & 7)) * EB + 16 * wid + fr];
        } else {
#pragma unroll
            for (int q = 0; q < 32; ++q) { const int key = (q >> 3) * 32 + fq * 8 + (q & 7); vr[q] = key < TS ? nv[(size_t)key * EB + 16 * wid + fr] : 0.f; }
        }
        const float bias = c < 16 ? cb[c * 128 + kl] : (kl < TS ? cb[PAST + kl] : 0.f);
        f32x4 sacc = {0.f, 0.f, 0.f, 0.f};
#pragma unroll
        for (int kk = 0; kk < 4; ++kk) { const f32x4 x0 = kr[2 * kk], x1 = kr[2 * kk + 1];
            u32x4 w; w.x = pk2(x0[0], x0[1]); w.y = pk2(x0[2], x0[3]); w.z = pk2(x1[0], x1[1]); w.w = pk2(x1[2], x1[3]);
            sacc = __builtin_amdgcn_mfma_f32_16x16x32_bf16(qf[kk], __builtin_bit_cast(bf16x8, w), sacc, 0, 0, 0); }
        if (c + 1 < 16) {
#pragma unroll
            for (int q = 0; q < 8; ++q) kr[q] = *(const f32x4*)(ck + (size_t)((c + 1) * 128 + kl) * EB + (q >> 1) * 32 + fq * 8 + (q & 1) * 4);
        } else if (c + 1 == 16) {
#pragma unroll
            for (int q = 0; q < 8; ++q) kr[q] = kl < TS ? *(const f32x4*)(nk + (size_t)kl * EB + (q >> 1) * 32 + fq * 8 + (q & 1) * 4) : (f32x4){0.f, 0.f, 0.f, 0.f};
        }
        float s[4], mw[4];
#pragma unroll
        for (int r = 0; r < 4; ++r) { s[r] = sacc[r] * att::SCALE + bias; if (c == 16 && (kl >= TS || kl > 4 * fq + r)) s[r] = -__builtin_inff(); mw[r] = s[r]; }
#pragma unroll
        for (int o = 1; o < 16; o <<= 1) {
#pragma unroll
            for (int r = 0; r < 4; ++r) mw[r] = fmaxf(mw[r], __shfl_xor(mw[r], o)); }
        if (fr == 0) {
#pragma unroll
            for (int r = 0; r < 4; ++r) wmx[buf * 128 + (4 * fq + r) * 8 + wid] = mw[r]; }
        __syncthreads();
        float p[4];
#pragma unroll
        for (int r = 0; r < 4; ++r) { const f32x4 w0 = *(const f32x4*)(wmx + buf * 128 + (4 * fq + r) * 8), w1 = *(const f32x4*)(wmx + buf * 128 + (4 * fq + r) * 8 + 4);
            const float mc = fmaxf(fmaxf(fmaxf(w0[0], w0[1]), fmaxf(w0[2], w0[3])), fmaxf(fmaxf(w1[0], w1[1]), fmaxf(w1[2], w1[3])));
            const float mn = fmaxf(m[r], mc), al = __expf(m[r] - mn); m[r] = mn; p[r] = __expf(s[r] - mn); ls[r] = ls[r] * al + p[r]; oacc[r] *= al;
            Pb[buf * 16 * PP + (4 * fq + r) * PP + kl] = (bf16_t)f2bf(p[r]); }
        __syncthreads();
#pragma unroll
        for (int kk = 0; kk < 4; ++kk) { const bf16x8 pa = *(const bf16x8*)(Pb + buf * 16 * PP + fr * PP + kk * 32 + fq * 8);
            u32x4 w; w.x = pk2(vr[kk * 8 + 0], vr[kk * 8 + 1]); w.y = pk2(vr[kk * 8 + 2], vr[kk * 8 + 3]); w.z = pk2(vr[kk * 8 + 4], vr[kk * 8 + 5]); w.w = pk2(vr[kk * 8 + 6], vr[kk * 8 + 7]);
            oacc = __builtin_amdgcn_mfma_f32_16x16x32_bf16(pa, __builtin_bit_cast(bf16x8, w), oacc, 0, 0, 0); }
        buf ^= 1;
    }
#pragma unroll
    for (int o = 1; o < 16; o <<= 1) {
#pragma unroll
        for (int r = 0; r < 4; ++r) ls[r] += __shfl_xor(ls[r], o); }
    if (fr == 0) {
#pragma unroll
        for (int r = 0; r < 4; ++r) lfin[wid * 16 + 4 * fq + r] = ls[r]; }
    __syncthreads();
#pragma unroll
    for (int r = 0; r < 4; ++r) { const int i = 4 * fq + r; float l = 0.f;
#pragma unroll
        for (int w = 0; w < 8; ++w) l += lfin[w * 16 + i];
        const size_t off = (size_t)(MP + b * TS + i) * EB + h * 128 + 16 * wid + fr;
        const float z = __uint_as_float((unsigned)ZS[off] << 16); O[off] = (bf16_t)f2bf(oacc[r] / l * z); }
    __syncthreads();
}

__device__ __forceinline__ void phase_attn(const Args& a, int j, unsigned char* ldsb, int mode = 0) {
    using namespace att;
    typedef __hip_bfloat16 T;
    const T* Q = (const T*)(a.p->ws + WS_R0); const T* K = (const T*)(a.p->ws + WS_R0 + RSZ); const T* V = (const T*)(a.p->ws + WS_R0 + 2 * RSZ); const T* Z = (const T*)(a.p->ws + WS_R0 + 3 * RSZ); T* O = (T*)(a.p->ws + (mode == 1 ? WS_DUMMY : WS_R0));
    const float* CB = (const float*)(a.p->ws + WS_CBP);
    char* lds = (char*)ldsb;
    constexpr int nqb = SEQ / QB, nx = nqb / 2, total = nx * NBH;
    const int stride = gridDim.x;
    int L = (gridDim.x == 256) ? (int)((blockIdx.x & 7) * 32 + (blockIdx.x >> 3)) : (int)blockIdx.x;
    if (mode == 2) L = total;
    if (L < total) {
#define MKREF(r, L_, pass_) do { const int bh_ = (L_) / nx, x_ = (L_) - bh_ * nx, qb_ = (pass_) ? x_ : nqb - 1 - x_,     b_ = bh_ >> 4, h_ = bh_ & 15; \
        const size_t ro_ = ((size_t)b_ * SEQ + (size_t)qb_ * QB) * PITCH + h_ * 128, ko_ = ((size_t)b_ * SEQ) * PITCH + h_ * 128; \
        (r).Q = Q + ro_; (r).O = O + ro_; (r).Z = Z + ro_; (r).K = K + ko_; (r).V = V + ko_; (r).CB = CB + (size_t)bh_ * SEQ; (r).P0 = qb_ * QB; } while (0)
        BlockRef<T, T> cur, nxt; int pass = 0;
        MKREF(cur, L, 0);
        Seam<T> S;
        causal_swa_prime<T, T>(cur, SEQ, lds, S);
        for (;;) {
            const bool more_pass = pass == 0, more_item = L + stride < total, last = !more_pass && !more_item;
            int passn = pass + 1, Ln = L;
            if (!more_pass) { passn = 0; Ln = more_item ? L + stride : L; }
            if (last) nxt = cur; else MKREF(nxt, Ln, passn);
            causal_swa_block<T, T>(cur, nxt, SEQ, SEQ, lds, S);
            if (last) break;
            cur = nxt; pass = passn; L = Ln;
        }
#undef MKREF
    }
    __syncthreads();
    if (mode != 1) for (int bh = (int)gridDim.x - 1 - (int)blockIdx.x; bh < NBH; bh += gridDim.x) sample_attn(a, j, bh, ldsb, mode == 2);
}

#define XB_TMO      128
#define XB_XCNT(j)  (256  + 64 * (j))
#define XB_XSUB(j)  (1280 + 64 * (j))
#define XB_XGEN(j)  (2304 + 64 * (j))
#define XB_TOP      3328
#define XB_TOPGEN   3392
#define XCD_BAR_WORDS 3456
#define XB_SPIN_CAP (1u << 18)

__device__ __forceinline__ unsigned xb_ld(unsigned* p)              { return __hip_atomic_load(p, __ATOMIC_RELAXED, __HIP_MEMORY_SCOPE_AGENT); }
__device__ __forceinline__ unsigned xb_add(unsigned* p, unsigned v) { return __hip_atomic_fetch_add(p, v, __ATOMIC_RELAXED, __HIP_MEMORY_SCOPE_AGENT); }
__device__ __forceinline__ unsigned xb_xcc_id() { return (unsigned)__builtin_amdgcn_s_getreg((3 << 11) | 20) & 0xFu; }
#define XB_SPIN(cond, bar) do { unsigned _sp = 0; while (cond) { __builtin_amdgcn_s_sleep(1); \
    if ((++_sp & 255u) == 0u) { if (xb_ld(&(bar)[XB_TMO])) break; if (_sp > XB_SPIN_CAP) { atomicAdd(&(bar)[XB_TMO], 1u); break; } } } } while (0)

struct XcdBarrier {
    unsigned* bar; unsigned x;
    volatile LAS unsigned* st;
};

__device__ __forceinline__ XcdBarrier xcd_barrier_post(unsigned* bar, volatile LAS unsigned* st) {
    XcdBarrier b; b.bar = bar; b.x = xb_xcc_id(); b.st = st;
    if (otid() == 0) (void)xb_add(&bar[XB_XCNT(b.x)], 1u);
    return b;
}
__device__ __forceinline__ void xcd_barrier_complete(unsigned* bar, unsigned x, unsigned& nloc, unsigned& nx) {
    const unsigned G = gridDim.x * gridDim.y * gridDim.z;
    unsigned sum, cnt, mine, sp = 0u;
    for (;;) {
        sum = 0u; cnt = 0u; mine = 0u;
#pragma unroll
        for (unsigned j = 0; j < 16; ++j) { const unsigned c = xb_ld(&bar[XB_XCNT(j)]); sum += c; cnt += (c > 0u) ? 1u : 0u; mine = (j == x) ? c : mine; }
        if (sum == G) break;
        __builtin_amdgcn_s_sleep(1);
        if ((++sp & 255u) == 0u) { if (xb_ld(&bar[XB_TMO])) break; if (sp > XB_SPIN_CAP) { atomicAdd(&bar[XB_TMO], 1u); break; } }
    }
    nloc = mine > 0u ? mine : 1u; nx = cnt > 0u ? cnt : 1u;
}

__device__ __forceinline__ void xcd_barrier(const XcdBarrier& b) {
    asm volatile("s_waitcnt vmcnt(0)" ::: "memory");
    __syncthreads();
    if (otid() == 0) {
        unsigned* bar = b.bar;
        __builtin_amdgcn_s_waitcnt(0);
        unsigned nloc = b.st[0], nx = b.st[1];
        if (nloc == 0u) { xcd_barrier_complete(bar, b.x, nloc, nx); b.st[0] = nloc; b.st[1] = nx; }
        const unsigned old = xb_add(&bar[XB_XSUB(b.x)], 1u);
        const unsigned gen = old / nloc;
        if (old + 1u == (gen + 1u) * nloc) {
            __builtin_amdgcn_fence(__ATOMIC_RELEASE, "agent");
            asm volatile("s_waitcnt vmcnt(0)" ::: "memory");
            const unsigned og = xb_add(&bar[XB_TOP], 1u);
            const unsigned tg = og / nx;
            if (og + 1u == (tg + 1u) * nx) xb_add(&bar[XB_TOPGEN], 1u);
            else XB_SPIN(xb_ld(&bar[XB_TOPGEN]) == tg, bar);
            __builtin_amdgcn_fence(__ATOMIC_ACQUIRE, "agent");
            xb_add(&bar[XB_XGEN(b.x)], 1u);
            asm volatile("s_waitcnt vmcnt(0)" ::: "memory");
        } else {
            XB_SPIN(xb_ld(&bar[XB_XGEN(b.x)]) == gen, bar);
            __builtin_amdgcn_fence(__ATOMIC_ACQUIRE, "agent");
            asm volatile("s_waitcnt vmcnt(0)" ::: "memory");
        }
    }
    __syncthreads();
}
#define WSPTRS() const Args a = getargs(); unsigned char* ws = a.p->ws; (void)ws; \
    bf16_t* HX = (bf16_t*)(ws + WS_HX); bf16_t* TB = (bf16_t*)(ws + WS_TB); bf16_t* PB = (bf16_t*)(ws + WS_PB); (void)HX; (void)TB; (void)PB; \
    bf16_t* R0 = (bf16_t*)(ws + WS_R0); bf16_t* R1 = (bf16_t*)(ws + WS_R0 + RSZ); bf16_t* R2 = (bf16_t*)(ws + WS_R0 + 2 * RSZ); bf16_t* R3 = (bf16_t*)(ws + WS_R0 + 3 * RSZ); (void)R0; (void)R1; (void)R2; (void)R3;
#define XBAR_MK() XcdBarrier xb_; xb_.bar = (unsigned*)(getargs().p->ws) + 1024; xb_.x = xb_xcc_id(); xb_.st = (volatile LAS unsigned*)((LAS unsigned char*)lds + (LDS_BYTES - 64))
#if PROBE_DUP == 7
#define GSYNC() do { XBAR_MK(); xcd_barrier(xb_); xcd_barrier(xb_); } while (0)
#else
#define GSYNC() do { XBAR_MK(); xcd_barrier(xb_); } while (0)
#endif
__global__ void __launch_bounds__(512, 2) fwd_megakernel(ArgsS args_unused) {
    extern __shared__ __attribute__((aligned(16))) unsigned char lds[];
    cg::grid_group grid = cg::this_grid();
    PG8_LAS unsigned char* gl = (PG8_LAS unsigned char*)lds;
    const int G = gridDim.x, c = blockIdx.x;
    { const unsigned hw = (unsigned)__builtin_amdgcn_s_getreg((5 << 11) | 4) & 63u;
      if ((threadIdx.x & 63) == 0) ((LAS int*)((LAS unsigned char*)lds + LDS_WIDTAB))[hw] = (int)(threadIdx.x >> 6);
      if (threadIdx.x < 16) ((LAS unsigned*)((LAS unsigned char*)lds + (LDS_BYTES - 64)))[threadIdx.x] = 0u; }
    __syncthreads();
    { XBAR_MK(); (void)xcd_barrier_post(xb_.bar, xb_.st); }
#ifndef SKIP_PRO
    { const Args a = getargs(); prologue(a, (float*)lds); }
#endif
    grid.sync();
    for (int layer = 0; layer < 4; ++layer) {
        const int j = layer >> 1;
#ifndef SKIP_E1
        for (int rp_ = (PROBE_DUP == 4 ? 0 : 1); rp_ < 2; ++rp_) { const Args a = getargs(); phase_e1(a, layer); if (!rp_) GSYNC(); }
#endif
        GSYNC();
        if ((layer & 1) == 0) {
#ifndef SKIP_G1G
            { WSPTRS(); pg8::Gemm g{HX, (const bf16_t*)(ws + WS_WGIN) + (size_t)j * 6144 * 1024, MA, 6144, 1024}; pg8::StaticOrder S; S.init(MA, 6144, G, c);
              EpiGmlpIn E{R0, R1, R2, (float*)(ws + WS_STAT)};
              for (int rp_ = 0; rp_ < (PROBE_DUP == 5 ? 2 : 1); ++rp_) pg8::gemm_phase<EpiGmlpIn, pg8::StaticOrder, true, true>(gl, g, S, E); }
#endif
        } else {
#ifndef SKIP_G1F
            { WSPTRS(); pg8::Gemm g{HX, (const bf16_t*)(ws + WS_WFIN) + (size_t)j * NFIN * 1024, MA, NFIN, 1024}; pg8::StaticOrder S; S.init(MA, NFIN, G, c);
              float* out = a.p->out;
              EpiFoxIn E{R0, R1, R2, R3, out + O_FKP + (size_t)j * MP * EB, out + O_FVP + (size_t)j * MP * EB, out + O_FLP + (size_t)j * MP * 16,
                         out + O_FKS + (size_t)j * MS * EB, out + O_FVS + (size_t)j * MS * EB, out + O_FLS + (size_t)j * MS * 16, a.p->in[16] + j * 16};
              for (int rp_ = 0; rp_ < (PROBE_DUP == 5 ? 2 : 1); ++rp_) pg8::gemm_phase<EpiFoxIn, pg8::StaticOrder, true, true>(gl, g, S, E); }
#endif
        }
#ifndef SKIP_GT
        { WSPTRS(); pg8::Gemm g{PB, (const bf16_t*)(ws + WS_WPP) + (size_t)layer * 1024 * 256, MA, 1024, 256}; const int nb_ = (layer & 1) ? 0 : 24;
          pg8::StaticOrder S; S.init(MA, 1024, G - nb_, c >= nb_ ? G - 1 - c : (1 << 24));
          EpiT E{TB, 1024};
          for (int rp_ = 0; rp_ < (PROBE_DUP == 6 ? 2 : 1); ++rp_) pg8::gemm_phase<EpiT, pg8::StaticOrder, true, true>(gl, g, S, E); }
#endif
        GSYNC();
        if ((layer & 1) == 0) {
#ifndef SKIP_S1
            for (int rp_ = (PROBE_DUP == 3 ? 0 : 1); rp_ < 2; ++rp_) { const Args a = getargs(); phase_s1(a, j, lds, !rp_); if (!rp_) GSYNC(); }
#endif
        } else {
#ifndef SKIP_C1
            { const Args a = getargs(); phase_c1(a, j); }
#endif
            GSYNC();
#ifndef SKIP_ATTN
            for (int rp_ = ((PROBE_DUP == 1 || PROBE_DUP == 2) ? 0 : 1); rp_ < 2; ++rp_) { const Args a = getargs(); phase_attn(a, j, lds, rp_ ? 0 : PROBE_DUP); if (!rp_) GSYNC(); }
#endif
        }
        GSYNC();
#ifndef SKIP_G2
        { WSPTRS(); pg8::Gemm g{R0, (const bf16_t*)(ws + ((layer & 1) ? WS_WFOUT : WS_WGOUT)) + (size_t)j * 1024 * 2048, MP, 1024, 2048}; pg8::StaticOrder S; S.init(MP, 1024, G, c);
          EpiT E{R1, 1024};
          for (int rp_ = 0; rp_ < (PROBE_DUP == 6 ? 2 : 1); ++rp_) pg8::gemm_phase<EpiT, pg8::StaticOrder, true, true>(gl, g, S, E); }
#endif
        { WSPTRS(); int ksl = 256; asm volatile("" : "+s"(ksl)); pg8::Gemm g{R0, (const bf16_t*)(ws + ((layer & 1) ? WS_WFOUT : WS_WGOUT)) + (size_t)j * 1024 * 2048, MA, 1024, ksl, 2048}; SplitOrder S{8, c};
          EpiPart E{(float*)(ws + WS_PART)};
          pg8::gemm_phase<EpiPart, SplitOrder, true, true>(gl, g, S, E); }
        GSYNC();
#ifndef SKIP_E3
        for (int rp_ = (PROBE_DUP == 4 ? 0 : 1); rp_ < 2; ++rp_) { const Args a = getargs(); phase_e3(a, layer, !rp_); if (!rp_) GSYNC(); }
#endif
        GSYNC();
#ifndef SKIP_G3
        { WSPTRS(); pg8::Gemm g{HX, (const bf16_t*)(ws + WS_WPG) + (size_t)layer * 1024 * 1024, MP, 1024, 1024}; pg8::StaticOrder S; S.init(MP, 1024, G, c);
          for (int rp_ = (PROBE_DUP == 6 ? 0 : 1); rp_ < 2; ++rp_) { EpiGate E{HX, rp_ ? a.p->out : (float*)(ws + WS_DUMMY), TB, layer == 3}; pg8::gemm_phase<EpiGate, pg8::StaticOrder, true, true>(gl, g, S, E); } }
#endif
        { WSPTRS(); int ksl = 256; asm volatile("" : "+s"(ksl)); pg8::Gemm g{HX, (const bf16_t*)(ws + WS_WPG) + (size_t)layer * 1024 * 1024, MA, 1024, ksl, 1024}; SplitOrder S{4, c};
          EpiPart E{(float*)(ws + WS_PART)};
          pg8::gemm_phase<EpiPart, SplitOrder, true, true>(gl, g, S, E); }
        GSYNC();
    }
    { const Args a = getargs(); phase_e1(a, 4); }
}

extern "C" void kernel_launch(void* const* d_in, const int* in_sizes, int n_in, void* d_out, int out_size, void* d_ws, size_t ws_size, hipStream_t stream) {
    static int grid = 0;
    if (grid == 0) {
        if (n_in != 20 || ws_size < WS_END) { fprintf(stderr, "kernel_launch: need 20 inputs and >= %zu bytes of workspace; got %d, %zu\n", (size_t)WS_END, n_in, ws_size); grid = -1; return; }
        int dev = 0, cus = 0, per_cu = 0;
        (void)hipGetDevice(&dev); (void)hipDeviceGetAttribute(&cus, hipDeviceAttributeMultiprocessorCount, dev);
        if (hipFuncSetAttribute((const void*)fwd_megakernel, hipFuncAttributeMaxDynamicSharedMemorySize, LDS_BYTES) != hipSuccess) { fprintf(stderr, "kernel_launch: hipFuncSetAttribute failed\n"); grid = -1; return; }
        if (hipOccupancyMaxActiveBlocksPerMultiprocessor(&per_cu, (const void*)fwd_megakernel, 512, LDS_BYTES) != hipSuccess || per_cu < 1) { fprintf(stderr, "kernel_launch: occupancy query says %d\n", per_cu); per_cu = 1; }
        (void)hipGetLastError();
        grid = cus > 0 ? cus : 256;
    }
    if (grid < 0) return;
    if (hipMemsetAsync(d_ws, 0, 65536, stream) != hipSuccess) { fprintf(stderr, "kernel_launch: memset of the barrier words failed\n"); return; }
    ArgsS a{};
    for (int i = 0; i < 20; ++i) a.in[i] = (const float*)d_in[i];
    a.out = (float*)d_out; a.ws = (unsigned char*)d_ws;
    void* args[] = {&a};
    hipError_t e = hipLaunchCooperativeKernel((const void*)fwd_megakernel, dim3(grid), dim3(512), args, LDS_BYTES, stream);
    if (e != hipSuccess) fprintf(stderr, "cooperative launch failed: %s (grid %d)\n", hipGetErrorString(e), grid);
}
```

```cpp
#include <hip/hip_runtime.h>
#include <hip/hip_bf16.h>
#include <hip/hip_cooperative_groups.h>
#include <cstdio>
#include <cstdint>
extern __shared__ __attribute__((aligned(16))) unsigned char g_lds[];
constexpr int LDS_TOTAL = 147456, LDS_WIDTAB = LDS_TOTAL - 512;
__device__ __forceinline__ int otid() {
    const unsigned hw = (unsigned)__builtin_amdgcn_s_getreg((5 << 11) | 4) & 63u;
    int w = ((volatile __attribute__((address_space(3))) int*)((__attribute__((address_space(3))) unsigned char*)g_lds + LDS_WIDTAB))[hw];
    w = __builtin_amdgcn_readfirstlane(w);
    int l; asm volatile("v_mbcnt_lo_u32_b32 %0, -1, 0" : "=v"(l)); asm volatile("v_mbcnt_hi_u32_b32 %0, -1, %0" : "+v"(l));
    return w * 64 + l;
}
namespace pg8 {
#define PG8_LAS __attribute__((address_space(3)))
typedef unsigned short bf16_t;
typedef short bf16x8 __attribute__((ext_vector_type(8)));
typedef float f32x4 __attribute__((ext_vector_type(4)));
typedef unsigned u32x4 __attribute__((ext_vector_type(4)));
constexpr int BM = 256, BK = 64, HALF = 128, HTB = HALF * BK * 2  , STAGE_BYTES = 8 * HTB, NXCD = 8, WGM = 8;

__host__ __device__ __forceinline__ int lds_byte(int r, int c) { const int st = (r >> 4) * 2 + (c >> 5), rr = r & 15, cc = c & 31, ob = rr * 64 + cc * 2; return st * 1024 + (ob ^ (((ob >> 9) & 1) << 5)); }
__host__ __device__ __forceinline__ void stage_rc(int b, int& R, int& C) { const int st = b / 1024, sb = b % 1024, swz = sb ^ (((sb >> 9) & 1) << 5); R = (st >> 1) * 16 + swz / 64; C = (st & 1) * 32 + (swz % 64) / 2; }
__host__ __device__ __forceinline__ int perm32(int rho) { const int n = rho >> 4, i = rho & 15; return 8 * (i >> 2) + 4 * n + (i & 3); }

struct Unit { int pm, pn, ko; };
struct Gemm { const bf16_t* A; const bf16_t* Bt; int M, N, K, ldk; };

struct StaticOrder {
    int nM, nN, nwg, G, c;
    __host__ __device__ void init(int M, int N, int G_, int c_) { nM = M / BM; nN = N / BM; nwg = nM * nN; G = G_; c = c_; }
    __host__ __device__ bool next(int i, Unit& u) const {
        const long L = (long)i * G + c; if (L >= nwg) return false;
        int wgid = (int)L; { const int q = nwg / NXCD, r = nwg % NXCD, xcd = wgid % NXCD, off = wgid / NXCD; wgid = (xcd < r ? xcd * (q + 1) : r * (q + 1) + (xcd - r) * q) + off; }
        const int nig = WGM * nN, gid = wgid / nig, fm = gid * WGM, gsz = (nM - fm) < WGM ? (nM - fm) : WGM;
        u.pm = fm + ((wgid % nig) % gsz); u.pn = (wgid % nig) / gsz; u.ko = 0; return true;
    }
    __device__ __forceinline__ void a_ready(const Unit&) const {}
    __device__ __forceinline__ void done(const Unit&) const {}
};

__device__ __forceinline__ unsigned cvt_pk_bf16(float lo, float hi) { unsigned r; asm volatile("v_cvt_pk_bf16_f32 %0, %1, %2" : "=v"(r) : "v"(lo), "v"(hi)); return r; }
typedef float f32x2 __attribute__((ext_vector_type(2)));
__device__ __forceinline__ f32x2 gelu_pk(f32x2 v) {
    const f32x2 av = __builtin_elementwise_abs(v), d = av * 0.2316418882f + 1.0f;
    f32x2 t; t.x = __builtin_amdgcn_rcpf(d.x); t.y = __builtin_amdgcn_rcpf(d.y);
    f32x2 q = t * 0.5307027145f + (-0.7265760135f); q = q * t + 0.7107068705f; q = q * t + (-0.142248368f); q = q * t + 0.127414796f; q = q * t;
    const f32x2 s = (v * v) * (-0.72134752044f);
    f32x2 e; e.x = __builtin_amdgcn_exp2f(s.x); e.y = __builtin_amdgcn_exp2f(s.y);
    const f32x2 m = v * (q * e), r = v - m;
    f32x2 o; o.x = v.x < 0.f ? m.x : r.x; o.y = v.y < 0.f ? m.y : r.y; return o;
}

template <int ACT  > struct EpiBf16 {
    static constexpr bool PERM = true, AFTER_DRAIN = false; static_assert(ACT == 0 || ACT == 1, "EpiBf16: ACT is 0 (none) or 1 (gelu_pk)");
    bf16_t* O; int ldc; const float* bias; int split_cols; size_t split_stride; float scale0;
    __device__ __forceinline__ void operator()(const f32x4 (&acc)[2][2][4][2], const Unit& u, int wr, int wc, int fr, int fq) const {
        const int row0 = u.pm * BM + wr * 64 + fr; int colt = u.pn * BM; bf16_t* base = O;
        float sc = 1.f; if (split_cols) { const int t = colt / split_cols; base += (size_t)t * split_stride; colt -= t * split_cols; if (t == 0) sc = scale0; }
        const int col0 = colt + wc * 32 + 8 * fq, bcol0 = u.pn * BM + wc * 32 + 8 * fq;
        f32x4 bv[2][2];
#pragma unroll
        for (int bj = 0; bj < 2; ++bj)
#pragma unroll
            for (int n = 0; n < 2; ++n) bv[bj][n] = bias ? *(const f32x4*)(bias + bcol0 + bj * HALF + 4 * n) : (f32x4){0.f, 0.f, 0.f, 0.f};
#pragma unroll
        for (int ai = 0; ai < 2; ++ai)
#pragma unroll
            for (int m = 0; m < 4; ++m) { bf16_t* rowp = base + (size_t)(row0 + ai * HALF + m * 16) * ldc + col0;
#pragma unroll
                for (int bj = 0; bj < 2; ++bj) { f32x4 v0 = acc[ai][bj][m][0] + bv[bj][0], v1 = acc[ai][bj][m][1] + bv[bj][1];
                    if (ACT == 1) { f32x2 a = gelu_pk((f32x2){v0[0], v0[1]}), b = gelu_pk((f32x2){v0[2], v0[3]}), c = gelu_pk((f32x2){v1[0], v1[1]}), d = gelu_pk((f32x2){v1[2], v1[3]});
                        v0 = (f32x4){a.x, a.y, b.x, b.y}; v1 = (f32x4){c.x, c.y, d.x, d.y}; }
                    v0 = v0 * sc; v1 = v1 * sc; u32x4 w; w.x = cvt_pk_bf16(v0[0], v0[1]); w.y = cvt_pk_bf16(v0[2], v0[3]); w.z = cvt_pk_bf16(v1[0], v1[1]); w.w = cvt_pk_bf16(v1[2], v1[3]);
                    *(u32x4*)(rowp + bj * HALF) = w; } }
    }
};


template <class Epi, class Sched, bool ALIGN_EPI = false, bool SP2 = false>
__device__ __forceinline__ void gemm_phase(PG8_LAS unsigned char* lds, const Gemm g, const Sched& S, const Epi& E) {
    const int tid = otid(), wid = __builtin_amdgcn_readfirstlane(tid >> 6), lane = tid & 63, wr = wid >> 2, wc = wid & 3, fr = lane & 15, fq = lane >> 4;
    const int K = g.K, nt = K / BK, LDK = g.ldk ? g.ldk : g.K;
    unsigned voffA[2], voffB[2];
#pragma unroll
    for (int i = 0; i < 2; ++i) { int R, C; stage_rc(tid * 16 + i * 8192, R, C); const int Rb = Epi::PERM ? ((R & ~31) + perm32(R & 31)) : R;
        voffA[i] = (unsigned)(R * LDK + C) * 2u; voffB[i] = (unsigned)(Rb * LDK + C) * 2u; }
    const size_t kstep = (size_t)(BK * 2);
    const size_t hstep = (size_t)HALF * LDK * 2;
    const size_t tstep = 2 * hstep;
    const unsigned ldsw = (unsigned)wid * 1024u;
    const int aoff = lds_byte(wr * 64 + fr, fq * 8), boff = lds_byte(wc * 32 + fr, fq * 8);
#define PG8_SA(b, h) (((b) * 2 + (h)) * HTB)
#define PG8_SB(b, h) ((4 + (b) * 2 + (h)) * HTB)
#define PG8_STAGE(bufoff, gbase, voff) do { _Pragma("unroll") for (int _i = 0; _i < 2; ++_i) \
        __builtin_amdgcn_global_load_lds((const unsigned*)((const char*)(gbase) + (voff)[_i]), (PG8_LAS unsigned*)(lds + (bufoff) + ldsw + _i * 8192), 16, 0, 0); } while (0)
#define PG8_LDA(dst, b, h) do { _Pragma("unroll") for (int m = 0; m < 4; ++m) _Pragma("unroll") for (int k = 0; k < 2; ++k) dst[m][k] = *(const PG8_LAS bf16x8*)(lds + PG8_SA(b, h) + aoff + m * 2048 + k * 1024); } while (0)
#define PG8_LDB(dst, b, h) do { _Pragma("unroll") for (int n = 0; n < 2; ++n) _Pragma("unroll") for (int k = 0; k < 2; ++k) dst[n][k] = *(const PG8_LAS bf16x8*)(lds + PG8_SB(b, h) + boff + n * 2048 + k * 1024); } while (0)
#define PG8_MMA(ai, bj, At, Bt) do { __builtin_amdgcn_s_setprio(1); _Pragma("unroll") for (int m = 0; m < 4; ++m) _Pragma("unroll") for (int n = 0; n < 2; ++n) _Pragma("unroll") for (int k = 0; k < 2; ++k) \
        acc[ai][bj][m][n] = __builtin_amdgcn_mfma_f32_16x16x32_bf16(Bt[n][k], At[m][k], acc[ai][bj][m][n], 0, 0, 0); __builtin_amdgcn_s_setprio(0); } while (0)
#define PG8_WAIT_V(n) asm volatile("s_waitcnt vmcnt(" #n ")" ::: "memory")
#define PG8_WAIT_L(n) asm volatile("s_waitcnt lgkmcnt(" #n ")" ::: "memory")
#define PG8_BAR __builtin_amdgcn_s_barrier()
#define PG8_SCHED __builtin_amdgcn_sched_barrier(0)
    Unit cur, nxt; int ui = 0;
    if (!S.next(0, cur)) return;
    f32x4 acc[2][2][4][2];
#pragma unroll
    for (int a = 0; a < 2; ++a)
#pragma unroll
        for (int b = 0; b < 2; ++b)
#pragma unroll
            for (int m = 0; m < 4; ++m)
#pragma unroll
                for (int n = 0; n < 2; ++n) acc[a][b][m][n] = (f32x4){0.f, 0.f, 0.f, 0.f};
    bf16x8 At[4][2], B0[2][2], B1[2][2];
    const char* cA = (const char*)g.A + (size_t)cur.pm * tstep + (size_t)cur.ko * 2; const char* cB = (const char*)g.Bt + (size_t)cur.pn * tstep + (size_t)cur.ko * 2;
    S.a_ready(cur);
    if constexpr (SP2) {
        PG8_STAGE(PG8_SB(0, 0), cB, voffB); PG8_STAGE(PG8_SB(0, 1), cB + hstep, voffB); PG8_STAGE(PG8_SA(0, 0), cA, voffA); PG8_STAGE(PG8_SA(0, 1), cA + hstep, voffA);
        if (wr == 1) PG8_BAR;
        PG8_WAIT_V(2); PG8_BAR;
        PG8_STAGE(PG8_SB(1, 0), cB + kstep, voffB); PG8_STAGE(PG8_SA(1, 0), cA + kstep, voffA); PG8_STAGE(PG8_SB(1, 1), cB + hstep + kstep, voffB);
        PG8_WAIT_V(6); PG8_BAR;
    } else {
        PG8_STAGE(PG8_SB(0, 0), cB, voffB); PG8_STAGE(PG8_SA(0, 0), cA, voffA); PG8_STAGE(PG8_SB(0, 1), cB + hstep, voffB); PG8_STAGE(PG8_SA(0, 1), cA + hstep, voffA);
        if (wr == 1) PG8_BAR;
        PG8_WAIT_V(4); PG8_BAR;
        PG8_STAGE(PG8_SB(1, 0), cB + kstep, voffB); PG8_STAGE(PG8_SA(1, 0), cA + kstep, voffA); PG8_STAGE(PG8_SB(1, 1), cB + hstep + kstep, voffB);
        PG8_WAIT_V(6); PG8_BAR;
    }
    for (;;) {
        const bool has_next = S.next(ui + 1, nxt);
        const char* nA = has_next ? (const char*)g.A + (size_t)nxt.pm * tstep + (size_t)nxt.ko * 2 : cA; const char* nB = has_next ? (const char*)g.Bt + (size_t)nxt.pn * tstep + (size_t)nxt.ko * 2 : cB;
        for (int t = 0; t < nt; t += 2) {
            const bool last = (t == nt - 2);
            const char* a1 = cA + (size_t)(t + 1) * kstep;
            const char* a2 = last ? nA : cA + (size_t)(t + 2) * kstep; const char* b2 = last ? nB : cB + (size_t)(t + 2) * kstep;
            const char* a3 = a2 + kstep; const char* b3 = b2 + kstep;
            if (last && has_next) S.a_ready(nxt);
            if constexpr (SP2) {
            PG8_LDB(B0, 0, 0); PG8_LDB(B1, 0, 1); PG8_SCHED; PG8_LDA(At, 0, 0); PG8_STAGE(PG8_SA(1, 1), a1 + hstep, voffA);
            PG8_WAIT_V(8); PG8_WAIT_L(0); PG8_BAR; PG8_MMA(0, 0, At, B0); PG8_MMA(0, 1, At, B1); PG8_BAR; PG8_SCHED;
            PG8_LDA(At, 0, 1); PG8_STAGE(PG8_SB(0, 0), b2, voffB); PG8_STAGE(PG8_SB(0, 1), b2 + hstep, voffB); PG8_STAGE(PG8_SA(0, 0), a2, voffA);
            PG8_WAIT_V(8); PG8_WAIT_L(0); PG8_BAR; PG8_MMA(1, 0, At, B0); PG8_MMA(1, 1, At, B1); PG8_BAR; PG8_SCHED;
            PG8_LDB(B0, 1, 0); PG8_LDB(B1, 1, 1); PG8_SCHED; PG8_LDA(At, 1, 0); PG8_STAGE(PG8_SA(0, 1), a2 + hstep, voffA);
            PG8_WAIT_V(8); PG8_WAIT_L(0); PG8_BAR; PG8_MMA(0, 0, At, B0); PG8_MMA(0, 1, At, B1); PG8_BAR; PG8_SCHED;
            PG8_LDA(At, 1, 1); PG8_STAGE(PG8_SB(1, 0), b3, voffB); PG8_STAGE(PG8_SB(1, 1), b3 + hstep, voffB); PG8_STAGE(PG8_SA(1, 0), a3, voffA);
            PG8_WAIT_V(8); PG8_WAIT_L(0); PG8_BAR; PG8_MMA(1, 0, At, B0); PG8_MMA(1, 1, At, B1); PG8_BAR; PG8_SCHED;
            } else {
            PG8_LDB(B0, 0, 0); PG8_SCHED; PG8_LDA(At, 0, 0); PG8_STAGE(PG8_SA(1, 1), a1 + hstep, voffA);
            PG8_WAIT_L(8); PG8_BAR; PG8_WAIT_L(0); PG8_MMA(0, 0, At, B0); PG8_BAR; PG8_SCHED;
            PG8_LDB(B1, 0, 1); PG8_STAGE(PG8_SB(0, 0), b2, voffB);
            PG8_BAR; PG8_WAIT_L(0); PG8_MMA(0, 1, At, B1); PG8_BAR;
            PG8_LDA(At, 0, 1); PG8_STAGE(PG8_SA(0, 0), a2, voffA);
            PG8_BAR; PG8_WAIT_L(0); PG8_MMA(1, 0, At, B0); PG8_BAR; PG8_SCHED;
            PG8_STAGE(PG8_SB(0, 1), b2 + hstep, voffB);
            PG8_WAIT_V(6); PG8_BAR; PG8_MMA(1, 1, At, B1); PG8_BAR;
            PG8_LDB(B0, 1, 0); PG8_SCHED; PG8_LDA(At, 1, 0); PG8_STAGE(PG8_SA(0, 1), a2 + hstep, voffA);
            PG8_WAIT_L(8); PG8_BAR; PG8_WAIT_L(0); PG8_MMA(0, 0, At, B0); PG8_BAR; PG8_SCHED;
            PG8_LDB(B1, 1, 1); PG8_STAGE(PG8_SB(1, 0), b3, voffB);
            PG8_BAR; PG8_WAIT_L(0); PG8_MMA(0, 1, At, B1); PG8_BAR;
            PG8_LDA(At, 1, 1); PG8_STAGE(PG8_SA(1, 0), a3, voffA);
            PG8_BAR; PG8_WAIT_L(0); PG8_MMA(1, 0, At, B0); PG8_BAR; PG8_SCHED;
            PG8_STAGE(PG8_SB(1, 1), b3 + hstep, voffB);
            PG8_WAIT_V(6); PG8_BAR; PG8_MMA(1, 1, At, B1); PG8_BAR;
            }
        }
        if constexpr (ALIGN_EPI) { if (wr == 0) PG8_BAR; }
        if constexpr (!Epi::AFTER_DRAIN) { E(acc, cur, wr, wc, fr, fq); S.done(cur); }
        if (!has_next) break;
#pragma unroll
        for (int a = 0; a < 2; ++a)
#pragma unroll
            for (int b = 0; b < 2; ++b)
#pragma unroll
                for (int m = 0; m < 4; ++m)
#pragma unroll
                    for (int n = 0; n < 2; ++n) acc[a][b][m][n] = (f32x4){0.f, 0.f, 0.f, 0.f};
        cur = nxt; cA = nA; cB = nB; ++ui;
        if constexpr (ALIGN_EPI) { if (wr == 1) PG8_BAR; }
    }
    PG8_WAIT_V(0);
    if constexpr (!ALIGN_EPI) { if (wr == 0) PG8_BAR; }
    PG8_BAR;
    if constexpr (Epi::AFTER_DRAIN) { E.fused(acc, cur, wr, wc, fr, fq, lds, wid, lane); S.done(cur); }
#undef PG8_SA
#undef PG8_SB
#undef PG8_STAGE
#undef PG8_LDA
#undef PG8_LDB
#undef PG8_MMA
#undef PG8_WAIT_V
#undef PG8_WAIT_L
#undef PG8_BAR
#undef PG8_SCHED
}
}
namespace att {
constexpr int D = 128, PITCH = 2048;
constexpr float THR = 8.f;
constexpr bool WSKIP = false;
constexpr float SCALE = 0.08838834764831845f;
constexpr int NW = 8, QBLK = 32, KVBLK = 64, QB = NW * QBLK;
constexpr int SHM_V = KVBLK * D * 2, SHM_K = KVBLK * D * 2;
constexpr int LDS_BYTES = 2 * SHM_V + 2 * SHM_K + NW * 64 * 4 + 512;
using bf16 = __hip_bfloat16;
typedef short bf16x8 __attribute__((ext_vector_type(8)));
typedef short s16x4 __attribute__((ext_vector_type(4)));
typedef float f32x16 __attribute__((ext_vector_type(16)));
typedef float f32x4 __attribute__((ext_vector_type(4)));
typedef unsigned u32x4 __attribute__((ext_vector_type(4)));
template <class A, class Bt> struct same_t { static constexpr bool v = false; };
template <class A> struct same_t<A, A> { static constexpr bool v = true; };

#define BPERM(k) ((((k) >> 2) & 1) * 32 + (((k) >> 3) & 3) * 4 + ((k) & 3))
#define KSWZ(row, colB) ((row) * 256 + ((colB) ^ (((row) & 7) << 4)))
#define SBAR() __builtin_amdgcn_sched_barrier(0)
__device__ __forceinline__ int v_st(int k, int c) { const int kk = (k & ~0xC) | ((k & 4) << 1) | ((k & 8) >> 1); return ((kk >> 3) * 4 + (c >> 5)) * 512 + ((kk & 7) * 32 + (c & 31)) * 2; }
__device__ __forceinline__ int v_rd_base(int lane) { return ((lane & 3) << 3) | (((lane >> 2) & 3) << 6) | (((lane >> 4) & 1) << 5) | (((lane >> 5) & 1) << 8); }
constexpr int v_rd_off(int d0, int ks, int half) { return d0 * 512 + ks * 4096 + half * 2048; }
__device__ __forceinline__ int crow(int r, int hi) { return (r & 3) + 8 * (r >> 2) + 4 * hi; }
__device__ __forceinline__ unsigned cvtpk(float lo, float hi) {
    unsigned r; asm volatile("v_cvt_pk_bf16_f32 %0, %1, %2" : "=v"(r) : "v"(lo), "v"(hi)); return r;
}
__device__ __forceinline__ bf16x8 pack8(f32x4 a, f32x4 b) {
    u32x4 w = {cvtpk(a[0], a[1]), cvtpk(a[2], a[3]), cvtpk(b[0], b[1]), cvtpk(b[2], b[3])};
    return *reinterpret_cast<bf16x8*>(&w);
}
template <class T> __device__ __forceinline__ bf16x8 load8(const T* p) {
    if constexpr (same_t<T, float>::v) { return pack8(*(const f32x4*)p, *(const f32x4*)(p + 4)); }
    else { return *reinterpret_cast<const bf16x8*>(p); }
}
__device__ __forceinline__ void mask_tile(f32x16& p0, f32x16& p1, int dq, unsigned W) {
    const float NEG = -__builtin_inff();
#pragma unroll
    for (int r = 0; r < 16; ++r) {
        const int c = (r & 3) + 8 * (r >> 2);
        if ((unsigned)(dq - c) >= W) p0[r] = NEG;
        if ((unsigned)(dq - c - 32) >= W) p1[r] = NEG;
    }
}
__device__ __forceinline__ void partialSM(f32x16& p0, f32x16& p1, float& m_reg, float& mn, float& alpha) {
    float pmax = p0[0]; for (int r = 1; r < 16; ++r) pmax = fmaxf(pmax, p0[r]); for (int r = 0; r < 16; ++r) pmax = fmaxf(pmax, p1[r]);
    { auto rr = __builtin_amdgcn_permlane32_swap(__float_as_uint(pmax), __float_as_uint(pmax), false, false);
      pmax = fmaxf(__uint_as_float(rr[0]), __uint_as_float(rr[1])); }
    constexpr float C2 = 1.4426950408889634f * SCALE;
    if (__builtin_expect(__all((pmax - m_reg) * SCALE <= THR), 1)) { mn = m_reg; alpha = 1.f; }
    else { mn = fmaxf(m_reg, pmax); alpha = __builtin_amdgcn_exp2f((m_reg - mn) * C2); m_reg = mn; }
    const float mnL = -mn * C2;
    for (int r = 0; r < 16; ++r) p0[r] = fmaf(p0[r], C2, mnL); for (int r = 0; r < 16; ++r) p1[r] = fmaf(p1[r], C2, mnL);
    for (int r = 0; r < 16; ++r) p0[r] = __builtin_amdgcn_exp2f(p0[r]);
}
__device__ __forceinline__ void finishSM(f32x16& p0, f32x16& p1, float alpha, float& l_reg, bf16x8& pa0, bf16x8& pa1, bf16x8& pa2, bf16x8& pa3) {
    for (int r = 0; r < 16; ++r) p1[r] = __builtin_amdgcn_exp2f(p1[r]);
    float ps = 0; for (int r = 0; r < 16; ++r) ps += p0[r]; for (int r = 0; r < 16; ++r) ps += p1[r];
    { auto rr = __builtin_amdgcn_permlane32_swap(__float_as_uint(ps), __float_as_uint(ps), false, false);
      ps = __uint_as_float(rr[0]) + __uint_as_float(rr[1]); }
    l_reg = l_reg * alpha + ps;
#define PK4(P, B_, OUT) do { unsigned a0 = cvtpk(P[B_+0], P[B_+1]), a1 = cvtpk(P[B_+2], P[B_+3]);                          \
        unsigned b0 = cvtpk(P[B_+4], P[B_+5]), b1 = cvtpk(P[B_+6], P[B_+7]);                                             \
        auto r0 = __builtin_amdgcn_permlane32_swap(a0, b0, false, false); auto r1 = __builtin_amdgcn_permlane32_swap(a1, b1, false, false); \
        u32x4 w = {r0[0], r1[0], r0[1], r1[1]}; OUT = *reinterpret_cast<bf16x8*>(&w); } while (0)
    PK4(p0, 0, pa0); PK4(p0, 8, pa1); PK4(p1, 0, pa2); PK4(p1, 8, pa3);
#undef PK4
}
template <int KB, bool SK>
__device__ __forceinline__ void qkt(f32x16& p0, f32x16& p1, const char* K_lds, const float* B_lds, int r32, int hi, const bf16x8* qr, bool act) {
    if (SK && !act) { const float NEG = -__builtin_inff();
#pragma unroll
        for (int r = 0; r < 16; ++r) { p0[r] = NEG; p1[r] = NEG; } return; }
#ifdef ATT_NOBIAS
    p0 = f32x16{}; p1 = f32x16{};
#else
    p0 = *(const f32x16*)(B_lds + KB * 64 + hi * 32); p1 = *(const f32x16*)(B_lds + KB * 64 + hi * 32 + 16);
#endif
    const char* kb[4];
#pragma unroll
    for (int dd = 0; dd < 4; ++dd) kb[dd] = K_lds + KB * SHM_K + KSWZ(r32, (dd * 16 + hi * 8) * 2);
#pragma unroll
    for (int d0 = 0; d0 < 8; ++d0) { const char* a = kb[d0 & 3] + (d0 >> 2) * 128;
        bf16x8 b0 = *reinterpret_cast<const bf16x8*>(a);
        bf16x8 b1 = *reinterpret_cast<const bf16x8*>(a + 32 * 256);
        p0 = __builtin_amdgcn_mfma_f32_32x32x16_bf16(b0, qr[d0], p0, 0, 0, 0);
        p1 = __builtin_amdgcn_mfma_f32_32x32x16_bf16(b1, qr[d0], p1, 0, 0, 0); }
}
template <int VB, bool SK>
__device__ __forceinline__ void pv_tile(f32x16* o, int vb0, bf16x8 pa0, bf16x8 pa1, bf16x8 pa2, bf16x8 pa3, bool act) {
    if (SK && !act) return;
#define TRRD(dst, off) asm volatile("ds_read_b64_tr_b16 %0, %1 offset:%2" : "=&v"(dst) : "v"(vb0), "i"(off) : "memory")
#define PV_D0(d0) do { s16x4 l0, l1, l2, l3, h0, h1, h2, h3; constexpr int b_ = VB * SHM_V + v_rd_off(d0, 0, 0);     \
        TRRD(l0, b_); TRRD(h0, b_ + 2048); TRRD(l1, b_ + 4096); TRRD(h1, b_ + 6144); TRRD(l2, b_ + 8192); TRRD(h2, b_ + 10240); TRRD(l3, b_ + 12288); TRRD(h3, b_ + 14336); \
        asm volatile("s_waitcnt lgkmcnt(0)" ::: "memory"); SBAR();                 \
        o[d0] = __builtin_amdgcn_mfma_f32_32x32x16_bf16(pa0, (bf16x8){l0[0], l0[1], l0[2], l0[3], h0[0], h0[1], h0[2], h0[3]}, o[d0], 0, 0, 0);   \
        o[d0] = __builtin_amdgcn_mfma_f32_32x32x16_bf16(pa1, (bf16x8){l1[0], l1[1], l1[2], l1[3], h1[0], h1[1], h1[2], h1[3]}, o[d0], 0, 0, 0);   \
        o[d0] = __builtin_amdgcn_mfma_f32_32x32x16_bf16(pa2, (bf16x8){l2[0], l2[1], l2[2], l2[3], h2[0], h2[1], h2[2], h2[3]}, o[d0], 0, 0, 0);   \
        o[d0] = __builtin_amdgcn_mfma_f32_32x32x16_bf16(pa3, (bf16x8){l3[0], l3[1], l3[2], l3[3], h3[0], h3[1], h3[2], h3[3]}, o[d0], 0, 0, 0); } while (0)
    PV_D0(0); PV_D0(1); PV_D0(2); PV_D0(3);
#undef PV_D0
#undef TRRD
}

template <class TIn, class TOut> struct BlockRef { const TIn* Q; const TIn* K; const TIn* V; TOut* O; const float* CB; const TIn* Z; int P0; };
template <class TIn> struct Seam {
    bf16x8 qr[8];
    bf16x8 st_v0, st_v1, st_k0, st_k1; float st_b0; f32x4 sf0, sf1, sf2, sf3;
    f32x4 tq[16];
};
__device__ __forceinline__ int swa_jlo(int P0, int W) { const int lowk = P0 - W + 1; return lowk > 0 ? lowk / KVBLK : 0; }
#define ROW(p, k0, rr) ((p) + (unsigned)(((k0) + (rr)) * PITCH + sc))
#define VMW() asm volatile("s_waitcnt vmcnt(0)" ::: "memory")
#define VMWN(n) asm volatile("s_waitcnt vmcnt(%0)" :: "i"(n) : "memory")
#define SLOAD_H(Kp, Vp, Cp, k0) do { S.st_b0 = (Cp)[(unsigned)((k0) + sr + 32 * (tid & 1))]; S.st_v0 = load8<TIn>(ROW(Vp, k0, sr)); S.st_v1 = load8<TIn>(ROW(Vp, k0, 32 + sr));              \
                         S.st_k0 = load8<TIn>(ROW(Kp, k0, sr)); S.st_k1 = load8<TIn>(ROW(Kp, k0, 32 + sr)); } while (0)
#define SWRITE_HK(bf) do { B_lds[(bf) * 64 + sr + 32 * (tid & 1)] = S.st_b0; *(bf16x8*)(K_lds + (bf) * SHM_K + kws) = S.st_k0; *(bf16x8*)(K_lds + (bf) * SHM_K + kws + 32 * 256) = S.st_k1; } while (0)
#define SWRITE_HV(bf) do { *(bf16x8*)(V_lds + (bf) * SHM_V + vst0) = S.st_v0; *(bf16x8*)(V_lds + (bf) * SHM_V + vst1) = S.st_v1; } while (0)
#define SWRITE_H(bf) do { SWRITE_HV(bf); SWRITE_HK(bf); } while (0)
#define SLOAD_F(p, k0) do { S.sf0 = *(const f32x4*)ROW(p, k0, sr); S.sf1 = *(const f32x4*)(ROW(p, k0, sr) + 4);                \
                            S.sf2 = *(const f32x4*)ROW(p, k0, 32 + sr); S.sf3 = *(const f32x4*)(ROW(p, k0, 32 + sr) + 4); } while (0)
#define SWRITE_KF(bf) do { *(bf16x8*)(K_lds + (bf) * SHM_K + kws) = pack8(S.sf0, S.sf1); *(bf16x8*)(K_lds + (bf) * SHM_K + kws + 32 * 256) = pack8(S.sf2, S.sf3); } while (0)
#define SWRITE_VF(bf) do { *(bf16x8*)(V_lds + (bf) * SHM_V + vst0) = pack8(S.sf0, S.sf1); *(bf16x8*)(V_lds + (bf) * SHM_V + vst1) = pack8(S.sf2, S.sf3); } while (0)
template <class TIn, class TOut>
__device__ __forceinline__ void causal_swa_prime(const BlockRef<TIn, TOut>& cur, int W, char* lds, Seam<TIn>& S) {
    constexpr bool F32 = same_t<TIn, float>::v;
    const int tid = otid(), wid = __builtin_amdgcn_readfirstlane(tid >> 6), lane = tid & 63, r32 = lane & 31, hi = lane >> 5;
    const int sr = tid >> 4, sc = (tid & 15) * 8, kws = KSWZ(sr, sc * 2); char* K_lds = lds + 2 * SHM_V; float* B_lds = (float*)(lds + 2 * SHM_V + 2 * SHM_K + NW * 64 * 4);
    const int kb0 = swa_jlo(cur.P0, W) * KVBLK;
    for (int d0 = 0; d0 < 8; ++d0) S.qr[d0] = load8<TIn>(cur.Q + (unsigned)((wid * QBLK + r32) * PITCH + d0 * 16 + hi * 8));
    if constexpr (F32) { SLOAD_F((const float*)cur.K, kb0); VMW(); SWRITE_KF(0); SBAR(); SLOAD_F((const float*)cur.V, kb0); }
    else { SLOAD_H(cur.K, cur.V, cur.CB, kb0); VMW(); SWRITE_HK(0); }
    __syncthreads();
}
template <class TIn, class TOut>
__device__ __forceinline__ void causal_swa_block(const BlockRef<TIn, TOut>& cur, const BlockRef<TIn, TOut>& nxt, int skv, int W, char* lds, Seam<TIn>& S) {
    constexpr bool F32 = same_t<TIn, float>::v;
    const int tid = otid(), wid = __builtin_amdgcn_readfirstlane(tid >> 6), lane = tid & 63, r32 = lane & 31, hi = lane >> 5;
    const int j_lo = swa_jlo(cur.P0, W);
    int j_hi = (cur.P0 + QB - 1) / KVBLK + 1; if (j_hi > skv / KVBLK) j_hi = skv / KVBLK;
    const int NT = j_hi - j_lo;
    const int kbn = swa_jlo(nxt.P0, W) * KVBLK;
    const int qlo = cur.P0 + wid * QBLK, qm = qlo + r32 - 4 * hi;
    char* V_lds = lds; char* K_lds = lds + 2 * SHM_V; float* B_lds = (float*)(lds + 2 * SHM_V + 2 * SHM_K + NW * 64 * 4);
    float* ws = (float*)(lds + 2 * SHM_V + 2 * SHM_K) + wid * 64; float* li_l = ws, * al_l = ws + 32;
    float m_reg = -1e30f, l_reg = 0; f32x16 o[4] = {};
    const int sr = tid >> 4, sc = (tid & 15) * 8, vst0 = v_st(sr, sc), vst1 = v_st(32 + sr, sc), kws = KSWZ(sr, sc * 2);
    const int vb0 = (int)(uintptr_t)V_lds + v_rd_base(lane);
    const TIn* Kh = cur.K; const TIn* Vh = cur.V; const float* Ch = cur.CB;
#define RESC(a) do { if (__any((a) < 1.f)) { if (hi == 0) al_l[r32] = (a); asm volatile("s_waitcnt lgkmcnt(0)" ::: "memory");              \
                     for (int d_ = 0; d_ < 4; ++d_) for (int r = 0; r < 16; ++r) o[d_][r] *= al_l[crow(r, hi)]; } } while (0)
#define KBASE(t) ((j_lo + (t)) * KVBLK)
#define ACT(t) (KBASE(t) <= qlo + QBLK - 1 && KBASE(t) + KVBLK - 1 >= qlo - W + 1)
#define MASKT(P0_, P1_, t) do { const int kb_ = KBASE(t); if ((!SK || ACT(t)) && (kb_ + KVBLK - 1 > qlo || kb_ <= qlo + QBLK - 1 - W)) mask_tile(P0_, P1_, qm - kb_, (unsigned)W); } while (0)
    constexpr int NQL = F32 ? 16 : 8;
    constexpr bool SK = WSKIP && !F32;
#define SEAM_K0() do { VMWN(NQL); if constexpr (F32) { SWRITE_KF(0); SBAR(); SLOAD_F((const float*)nxt.V, kbn); } else { SWRITE_HK(0); } SBAR(); } while (0)
    f32x16 pA0, pA1, pB0, pB1; float mnA, mnB, alA, alB; bf16x8 pa0, pa1, pa2, pa3;
    if constexpr (F32) { VMW(); SWRITE_VF(0); SBAR(); } else { SWRITE_HV(0); SBAR(); }
    if (NT > 1) { if constexpr (F32) SLOAD_F((const float*)Kh, KBASE(1)); else SLOAD_H(Kh, Vh, Ch, KBASE(1)); }
    SBAR(); qkt<0, SK>(pA0, pA1, K_lds, B_lds, r32, hi, S.qr, ACT(0));
    if constexpr (F32) { if (NT > 1) { VMW(); SWRITE_KF(1); SBAR(); SLOAD_F((const float*)Vh, KBASE(1)); } }
    MASKT(pA0, pA1, 0); partialSM(pA0, pA1, m_reg, mnA, alA);
    if (NT > 1) { VMW(); if constexpr (F32) { SWRITE_VF(1); SBAR(); if (NT > 2) SLOAD_F((const float*)Kh, KBASE(2)); } else SWRITE_H(1); }
    __syncthreads();
#define HALF_STEP(PX0, PX1, mnX, alX, PY0, PY1, alY, t, KB, VB, SB) do {                                                      \
        SBAR(); qkt<KB, SK>(PX0, PX1, K_lds, B_lds, r32, hi, S.qr, ACT(t));                                             \
        finishSM(PY0, PY1, alY, l_reg, pa0, pa1, pa2, pa3); SBAR();                                                           \
        if ((t) + 1 < NT) { if constexpr (F32) { VMW(); SWRITE_KF(SB); SBAR(); SLOAD_F((const float*)Vh, KBASE((t) + 1)); }  \
                            else { SLOAD_H(Kh, Vh, Ch, KBASE((t) + 1)); } SBAR(); }                                               \
        pv_tile<VB, SK>(o, vb0, pa0, pa1, pa2, pa3, ACT((t) - 1)); MASKT(PX0, PX1, (t)); partialSM(PX0, PX1, m_reg, mnX, alX);                                        \
        __syncthreads();                                                                                                      \
        if ((t) + 1 < NT) { VMW(); if constexpr (F32) { SWRITE_VF(SB); SBAR(); if ((t) + 2 < NT) SLOAD_F((const float*)Kh, KBASE((t) + 2)); } \
                            else { SWRITE_H(SB); } }                                                                          \
        RESC(alX); __syncthreads(); } while (0)
    for (int t = 1; t + 1 < NT; t += 2) {
        HALF_STEP(pB0, pB1, mnB, alB, pA0, pA1, alA, t, 1, 0, 0);
        HALF_STEP(pA0, pA1, mnA, alA, pB0, pB1, alB, t + 1, 0, 1, 1);
    }
    const bool even = (NT & 1) == 0;
    if (even) { SBAR(); qkt<1, SK>(pB0, pB1, K_lds, B_lds, r32, hi, S.qr, ACT(NT - 1)); SBAR(); }
#define QROW(e) (nxt.Q + (size_t)(wid * QBLK + r32) * PITCH + ((e) >> 1) * 16 + hi * 8 + ((e) & 1) * 4)
    if constexpr (F32) { SLOAD_F((const float*)nxt.K, kbn); SBAR();
#pragma unroll
        for (int e = 0; e < 8; ++e) S.tq[e] = *(const f32x4*)QROW(e); }
    else { SLOAD_H(nxt.K, nxt.V, nxt.CB, kbn); SBAR();
#pragma unroll
        for (int d0 = 0; d0 < 8; ++d0) S.qr[d0] = load8<TIn>(nxt.Q + (unsigned)((wid * QBLK + r32) * PITCH + d0 * 16 + hi * 8)); }
    SBAR();
    finishSM(pA0, pA1, alA, l_reg, pa0, pa1, pa2, pa3); SBAR();
    if constexpr (F32) {
#pragma unroll
        for (int e = 8; e < 16; ++e) S.tq[e] = *(const f32x4*)QROW(e); SBAR(); }
#undef QROW
    pv_tile<0, SK>(o, vb0, pa0, pa1, pa2, pa3, ACT(even ? NT - 2 : NT - 1));
    if (even) { MASKT(pB0, pB1, NT - 1); partialSM(pB0, pB1, m_reg, mnB, alB); __syncthreads(); RESC(alB);
        finishSM(pB0, pB1, alB, l_reg, pa0, pa1, pa2, pa3); SBAR(); pv_tile<1, SK>(o, vb0, pa0, pa1, pa2, pa3, ACT(NT - 1)); }
    SBAR(); SEAM_K0();
    if (hi == 0) li_l[r32] = l_reg; asm volatile("s_waitcnt lgkmcnt(0)" ::: "memory");
    float rli[16];
#pragma unroll
    for (int r = 0; r < 16; ++r) rli[r] = __builtin_amdgcn_rcpf(li_l[crow(r, hi)]);
    TOut* Ow = cur.O + (size_t)(wid * QBLK) * PITCH; const TIn* Zw = cur.Z + (size_t)(wid * QBLK) * PITCH; unsigned lo_ = (unsigned)(4 * hi) * PITCH + r32; asm volatile("" : "+v"(lo_));
#pragma unroll
    for (int r = 0; r < 16; ++r) { const int orow = crow(r, hi);
#pragma unroll
        for (int d0 = 0; d0 < 4; ++d0) { const float v = o[d0][r] * rli[r];
            if constexpr (same_t<TOut, float>::v) { Ow[(size_t)orow * PITCH + d0 * 32 + r32] = v; }
            else { const float vn = __shfl_xor(v, 1);
                   if ((r32 & 1) == 0) { const unsigned of_ = lo_ + (unsigned)(orow - 4 * hi) * PITCH + d0 * 32; const unsigned zz = *(const unsigned*)(Zw + of_);
                       *(unsigned*)(Ow + of_) = cvtpk(v * __uint_as_float(zz << 16), vn * __uint_as_float(zz & 0xffff0000u)); } } } }
    if constexpr (F32) {
#pragma unroll
        for (int d0 = 0; d0 < 8; ++d0) S.qr[d0] = pack8(S.tq[2 * d0], S.tq[2 * d0 + 1]); }
    __syncthreads();
#undef RESC
#undef KBASE
#undef ACT
#undef MASKT
#undef SEAM_K0
#undef HALF_STEP
}
#undef ROW
#undef VMW
#undef VMWN
#undef SLOAD_H
#undef SWRITE_HK
#undef SWRITE_HV
#undef SWRITE_H
#undef SLOAD_F
#undef SWRITE_KF
#undef SWRITE_VF
}

namespace cg = cooperative_groups;
#define LAS __attribute__((address_space(3)))
typedef unsigned short bf16_t;
typedef float f32x4 __attribute__((ext_vector_type(4)));
typedef float f32x2 __attribute__((ext_vector_type(2)));
typedef unsigned u32x4 __attribute__((ext_vector_type(4)));
typedef unsigned u32x2 __attribute__((ext_vector_type(2)));
typedef short bf16x8 __attribute__((ext_vector_type(8)));

constexpr int DM = 1024, EB = 2048, MP = 32768, MS = 128, MV = MP + MS  , MA = 33024  ;
constexpr int SEQ = 4096, NBH = 128, PAST = 2048, TS = 16, SKS = 2112  ;
constexpr int NFIN = 8448;
constexpr float RMS_EPS = 1e-6f, LN_EPS = 1e-5f;
constexpr size_t O_YP = 0, O_YS = 33554432, O_GV = 33685504, O_FKP = 34209792, O_FVP = 168427520, O_FLP = 302645248, O_FKS = 303693824, O_FVS = 304218112, O_FLS = 304742400;
constexpr size_t MiB = 1u << 20;
constexpr size_t WS_WGIN = 1 * MiB;
constexpr size_t WS_WGOUT = 25 * MiB;
constexpr size_t WS_WFIN = 33 * MiB;
constexpr size_t WS_WFOUT = 66 * MiB;
constexpr size_t WS_WPP = 74 * MiB;
constexpr size_t WS_WPG = 76 * MiB;
constexpr size_t WS_WM = 84 * MiB;
constexpr size_t WS_WMS = 85 * MiB;
constexpr size_t WS_PB = 88 * MiB;
constexpr size_t WS_HX = 105 * MiB;
constexpr size_t WS_TB = 170 * MiB;
constexpr size_t WS_STAT = 756 * MiB;
constexpr size_t WS_CBP = 236 * MiB;
constexpr size_t WS_CBS = 238 * MiB + 512 * 1024;
constexpr size_t WS_R0 = 240 * MiB, RSZ = 129 * MiB;
constexpr size_t WS_END = 775 * MiB;
constexpr size_t WS_PART = 766 * MiB;
constexpr size_t WS_DUMMY = 776 * MiB;
constexpr int LDS_BYTES = LDS_TOTAL;
#ifndef PROBE_DUP
#define PROBE_DUP 0
#endif

struct ArgsS { const float* in[20]; float* out; unsigned char* ws; };
typedef const __attribute__((address_space(4))) ArgsS* ArgsP;
struct Args { ArgsP p; };
__device__ __forceinline__ Args getargs() { ArgsP p = (ArgsP)__builtin_amdgcn_kernarg_segment_ptr(); asm volatile("" : "+s"(p)); Args a; a.p = p; return a; }

__device__ __forceinline__ unsigned f2bf(float f) { unsigned u = __builtin_bit_cast(unsigned, f); return (u + 0x7fffu + ((u >> 16) & 1u)) >> 16; }
__device__ __forceinline__ unsigned pk2(float lo, float hi) { return pg8::cvt_pk_bf16(lo, hi); }
__device__ __forceinline__ float bflo(unsigned u) { return __uint_as_float(u << 16); }
__device__ __forceinline__ float bfhi(unsigned u) { return __uint_as_float(u & 0xffff0000u); }
__device__ __forceinline__ float wave_sum(float v) { for (int o = 32; o > 0; o >>= 1) v += __shfl_xor(v, o); return v; }
__device__ __forceinline__ float wave_max(float v) { for (int o = 32; o > 0; o >>= 1) v = fmaxf(v, __shfl_xor(v, o)); return v; }
__device__ __forceinline__ float gelu_t(float x) { const float t = x * x; const float e = __builtin_amdgcn_exp2f((-2.3022082f * x) * (1.f + 0.044715f * t)); return x * __builtin_amdgcn_rcpf(1.f + e); }
__device__ __forceinline__ float silu_f(float x) { return x * __builtin_amdgcn_rcpf(1.f + __builtin_amdgcn_exp2f(-1.4426950408889634f * x)); }
__device__ __forceinline__ float sigm_f(float x) { return __builtin_amdgcn_rcpf(1.f + __builtin_amdgcn_exp2f(-1.4426950408889634f * x)); }
__device__ __forceinline__ f32x2 sigm2(f32x2 v) { const f32x2 a = v * -1.4426950408889634f; f32x2 e; e.x = __builtin_amdgcn_exp2f(a.x); e.y = __builtin_amdgcn_exp2f(a.y); const f32x2 d = e + 1.0f; f32x2 r; r.x = __builtin_amdgcn_rcpf(d.x); r.y = __builtin_amdgcn_rcpf(d.y); return r; }
__device__ __forceinline__ f32x2 silu2(f32x2 v) { return v * sigm2(v); }
__device__ __forceinline__ f32x2 gelu2(f32x2 v) { const f32x2 t = v * v; const f32x2 a = (v * -2.3022082f) * (t * 0.044715f + 1.0f); f32x2 e; e.x = __builtin_amdgcn_exp2f(a.x); e.y = __builtin_amdgcn_exp2f(a.y); const f32x2 d = e + 1.0f; f32x2 r; r.x = __builtin_amdgcn_rcpf(d.x); r.y = __builtin_amdgcn_rcpf(d.y); return v * r; }
__device__ __forceinline__ float logsig_f(float x) { const float e = __expf(-fabsf(x)); const float l = e < 0.03f ? e * (1.f - e * (0.5f - e * (0.33333334f - 0.25f * e))) : __logf(1.f + e); return fminf(x, 0.f) - l; }

using pg8::Unit; using pg8::HALF; using pg8::BM;
struct EpiGmlpIn {
    static constexpr bool PERM = true, AFTER_DRAIN = false;
    bf16_t* U; bf16_t* VT; bf16_t* ZS; float* stat;
    __device__ __forceinline__ void operator()(const pg8::f32x4 (&acc)[2][2][4][2], const Unit& u, int wr, int wc, int fr_, int fq_) const {
        const int lane_ = otid() & 63, fr = lane_ & 15, fq = lane_ >> 4; (void)fr_; (void)fq_;
        const int row0 = u.pm * BM + wr * 64 + fr, colt = u.pn * BM, region = colt >> 11, cb = (colt & 2047) + wc * 32 + 8 * fq;
#pragma unroll
        for (int ai = 0; ai < 2; ++ai)
#pragma unroll
            for (int m = 0; m < 4; ++m) {
                const int row = row0 + ai * HALF + m * 16; float s = 0.f, q = 0.f;
#pragma unroll
                for (int bj = 0; bj < 2; ++bj) {
                    const int col = cb + bj * HALF; const pg8::f32x4 v0 = acc[ai][bj][m][0], v1 = acc[ai][bj][m][1];
                    float x[8] = {v0[0], v0[1], v0[2], v0[3], v1[0], v1[1], v1[2], v1[3]};
                    if (region == 2) {
#pragma unroll
                        for (int e = 0; e < 8; e += 2) { const f32x2 r = silu2((f32x2){x[e], x[e + 1]}); x[e] = r.x; x[e + 1] = r.y; }
                    } else {
#pragma unroll
                        for (int e = 0; e < 8; e += 2) { const f32x2 r = gelu2((f32x2){x[e], x[e + 1]}); x[e] = r.x; x[e + 1] = r.y; }
                    }
                    u32x4 w; w.x = pk2(x[0], x[1]); w.y = pk2(x[2], x[3]); w.z = pk2(x[4], x[5]); w.w = pk2(x[6], x[7]);
                    if (region == 1) {
                        bf16_t* vp = VT + ((size_t)(row >> 7) * 2048 + col) * 128 + (row & 127);
                        const unsigned ww[4] = {w.x, w.y, w.z, w.w};
#pragma unroll
                        for (int e = 0; e < 4; ++e) { vp[(2 * e) * 128] = (bf16_t)(ww[e] & 0xffffu); vp[(2 * e + 1) * 128] = (bf16_t)(ww[e] >> 16);
                            const float a = bflo(ww[e]), b = bfhi(ww[e]); s += a + b; q += a * a + b * b; }
                    } else {
                        bf16_t* dst = (region == 0 ? U : ZS) + (size_t)row * 2048 + col;
                        *(u32x4*)dst = w;
                    }
                }
                if (region == 1) {
                    s += __shfl_xor(s, 16); s += __shfl_xor(s, 32); q += __shfl_xor(q, 16); q += __shfl_xor(q, 32);
                    if (fq == 0) { const int slot = ((colt & 2047) >> 6) + wc; stat[(size_t)row * 64 + slot] = s; stat[(size_t)row * 64 + 32 + slot] = q; }
                }
            }
    }
};
struct EpiFoxIn {
    static constexpr bool PERM = true, AFTER_DRAIN = false;
    bf16_t* QB; bf16_t* KB; bf16_t* VB; bf16_t* ZS; float* okp; float* ovp; float* olp; float* oks; float* ovs; float* ols; const float* bf;
    __device__ __forceinline__ void operator()(const pg8::f32x4 (&acc)[2][2][4][2], const Unit& u, int wr, int wc, int fr_, int fq_) const {
        const int lane_ = otid() & 63, fr = lane_ & 15, fq = lane_ >> 4; (void)fr_; (void)fq_;
        const int row0 = u.pm * BM + wr * 64 + fr, colt = u.pn * BM, region = colt >> 11, cb = (colt & 2047) + wc * 32 + 8 * fq;
        if (region == 4) {
            if (wc != 0 || fq >= 2) return;
#pragma unroll
            for (int ai = 0; ai < 2; ++ai)
#pragma unroll
                for (int m = 0; m < 4; ++m) {
                    const int row = row0 + ai * HALF + m * 16; if (row >= MV) continue;
                    const pg8::f32x4 v0 = acc[ai][0][m][0], v1 = acc[ai][0][m][1];
                    const f32x4 b0 = *(const f32x4*)(bf + 8 * fq), b1 = *(const f32x4*)(bf + 8 * fq + 4);
                    f32x4 r0, r1;
#pragma unroll
                    for (int e = 0; e < 4; ++e) { r0[e] = logsig_f(v0[e] + b0[e]); r1[e] = logsig_f(v1[e] + b1[e]); }
                    float* dst = row < MP ? olp + (size_t)row * 16 + 8 * fq : ols + (size_t)(row - MP) * 16 + 8 * fq;
                    *(f32x4*)dst = r0; *(f32x4*)(dst + 4) = r1;
                }
            return;
        }
        bf16_t* B = region == 0 ? QB : region == 1 ? KB : region == 2 ? VB : ZS;
#pragma unroll
        for (int ai = 0; ai < 2; ++ai)
#pragma unroll
            for (int m = 0; m < 4; ++m) {
                const int row = row0 + ai * HALF + m * 16;
#pragma unroll
                for (int bj = 0; bj < 2; ++bj) {
                    const int col = cb + bj * HALF; pg8::f32x4 v0 = acc[ai][bj][m][0], v1 = acc[ai][bj][m][1];
                    if (region == 3) {
#pragma unroll
                        for (int e = 0; e < 4; e += 2) { const f32x2 r0 = silu2((f32x2){v0[e], v0[e + 1]}), r1 = silu2((f32x2){v1[e], v1[e + 1]}); v0[e] = r0.x; v0[e + 1] = r0.y; v1[e] = r1.x; v1[e + 1] = r1.y; }
                    }
                    u32x4 w; w.x = pk2(v0[0], v0[1]); w.y = pk2(v0[2], v0[3]); w.z = pk2(v1[0], v1[1]); w.w = pk2(v1[2], v1[3]);
                    *(u32x4*)(B + (size_t)row * 2048 + col) = w;
                    if ((region == 1 || region == 2) && row < MV) {
                        float* o = region == 1 ? (row < MP ? okp + (size_t)row * 2048 : oks + (size_t)(row - MP) * 2048) : (row < MP ? ovp + (size_t)row * 2048 : ovs + (size_t)(row - MP) * 2048);
                        *(pg8::f32x4*)(o + col) = v0; *(pg8::f32x4*)(o + col + 4) = v1;
                    }
                }
            }
    }
};
struct EpiT {
    static constexpr bool PERM = true, AFTER_DRAIN = false;
    bf16_t* O; int ldc;
    __device__ __forceinline__ void operator()(const pg8::f32x4 (&acc)[2][2][4][2], const Unit& u, int wr, int wc, int fr_, int fq_) const {
        const int lane_ = otid() & 63, fr = lane_ & 15, fq = lane_ >> 4; (void)fr_; (void)fq_;
        const int row0 = u.pm * BM + wr * 64 + fr, col0 = u.pn * BM + wc * 32 + 8 * fq;
#pragma unroll
        for (int ai = 0; ai < 2; ++ai)
#pragma unroll
            for (int m = 0; m < 4; ++m) { bf16_t* rp = O + (size_t)(row0 + ai * HALF + m * 16) * ldc + col0;
#pragma unroll
                for (int bj = 0; bj < 2; ++bj) { const pg8::f32x4 v0 = acc[ai][bj][m][0], v1 = acc[ai][bj][m][1];
                    u32x4 w; w.x = pk2(v0[0], v0[1]); w.y = pk2(v0[2], v0[3]); w.z = pk2(v1[0], v1[1]); w.w = pk2(v1[2], v1[3]);
                    *(u32x4*)(rp + bj * HALF) = w; } }
    }
};
struct EpiF32 {
    static constexpr bool PERM = true, AFTER_DRAIN = false;
    float* O; int ldc;
    __device__ __forceinline__ void operator()(const pg8::f32x4 (&acc)[2][2][4][2], const Unit& u, int wr, int wc, int fr_, int fq_) const {
        const int lane_ = otid() & 63, fr = lane_ & 15, fq = lane_ >> 4; (void)fr_; (void)fq_;
        const int row0 = u.pm * BM + wr * 64 + fr, col0 = u.pn * BM + wc * 32 + 8 * fq;
#pragma unroll
        for (int ai = 0; ai < 2; ++ai)
#pragma unroll
            for (int m = 0; m < 4; ++m) { float* rp = O + (size_t)(row0 + ai * HALF + m * 16) * ldc + col0;
#pragma unroll
                for (int bj = 0; bj < 2; ++bj) { *(pg8::f32x4*)(rp + bj * HALF) = acc[ai][bj][m][0]; *(pg8::f32x4*)(rp + bj * HALF + 4) = acc[ai][bj][m][1]; } }
    }
};
struct EpiPart {
    static constexpr bool PERM = true, AFTER_DRAIN = false;
    float* P;
    __device__ __forceinline__ void operator()(const pg8::f32x4 (&acc)[2][2][4][2], const Unit& u, int wr, int wc, int fr_, int fq_) const {
        const int lane_ = otid() & 63, fr = lane_ & 15, fq = lane_ >> 4; (void)fr_; (void)fq_;
        const int row0 = wr * 64 + fr, col0 = u.pn * BM + wc * 32 + 8 * fq; float* base = P + (size_t)(u.ko >> 8) * 256 * 1024;
#pragma unroll
        for (int ai = 0; ai < 2; ++ai)
#pragma unroll
            for (int m = 0; m < 4; ++m) { float* rp = base + (size_t)(row0 + ai * HALF + m * 16) * 1024 + col0;
#pragma unroll
                for (int bj = 0; bj < 2; ++bj) { *(pg8::f32x4*)(rp + bj * HALF) = acc[ai][bj][m][0]; *(pg8::f32x4*)(rp + bj * HALF + 4) = acc[ai][bj][m][1]; } }
    }
};
struct SplitOrder {
    int nsplit, c;
    __device__ bool next(int i, Unit& u) const { if (i != 0 || c >= 4 * nsplit) return false; u.pm = 128; u.pn = c & 3; u.ko = (c >> 2) * 256; return true; }
    __device__ __forceinline__ void a_ready(const Unit&) const {}
    __device__ __forceinline__ void done(const Unit&) const {}
};
struct EpiGate {
    static constexpr bool PERM = true, AFTER_DRAIN = false;
    const bf16_t* XB; float* Xo; const bf16_t* T; int f32out;
    __device__ __forceinline__ void operator()(const pg8::f32x4 (&acc)[2][2][4][2], const Unit& u, int wr, int wc, int fr_, int fq_) const {
        const int lane_ = otid() & 63, fr = lane_ & 15, fq = lane_ >> 4; (void)fr_; (void)fq_;
        const int row0 = u.pm * BM + wr * 64 + fr, col0 = u.pn * BM + wc * 32 + 8 * fq;
#pragma unroll
        for (int ai = 0; ai < 2; ++ai)
#pragma unroll
            for (int m = 0; m < 4; ++m) { const int row = row0 + ai * HALF + m * 16; if (row >= MV) continue;
#pragma unroll
                for (int bj = 0; bj < 2; ++bj) { const size_t off = (size_t)row * DM + col0 + bj * HALF;
                    const u32x4 t = *(const u32x4*)(T + off); const u32x4 xb = *(const u32x4*)(XB + off);
                    pg8::f32x4 x0 = {bflo(xb.x), bfhi(xb.x), bflo(xb.y), bfhi(xb.y)}, x1 = {bflo(xb.z), bfhi(xb.z), bflo(xb.w), bfhi(xb.w)};
                    const pg8::f32x4 a0 = acc[ai][bj][m][0], a1 = acc[ai][bj][m][1];
                    { const f32x2 s0 = sigm2((f32x2){a0[0], a0[1]}), s1 = sigm2((f32x2){a0[2], a0[3]}), s2 = sigm2((f32x2){a1[0], a1[1]}), s3 = sigm2((f32x2){a1[2], a1[3]});
                      x0[0] += s0.x * bflo(t.x); x0[1] += s0.y * bfhi(t.x); x0[2] += s1.x * bflo(t.y); x0[3] += s1.y * bfhi(t.y);
                      x1[0] += s2.x * bflo(t.z); x1[1] += s2.y * bfhi(t.z); x1[2] += s3.x * bflo(t.w); x1[3] += s3.y * bfhi(t.w); }
                    if (f32out) { *(pg8::f32x4*)(Xo + off) = x0; *(pg8::f32x4*)(Xo + off + 4) = x1; }
                    else { u32x4 w; w.x = pk2(x0[0], x0[1]); w.y = pk2(x0[2], x0[3]); w.z = pk2(x1[0], x1[1]); w.w = pk2(x1[2], x1[3]); *(u32x4*)((bf16_t*)Xo + off) = w; } } }
    }
};

__device__ __forceinline__ void cvt_wt(const float* __restrict__ W, bf16_t* __restrict__ Wt, int K, int N, int Npad, float* tile  ) {
    const int tid = otid(), ntn = Npad / 64, nt = ntn * (K / 64);
    for (int t = blockIdx.x; t < nt; t += gridDim.x) {
        const int n0 = (t % ntn) * 64, k0 = (t / ntn) * 64;
#pragma unroll
        for (int i = 0; i < 2; ++i) { const int kk = (tid >> 4) + 32 * i, n4 = (tid & 15) * 4;
            f32x4 v = {0.f, 0.f, 0.f, 0.f}; if (n0 + n4 < N) v = *(const f32x4*)(W + (size_t)(k0 + kk) * N + n0 + n4);
            tile[kk * 65 + n4] = v[0]; tile[kk * 65 + n4 + 1] = v[1]; tile[kk * 65 + n4 + 2] = v[2]; tile[kk * 65 + n4 + 3] = v[3]; }
        __syncthreads();
        { const int nn = tid >> 3, k8 = (tid & 7) * 8; u32x4 w;
          w.x = pk2(tile[(k8 + 0) * 65 + nn], tile[(k8 + 1) * 65 + nn]); w.y = pk2(tile[(k8 + 2) * 65 + nn], tile[(k8 + 3) * 65 + nn]);
          w.z = pk2(tile[(k8 + 4) * 65 + nn], tile[(k8 + 5) * 65 + nn]); w.w = pk2(tile[(k8 + 6) * 65 + nn], tile[(k8 + 7) * 65 + nn]);
          *(u32x4*)(Wt + (size_t)(n0 + nn) * K + k0 + k8) = w; }
        __syncthreads();
    }
}
__device__ __forceinline__ void prologue(const Args& a, float* tile) {
    unsigned char* ws = a.p->ws;
    for (int j = 0; j < 2; ++j) {
        cvt_wt(a.p->in[9] + (size_t)j * 1024 * 6144, (bf16_t*)(ws + WS_WGIN) + (size_t)j * 6144 * 1024, 1024, 6144, 6144, tile);
        cvt_wt(a.p->in[14] + (size_t)j * 2048 * 1024, (bf16_t*)(ws + WS_WGOUT) + (size_t)j * 1024 * 2048, 2048, 1024, 1024, tile);
        cvt_wt(a.p->in[15] + (size_t)j * 1024 * 8208, (bf16_t*)(ws + WS_WFIN) + (size_t)j * NFIN * 1024, 1024, 8208, NFIN, tile);
        cvt_wt(a.p->in[17] + (size_t)j * 2048 * 1024, (bf16_t*)(ws + WS_WFOUT) + (size_t)j * 1024 * 2048, 2048, 1024, 1024, tile);
    }
    for (int i = 0; i < 4; ++i) {
        cvt_wt(a.p->in[18] + (size_t)i * 256 * 1024, (bf16_t*)(ws + WS_WPP) + (size_t)i * 1024 * 256, 256, 1024, 1024, tile);
        cvt_wt(a.p->in[19] + (size_t)i * 1024 * 1024, (bf16_t*)(ws + WS_WPG) + (size_t)i * 1024 * 1024, 1024, 1024, 1024, tile);
    }
    const float* wsrc = a.p->in[12]; bf16_t* wm = (bf16_t*)(ws + WS_WM); bf16_t* wms = (bf16_t*)(ws + WS_WMS);
    for (int idx = blockIdx.x * 512 + otid(); idx < 2 * 16 * 128 * 128; idx += gridDim.x * 512) {
        const int jj = idx & 127, i = (idx >> 7) & 127, lg = idx >> 14;
        const float w = wsrc[idx]; wm[idx] = (bf16_t)f2bf((jj >> 6) <= (i >> 6) ? w : 0.f);
        const float w2 = wsrc[((size_t)lg * 128 + (i & 15)) * 128 + (jj & 15)]; wms[idx] = (bf16_t)f2bf((i >> 4) == (jj >> 4) ? w2 : 0.f);
    }
}

__device__ __forceinline__ void phase_e1(const Args& a, int layer) {
    const int tid = otid(), lane = tid & 63, gw = blockIdx.x * 8 + (tid >> 6), nw = gridDim.x * 8;
    float* X = a.p->out; bf16_t* X16 = (bf16_t*)a.p->out; bf16_t* HX = (bf16_t*)(a.p->ws + WS_HX); bf16_t* PB = (bf16_t*)(a.p->ws + WS_PB);
    const float* g = a.p->in[7] + (layer & 3) * DM;
    f32x4 gv[4];
#pragma unroll
    for (int q = 0; q < 4; ++q) gv[q] = *(const f32x4*)(g + q * 256 + lane * 4);
#define E1_LOAD(v, r) do { if (layer == 0) { _Pragma("unroll") for (int q = 0; q < 4; ++q) v[q] = *(const f32x4*)(a.p->in[0] + (size_t)(r) * DM + q * 256 + lane * 4); } \
        else { _Pragma("unroll") for (int q = 0; q < 4; ++q) { const u32x2 xb = *(const u32x2*)(X16 + (size_t)(r) * DM + q * 256 + lane * 4); v[q] = (f32x4){bflo(xb.x), bfhi(xb.x), bflo(xb.y), bfhi(xb.y)}; } } } while (0)
#define E1_FIN(v, r, p) do { float ss = 0.f; _Pragma("unroll") for (int q = 0; q < 4; ++q) ss += v[q][0] * v[q][0] + v[q][1] * v[q][1] + v[q][2] * v[q][2] + v[q][3] * v[q][3]; \
        ss = wave_sum(ss); const float rr = rsqrtf(ss * (1.f / DM) + RMS_EPS); \
        _Pragma("unroll") for (int q = 0; q < 4; ++q) { u32x2 hw; hw.x = pk2(v[q][0] * rr * gv[q][0], v[q][1] * rr * gv[q][1]); hw.y = pk2(v[q][2] * rr * gv[q][2], v[q][3] * rr * gv[q][3]); \
            *(u32x2*)(HX + (size_t)(r) * DM + q * 256 + lane * 4) = hw; } \
        u32x2 pw; pw.x = pk2(p[0], p[1]); pw.y = pk2(p[2], p[3]); *(u32x2*)(PB + (size_t)(r) * 256 + lane * 4) = pw; } while (0)
    if (layer < 4) {
        const float* pp = a.p->in[5] + (size_t)layer * MP * 256;
        for (int row = gw; row < MP; row += 2 * nw) {
            const int r1 = row + nw; const bool has1 = r1 < MP;
            f32x4 v0[4], v1[4]; f32x4 p0, p1 = {0.f, 0.f, 0.f, 0.f};
            E1_LOAD(v0, row); p0 = *(const f32x4*)(pp + (size_t)row * 256 + lane * 4);
            if (has1) { E1_LOAD(v1, r1); p1 = *(const f32x4*)(pp + (size_t)r1 * 256 + lane * 4); }
            E1_FIN(v0, row, p0);
            if (has1) E1_FIN(v1, r1, p1);
        }
    }
    for (int row = MP + gw; row < (layer == 4 ? MV : MA); row += nw) {
        if (row < MV) {
            f32x4 v[4];
            if (layer > 0) {
                const bf16_t* TBp = (const bf16_t*)(a.p->ws + WS_TB);
#pragma unroll
                for (int q = 0; q < 4; ++q) { const size_t off = (size_t)row * DM + q * 256 + lane * 4; const float* pq = (const float*)(a.p->ws + WS_PART) + (size_t)(row - MP) * 1024 + q * 256 + lane * 4;
                    f32x4 g4 = *(const f32x4*)pq;
#pragma unroll
                    for (int ks = 1; ks < 4; ++ks) g4 += *(const f32x4*)(pq + (size_t)ks * 256 * 1024);
                    const u32x2 xb = *(const u32x2*)(HX + off), tb = *(const u32x2*)(TBp + off);
                    v[q] = (f32x4){bflo(xb.x) + sigm_f(g4[0]) * bflo(tb.x), bfhi(xb.x) + sigm_f(g4[1]) * bfhi(tb.x), bflo(xb.y) + sigm_f(g4[2]) * bflo(tb.y), bfhi(xb.y) + sigm_f(g4[3]) * bfhi(tb.y)};
                    if (layer == 4) *(f32x4*)(X + off) = v[q]; else { u32x2 w; w.x = pk2(v[q][0], v[q][1]); w.y = pk2(v[q][2], v[q][3]); *(u32x2*)(X16 + off) = w; } }
                if (layer == 4) continue;
            } else {
#pragma unroll
                for (int q = 0; q < 4; ++q) v[q] = *(const f32x4*)(a.p->in[1] + (size_t)(row - MP) * DM + q * 256 + lane * 4);
            }
            const f32x4 p = *(const f32x4*)(a.p->in[6] + ((size_t)layer * MS + (row - MP)) * 256 + lane * 4);
            E1_FIN(v, row, p);
        } else {
#pragma unroll
            for (int q = 0; q < 4; ++q) *(u32x2*)(HX + (size_t)row * DM + q * 256 + lane * 4) = (u32x2){0u, 0u};
            *(u32x2*)(PB + (size_t)row * 256 + lane * 4) = (u32x2){0u, 0u};
        }
    }
#undef E1_LOAD
#undef E1_FIN
}
__device__ __forceinline__ void phase_e3(const Args& a, int layer, bool dummy = false) {
    const int tid = otid(), lane = tid & 63, gw = blockIdx.x * 8 + (tid >> 6), nw = gridDim.x * 8;
    const bf16_t* X16 = (const bf16_t*)a.p->out; bf16_t* HX = (bf16_t*)(a.p->ws + (dummy ? WS_DUMMY + 136 * MiB : WS_HX)); const bf16_t* OP = (const bf16_t*)(a.p->ws + WS_R0 + RSZ);
    const float* g = a.p->in[8] + layer * DM;
    f32x4 gv[4];
#pragma unroll
    for (int q = 0; q < 4; ++q) gv[q] = *(const f32x4*)(g + q * 256 + lane * 4);
#define E3_LOADX(XX, r, src0) do { if (layer == 0) { _Pragma("unroll") for (int q = 0; q < 4; ++q) XX[q] = *(const f32x4*)((src0) + q * 256 + lane * 4); } \
        else { _Pragma("unroll") for (int q = 0; q < 4; ++q) { const u32x2 xb = *(const u32x2*)(X16 + (size_t)(r) * DM + q * 256 + lane * 4); XX[q] = (f32x4){bflo(xb.x), bfhi(xb.x), bflo(xb.y), bfhi(xb.y)}; } } } while (0)
#define E3_FIN(v, XX, r) do { float ss = 0.f; _Pragma("unroll") for (int q = 0; q < 4; ++q) ss += v[q][0] * v[q][0] + v[q][1] * v[q][1] + v[q][2] * v[q][2] + v[q][3] * v[q][3]; \
        ss = wave_sum(ss); const float rr = rsqrtf(ss * (1.f / DM) + RMS_EPS); \
        _Pragma("unroll") for (int q = 0; q < 4; ++q) { u32x2 hw; hw.x = pk2(XX[q][0] + v[q][0] * rr * gv[q][0], XX[q][1] + v[q][1] * rr * gv[q][1]); hw.y = pk2(XX[q][2] + v[q][2] * rr * gv[q][2], XX[q][3] + v[q][3] * rr * gv[q][3]); \
            *(u32x2*)(HX + (size_t)(r) * DM + q * 256 + lane * 4) = hw; } } while (0)
#define E3_LOADOP(v, r) do { _Pragma("unroll") for (int q = 0; q < 4; ++q) { const u32x2 ob = *(const u32x2*)(OP + (size_t)(r) * DM + q * 256 + lane * 4); v[q] = (f32x4){bflo(ob.x), bfhi(ob.x), bflo(ob.y), bfhi(ob.y)}; } } while (0)
    for (int row = gw; row < MP; row += 2 * nw) {
        const int r1 = row + nw; const bool has1 = r1 < MP;
        f32x4 v0[4], x0[4], v1[4], x1[4];
        E3_LOADOP(v0, row); E3_LOADX(x0, row, a.p->in[0] + (size_t)row * DM);
        if (has1) { E3_LOADOP(v1, r1); E3_LOADX(x1, r1, a.p->in[0] + (size_t)r1 * DM); }
        E3_FIN(v0, x0, row);
        if (has1) E3_FIN(v1, x1, r1);
    }
    for (int row = MP + gw; row < MA; row += nw) {
        if (row < MV) {
            f32x4 v[4], x[4];
#pragma unroll
            for (int q = 0; q < 4; ++q) { const float* pq = (const float*)(a.p->ws + WS_PART) + (size_t)(row - MP) * 1024 + q * 256 + lane * 4; v[q] = *(const f32x4*)pq;
#pragma unroll
                for (int ks = 1; ks < 8; ++ks) v[q] += *(const f32x4*)(pq + (size_t)ks * 256 * 1024); }
            E3_LOADX(x, row, a.p->in[1] + (size_t)(row - MP) * DM);
            E3_FIN(v, x, row);
        } else {
#pragma unroll
            for (int q = 0; q < 4; ++q) *(u32x2*)(HX + (size_t)row * DM + q * 256 + lane * 4) = (u32x2){0u, 0u};
        }
    }
#undef E3_LOADX
#undef E3_FIN
#undef E3_LOADOP
}

__device__ __forceinline__ void phase_s1(const Args& a, int j, unsigned char* lds, bool dummy = false) {
    constexpr int LP = 136;
    bf16_t* As = (bf16_t*)lds; bf16_t* Bs = As + 128 * LP; float* fl = (float*)(Bs + 128 * LP);
    float* mu = fl, * rs = fl + 128, * t1 = fl + 256, * t2 = fl + 384;
    const int tid = otid(), lane = tid & 63, wid = tid >> 6, fr = lane & 15, fq = lane >> 4;
    const bf16_t* U = (const bf16_t*)(a.p->ws + WS_R0); bf16_t* Uo = (bf16_t*)(a.p->ws + (dummy ? WS_DUMMY : WS_R0)); const bf16_t* VT = (const bf16_t*)(a.p->ws + WS_R0 + RSZ); const bf16_t* ZS = (const bf16_t*)(a.p->ws + WS_R0 + 2 * RSZ);
    const float* stat = (const float*)(a.p->ws + WS_STAT);
    const float* lng = a.p->in[10] + j * EB; const float* lnb = a.p->in[11] + j * EB; const float* bsv = a.p->in[13] + j * 16 * 128;
    float* gvs = a.p->out + O_GV + (size_t)j * MS * EB;
    constexpr int NU = 257 * 16;
    const int G_ = gridDim.x, w_ = blockIdx.x;
#define S1_UNIT(k) ((G_ == 256) ? ((k) < 16 ? w_ * 16 + (((k) + w_) & 15) :     ((k) == 16 && w_ < 16 ? 4096 + w_ : NU)) : (w_ + (k) * G_))
#define S1_LOAD_AB(u_) do { const int blk_ = (u_) >> 4, g_ = (u_) & 15; \
        const bf16_t* wsrc_ = (const bf16_t*)(a.p->ws + (blk_ == 256 ? WS_WMS : WS_WM)) + ((size_t)(j * 16 + g_) * 128) * 128; const bf16_t* vsrc_ = VT + ((size_t)blk_ * 2048 + g_ * 128) * 128; \
        _Pragma("unroll") for (int q = 0; q < 4; ++q) { ar[q] = *(const u32x4*)(wsrc_ + (tid >> 2) * 128 + (tid & 3) * 32 + q * 8); br[q] = *(const u32x4*)(vsrc_ + (tid >> 2) * 128 + (tid & 3) * 32 + q * 8); } } while (0)
    int un = S1_UNIT(0);
    if (un >= NU) return;
    u32x4 ar[4], br[4];
    S1_LOAD_AB(un);
    int prev_blk = -1;
    for (int k = 0;; ++k) {
        const int blk = un >> 4, g = un & 15, issamp = blk == 256;
        if (blk != prev_blk) {
          { const int r_ = tid >> 2, p_ = tid & 3; const float* sp = stat + (size_t)(blk * 128 + r_) * 64 + p_ * 8;
          const f32x4 s0 = *(const f32x4*)sp, s1 = *(const f32x4*)(sp + 4), q0 = *(const f32x4*)(sp + 32), q1 = *(const f32x4*)(sp + 36);
          float s = ((s0[0] + s0[1]) + (s0[2] + s0[3])) + ((s1[0] + s1[1]) + (s1[2] + s1[3])), q = ((q0[0] + q0[1]) + (q0[2] + q0[3])) + ((q1[0] + q1[1]) + (q1[2] + q1[3]));
          s += __shfl_xor(s, 1); s += __shfl_xor(s, 2); q += __shfl_xor(q, 1); q += __shfl_xor(q, 2);
          if (p_ == 0) { const float m = s * (1.f / EB); const float var = fmaxf(q * (1.f / EB) - m * m, 0.f); mu[r_] = m; rs[r_] = rsqrtf(var + LN_EPS); } }
          __syncthreads(); prev_blk = blk;
        }
        { const int i = tid >> 2, part = tid & 3; float a1 = 0.f, a2 = 0.f;
#pragma unroll
          for (int q = 0; q < 4; ++q) { const int j0 = part * 32 + q * 8; const u32x4 w = ar[q]; const unsigned ww[4] = {w.x, w.y, w.z, w.w}; float o[8];
#pragma unroll
              for (int e = 0; e < 4; ++e) { const float w0 = bflo(ww[e]), w1 = bfhi(ww[e]); const float r0 = rs[j0 + 2 * e], r1 = rs[j0 + 2 * e + 1];
                  o[2 * e] = w0 * r0; o[2 * e + 1] = w1 * r1; a1 += w0 * r0 * mu[j0 + 2 * e] + w1 * r1 * mu[j0 + 2 * e + 1]; a2 += w0 + w1; }
              u32x4 ow; ow.x = pk2(o[0], o[1]); ow.y = pk2(o[2], o[3]); ow.z = pk2(o[4], o[5]); ow.w = pk2(o[6], o[7]);
              *(u32x4*)(As + i * LP + j0) = ow; *(u32x4*)(Bs + i * LP + j0) = br[q]; }
          a1 += __shfl_xor(a1, 1); a1 += __shfl_xor(a1, 2); a2 += __shfl_xor(a2, 1); a2 += __shfl_xor(a2, 2);
          if (part == 0) { t1[i] = a1; t2[i] = a2; }
        }
        __syncthreads();
        const int un_next = S1_UNIT(k + 1); const bool has_next = un_next < NU;
        if (has_next) S1_LOAD_AB(un_next);
        const int i0 = (wid >> 1) * 32, c0 = (wid & 1) * 64;
        f32x4 acc[2][4];
#pragma unroll
        for (int mt = 0; mt < 2; ++mt)
#pragma unroll
            for (int nt = 0; nt < 4; ++nt) acc[mt][nt] = (f32x4){0.f, 0.f, 0.f, 0.f};
#pragma unroll
        for (int kk = 0; kk < 4; ++kk) {
            bf16x8 af[2], bfr[4];
#pragma unroll
            for (int mt = 0; mt < 2; ++mt) af[mt] = *(const bf16x8*)(As + (i0 + mt * 16 + fr) * LP + kk * 32 + fq * 8);
#pragma unroll
            for (int nt = 0; nt < 4; ++nt) bfr[nt] = *(const bf16x8*)(Bs + (c0 + nt * 16 + fr) * LP + kk * 32 + fq * 8);
#pragma unroll
            for (int mt = 0; mt < 2; ++mt)
#pragma unroll
                for (int nt = 0; nt < 4; ++nt) acc[mt][nt] = __builtin_amdgcn_mfma_f32_16x16x32_bf16(bfr[nt], af[mt], acc[mt][nt], 0, 0, 0);
        }
        const int ei = tid >> 2, ec = (tid & 3) * 32; const size_t erow = (size_t)blk * 128 + ei;
        u32x4 uu[4], zz[4];
#pragma unroll
        for (int q = 0; q < 4; ++q) { uu[q] = *(const u32x4*)(U + erow * EB + g * 128 + ec + q * 8); zz[q] = *(const u32x4*)(ZS + erow * EB + g * 128 + ec + q * 8); }
        if (issamp) {
            for (int idx = tid; idx < 128 * 128; idx += 512) { const int c = idx & 127, i = idx >> 7; const float v = __uint_as_float((unsigned)Bs[c * LP + i] << 16);
                gvs[(size_t)i * EB + g * 128 + c] = (v - mu[i]) * rs[i] * lng[g * 128 + c] + lnb[g * 128 + c]; }
        }
        __syncthreads();
        float* S32 = (float*)lds; constexpr int SP = 132;
#pragma unroll
        for (int mt = 0; mt < 2; ++mt)
#pragma unroll
            for (int nt = 0; nt < 4; ++nt) *(f32x4*)(S32 + (i0 + mt * 16 + fr) * SP + c0 + nt * 16 + fq * 4) = acc[mt][nt];
        __syncthreads();
        { const float t1i = t1[ei], t2i = t2[ei], bi = bsv[g * 128 + (issamp ? (ei & 15) : ei)];
#pragma unroll
          for (int q = 0; q < 4; ++q) { const int cg = g * 128 + ec + q * 8;
              const f32x4 sa = *(const f32x4*)(S32 + ei * SP + ec + q * 8), sb = *(const f32x4*)(S32 + ei * SP + ec + q * 8 + 4);
              const f32x4 lga = *(const f32x4*)(lng + cg), lgb = *(const f32x4*)(lng + cg + 4), lba = *(const f32x4*)(lnb + cg), lbb = *(const f32x4*)(lnb + cg + 4);
              float s[8];
#pragma unroll
              for (int e = 0; e < 4; ++e) { s[e] = lga[e] * (sa[e] - t1i) + lba[e] * t2i + bi; s[4 + e] = lgb[e] * (sb[e] - t1i) + lbb[e] * t2i + bi; }
              const unsigned u4[4] = {uu[q].x, uu[q].y, uu[q].z, uu[q].w}, z4[4] = {zz[q].x, zz[q].y, zz[q].z, zz[q].w}; unsigned y4[4];
#pragma unroll
              for (int e = 0; e < 4; ++e) y4[e] = pk2(bflo(u4[e]) * s[2 * e] * bflo(z4[e]), bfhi(u4[e]) * s[2 * e + 1] * bfhi(z4[e]));
              *(u32x4*)(Uo + erow * EB + cg) = (u32x4){y4[0], y4[1], y4[2], y4[3]}; } }
        __syncthreads();
        if (!has_next) break;
        un = un_next;
    }
#undef S1_UNIT
#undef S1_LOAD_AB
}

__device__ __forceinline__ void phase_c1(const Args& a, int j) {
    const int tid = otid(); if ((tid >> 6) != 0) return;
    const int lane = tid & 63;
    for (int sq = blockIdx.x; sq < 256; sq += gridDim.x) {
        if (sq < 128) {
            const int b = sq >> 4, h = sq & 15; const float* src = a.p->out + O_FLP + ((size_t)j * MP + (size_t)b * SEQ) * 16 + h; float* dst = (float*)(a.p->ws + WS_CBP) + (size_t)sq * SEQ;
            float tot = 0.f; for (int s = 0; s < 64; ++s) tot += src[(size_t)(lane * 64 + s) * 16];
            float inc = tot; for (int o = 1; o < 64; o <<= 1) { const float t = __shfl_up(inc, o); if (lane >= o) inc += t; }
            float run = inc - tot;
            for (int s = 0; s < 64; ++s) { run += src[(size_t)(lane * 64 + s) * 16];
                dst[lane * 64 + (((s >> 2) & 1) * 32 + ((s >> 3) & 3) * 4 + (s & 3) + 16 * (s >> 5))] = -run * 11.313708498984761f; }
        } else {
            const int bh = sq - 128, b = bh >> 4, h = bh & 15; const float* c0 = a.p->in[4] + ((size_t)(j * 8 + b) * PAST) * 16 + h; const float* c1 = a.p->out + O_FLS + ((size_t)j * MS + b * TS) * 16 + h;
            float* dst = (float*)(a.p->ws + WS_CBS) + (size_t)bh * SKS;
            float tot = 0.f; for (int s = 0; s < 33; ++s) { const int k = lane * 33 + s; const float v = k < PAST ? c0[(size_t)k * 16] : (k < PAST + TS ? c1[(size_t)(k - PAST) * 16] : 0.f); tot += v; }
            float inc = tot; for (int o = 1; o < 64; o <<= 1) { const float t = __shfl_up(inc, o); if (lane >= o) inc += t; }
            float run = inc - tot;
            for (int s = 0; s < 33; ++s) { const int k = lane * 33 + s; const float v = k < PAST ? c0[(size_t)k * 16] : (k < PAST + TS ? c1[(size_t)(k - PAST) * 16] : 0.f); run += v; dst[k] = -run; }
        }
    }
}

__device__ __forceinline__ void sample_attn(const Args& a, int j, int bh, unsigned char* ldsb, bool dummy = false) {
    constexpr int PP = 136;
    float* wmx = (float*)ldsb;
    bf16_t* Pb = (bf16_t*)(ldsb + 1024);
    float* lfin = (float*)(ldsb + 1024 + 2 * 16 * PP * 2);
    const int tid = otid(), lane = tid & 63, wid = __builtin_amdgcn_readfirstlane(tid >> 6), fr = lane & 15, fq = lane >> 4, b = bh >> 4, h = bh & 15;
    const bf16_t* Qb = (const bf16_t*)(a.p->ws + WS_R0); const bf16_t* ZS = (const bf16_t*)(a.p->ws + WS_R0 + 3 * RSZ); bf16_t* O = (bf16_t*)(a.p->ws + (dummy ? WS_DUMMY : WS_R0));
    const float* ck = a.p->in[2] + (size_t)(j * 8 + b) * PAST * EB + h * 128; const float* cv = a.p->in[3] + (size_t)(j * 8 + b) * PAST * EB + h * 128;
    const float* nk = a.p->out + O_FKS + ((size_t)j * MS + b * TS) * EB + h * 128; const float* nv = a.p->out + O_FVS + ((size_t)j * MS + b * TS) * EB + h * 128;
    const float* cb = (const float*)(a.p->ws + WS_CBS) + (size_t)bh * SKS;
    bf16x8 qf[4];
#pragma unroll
    for (int kk = 0; kk < 4; ++kk) qf[kk] = *(const bf16x8*)(Qb + (size_t)(MP + b * TS + fr) * EB + h * 128 + kk * 32 + fq * 8);
    const int kl = 16 * wid + fr;
    float m[4], ls[4]; f32x4 oacc = {0.f, 0.f, 0.f, 0.f};
#pragma unroll
    for (int r = 0; r < 4; ++r) { m[r] = -1e30f; ls[r] = 0.f; }
    f32x4 kr[8];
#pragma unroll
    for (int q = 0; q < 8; ++q) kr[q] = *(const f32x4*)(ck + (size_t)kl * EB + (q >> 1) * 32 + fq * 8 + (q & 1) * 4);
    int buf = 0;
    for (int c = 0; c < 17; ++c) {
        float vr[32];
        if (c < 16) {
#pragma unroll
            for (int q = 0; q < 32; ++q) vr[q] = cv[(size_t)(c * 128 + (q >> 3) * 32 + fq * 8 + (q & 7)) * EB + 16 * wid + fr];
        } else {
#pragma unroll
            for (int q = 0; q < 32; ++q) { const int key = (q >> 3) * 32 + fq * 8 + (q & 7); vr[q] = key < TS ? nv[(size_t)key * EB + 16 * wid + fr] : 0.f; }
        }
        const float bias = c < 16 ? cb[c * 128 + kl] : (kl < TS ? cb[PAST + kl] : 0.f);
        f32x4 sacc = {0.f, 0.f, 0.f, 0.f};
#pragma unroll
        for (int kk = 0; kk < 4; ++kk) { const f32x4 x0 = kr[2 * kk], x1 = kr[2 * kk + 1];
            u32x4 w; w.x = pk2(x0[0], x0[1]); w.y = pk2(x0[2], x0[3]); w.z = pk2(x1[0], x1[1]); w.w = pk2(x1[2], x1[3]);
            sacc = __builtin_amdgcn_mfma_f32_16x16x32_bf16(qf[kk], __builtin_bit_cast(bf16x8, w), sacc, 0, 0, 0); }
        if (c + 1 < 16) {
#pragma unroll
            for (int q = 0; q < 8; ++q) kr[q] = *(const f32x4*)(ck + (size_t)((c + 1) * 128 + kl) * EB + (q >> 1) * 32 + fq * 8 + (q & 1) * 4);
        } else if (c + 1 == 16) {
#pragma unroll
            for (int q = 0; q < 8; ++q) kr[q] = kl < TS ? *(const f32x4*)(nk + (size_t)kl * EB + (q >> 1) * 32 + fq * 8 + (q & 1) * 4) : (f32x4){0.f, 0.f, 0.f, 0.f};
        }
        float s[4], mw[4];
#pragma unroll
        for (int r = 0; r < 4; ++r) { s[r] = sacc[r] * att::SCALE + bias; if (c == 16 && (kl >= TS || kl > 4 * fq + r)) s[r] = -__builtin_inff(); mw[r] = s[r]; }
#pragma unroll
        for (int o = 1; o < 16; o <<= 1) {
#pragma unroll
            for (int r = 0; r < 4; ++r) mw[r] = fmaxf(mw[r], __shfl_xor(mw[r], o)); }
        if (fr == 0) {
#pragma unroll
            for (int r = 0; r < 4; ++r) wmx[buf * 128 + (4 * fq + r) * 8 + wid] = mw[r]; }
        __syncthreads();
        float p[4];
#pragma unroll
        for (int r = 0; r < 4; ++r) { const f32x4 w0 = *(const f32x4*)(wmx + buf * 128 + (4 * fq + r) * 8), w1 = *(const f32x4*)(wmx + buf * 128 + (4 * fq + r) * 8 + 4);
            const float mc = fmaxf(fmaxf(fmaxf(w0[0], w0[1]), fmaxf(w0[2], w0[3])), fmaxf(fmaxf(w1[0], w1[1]), fmaxf(w1[2], w1[3])));
            const float mn = fmaxf(m[r], mc), al = __expf(m[r] - mn); m[r] = mn; p[r] = __expf(s[r] - mn); ls[r] = ls[r] * al + p[r]; oacc[r] *= al;
            Pb[buf * 16 * PP + (4 * fq + r) * PP + kl] = (bf16_t)f2bf(p[r]); }
        __syncthreads();
#pragma unroll
        for (int kk = 0; kk < 4; ++kk) { const bf16x8 pa = *(const bf16x8*)(Pb + buf * 16 * PP + fr * PP + kk * 32 + fq * 8);
            u32x4 w; w.x = pk2(vr[kk * 8 + 0], vr[kk * 8 + 1]); w.y = pk2(vr[kk * 8 + 2], vr[kk * 8 + 3]); w.z = pk2(vr[kk * 8 + 4], vr[kk * 8 + 5]); w.w = pk2(vr[kk * 8 + 6], vr[kk * 8 + 7]);
            oacc = __builtin_amdgcn_mfma_f32_16x16x32_bf16(pa, __builtin_bit_cast(bf16x8, w), oacc, 0, 0, 0); }
        buf ^= 1;
    }
#pragma unroll
    for (int o = 1; o < 16; o <<= 1) {
#pragma unroll
        for (int r = 0; r < 4; ++r) ls[r] += __shfl_xor(ls[r], o); }
    if (fr == 0) {
#pragma unroll
        for (int r = 0; r < 4; ++r) lfin[wid * 16 + 4 * fq + r] = ls[r]; }
    __syncthreads();
#pragma unroll
    for (int r = 0; r < 4; ++r) { const int i = 4 * fq + r; float l = 0.f;
#pragma unroll
        for (int w = 0; w < 8; ++w) l += lfin[w * 16 + i];
        const size_t off = (size_t)(MP + b * TS + i) * EB + h * 128 + 16 * wid + fr;
        const float z = __uint_as_float((unsigned)ZS[off] << 16); O[off] = (bf16_t)f2bf(oacc[r] / l * z); }
    __syncthreads();
}

__device__ __forceinline__ void phase_attn(const Args& a, int j, unsigned char* ldsb, int mode = 0) {
    using namespace att;
    typedef __hip_bfloat16 T;
    const T* Q = (const T*)(a.p->ws + WS_R0); const T* K = (const T*)(a.p->ws + WS_R0 + RSZ); const T* V = (const T*)(a.p->ws + WS_R0 + 2 * RSZ); const T* Z = (const T*)(a.p->ws + WS_R0 + 3 * RSZ); T* O = (T*)(a.p->ws + (mode == 1 ? WS_DUMMY : WS_R0));
    const float* CB = (const float*)(a.p->ws + WS_CBP);
    char* lds = (char*)ldsb;
    constexpr int nqb = SEQ / QB, nx = nqb / 2, total = nx * NBH;
    const int stride = gridDim.x;
    int L = (gridDim.x == 256) ? (int)((blockIdx.x & 7) * 32 + (blockIdx.x >> 3)) : (int)blockIdx.x;
    if (mode == 2) L = total;
    if (L < total) {
#define MKREF(r, L_, pass_) do { const int bh_ = (L_) / nx, x_ = (L_) - bh_ * nx, qb_ = (pass_) ? x_ : nqb - 1 - x_,     b_ = bh_ >> 4, h_ = bh_ & 15; \
        const size_t ro_ = ((size_t)b_ * SEQ + (size_t)qb_ * QB) * PITCH + h_ * 128, ko_ = ((size_t)b_ * SEQ) * PITCH + h_ * 128; \
        (r).Q = Q + ro_; (r).O = O + ro_; (r).Z = Z + ro_; (r).K = K + ko_; (r).V = V + ko_; (r).CB = CB + (size_t)bh_ * SEQ; (r).P0 = qb_ * QB; } while (0)
        BlockRef<T, T> cur, nxt; int pass = 0;
        MKREF(cur, L, 0);
        Seam<T> S;
        causal_swa_prime<T, T>(cur, SEQ, lds, S);
        for (;;) {
            const bool more_pass = pass == 0, more_item = L + stride < total, last = !more_pass && !more_item;
            int passn = pass + 1, Ln = L;
            if (!more_pass) { passn = 0; Ln = more_item ? L + stride : L; }
            if (last) nxt = cur; else MKREF(nxt, Ln, passn);
            causal_swa_block<T, T>(cur, nxt, SEQ, SEQ, lds, S);
            if (last) break;
            cur = nxt; pass = passn; L = Ln;
        }
#undef MKREF
    }
    __syncthreads();
    if (mode != 1) for (int bh = (int)gridDim.x - 1 - (int)blockIdx.x; bh < NBH; bh += gridDim.x) sample_attn(a, j, bh, ldsb, mode == 2);
}

#define XB_TMO      128
#define XB_XCNT(j)  (256  + 64 * (j))
#define XB_XSUB(j)  (1280 + 64 * (j))
#define XB_XGEN(j)  (2304 + 64 * (j))
#define XB_TOP      3328
#define XB_TOPGEN   3392
#define XCD_BAR_WORDS 3456
#define XB_SPIN_CAP (1u << 18)

__device__ __forceinline__ unsigned xb_ld(unsigned* p)              { return __hip_atomic_load(p, __ATOMIC_RELAXED, __HIP_MEMORY_SCOPE_AGENT); }
__device__ __forceinline__ unsigned xb_add(unsigned* p, unsigned v) { return __hip_atomic_fetch_add(p, v, __ATOMIC_RELAXED, __HIP_MEMORY_SCOPE_AGENT); }
__device__ __forceinline__ unsigned xb_xcc_id() { return (unsigned)__builtin_amdgcn_s_getreg((3 << 11) | 20) & 0xFu; }
#define XB_SPIN(cond, bar) do { unsigned _sp = 0; while (cond) { __builtin_amdgcn_s_sleep(1); \
    if ((++_sp & 255u) == 0u) { if (xb_ld(&(bar)[XB_TMO])) break; if (_sp > XB_SPIN_CAP) { atomicAdd(&(bar)[XB_TMO], 1u); break; } } } } while (0)

struct XcdBarrier {
    unsigned* bar; unsigned x;
    volatile LAS unsigned* st;
};

__device__ __forceinline__ XcdBarrier xcd_barrier_post(unsigned* bar, volatile LAS unsigned* st) {
    XcdBarrier b; b.bar = bar; b.x = xb_xcc_id(); b.st = st;
    if (otid() == 0) (void)xb_add(&bar[XB_XCNT(b.x)], 1u);
    return b;
}
__device__ __forceinline__ void xcd_barrier_complete(unsigned* bar, unsigned x, unsigned& nloc, unsigned& nx) {
    const unsigned G = gridDim.x * gridDim.y * gridDim.z;
    unsigned sum, cnt, mine, sp = 0u;
    for (;;) {
        sum = 0u; cnt = 0u; mine = 0u;
#pragma unroll
        for (unsigned j = 0; j < 16; ++j) { const unsigned c = xb_ld(&bar[XB_XCNT(j)]); sum += c; cnt += (c > 0u) ? 1u : 0u; mine = (j == x) ? c : mine; }
        if (sum == G) break;
        __builtin_amdgcn_s_sleep(1);
        if ((++sp & 255u) == 0u) { if (xb_ld(&bar[XB_TMO])) break; if (sp > XB_SPIN_CAP) { atomicAdd(&bar[XB_TMO], 1u); break; } }
    }
    nloc = mine > 0u ? mine : 1u; nx = cnt > 0u ? cnt : 1u;
}

__device__ __forceinline__ void xcd_barrier(const XcdBarrier& b) {
    asm volatile("s_waitcnt vmcnt(0)" ::: "memory");
    __syncthreads();
    if (otid() == 0) {
        unsigned* bar = b.bar;
        __builtin_amdgcn_s_waitcnt(0);
        unsigned nloc = b.st[0], nx = b.st[1];
        if (nloc == 0u) { xcd_barrier_complete(bar, b.x, nloc, nx); b.st[0] = nloc; b.st[1] = nx; }
        const unsigned old = xb_add(&bar[XB_XSUB(b.x)], 1u);
        const unsigned gen = old / nloc;
        if (old + 1u == (gen + 1u) * nloc) {
            __builtin_amdgcn_fence(__ATOMIC_RELEASE, "agent");
            asm volatile("s_waitcnt vmcnt(0)" ::: "memory");
            const unsigned og = xb_add(&bar[XB_TOP], 1u);
            const unsigned tg = og / nx;
            if (og + 1u == (tg + 1u) * nx) xb_add(&bar[XB_TOPGEN], 1u);
            else XB_SPIN(xb_ld(&bar[XB_TOPGEN]) == tg, bar);
            __builtin_amdgcn_fence(__ATOMIC_ACQUIRE, "agent");
            xb_add(&bar[XB_XGEN(b.x)], 1u);
            asm volatile("s_waitcnt vmcnt(0)" ::: "memory");
        } else {
            XB_SPIN(xb_ld(&bar[XB_XGEN(b.x)]) == gen, bar);
            __builtin_amdgcn_fence(__ATOMIC_ACQUIRE, "agent");
            asm volatile("s_waitcnt vmcnt(0)" ::: "memory");
        }
    }
    __syncthreads();
}
#define WSPTRS() const Args a = getargs(); unsigned char* ws = a.p->ws; (void)ws; \
    bf16_t* HX = (bf16_t*)(ws + WS_HX); bf16_t* TB = (bf16_t*)(ws + WS_TB); bf16_t* PB = (bf16_t*)(ws + WS_PB); (void)HX; (void)TB; (void)PB; \
    bf16_t* R0 = (bf16_t*)(ws + WS_R0); bf16_t* R1 = (bf16_t*)(ws + WS_R0 + RSZ); bf16_t* R2 = (bf16_t*)(ws + WS_R0 + 2 * RSZ); bf16_t* R3 = (bf16_t*)(ws + WS_R0 + 3 * RSZ); (void)R0; (void)R1; (void)R2; (void)R3;
#define XBAR_MK() XcdBarrier xb_; xb_.bar = (unsigned*)(getargs().p->ws) + 1024; xb_.x = xb_xcc_id(); xb_.st = (volatile LAS unsigned*)((LAS unsigned char*)lds + (LDS_BYTES - 64))
#if PROBE_DUP == 7
#define GSYNC() do { XBAR_MK(); xcd_barrier(xb_); xcd_barrier(xb_); } while (0)
#else
#define GSYNC() do { XBAR_MK(); xcd_barrier(xb_); } while (0)
#endif
__global__ void __launch_bounds__(512, 2) fwd_megakernel(ArgsS args_unused) {
    extern __shared__ __attribute__((aligned(16))) unsigned char lds[];
    cg::grid_group grid = cg::this_grid();
    PG8_LAS unsigned char* gl = (PG8_LAS unsigned char*)lds;
    const int G = gridDim.x, c = blockIdx.x;
    { const unsigned hw = (unsigned)__builtin_amdgcn_s_getreg((5 << 11) | 4) & 63u;
      if ((threadIdx.x & 63) == 0) ((LAS int*)((LAS unsigned char*)lds + LDS_WIDTAB))[hw] = (int)(threadIdx.x >> 6);
      if (threadIdx.x < 16) ((LAS unsigned*)((LAS unsigned char*)lds + (LDS_BYTES - 64)))[threadIdx.x] = 0u; }
    __syncthreads();
    { XBAR_MK(); (void)xcd_barrier_post(xb_.bar, xb_.st); }
#ifndef SKIP_PRO
    { const Args a = getargs(); prologue(a, (float*)lds); }
#endif
    { const Args a = getargs(); if (a.p->ws == nullptr) grid.sync(); }
    GSYNC();
    for (int layer = 0; layer < 4; ++layer) {
        const int j = layer >> 1;
#ifndef SKIP_E1
        for (int rp_ = (PROBE_DUP == 4 ? 0 : 1); rp_ < 2; ++rp_) { const Args a = getargs(); phase_e1(a, layer); if (!rp_) GSYNC(); }
#endif
        GSYNC();
        if ((layer & 1) == 0) {
#ifndef SKIP_G1G
            { WSPTRS(); pg8::Gemm g{HX, (const bf16_t*)(ws + WS_WGIN) + (size_t)j * 6144 * 1024, MA, 6144, 1024}; pg8::StaticOrder S; S.init(MA, 6144, G, c);
              EpiGmlpIn E{R0, R1, R2, (float*)(ws + WS_STAT)};
              for (int rp_ = 0; rp_ < (PROBE_DUP == 5 ? 2 : 1); ++rp_) pg8::gemm_phase<EpiGmlpIn, pg8::StaticOrder, true, true>(gl, g, S, E); }
#endif
        } else {
#ifndef SKIP_G1F
            { WSPTRS(); pg8::Gemm g{HX, (const bf16_t*)(ws + WS_WFIN) + (size_t)j * NFIN * 1024, MA, NFIN, 1024}; pg8::StaticOrder S; S.init(MA, NFIN, G, c);
              float* out = a.p->out;
              EpiFoxIn E{R0, R1, R2, R3, out + O_FKP + (size_t)j * MP * EB, out + O_FVP + (size_t)j * MP * EB, out + O_FLP + (size_t)j * MP * 16,
                         out + O_FKS + (size_t)j * MS * EB, out + O_FVS + (size_t)j * MS * EB, out + O_FLS + (size_t)j * MS * 16, a.p->in[16] + j * 16};
              for (int rp_ = 0; rp_ < (PROBE_DUP == 5 ? 2 : 1); ++rp_) pg8::gemm_phase<EpiFoxIn, pg8::StaticOrder, true, true>(gl, g, S, E); }
#endif
        }
#ifndef SKIP_GT
        { WSPTRS(); pg8::Gemm g{PB, (const bf16_t*)(ws + WS_WPP) + (size_t)layer * 1024 * 256, MA, 1024, 256}; const int nb_ = (layer & 1) ? 0 : 24;
          pg8::StaticOrder S; S.init(MA, 1024, G - nb_, c >= nb_ ? G - 1 - c : (1 << 24));
          EpiT E{TB, 1024};
          for (int rp_ = 0; rp_ < (PROBE_DUP == 6 ? 2 : 1); ++rp_) pg8::gemm_phase<EpiT, pg8::StaticOrder, true, true>(gl, g, S, E); }
#endif
        GSYNC();
        if ((layer & 1) == 0) {
#ifndef SKIP_S1
            for (int rp_ = (PROBE_DUP == 3 ? 0 : 1); rp_ < 2; ++rp_) { const Args a = getargs(); phase_s1(a, j, lds, !rp_); if (!rp_) GSYNC(); }
#endif
        } else {
#ifndef SKIP_C1
            { const Args a = getargs(); phase_c1(a, j); }
#endif
            GSYNC();
#ifndef SKIP_ATTN
            for (int rp_ = ((PROBE_DUP == 1 || PROBE_DUP == 2) ? 0 : 1); rp_ < 2; ++rp_) { const Args a = getargs(); phase_attn(a, j, lds, rp_ ? 0 : PROBE_DUP); if (!rp_) GSYNC(); }
#endif
        }
        GSYNC();
#ifndef SKIP_G2
        { WSPTRS(); pg8::Gemm g{R0, (const bf16_t*)(ws + ((layer & 1) ? WS_WFOUT : WS_WGOUT)) + (size_t)j * 1024 * 2048, MP, 1024, 2048}; pg8::StaticOrder S; S.init(MP, 1024, G, c);
          EpiT E{R1, 1024};
          for (int rp_ = 0; rp_ < (PROBE_DUP == 6 ? 2 : 1); ++rp_) pg8::gemm_phase<EpiT, pg8::StaticOrder, true, true>(gl, g, S, E); }
#endif
        { WSPTRS(); int ksl = 256; asm volatile("" : "+s"(ksl)); pg8::Gemm g{R0, (const bf16_t*)(ws + ((layer & 1) ? WS_WFOUT : WS_WGOUT)) + (size_t)j * 1024 * 2048, MA, 1024, ksl, 2048}; SplitOrder S{8, c};
          EpiPart E{(float*)(ws + WS_PART)};
          pg8::gemm_phase<EpiPart, SplitOrder, true, true>(gl, g, S, E); }
        GSYNC();
#ifndef SKIP_E3
        for (int rp_ = (PROBE_DUP == 4 ? 0 : 1); rp_ < 2; ++rp_) { const Args a = getargs(); phase_e3(a, layer, !rp_); if (!rp_) GSYNC(); }
#endif
        GSYNC();
#ifndef SKIP_G3
        { WSPTRS(); pg8::Gemm g{HX, (const bf16_t*)(ws + WS_WPG) + (size_t)layer * 1024 * 1024, MP, 1024, 1024}; pg8::StaticOrder S; S.init(MP, 1024, G, c);
          for (int rp_ = (PROBE_DUP == 6 ? 0 : 1); rp_ < 2; ++rp_) { EpiGate E{HX, rp_ ? a.p->out : (float*)(ws + WS_DUMMY), TB, layer == 3}; pg8::gemm_phase<EpiGate, pg8::StaticOrder, true, true>(gl, g, S, E); } }
#endif
        { WSPTRS(); int ksl = 256; asm volatile("" : "+s"(ksl)); pg8::Gemm g{HX, (const bf16_t*)(ws + WS_WPG) + (size_t)layer * 1024 * 1024, MA, 1024, ksl, 1024}; SplitOrder S{4, c};
          EpiPart E{(float*)(ws + WS_PART)};
          pg8::gemm_phase<EpiPart, SplitOrder, true, true>(gl, g, S, E); }
        GSYNC();
    }
    { const Args a = getargs(); phase_e1(a, 4); }
}

extern "C" void kernel_launch(void* const* d_in, const int* in_sizes, int n_in, void* d_out, int out_size, void* d_ws, size_t ws_size, hipStream_t stream) {
    static int grid = 0;
    if (grid == 0) {
        if (n_in != 20 || ws_size < WS_END) { fprintf(stderr, "kernel_launch: need 20 inputs and >= %zu bytes of workspace; got %d, %zu\n", (size_t)WS_END, n_in, ws_size); grid = -1; return; }
        int dev = 0, cus = 0, per_cu = 0;
        (void)hipGetDevice(&dev); (void)hipDeviceGetAttribute(&cus, hipDeviceAttributeMultiprocessorCount, dev);
        if (hipFuncSetAttribute((const void*)fwd_megakernel, hipFuncAttributeMaxDynamicSharedMemorySize, LDS_BYTES) != hipSuccess) { fprintf(stderr, "kernel_launch: hipFuncSetAttribute failed\n"); grid = -1; return; }
        if (hipOccupancyMaxActiveBlocksPerMultiprocessor(&per_cu, (const void*)fwd_megakernel, 512, LDS_BYTES) != hipSuccess || per_cu < 1) { fprintf(stderr, "kernel_launch: occupancy query says %d\n", per_cu); per_cu = 1; }
        (void)hipGetLastError();
        grid = cus > 0 ? cus : 256;
    }
    if (grid < 0) return;
    if (hipMemsetAsync(d_ws, 0, 65536, stream) != hipSuccess) { fprintf(stderr, "kernel_launch: memset of the barrier words failed\n"); return; }
    ArgsS a{};
    for (int i = 0; i < 20; ++i) a.in[i] = (const float*)d_in[i];
    a.out = (float*)d_out; a.ws = (unsigned char*)d_ws;
    void* args[] = {&a};
    hipError_t e = hipLaunchCooperativeKernel((const void*)fwd_megakernel, dim3(grid), dim3(512), args, LDS_BYTES, stream);
    if (e != hipSuccess) fprintf(stderr, "cooperative launch failed: %s (grid %d)\n", hipGetErrorString(e), grid);
}
```

```cpp
#include <hip/hip_runtime.h>
#include <hip/hip_bf16.h>
#include <hip/hip_cooperative_groups.h>
#include <cstdio>
#include <cstdint>
extern __shared__ __attribute__((aligned(16))) unsigned char g_lds[];
constexpr int LDS_TOTAL = 147456, LDS_WIDTAB = LDS_TOTAL - 512;
__device__ __forceinline__ int otid() {
    const unsigned hw = (unsigned)__builtin_amdgcn_s_getreg((5 << 11) | 4) & 63u;
    int w = ((volatile __attribute__((address_space(3))) int*)((__attribute__((address_space(3))) unsigned char*)g_lds + LDS_WIDTAB))[hw];
    w = __builtin_amdgcn_readfirstlane(w);
    int l; asm volatile("v_mbcnt_lo_u32_b32 %0, -1, 0" : "=v"(l)); asm volatile("v_mbcnt_hi_u32_b32 %0, -1, %0" : "+v"(l));
    return w * 64 + l;
}
namespace pg8 {
#define PG8_LAS __attribute__((address_space(3)))
typedef unsigned short bf16_t;
typedef short bf16x8 __attribute__((ext_vector_type(8)));
typedef float f32x4 __attribute__((ext_vector_type(4)));
typedef unsigned u32x4 __attribute__((ext_vector_type(4)));
constexpr int BM = 256, BK = 64, HALF = 128, HTB = HALF * BK * 2  , STAGE_BYTES = 8 * HTB, NXCD = 8, WGM = 8;

__host__ __device__ __forceinline__ int lds_byte(int r, int c) { const int st = (r >> 4) * 2 + (c >> 5), rr = r & 15, cc = c & 31, ob = rr * 64 + cc * 2; return st * 1024 + (ob ^ (((ob >> 9) & 1) << 5)); }
__host__ __device__ __forceinline__ void stage_rc(int b, int& R, int& C) { const int st = b / 1024, sb = b % 1024, swz = sb ^ (((sb >> 9) & 1) << 5); R = (st >> 1) * 16 + swz / 64; C = (st & 1) * 32 + (swz % 64) / 2; }
__host__ __device__ __forceinline__ int perm32(int rho) { const int n = rho >> 4, i = rho & 15; return 8 * (i >> 2) + 4 * n + (i & 3); }

struct Unit { int pm, pn, ko; };
struct Gemm { const bf16_t* A; const bf16_t* Bt; int M, N, K, ldk; };

struct StaticOrder {
    int nM, nN, nwg, G, c;
    __host__ __device__ void init(int M, int N, int G_, int c_) { nM = M / BM; nN = N / BM; nwg = nM * nN; G = G_; c = c_; }
    __host__ __device__ bool next(int i, Unit& u) const {
        const long L = (long)i * G + c; if (L >= nwg) return false;
        int wgid = (int)L; { const int q = nwg / NXCD, r = nwg % NXCD, xcd = wgid % NXCD, off = wgid / NXCD; wgid = (xcd < r ? xcd * (q + 1) : r * (q + 1) + (xcd - r) * q) + off; }
        const int nig = WGM * nN, gid = wgid / nig, fm = gid * WGM, gsz = (nM - fm) < WGM ? (nM - fm) : WGM;
        u.pm = fm + ((wgid % nig) % gsz); u.pn = (wgid % nig) / gsz; u.ko = 0; return true;
    }
    __device__ __forceinline__ void a_ready(const Unit&) const {}
    __device__ __forceinline__ void done(const Unit&) const {}
};

__device__ __forceinline__ unsigned cvt_pk_bf16(float lo, float hi) { unsigned r; asm volatile("v_cvt_pk_bf16_f32 %0, %1, %2" : "=v"(r) : "v"(lo), "v"(hi)); return r; }
typedef float f32x2 __attribute__((ext_vector_type(2)));
__device__ __forceinline__ f32x2 gelu_pk(f32x2 v) {
    const f32x2 av = __builtin_elementwise_abs(v), d = av * 0.2316418882f + 1.0f;
    f32x2 t; t.x = __builtin_amdgcn_rcpf(d.x); t.y = __builtin_amdgcn_rcpf(d.y);
    f32x2 q = t * 0.5307027145f + (-0.7265760135f); q = q * t + 0.7107068705f; q = q * t + (-0.142248368f); q = q * t + 0.127414796f; q = q * t;
    const f32x2 s = (v * v) * (-0.72134752044f);
    f32x2 e; e.x = __builtin_amdgcn_exp2f(s.x); e.y = __builtin_amdgcn_exp2f(s.y);
    const f32x2 m = v * (q * e), r = v - m;
    f32x2 o; o.x = v.x < 0.f ? m.x : r.x; o.y = v.y < 0.f ? m.y : r.y; return o;
}

template <int ACT  > struct EpiBf16 {
    static constexpr bool PERM = true, AFTER_DRAIN = false; static_assert(ACT == 0 || ACT == 1, "EpiBf16: ACT is 0 (none) or 1 (gelu_pk)");
    bf16_t* O; int ldc; const float* bias; int split_cols; size_t split_stride; float scale0;
    __device__ __forceinline__ void operator()(const f32x4 (&acc)[2][2][4][2], const Unit& u, int wr, int wc, int fr, int fq) const {
        const int row0 = u.pm * BM + wr * 64 + fr; int colt = u.pn * BM; bf16_t* base = O;
        float sc = 1.f; if (split_cols) { const int t = colt / split_cols; base += (size_t)t * split_stride; colt -= t * split_cols; if (t == 0) sc = scale0; }
        const int col0 = colt + wc * 32 + 8 * fq, bcol0 = u.pn * BM + wc * 32 + 8 * fq;
        f32x4 bv[2][2];
#pragma unroll
        for (int bj = 0; bj < 2; ++bj)
#pragma unroll
            for (int n = 0; n < 2; ++n) bv[bj][n] = bias ? *(const f32x4*)(bias + bcol0 + bj * HALF + 4 * n) : (f32x4){0.f, 0.f, 0.f, 0.f};
#pragma unroll
        for (int ai = 0; ai < 2; ++ai)
#pragma unroll
            for (int m = 0; m < 4; ++m) { bf16_t* rowp = base + (size_t)(row0 + ai * HALF + m * 16) * ldc + col0;
#pragma unroll
                for (int bj = 0; bj < 2; ++bj) { f32x4 v0 = acc[ai][bj][m][0] + bv[bj][0], v1 = acc[ai][bj][m][1] + bv[bj][1];
                    if (ACT == 1) { f32x2 a = gelu_pk((f32x2){v0[0], v0[1]}), b = gelu_pk((f32x2){v0[2], v0[3]}), c = gelu_pk((f32x2){v1[0], v1[1]}), d = gelu_pk((f32x2){v1[2], v1[3]});
                        v0 = (f32x4){a.x, a.y, b.x, b.y}; v1 = (f32x4){c.x, c.y, d.x, d.y}; }
                    v0 = v0 * sc; v1 = v1 * sc; u32x4 w; w.x = cvt_pk_bf16(v0[0], v0[1]); w.y = cvt_pk_bf16(v0[2], v0[3]); w.z = cvt_pk_bf16(v1[0], v1[1]); w.w = cvt_pk_bf16(v1[2], v1[3]);
                    *(u32x4*)(rowp + bj * HALF) = w; } }
    }
};


template <class Epi, class Sched, bool ALIGN_EPI = false, bool SP2 = false>
__device__ __forceinline__ void gemm_phase(PG8_LAS unsigned char* lds, const Gemm g, const Sched& S, const Epi& E) {
    const int tid = otid(), wid = __builtin_amdgcn_readfirstlane(tid >> 6), lane = tid & 63, wr = wid >> 2, wc = wid & 3, fr = lane & 15, fq = lane >> 4;
    const int K = g.K, nt = K / BK, LDK = g.ldk ? g.ldk : g.K;
    unsigned voffA[2], voffB[2];
#pragma unroll
    for (int i = 0; i < 2; ++i) { int R, C; stage_rc(tid * 16 + i * 8192, R, C); const int Rb = Epi::PERM ? ((R & ~31) + perm32(R & 31)) : R;
        voffA[i] = (unsigned)(R * LDK + C) * 2u; voffB[i] = (unsigned)(Rb * LDK + C) * 2u; }
    const size_t kstep = (size_t)(BK * 2);
    const size_t hstep = (size_t)HALF * LDK * 2;
    const size_t tstep = 2 * hstep;
    const unsigned ldsw = (unsigned)wid * 1024u;
    const int aoff = lds_byte(wr * 64 + fr, fq * 8), boff = lds_byte(wc * 32 + fr, fq * 8);
#define PG8_SA(b, h) (((b) * 2 + (h)) * HTB)
#define PG8_SB(b, h) ((4 + (b) * 2 + (h)) * HTB)
#define PG8_STAGE(bufoff, gbase, voff) do { _Pragma("unroll") for (int _i = 0; _i < 2; ++_i) \
        __builtin_amdgcn_global_load_lds((const unsigned*)((const char*)(gbase) + (voff)[_i]), (PG8_LAS unsigned*)(lds + (bufoff) + ldsw + _i * 8192), 16, 0, 0); } while (0)
#define PG8_LDA(dst, b, h) do { _Pragma("unroll") for (int m = 0; m < 4; ++m) _Pragma("unroll") for (int k = 0; k < 2; ++k) dst[m][k] = *(const PG8_LAS bf16x8*)(lds + PG8_SA(b, h) + aoff + m * 2048 + k * 1024); } while (0)
#define PG8_LDB(dst, b, h) do { _Pragma("unroll") for (int n = 0; n < 2; ++n) _Pragma("unroll") for (int k = 0; k < 2; ++k) dst[n][k] = *(const PG8_LAS bf16x8*)(lds + PG8_SB(b, h) + boff + n * 2048 + k * 1024); } while (0)
#define PG8_MMA(ai, bj, At, Bt) do { __builtin_amdgcn_s_setprio(1); _Pragma("unroll") for (int m = 0; m < 4; ++m) _Pragma("unroll") for (int n = 0; n < 2; ++n) _Pragma("unroll") for (int k = 0; k < 2; ++k) \
        acc[ai][bj][m][n] = __builtin_amdgcn_mfma_f32_16x16x32_bf16(Bt[n][k], At[m][k], acc[ai][bj][m][n], 0, 0, 0); __builtin_amdgcn_s_setprio(0); } while (0)
#define PG8_WAIT_V(n) asm volatile("s_waitcnt vmcnt(" #n ")" ::: "memory")
#define PG8_WAIT_L(n) asm volatile("s_waitcnt lgkmcnt(" #n ")" ::: "memory")
#define PG8_BAR __builtin_amdgcn_s_barrier()
#define PG8_SCHED __builtin_amdgcn_sched_barrier(0)
    Unit cur, nxt; int ui = 0;
    if (!S.next(0, cur)) return;
    f32x4 acc[2][2][4][2];
#pragma unroll
    for (int a = 0; a < 2; ++a)
#pragma unroll
        for (int b = 0; b < 2; ++b)
#pragma unroll
            for (int m = 0; m < 4; ++m)
#pragma unroll
                for (int n = 0; n < 2; ++n) acc[a][b][m][n] = (f32x4){0.f, 0.f, 0.f, 0.f};
    bf16x8 At[4][2], B0[2][2], B1[2][2];
    const char* cA = (const char*)g.A + (size_t)cur.pm * tstep + (size_t)cur.ko * 2; const char* cB = (const char*)g.Bt + (size_t)cur.pn * tstep + (size_t)cur.ko * 2;
    S.a_ready(cur);
    if constexpr (SP2) {
        PG8_STAGE(PG8_SB(0, 0), cB, voffB); PG8_STAGE(PG8_SB(0, 1), cB + hstep, voffB); PG8_STAGE(PG8_SA(0, 0), cA, voffA); PG8_STAGE(PG8_SA(0, 1), cA + hstep, voffA);
        if (wr == 1) PG8_BAR;
        PG8_WAIT_V(2); PG8_BAR;
        PG8_STAGE(PG8_SB(1, 0), cB + kstep, voffB); PG8_STAGE(PG8_SA(1, 0), cA + kstep, voffA); PG8_STAGE(PG8_SB(1, 1), cB + hstep + kstep, voffB);
        PG8_WAIT_V(6); PG8_BAR;
    } else {
        PG8_STAGE(PG8_SB(0, 0), cB, voffB); PG8_STAGE(PG8_SA(0, 0), cA, voffA); PG8_STAGE(PG8_SB(0, 1), cB + hstep, voffB); PG8_STAGE(PG8_SA(0, 1), cA + hstep, voffA);
        if (wr == 1) PG8_BAR;
        PG8_WAIT_V(4); PG8_BAR;
        PG8_STAGE(PG8_SB(1, 0), cB + kstep, voffB); PG8_STAGE(PG8_SA(1, 0), cA + kstep, voffA); PG8_STAGE(PG8_SB(1, 1), cB + hstep + kstep, voffB);
        PG8_WAIT_V(6); PG8_BAR;
    }
    for (;;) {
        const bool has_next = S.next(ui + 1, nxt);
        const char* nA = has_next ? (const char*)g.A + (size_t)nxt.pm * tstep + (size_t)nxt.ko * 2 : cA; const char* nB = has_next ? (const char*)g.Bt + (size_t)nxt.pn * tstep + (size_t)nxt.ko * 2 : cB;
        for (int t = 0; t < nt; t += 2) {
            const bool last = (t == nt - 2);
            const char* a1 = cA + (size_t)(t + 1) * kstep;
            const char* a2 = last ? nA : cA + (size_t)(t + 2) * kstep; const char* b2 = last ? nB : cB + (size_t)(t + 2) * kstep;
            const char* a3 = a2 + kstep; const char* b3 = b2 + kstep;
            if (last && has_next) S.a_ready(nxt);
            if constexpr (SP2) {
            PG8_LDB(B0, 0, 0); PG8_LDB(B1, 0, 1); PG8_SCHED; PG8_LDA(At, 0, 0); PG8_STAGE(PG8_SA(1, 1), a1 + hstep, voffA);
            PG8_WAIT_V(8); PG8_WAIT_L(0); PG8_BAR; PG8_MMA(0, 0, At, B0); PG8_MMA(0, 1, At, B1); PG8_BAR; PG8_SCHED;
            PG8_LDA(At, 0, 1); PG8_STAGE(PG8_SB(0, 0), b2, voffB); PG8_STAGE(PG8_SB(0, 1), b2 + hstep, voffB); PG8_STAGE(PG8_SA(0, 0), a2, voffA);
            PG8_WAIT_V(8); PG8_WAIT_L(0); PG8_BAR; PG8_MMA(1, 0, At, B0); PG8_MMA(1, 1, At, B1); PG8_BAR; PG8_SCHED;
            PG8_LDB(B0, 1, 0); PG8_LDB(B1, 1, 1); PG8_SCHED; PG8_LDA(At, 1, 0); PG8_STAGE(PG8_SA(0, 1), a2 + hstep, voffA);
            PG8_WAIT_V(8); PG8_WAIT_L(0); PG8_BAR; PG8_MMA(0, 0, At, B0); PG8_MMA(0, 1, At, B1); PG8_BAR; PG8_SCHED;
            PG8_LDA(At, 1, 1); PG8_STAGE(PG8_SB(1, 0), b3, voffB); PG8_STAGE(PG8_SB(1, 1), b3 + hstep, voffB); PG8_STAGE(PG8_SA(1, 0), a3, voffA);
            PG8_WAIT_V(8); PG8_WAIT_L(0); PG8_BAR; PG8_MMA(1, 0, At, B0); PG8_MMA(1, 1, At, B1); PG8_BAR; PG8_SCHED;
            } else {
            PG8_LDB(B0, 0, 0); PG8_SCHED; PG8_LDA(At, 0, 0); PG8_STAGE(PG8_SA(1, 1), a1 + hstep, voffA);
            PG8_WAIT_L(8); PG8_BAR; PG8_WAIT_L(0); PG8_MMA(0, 0, At, B0); PG8_BAR; PG8_SCHED;
            PG8_LDB(B1, 0, 1); PG8_STAGE(PG8_SB(0, 0), b2, voffB);
            PG8_BAR; PG8_WAIT_L(0); PG8_MMA(0, 1, At, B1); PG8_BAR;
            PG8_LDA(At, 0, 1); PG8_STAGE(PG8_SA(0, 0), a2, voffA);
            PG8_BAR; PG8_WAIT_L(0); PG8_MMA(1, 0, At, B0); PG8_BAR; PG8_SCHED;
            PG8_STAGE(PG8_SB(0, 1), b2 + hstep, voffB);
            PG8_WAIT_V(6); PG8_BAR; PG8_MMA(1, 1, At, B1); PG8_BAR;
            PG8_LDB(B0, 1, 0); PG8_SCHED; PG8_LDA(At, 1, 0); PG8_STAGE(PG8_SA(0, 1), a2 + hstep, voffA);
            PG8_WAIT_L(8); PG8_BAR; PG8_WAIT_L(0); PG8_MMA(0, 0, At, B0); PG8_BAR; PG8_SCHED;
            PG8_LDB(B1, 1, 1); PG8_STAGE(PG8_SB(1, 0), b3, voffB);
            PG8_BAR; PG8_WAIT_L(0); PG8_MMA(0, 1, At, B1); PG8_BAR;
            PG8_LDA(At, 1, 1); PG8_STAGE(PG8_SA(1, 0), a3, voffA);
            PG8_BAR; PG8_WAIT_L(0); PG8_MMA(1, 0, At, B0); PG8_BAR; PG8_SCHED;
            PG8_STAGE(PG8_SB(1, 1), b3 + hstep, voffB);
            PG8_WAIT_V(6); PG8_BAR; PG8_MMA(1, 1, At, B1); PG8_BAR;
            }
        }
        if constexpr (ALIGN_EPI) { if (wr == 0) PG8_BAR; }
        if constexpr (!Epi::AFTER_DRAIN) { E(acc, cur, wr, wc, fr, fq); S.done(cur); }
        if (!has_next) break;
#pragma unroll
        for (int a = 0; a < 2; ++a)
#pragma unroll
            for (int b = 0; b < 2; ++b)
#pragma unroll
                for (int m = 0; m < 4; ++m)
#pragma unroll
                    for (int n = 0; n < 2; ++n) acc[a][b][m][n] = (f32x4){0.f, 0.f, 0.f, 0.f};
        cur = nxt; cA = nA; cB = nB; ++ui;
        if constexpr (ALIGN_EPI) { if (wr == 1) PG8_BAR; }
    }
    PG8_WAIT_V(0);
    if constexpr (!ALIGN_EPI) { if (wr == 0) PG8_BAR; }
    PG8_BAR;
    if constexpr (Epi::AFTER_DRAIN) { E.fused(acc, cur, wr, wc, fr, fq, lds, wid, lane); S.done(cur); }
#undef PG8_SA
#undef PG8_SB
#undef PG8_STAGE
#undef PG8_LDA
#undef PG8_LDB
#undef PG8_MMA
#undef PG8_WAIT_V
#undef PG8_WAIT_L
#undef PG8_BAR
#undef PG8_SCHED
}
}
namespace att {
constexpr int D = 128, PITCH = 2048;
constexpr float THR = 8.f;
constexpr bool WSKIP = false;
constexpr float SCALE = 0.08838834764831845f;
constexpr int NW = 8, QBLK = 32, KVBLK = 64, QB = NW * QBLK;
constexpr int SHM_V = KVBLK * D * 2, SHM_K = KVBLK * D * 2;
constexpr int LDS_BYTES = 2 * SHM_V + 2 * SHM_K + NW * 64 * 4 + 512;
using bf16 = __hip_bfloat16;
typedef short bf16x8 __attribute__((ext_vector_type(8)));
typedef short s16x4 __attribute__((ext_vector_type(4)));
typedef float f32x16 __attribute__((ext_vector_type(16)));
typedef float f32x4 __attribute__((ext_vector_type(4)));
typedef unsigned u32x4 __attribute__((ext_vector_type(4)));
template <class A, class Bt> struct same_t { static constexpr bool v = false; };
template <class A> struct same_t<A, A> { static constexpr bool v = true; };

#define BPERM(k) ((((k) >> 2) & 1) * 32 + (((k) >> 3) & 3) * 4 + ((k) & 3))
#define KSWZ(row, colB) ((row) * 256 + ((colB) ^ (((row) & 7) << 4)))
#define SBAR() __builtin_amdgcn_sched_barrier(0)
__device__ __forceinline__ int v_st(int k, int c) { const int kk = (k & ~0xC) | ((k & 4) << 1) | ((k & 8) >> 1); return ((kk >> 3) * 4 + (c >> 5)) * 512 + ((kk & 7) * 32 + (c & 31)) * 2; }
__device__ __forceinline__ int v_rd_base(int lane) { return ((lane & 3) << 3) | (((lane >> 2) & 3) << 6) | (((lane >> 4) & 1) << 5) | (((lane >> 5) & 1) << 8); }
constexpr int v_rd_off(int d0, int ks, int half) { return d0 * 512 + ks * 4096 + half * 2048; }
__device__ __forceinline__ int crow(int r, int hi) { return (r & 3) + 8 * (r >> 2) + 4 * hi; }
__device__ __forceinline__ unsigned cvtpk(float lo, float hi) {
    unsigned r; asm volatile("v_cvt_pk_bf16_f32 %0, %1, %2" : "=v"(r) : "v"(lo), "v"(hi)); return r;
}
__device__ __forceinline__ bf16x8 pack8(f32x4 a, f32x4 b) {
    u32x4 w = {cvtpk(a[0], a[1]), cvtpk(a[2], a[3]), cvtpk(b[0], b[1]), cvtpk(b[2], b[3])};
    return *reinterpret_cast<bf16x8*>(&w);
}
template <class T> __device__ __forceinline__ bf16x8 load8(const T* p) {
    if constexpr (same_t<T, float>::v) { return pack8(*(const f32x4*)p, *(const f32x4*)(p + 4)); }
    else { return *reinterpret_cast<const bf16x8*>(p); }
}
__device__ __forceinline__ void mask_tile(f32x16& p0, f32x16& p1, int dq, unsigned W) {
    const float NEG = -__builtin_inff();
#pragma unroll
    for (int r = 0; r < 16; ++r) {
        const int c = (r & 3) + 8 * (r >> 2);
        if ((unsigned)(dq - c) >= W) p0[r] = NEG;
        if ((unsigned)(dq - c - 32) >= W) p1[r] = NEG;
    }
}
__device__ __forceinline__ void partialSM(f32x16& p0, f32x16& p1, float& m_reg, float& mn, float& alpha) {
    float pmax = p0[0]; for (int r = 1; r < 16; ++r) pmax = fmaxf(pmax, p0[r]); for (int r = 0; r < 16; ++r) pmax = fmaxf(pmax, p1[r]);
    { auto rr = __builtin_amdgcn_permlane32_swap(__float_as_uint(pmax), __float_as_uint(pmax), false, false);
      pmax = fmaxf(__uint_as_float(rr[0]), __uint_as_float(rr[1])); }
    constexpr float C2 = 1.4426950408889634f * SCALE;
    if (__builtin_expect(__all((pmax - m_reg) * SCALE <= THR), 1)) { mn = m_reg; alpha = 1.f; }
    else { mn = fmaxf(m_reg, pmax); alpha = __builtin_amdgcn_exp2f((m_reg - mn) * C2); m_reg = mn; }
    const float mnL = -mn * C2;
    for (int r = 0; r < 16; ++r) p0[r] = fmaf(p0[r], C2, mnL); for (int r = 0; r < 16; ++r) p1[r] = fmaf(p1[r], C2, mnL);
    for (int r = 0; r < 16; ++r) p0[r] = __builtin_amdgcn_exp2f(p0[r]);
}
__device__ __forceinline__ void finishSM(f32x16& p0, f32x16& p1, float alpha, float& l_reg, bf16x8& pa0, bf16x8& pa1, bf16x8& pa2, bf16x8& pa3) {
    for (int r = 0; r < 16; ++r) p1[r] = __builtin_amdgcn_exp2f(p1[r]);
    float ps = 0; for (int r = 0; r < 16; ++r) ps += p0[r]; for (int r = 0; r < 16; ++r) ps += p1[r];
    { auto rr = __builtin_amdgcn_permlane32_swap(__float_as_uint(ps), __float_as_uint(ps), false, false);
      ps = __uint_as_float(rr[0]) + __uint_as_float(rr[1]); }
    l_reg = l_reg * alpha + ps;
#define PK4(P, B_, OUT) do { unsigned a0 = cvtpk(P[B_+0], P[B_+1]), a1 = cvtpk(P[B_+2], P[B_+3]);                          \
        unsigned b0 = cvtpk(P[B_+4], P[B_+5]), b1 = cvtpk(P[B_+6], P[B_+7]);                                             \
        auto r0 = __builtin_amdgcn_permlane32_swap(a0, b0, false, false); auto r1 = __builtin_amdgcn_permlane32_swap(a1, b1, false, false); \
        u32x4 w = {r0[0], r1[0], r0[1], r1[1]}; OUT = *reinterpret_cast<bf16x8*>(&w); } while (0)
    PK4(p0, 0, pa0); PK4(p0, 8, pa1); PK4(p1, 0, pa2); PK4(p1, 8, pa3);
#undef PK4
}
template <int KB, bool SK>
__device__ __forceinline__ void qkt(f32x16& p0, f32x16& p1, const char* K_lds, const float* B_lds, int r32, int hi, const bf16x8* qr, bool act) {
    if (SK && !act) { const float NEG = -__builtin_inff();
#pragma unroll
        for (int r = 0; r < 16; ++r) { p0[r] = NEG; p1[r] = NEG; } return; }
#ifdef ATT_NOBIAS
    p0 = f32x16{}; p1 = f32x16{};
#else
    p0 = *(const f32x16*)(B_lds + KB * 64 + hi * 32); p1 = *(const f32x16*)(B_lds + KB * 64 + hi * 32 + 16);
#endif
    const char* kb[4];
#pragma unroll
    for (int dd = 0; dd < 4; ++dd) kb[dd] = K_lds + KB * SHM_K + KSWZ(r32, (dd * 16 + hi * 8) * 2);
#pragma unroll
    for (int d0 = 0; d0 < 8; ++d0) { const char* a = kb[d0 & 3] + (d0 >> 2) * 128;
        bf16x8 b0 = *reinterpret_cast<const bf16x8*>(a);
        bf16x8 b1 = *reinterpret_cast<const bf16x8*>(a + 32 * 256);
        p0 = __builtin_amdgcn_mfma_f32_32x32x16_bf16(b0, qr[d0], p0, 0, 0, 0);
        p1 = __builtin_amdgcn_mfma_f32_32x32x16_bf16(b1, qr[d0], p1, 0, 0, 0); }
}
template <int VB, bool SK>
__device__ __forceinline__ void pv_tile(f32x16* o, int vb0, bf16x8 pa0, bf16x8 pa1, bf16x8 pa2, bf16x8 pa3, bool act) {
    if (SK && !act) return;
#define TRRD(dst, off) asm volatile("ds_read_b64_tr_b16 %0, %1 offset:%2" : "=&v"(dst) : "v"(vb0), "i"(off) : "memory")
#define PV_D0(d0) do { s16x4 l0, l1, l2, l3, h0, h1, h2, h3; constexpr int b_ = VB * SHM_V + v_rd_off(d0, 0, 0);     \
        TRRD(l0, b_); TRRD(h0, b_ + 2048); TRRD(l1, b_ + 4096); TRRD(h1, b_ + 6144); TRRD(l2, b_ + 8192); TRRD(h2, b_ + 10240); TRRD(l3, b_ + 12288); TRRD(h3, b_ + 14336); \
        asm volatile("s_waitcnt lgkmcnt(0)" ::: "memory"); SBAR();                 \
        o[d0] = __builtin_amdgcn_mfma_f32_32x32x16_bf16(pa0, (bf16x8){l0[0], l0[1], l0[2], l0[3], h0[0], h0[1], h0[2], h0[3]}, o[d0], 0, 0, 0);   \
        o[d0] = __builtin_amdgcn_mfma_f32_32x32x16_bf16(pa1, (bf16x8){l1[0], l1[1], l1[2], l1[3], h1[0], h1[1], h1[2], h1[3]}, o[d0], 0, 0, 0);   \
        o[d0] = __builtin_amdgcn_mfma_f32_32x32x16_bf16(pa2, (bf16x8){l2[0], l2[1], l2[2], l2[3], h2[0], h2[1], h2[2], h2[3]}, o[d0], 0, 0, 0);   \
        o[d0] = __builtin_amdgcn_mfma_f32_32x32x16_bf16(pa3, (bf16x8){l3[0], l3[1], l3[2], l3[3], h3[0], h3[1], h3[2], h3[3]}, o[d0], 0, 0, 0); } while (0)
    PV_D0(0); PV_D0(1); PV_D0(2); PV_D0(3);
#undef PV_D0
#undef TRRD
}

template <class TIn, class TOut> struct BlockRef { const TIn* Q; const TIn* K; const TIn* V; TOut* O; const float* CB; const TIn* Z; int P0; };
template <class TIn> struct Seam {
    bf16x8 qr[8];
    bf16x8 st_v0, st_v1, st_k0, st_k1; float st_b0; f32x4 sf0, sf1, sf2, sf3;
    f32x4 tq[16];
};
__device__ __forceinline__ int swa_jlo(int P0, int W) { const int lowk = P0 - W + 1; return lowk > 0 ? lowk / KVBLK : 0; }
#define ROW(p, k0, rr) ((p) + (unsigned)(((k0) + (rr)) * PITCH + sc))
#define VMW() asm volatile("s_waitcnt vmcnt(0)" ::: "memory")
#define VMWN(n) asm volatile("s_waitcnt vmcnt(%0)" :: "i"(n) : "memory")
#define SLOAD_H(Kp, Vp, Cp, k0) do { S.st_b0 = (Cp)[(unsigned)((k0) + sr + 32 * (tid & 1))]; S.st_v0 = load8<TIn>(ROW(Vp, k0, sr)); S.st_v1 = load8<TIn>(ROW(Vp, k0, 32 + sr));              \
                         S.st_k0 = load8<TIn>(ROW(Kp, k0, sr)); S.st_k1 = load8<TIn>(ROW(Kp, k0, 32 + sr)); } while (0)
#define SWRITE_HK(bf) do { B_lds[(bf) * 64 + sr + 32 * (tid & 1)] = S.st_b0; *(bf16x8*)(K_lds + (bf) * SHM_K + kws) = S.st_k0; *(bf16x8*)(K_lds + (bf) * SHM_K + kws + 32 * 256) = S.st_k1; } while (0)
#define SWRITE_HV(bf) do { *(bf16x8*)(V_lds + (bf) * SHM_V + vst0) = S.st_v0; *(bf16x8*)(V_lds + (bf) * SHM_V + vst1) = S.st_v1; } while (0)
#define SWRITE_H(bf) do { SWRITE_HV(bf); SWRITE_HK(bf); } while (0)
#define SLOAD_F(p, k0) do { S.sf0 = *(const f32x4*)ROW(p, k0, sr); S.sf1 = *(const f32x4*)(ROW(p, k0, sr) + 4);                \
                            S.sf2 = *(const f32x4*)ROW(p, k0, 32 + sr); S.sf3 = *(const f32x4*)(ROW(p, k0, 32 + sr) + 4); } while (0)
#define SWRITE_KF(bf) do { *(bf16x8*)(K_lds + (bf) * SHM_K + kws) = pack8(S.sf0, S.sf1); *(bf16x8*)(K_lds + (bf) * SHM_K + kws + 32 * 256) = pack8(S.sf2, S.sf3); } while (0)
#define SWRITE_VF(bf) do { *(bf16x8*)(V_lds + (bf) * SHM_V + vst0) = pack8(S.sf0, S.sf1); *(bf16x8*)(V_lds + (bf) * SHM_V + vst1) = pack8(S.sf2, S.sf3); } while (0)
template <class TIn, class TOut>
__device__ __forceinline__ void causal_swa_prime(const BlockRef<TIn, TOut>& cur, int W, char* lds, Seam<TIn>& S) {
    constexpr bool F32 = same_t<TIn, float>::v;
    const int tid = otid(), wid = __builtin_amdgcn_readfirstlane(tid >> 6), lane = tid & 63, r32 = lane & 31, hi = lane >> 5;
    const int sr = tid >> 4, sc = (tid & 15) * 8, kws = KSWZ(sr, sc * 2); char* K_lds = lds + 2 * SHM_V; float* B_lds = (float*)(lds + 2 * SHM_V + 2 * SHM_K + NW * 64 * 4);
    const int kb0 = swa_jlo(cur.P0, W) * KVBLK;
    for (int d0 = 0; d0 < 8; ++d0) S.qr[d0] = load8<TIn>(cur.Q + (unsigned)((wid * QBLK + r32) * PITCH + d0 * 16 + hi * 8));
    if constexpr (F32) { SLOAD_F((const float*)cur.K, kb0); VMW(); SWRITE_KF(0); SBAR(); SLOAD_F((const float*)cur.V, kb0); }
    else { SLOAD_H(cur.K, cur.V, cur.CB, kb0); VMW(); SWRITE_HK(0); }
    __syncthreads();
}
template <class TIn, class TOut>
__device__ __forceinline__ void causal_swa_block(const BlockRef<TIn, TOut>& cur, const BlockRef<TIn, TOut>& nxt, int skv, int W, char* lds, Seam<TIn>& S) {
    constexpr bool F32 = same_t<TIn, float>::v;
    const int tid = otid(), wid = __builtin_amdgcn_readfirstlane(tid >> 6), lane = tid & 63, r32 = lane & 31, hi = lane >> 5;
    const int j_lo = swa_jlo(cur.P0, W);
    int j_hi = (cur.P0 + QB - 1) / KVBLK + 1; if (j_hi > skv / KVBLK) j_hi = skv / KVBLK;
    const int NT = j_hi - j_lo;
    const int kbn = swa_jlo(nxt.P0, W) * KVBLK;
    const int qlo = cur.P0 + wid * QBLK, qm = qlo + r32 - 4 * hi;
    char* V_lds = lds; char* K_lds = lds + 2 * SHM_V; float* B_lds = (float*)(lds + 2 * SHM_V + 2 * SHM_K + NW * 64 * 4);
    float* ws = (float*)(lds + 2 * SHM_V + 2 * SHM_K) + wid * 64; float* li_l = ws, * al_l = ws + 32;
    float m_reg = -1e30f, l_reg = 0; f32x16 o[4] = {};
    const int sr = tid >> 4, sc = (tid & 15) * 8, vst0 = v_st(sr, sc), vst1 = v_st(32 + sr, sc), kws = KSWZ(sr, sc * 2);
    const int vb0 = (int)(uintptr_t)V_lds + v_rd_base(lane);
    const TIn* Kh = cur.K; const TIn* Vh = cur.V; const float* Ch = cur.CB;
#define RESC(a) do { if (__any((a) < 1.f)) { if (hi == 0) al_l[r32] = (a); asm volatile("s_waitcnt lgkmcnt(0)" ::: "memory");              \
                     for (int d_ = 0; d_ < 4; ++d_) for (int r = 0; r < 16; ++r) o[d_][r] *= al_l[crow(r, hi)]; } } while (0)
#define KBASE(t) ((j_lo + (t)) * KVBLK)
#define ACT(t) (KBASE(t) <= qlo + QBLK - 1 && KBASE(t) + KVBLK - 1 >= qlo - W + 1)
#define MASKT(P0_, P1_, t) do { const int kb_ = KBASE(t); if ((!SK || ACT(t)) && (kb_ + KVBLK - 1 > qlo || kb_ <= qlo + QBLK - 1 - W)) mask_tile(P0_, P1_, qm - kb_, (unsigned)W); } while (0)
    constexpr int NQL = F32 ? 16 : 8;
    constexpr bool SK = WSKIP && !F32;
#define SEAM_K0() do { VMWN(NQL); if constexpr (F32) { SWRITE_KF(0); SBAR(); SLOAD_F((const float*)nxt.V, kbn); } else { SWRITE_HK(0); } SBAR(); } while (0)
    f32x16 pA0, pA1, pB0, pB1; float mnA, mnB, alA, alB; bf16x8 pa0, pa1, pa2, pa3;
    if constexpr (F32) { VMW(); SWRITE_VF(0); SBAR(); } else { SWRITE_HV(0); SBAR(); }
    if (NT > 1) { if constexpr (F32) SLOAD_F((const float*)Kh, KBASE(1)); else SLOAD_H(Kh, Vh, Ch, KBASE(1)); }
    SBAR(); qkt<0, SK>(pA0, pA1, K_lds, B_lds, r32, hi, S.qr, ACT(0));
    if constexpr (F32) { if (NT > 1) { VMW(); SWRITE_KF(1); SBAR(); SLOAD_F((const float*)Vh, KBASE(1)); } }
    MASKT(pA0, pA1, 0); partialSM(pA0, pA1, m_reg, mnA, alA);
    if (NT > 1) { VMW(); if constexpr (F32) { SWRITE_VF(1); SBAR(); if (NT > 2) SLOAD_F((const float*)Kh, KBASE(2)); } else SWRITE_H(1); }
    __syncthreads();
#define HALF_STEP(PX0, PX1, mnX, alX, PY0, PY1, alY, t, KB, VB, SB) do {                                                      \
        SBAR(); qkt<KB, SK>(PX0, PX1, K_lds, B_lds, r32, hi, S.qr, ACT(t));                                             \
        finishSM(PY0, PY1, alY, l_reg, pa0, pa1, pa2, pa3); SBAR();                                                           \
        if ((t) + 1 < NT) { if constexpr (F32) { VMW(); SWRITE_KF(SB); SBAR(); SLOAD_F((const float*)Vh, KBASE((t) + 1)); }  \
                            else { SLOAD_H(Kh, Vh, Ch, KBASE((t) + 1)); } SBAR(); }                                               \
        pv_tile<VB, SK>(o, vb0, pa0, pa1, pa2, pa3, ACT((t) - 1)); MASKT(PX0, PX1, (t)); partialSM(PX0, PX1, m_reg, mnX, alX);                                        \
        __syncthreads();                                                                                                      \
        if ((t) + 1 < NT) { VMW(); if constexpr (F32) { SWRITE_VF(SB); SBAR(); if ((t) + 2 < NT) SLOAD_F((const float*)Kh, KBASE((t) + 2)); } \
                            else { SWRITE_H(SB); } }                                                                          \
        RESC(alX); __syncthreads(); } while (0)
    for (int t = 1; t + 1 < NT; t += 2) {
        HALF_STEP(pB0, pB1, mnB, alB, pA0, pA1, alA, t, 1, 0, 0);
        HALF_STEP(pA0, pA1, mnA, alA, pB0, pB1, alB, t + 1, 0, 1, 1);
    }
    const bool even = (NT & 1) == 0;
    if (even) { SBAR(); qkt<1, SK>(pB0, pB1, K_lds, B_lds, r32, hi, S.qr, ACT(NT - 1)); SBAR(); }
#define QROW(e) (nxt.Q + (size_t)(wid * QBLK + r32) * PITCH + ((e) >> 1) * 16 + hi * 8 + ((e) & 1) * 4)
    if constexpr (F32) { SLOAD_F((const float*)nxt.K, kbn); SBAR();
#pragma unroll
        for (int e = 0; e < 8; ++e) S.tq[e] = *(const f32x4*)QROW(e); }
    else { SLOAD_H(nxt.K, nxt.V, nxt.CB, kbn); SBAR();
#pragma unroll
        for (int d0 = 0; d0 < 8; ++d0) S.qr[d0] = load8<TIn>(nxt.Q + (unsigned)((wid * QBLK + r32) * PITCH + d0 * 16 + hi * 8)); }
    SBAR();
    finishSM(pA0, pA1, alA, l_reg, pa0, pa1, pa2, pa3); SBAR();
    if constexpr (F32) {
#pragma unroll
        for (int e = 8; e < 16; ++e) S.tq[e] = *(const f32x4*)QROW(e); SBAR(); }
#undef QROW
    pv_tile<0, SK>(o, vb0, pa0, pa1, pa2, pa3, ACT(even ? NT - 2 : NT - 1));
    if (even) { MASKT(pB0, pB1, NT - 1); partialSM(pB0, pB1, m_reg, mnB, alB); __syncthreads(); RESC(alB);
        finishSM(pB0, pB1, alB, l_reg, pa0, pa1, pa2, pa3); SBAR(); pv_tile<1, SK>(o, vb0, pa0, pa1, pa2, pa3, ACT(NT - 1)); }
    SBAR(); SEAM_K0();
    if (hi == 0) li_l[r32] = l_reg; asm volatile("s_waitcnt lgkmcnt(0)" ::: "memory");
    float rli[16];
#pragma unroll
    for (int r = 0; r < 16; ++r) rli[r] = __builtin_amdgcn_rcpf(li_l[crow(r, hi)]);
    TOut* Ow = cur.O + (size_t)(wid * QBLK) * PITCH; const TIn* Zw = cur.Z + (size_t)(wid * QBLK) * PITCH; unsigned lo_ = (unsigned)(4 * hi) * PITCH + r32; asm volatile("" : "+v"(lo_));
#pragma unroll
    for (int r = 0; r < 16; ++r) { const int orow = crow(r, hi);
#pragma unroll
        for (int d0 = 0; d0 < 4; ++d0) { const float v = o[d0][r] * rli[r];
            if constexpr (same_t<TOut, float>::v) { Ow[(size_t)orow * PITCH + d0 * 32 + r32] = v; }
            else { const float vn = __shfl_xor(v, 1);
                   if ((r32 & 1) == 0) { const unsigned of_ = lo_ + (unsigned)(orow - 4 * hi) * PITCH + d0 * 32; const unsigned zz = *(const unsigned*)(Zw + of_);
                       *(unsigned*)(Ow + of_) = cvtpk(v * __uint_as_float(zz << 16), vn * __uint_as_float(zz & 0xffff0000u)); } } } }
    if constexpr (F32) {
#pragma unroll
        for (int d0 = 0; d0 < 8; ++d0) S.qr[d0] = pack8(S.tq[2 * d0], S.tq[2 * d0 + 1]); }
    __syncthreads();
#undef RESC
#undef KBASE
#undef ACT
#undef MASKT
#undef SEAM_K0
#undef HALF_STEP
}
#undef ROW
#undef VMW
#undef VMWN
#undef SLOAD_H
#undef SWRITE_HK
#undef SWRITE_HV
#undef SWRITE_H
#undef SLOAD_F
#undef SWRITE_KF
#undef SWRITE_VF
}

namespace cg = cooperative_groups;
#define LAS __attribute__((address_space(3)))
typedef unsigned short bf16_t;
typedef float f32x4 __attribute__((ext_vector_type(4)));
typedef float f32x2 __attribute__((ext_vector_type(2)));
typedef unsigned u32x4 __attribute__((ext_vector_type(4)));
typedef unsigned u32x2 __attribute__((ext_vector_type(2)));
typedef short bf16x8 __attribute__((ext_vector_type(8)));

constexpr int DM = 1024, EB = 2048, MP = 32768, MS = 128, MV = MP + MS  , MA = 33024  ;
constexpr int SEQ = 4096, NBH = 128, PAST = 2048, TS = 16, SKS = 2112  ;
constexpr int NFIN = 8448;
constexpr float RMS_EPS = 1e-6f, LN_EPS = 1e-5f;
constexpr size_t O_YP = 0, O_YS = 33554432, O_GV = 33685504, O_FKP = 34209792, O_FVP = 168427520, O_FLP = 302645248, O_FKS = 303693824, O_FVS = 304218112, O_FLS = 304742400;
constexpr size_t MiB = 1u << 20;
constexpr size_t WS_WGIN = 1 * MiB;
constexpr size_t WS_WGOUT = 25 * MiB;
constexpr size_t WS_WFIN = 33 * MiB;
constexpr size_t WS_WFOUT = 66 * MiB;
constexpr size_t WS_WPP = 74 * MiB;
constexpr size_t WS_WPG = 76 * MiB;
constexpr size_t WS_WM = 84 * MiB;
constexpr size_t WS_WMS = 85 * MiB;
constexpr size_t WS_PB = 88 * MiB;
constexpr size_t WS_HX = 105 * MiB;
constexpr size_t WS_TB = 170 * MiB;
constexpr size_t WS_STAT = 756 * MiB;
constexpr size_t WS_CBP = 236 * MiB;
constexpr size_t WS_CBS = 238 * MiB + 512 * 1024;
constexpr size_t WS_R0 = 240 * MiB, RSZ = 129 * MiB;
constexpr size_t WS_END = 775 * MiB;
constexpr size_t WS_PART = 766 * MiB;
constexpr size_t WS_DUMMY = 776 * MiB;
constexpr int LDS_BYTES = LDS_TOTAL;
#ifndef PROBE_DUP
#define PROBE_DUP 0
#endif

struct ArgsS { const float* in[20]; float* out; unsigned char* ws; };
typedef const __attribute__((address_space(4))) ArgsS* ArgsP;
struct Args { ArgsP p; };
__device__ __forceinline__ Args getargs() { ArgsP p = (ArgsP)__builtin_amdgcn_kernarg_segment_ptr(); asm volatile("" : "+s"(p)); Args a; a.p = p; return a; }

__device__ __forceinline__ unsigned f2bf(float f) { unsigned u = __builtin_bit_cast(unsigned, f); return (u + 0x7fffu + ((u >> 16) & 1u)) >> 16; }
__device__ __forceinline__ unsigned pk2(float lo, float hi) { return pg8::cvt_pk_bf16(lo, hi); }
__device__ __forceinline__ float bflo(unsigned u) { return __uint_as_float(u << 16); }
__device__ __forceinline__ float bfhi(unsigned u) { return __uint_as_float(u & 0xffff0000u); }
__device__ __forceinline__ float wave_sum(float v) { for (int o = 32; o > 0; o >>= 1) v += __shfl_xor(v, o); return v; }
__device__ __forceinline__ float wave_max(float v) { for (int o = 32; o > 0; o >>= 1) v = fmaxf(v, __shfl_xor(v, o)); return v; }
__device__ __forceinline__ float gelu_t(float x) { const float t = x * x; const float e = __builtin_amdgcn_exp2f((-2.3022082f * x) * (1.f + 0.044715f * t)); return x * __builtin_amdgcn_rcpf(1.f + e); }
__device__ __forceinline__ float silu_f(float x) { return x * __builtin_amdgcn_rcpf(1.f + __builtin_amdgcn_exp2f(-1.4426950408889634f * x)); }
__device__ __forceinline__ float sigm_f(float x) { return __builtin_amdgcn_rcpf(1.f + __builtin_amdgcn_exp2f(-1.4426950408889634f * x)); }
__device__ __forceinline__ f32x2 sigm2(f32x2 v) { const f32x2 a = v * -1.4426950408889634f; f32x2 e; e.x = __builtin_amdgcn_exp2f(a.x); e.y = __builtin_amdgcn_exp2f(a.y); const f32x2 d = e + 1.0f; f32x2 r; r.x = __builtin_amdgcn_rcpf(d.x); r.y = __builtin_amdgcn_rcpf(d.y); return r; }
__device__ __forceinline__ f32x2 silu2(f32x2 v) { return v * sigm2(v); }
__device__ __forceinline__ f32x2 gelu2(f32x2 v) { const f32x2 t = v * v; const f32x2 a = (v * -2.3022082f) * (t * 0.044715f + 1.0f); f32x2 e; e.x = __builtin_amdgcn_exp2f(a.x); e.y = __builtin_amdgcn_exp2f(a.y); const f32x2 d = e + 1.0f; f32x2 r; r.x = __builtin_amdgcn_rcpf(d.x); r.y = __builtin_amdgcn_rcpf(d.y); return v * r; }
__device__ __forceinline__ float logsig_f(float x) { const float e = __expf(-fabsf(x)); const float l = e < 0.03f ? e * (1.f - e * (0.5f - e * (0.33333334f - 0.25f * e))) : __logf(1.f + e); return fminf(x, 0.f) - l; }

using pg8::Unit; using pg8::HALF; using pg8::BM;
struct EpiGmlpIn {
    static constexpr bool PERM = true, AFTER_DRAIN = false;
    bf16_t* U; bf16_t* VT; bf16_t* ZS; float* stat;
    __device__ __forceinline__ void operator()(const pg8::f32x4 (&acc)[2][2][4][2], const Unit& u, int wr, int wc, int fr_, int fq_) const {
        const int lane_ = otid() & 63, fr = lane_ & 15, fq = lane_ >> 4; (void)fr_; (void)fq_;
        const int row0 = u.pm * BM + wr * 64 + fr, colt = u.pn * BM, region = colt >> 11, cb = (colt & 2047) + wc * 32 + 8 * fq;
#pragma unroll
        for (int ai = 0; ai < 2; ++ai)
#pragma unroll
            for (int m = 0; m < 4; ++m) {
                const int row = row0 + ai * HALF + m * 16; float s = 0.f, q = 0.f;
#pragma unroll
                for (int bj = 0; bj < 2; ++bj) {
                    const int col = cb + bj * HALF; const pg8::f32x4 v0 = acc[ai][bj][m][0], v1 = acc[ai][bj][m][1];
                    float x[8] = {v0[0], v0[1], v0[2], v0[3], v1[0], v1[1], v1[2], v1[3]};
                    if (region == 2) {
#pragma unroll
                        for (int e = 0; e < 8; e += 2) { const f32x2 r = silu2((f32x2){x[e], x[e + 1]}); x[e] = r.x; x[e + 1] = r.y; }
                    } else {
#pragma unroll
                        for (int e = 0; e < 8; e += 2) { const f32x2 r = gelu2((f32x2){x[e], x[e + 1]}); x[e] = r.x; x[e + 1] = r.y; }
                    }
                    u32x4 w; w.x = pk2(x[0], x[1]); w.y = pk2(x[2], x[3]); w.z = pk2(x[4], x[5]); w.w = pk2(x[6], x[7]);
                    if (region == 1) {
                        bf16_t* vp = VT + ((size_t)(row >> 7) * 2048 + col) * 128 + (row & 127);
                        const unsigned ww[4] = {w.x, w.y, w.z, w.w};
#pragma unroll
                        for (int e = 0; e < 4; ++e) { vp[(2 * e) * 128] = (bf16_t)(ww[e] & 0xffffu); vp[(2 * e + 1) * 128] = (bf16_t)(ww[e] >> 16);
                            const float a = bflo(ww[e]), b = bfhi(ww[e]); s += a + b; q += a * a + b * b; }
                    } else {
                        bf16_t* dst = (region == 0 ? U : ZS) + (size_t)row * 2048 + col;
                        *(u32x4*)dst = w;
                    }
                }
                if (region == 1) {
                    s += __shfl_xor(s, 16); s += __shfl_xor(s, 32); q += __shfl_xor(q, 16); q += __shfl_xor(q, 32);
                    if (fq == 0) { const int slot = ((colt & 2047) >> 6) + wc; stat[(size_t)row * 64 + slot] = s; stat[(size_t)row * 64 + 32 + slot] = q; }
                }
            }
    }
};
struct EpiFoxIn {
    static constexpr bool PERM = true, AFTER_DRAIN = false;
    bf16_t* QB; bf16_t* KB; bf16_t* VB; bf16_t* ZS; float* okp; float* ovp; float* olp; float* oks; float* ovs; float* ols; const float* bf;
    __device__ __forceinline__ void operator()(const pg8::f32x4 (&acc)[2][2][4][2], const Unit& u, int wr, int wc, int fr_, int fq_) const {
        const int lane_ = otid() & 63, fr = lane_ & 15, fq = lane_ >> 4; (void)fr_; (void)fq_;
        const int row0 = u.pm * BM + wr * 64 + fr, colt = u.pn * BM, region = colt >> 11, cb = (colt & 2047) + wc * 32 + 8 * fq;
        if (region == 4) {
            if (wc != 0 || fq >= 2) return;
#pragma unroll
            for (int ai = 0; ai < 2; ++ai)
#pragma unroll
                for (int m = 0; m < 4; ++m) {
                    const int row = row0 + ai * HALF + m * 16; if (row >= MV) continue;
                    const pg8::f32x4 v0 = acc[ai][0][m][0], v1 = acc[ai][0][m][1];
                    const f32x4 b0 = *(const f32x4*)(bf + 8 * fq), b1 = *(const f32x4*)(bf + 8 * fq + 4);
                    f32x4 r0, r1;
#pragma unroll
                    for (int e = 0; e < 4; ++e) { r0[e] = logsig_f(v0[e] + b0[e]); r1[e] = logsig_f(v1[e] + b1[e]); }
                    float* dst = row < MP ? olp + (size_t)row * 16 + 8 * fq : ols + (size_t)(row - MP) * 16 + 8 * fq;
                    *(f32x4*)dst = r0; *(f32x4*)(dst + 4) = r1;
                }
            return;
        }
        bf16_t* B = region == 0 ? QB : region == 1 ? KB : region == 2 ? VB : ZS;
#pragma unroll
        for (int ai = 0; ai < 2; ++ai)
#pragma unroll
            for (int m = 0; m < 4; ++m) {
                const int row = row0 + ai * HALF + m * 16;
#pragma unroll
                for (int bj = 0; bj < 2; ++bj) {
                    const int col = cb + bj * HALF; pg8::f32x4 v0 = acc[ai][bj][m][0], v1 = acc[ai][bj][m][1];
                    if (region == 3) {
#pragma unroll
                        for (int e = 0; e < 4; e += 2) { const f32x2 r0 = silu2((f32x2){v0[e], v0[e + 1]}), r1 = silu2((f32x2){v1[e], v1[e + 1]}); v0[e] = r0.x; v0[e + 1] = r0.y; v1[e] = r1.x; v1[e + 1] = r1.y; }
                    }
                    u32x4 w; w.x = pk2(v0[0], v0[1]); w.y = pk2(v0[2], v0[3]); w.z = pk2(v1[0], v1[1]); w.w = pk2(v1[2], v1[3]);
                    *(u32x4*)(B + (size_t)row * 2048 + col) = w;
                    if ((region == 1 || region == 2) && row < MV) {
                        float* o = region == 1 ? (row < MP ? okp + (size_t)row * 2048 : oks + (size_t)(row - MP) * 2048) : (row < MP ? ovp + (size_t)row * 2048 : ovs + (size_t)(row - MP) * 2048);
                        *(pg8::f32x4*)(o + col) = v0; *(pg8::f32x4*)(o + col + 4) = v1;
                    }
                }
            }
    }
};
struct EpiT {
    static constexpr bool PERM = true, AFTER_DRAIN = false;
    bf16_t* O; int ldc;
    __device__ __forceinline__ void operator()(const pg8::f32x4 (&acc)[2][2][4][2], const Unit& u, int wr, int wc, int fr_, int fq_) const {
        const int lane_ = otid() & 63, fr = lane_ & 15, fq = lane_ >> 4; (void)fr_; (void)fq_;
        const int row0 = u.pm * BM + wr * 64 + fr, col0 = u.pn * BM + wc * 32 + 8 * fq;
#pragma unroll
        for (int ai = 0; ai < 2; ++ai)
#pragma unroll
            for (int m = 0; m < 4; ++m) { bf16_t* rp = O + (size_t)(row0 + ai * HALF + m * 16) * ldc + col0;
#pragma unroll
                for (int bj = 0; bj < 2; ++bj) { const pg8::f32x4 v0 = acc[ai][bj][m][0], v1 = acc[ai][bj][m][1];
                    u32x4 w; w.x = pk2(v0[0], v0[1]); w.y = pk2(v0[2], v0[3]); w.z = pk2(v1[0], v1[1]); w.w = pk2(v1[2], v1[3]);
                    *(u32x4*)(rp + bj * HALF) = w; } }
    }
};
struct EpiF32 {
    static constexpr bool PERM = true, AFTER_DRAIN = false;
    float* O; int ldc;
    __device__ __forceinline__ void operator()(const pg8::f32x4 (&acc)[2][2][4][2], const Unit& u, int wr, int wc, int fr_, int fq_) const {
        const int lane_ = otid() & 63, fr = lane_ & 15, fq = lane_ >> 4; (void)fr_; (void)fq_;
        const int row0 = u.pm * BM + wr * 64 + fr, col0 = u.pn * BM + wc * 32 + 8 * fq;
#pragma unroll
        for (int ai = 0; ai < 2; ++ai)
#pragma unroll
            for (int m = 0; m < 4; ++m) { float* rp = O + (size_t)(row0 + ai * HALF + m * 16) * ldc + col0;
#pragma unroll
                for (int bj = 0; bj < 2; ++bj) { *(pg8::f32x4*)(rp + bj * HALF) = acc[ai][bj][m][0]; *(pg8::f32x4*)(rp + bj * HALF + 4) = acc[ai][bj][m][1]; } }
    }
};
struct EpiPart {
    static constexpr bool PERM = true, AFTER_DRAIN = false;
    float* P;
    __device__ __forceinline__ void operator()(const pg8::f32x4 (&acc)[2][2][4][2], const Unit& u, int wr, int wc, int fr_, int fq_) const {
        const int lane_ = otid() & 63, fr = lane_ & 15, fq = lane_ >> 4; (void)fr_; (void)fq_;
        const int row0 = wr * 64 + fr, col0 = u.pn * BM + wc * 32 + 8 * fq; float* base = P + (size_t)(u.ko >> 8) * 256 * 1024;
#pragma unroll
        for (int ai = 0; ai < 2; ++ai)
#pragma unroll
            for (int m = 0; m < 4; ++m) { float* rp = base + (size_t)(row0 + ai * HALF + m * 16) * 1024 + col0;
#pragma unroll
                for (int bj = 0; bj < 2; ++bj) { *(pg8::f32x4*)(rp + bj * HALF) = acc[ai][bj][m][0]; *(pg8::f32x4*)(rp + bj * HALF + 4) = acc[ai][bj][m][1]; } }
    }
};
struct SplitOrder {
    int nsplit, c;
    __device__ bool next(int i, Unit& u) const { if (i != 0 || c >= 4 * nsplit) return false; u.pm = 128; u.pn = c & 3; u.ko = (c >> 2) * 256; return true; }
    __device__ __forceinline__ void a_ready(const Unit&) const {}
    __device__ __forceinline__ void done(const Unit&) const {}
};
struct EpiGate {
    static constexpr bool PERM = true, AFTER_DRAIN = false;
    const bf16_t* XB; float* Xo; const bf16_t* T; int f32out;
    __device__ __forceinline__ void operator()(const pg8::f32x4 (&acc)[2][2][4][2], const Unit& u, int wr, int wc, int fr_, int fq_) const {
        const int lane_ = otid() & 63, fr = lane_ & 15, fq = lane_ >> 4; (void)fr_; (void)fq_;
        const int row0 = u.pm * BM + wr * 64 + fr, col0 = u.pn * BM + wc * 32 + 8 * fq;
#pragma unroll
        for (int ai = 0; ai < 2; ++ai)
#pragma unroll
            for (int m = 0; m < 4; ++m) { const int row = row0 + ai * HALF + m * 16; if (row >= MV) continue;
#pragma unroll
                for (int bj = 0; bj < 2; ++bj) { const size_t off = (size_t)row * DM + col0 + bj * HALF;
                    const u32x4 t = *(const u32x4*)(T + off); const u32x4 xb = *(const u32x4*)(XB + off);
                    pg8::f32x4 x0 = {bflo(xb.x), bfhi(xb.x), bflo(xb.y), bfhi(xb.y)}, x1 = {bflo(xb.z), bfhi(xb.z), bflo(xb.w), bfhi(xb.w)};
                    const pg8::f32x4 a0 = acc[ai][bj][m][0], a1 = acc[ai][bj][m][1];
                    { const f32x2 s0 = sigm2((f32x2){a0[0], a0[1]}), s1 = sigm2((f32x2){a0[2], a0[3]}), s2 = sigm2((f32x2){a1[0], a1[1]}), s3 = sigm2((f32x2){a1[2], a1[3]});
                      x0[0] += s0.x * bflo(t.x); x0[1] += s0.y * bfhi(t.x); x0[2] += s1.x * bflo(t.y); x0[3] += s1.y * bfhi(t.y);
                      x1[0] += s2.x * bflo(t.z); x1[1] += s2.y * bfhi(t.z); x1[2] += s3.x * bflo(t.w); x1[3] += s3.y * bfhi(t.w); }
                    if (f32out) { *(pg8::f32x4*)(Xo + off) = x0; *(pg8::f32x4*)(Xo + off + 4) = x1; }
                    else { u32x4 w; w.x = pk2(x0[0], x0[1]); w.y = pk2(x0[2], x0[3]); w.z = pk2(x1[0], x1[1]); w.w = pk2(x1[2], x1[3]); *(u32x4*)((bf16_t*)Xo + off) = w; } } }
    }
};

__device__ __forceinline__ void cvt_wt(const float* __restrict__ W, bf16_t* __restrict__ Wt, int K, int N, int Npad, float* tile  ) {
    const int tid = otid(), ntn = Npad / 64, nt = ntn * (K / 64);
    for (int t = blockIdx.x; t < nt; t += gridDim.x) {
        const int n0 = (t % ntn) * 64, k0 = (t / ntn) * 64;
#pragma unroll
        for (int i = 0; i < 2; ++i) { const int kk = (tid >> 4) + 32 * i, n4 = (tid & 15) * 4;
            f32x4 v = {0.f, 0.f, 0.f, 0.f}; if (n0 + n4 < N) v = *(const f32x4*)(W + (size_t)(k0 + kk) * N + n0 + n4);
            tile[kk * 65 + n4] = v[0]; tile[kk * 65 + n4 + 1] = v[1]; tile[kk * 65 + n4 + 2] = v[2]; tile[kk * 65 + n4 + 3] = v[3]; }
        __syncthreads();
        { const int nn = tid >> 3, k8 = (tid & 7) * 8; u32x4 w;
          w.x = pk2(tile[(k8 + 0) * 65 + nn], tile[(k8 + 1) * 65 + nn]); w.y = pk2(tile[(k8 + 2) * 65 + nn], tile[(k8 + 3) * 65 + nn]);
          w.z = pk2(tile[(k8 + 4) * 65 + nn], tile[(k8 + 5) * 65 + nn]); w.w = pk2(tile[(k8 + 6) * 65 + nn], tile[(k8 + 7) * 65 + nn]);
          *(u32x4*)(Wt + (size_t)(n0 + nn) * K + k0 + k8) = w; }
        __syncthreads();
    }
}
__device__ __forceinline__ void prologue(const Args& a, float* tile) {
    unsigned char* ws = a.p->ws;
    for (int j = 0; j < 2; ++j) {
        cvt_wt(a.p->in[9] + (size_t)j * 1024 * 6144, (bf16_t*)(ws + WS_WGIN) + (size_t)j * 6144 * 1024, 1024, 6144, 6144, tile);
        cvt_wt(a.p->in[14] + (size_t)j * 2048 * 1024, (bf16_t*)(ws + WS_WGOUT) + (size_t)j * 1024 * 2048, 2048, 1024, 1024, tile);
        cvt_wt(a.p->in[15] + (size_t)j * 1024 * 8208, (bf16_t*)(ws + WS_WFIN) + (size_t)j * NFIN * 1024, 1024, 8208, NFIN, tile);
        cvt_wt(a.p->in[17] + (size_t)j * 2048 * 1024, (bf16_t*)(ws + WS_WFOUT) + (size_t)j * 1024 * 2048, 2048, 1024, 1024, tile);
    }
    for (int i = 0; i < 4; ++i) {
        cvt_wt(a.p->in[18] + (size_t)i * 256 * 1024, (bf16_t*)(ws + WS_WPP) + (size_t)i * 1024 * 256, 256, 1024, 1024, tile);
        cvt_wt(a.p->in[19] + (size_t)i * 1024 * 1024, (bf16_t*)(ws + WS_WPG) + (size_t)i * 1024 * 1024, 1024, 1024, 1024, tile);
    }
    const float* wsrc = a.p->in[12]; bf16_t* wm = (bf16_t*)(ws + WS_WM); bf16_t* wms = (bf16_t*)(ws + WS_WMS);
    for (int idx = blockIdx.x * 512 + otid(); idx < 2 * 16 * 128 * 128; idx += gridDim.x * 512) {
        const int jj = idx & 127, i = (idx >> 7) & 127, lg = idx >> 14;
        const float w = wsrc[idx]; wm[idx] = (bf16_t)f2bf((jj >> 6) <= (i >> 6) ? w : 0.f);
        const float w2 = wsrc[((size_t)lg * 128 + (i & 15)) * 128 + (jj & 15)]; wms[idx] = (bf16_t)f2bf((i >> 4) == (jj >> 4) ? w2 : 0.f);
    }
}

__device__ __forceinline__ void phase_e1(const Args& a, int layer) {
    const int tid = otid(), lane = tid & 63, gw = blockIdx.x * 8 + (tid >> 6), nw = gridDim.x * 8;
    float* X = a.p->out; bf16_t* X16 = (bf16_t*)a.p->out; bf16_t* HX = (bf16_t*)(a.p->ws + WS_HX); bf16_t* PB = (bf16_t*)(a.p->ws + WS_PB);
    const float* g = a.p->in[7] + (layer & 3) * DM;
    f32x4 gv[4];
#pragma unroll
    for (int q = 0; q < 4; ++q) gv[q] = *(const f32x4*)(g + q * 256 + lane * 4);
#define E1_LOAD(v, r) do { if (layer == 0) { _Pragma("unroll") for (int q = 0; q < 4; ++q) v[q] = *(const f32x4*)(a.p->in[0] + (size_t)(r) * DM + q * 256 + lane * 4); } \
        else { _Pragma("unroll") for (int q = 0; q < 4; ++q) { const u32x2 xb = *(const u32x2*)(X16 + (size_t)(r) * DM + q * 256 + lane * 4); v[q] = (f32x4){bflo(xb.x), bfhi(xb.x), bflo(xb.y), bfhi(xb.y)}; } } } while (0)
#define E1_FIN(v, r, p) do { float ss = 0.f; _Pragma("unroll") for (int q = 0; q < 4; ++q) ss += v[q][0] * v[q][0] + v[q][1] * v[q][1] + v[q][2] * v[q][2] + v[q][3] * v[q][3]; \
        ss = wave_sum(ss); const float rr = rsqrtf(ss * (1.f / DM) + RMS_EPS); \
        _Pragma("unroll") for (int q = 0; q < 4; ++q) { u32x2 hw; hw.x = pk2(v[q][0] * rr * gv[q][0], v[q][1] * rr * gv[q][1]); hw.y = pk2(v[q][2] * rr * gv[q][2], v[q][3] * rr * gv[q][3]); \
            *(u32x2*)(HX + (size_t)(r) * DM + q * 256 + lane * 4) = hw; } \
        u32x2 pw; pw.x = pk2(p[0], p[1]); pw.y = pk2(p[2], p[3]); *(u32x2*)(PB + (size_t)(r) * 256 + lane * 4) = pw; } while (0)
    if (layer < 4) {
        const float* pp = a.p->in[5] + (size_t)layer * MP * 256;
        for (int row = gw; row < MP; row += 2 * nw) {
            const int r1 = row + nw; const bool has1 = r1 < MP;
            f32x4 v0[4], v1[4]; f32x4 p0, p1 = {0.f, 0.f, 0.f, 0.f};
            E1_LOAD(v0, row); p0 = *(const f32x4*)(pp + (size_t)row * 256 + lane * 4);
            if (has1) { E1_LOAD(v1, r1); p1 = *(const f32x4*)(pp + (size_t)r1 * 256 + lane * 4); }
            E1_FIN(v0, row, p0);
            if (has1) E1_FIN(v1, r1, p1);
        }
    }
    for (int row = MP + gw; row < (layer == 4 ? MV : MA); row += nw) {
        if (row < MV) {
            f32x4 v[4];
            if (layer > 0) {
                const bf16_t* TBp = (const bf16_t*)(a.p->ws + WS_TB);
#pragma unroll
                for (int q = 0; q < 4; ++q) { const size_t off = (size_t)row * DM + q * 256 + lane * 4; const float* pq = (const float*)(a.p->ws + WS_PART) + (size_t)(row - MP) * 1024 + q * 256 + lane * 4;
                    f32x4 g4 = *(const f32x4*)pq;
#pragma unroll
                    for (int ks = 1; ks < 4; ++ks) g4 += *(const f32x4*)(pq + (size_t)ks * 256 * 1024);
                    const u32x2 xb = *(const u32x2*)(HX + off), tb = *(const u32x2*)(TBp + off);
                    v[q] = (f32x4){bflo(xb.x) + sigm_f(g4[0]) * bflo(tb.x), bfhi(xb.x) + sigm_f(g4[1]) * bfhi(tb.x), bflo(xb.y) + sigm_f(g4[2]) * bflo(tb.y), bfhi(xb.y) + sigm_f(g4[3]) * bfhi(tb.y)};
                    if (layer == 4) *(f32x4*)(X + off) = v[q]; else { u32x2 w; w.x = pk2(v[q][0], v[q][1]); w.y = pk2(v[q][2], v[q][3]); *(u32x2*)(X16 + off) = w; } }
                if (layer == 4) continue;
            } else {
#pragma unroll
                for (int q = 0; q < 4; ++q) v[q] = *(const f32x4*)(a.p->in[1] + (size_t)(row - MP) * DM + q * 256 + lane * 4);
            }
            const f32x4 p = *(const f32x4*)(a.p->in[6] + ((size_t)layer * MS + (row - MP)) * 256 + lane * 4);
            E1_FIN(v, row, p);
        } else {
#pragma unroll
            for (int q = 0; q < 4; ++q) *(u32x2*)(HX + (size_t)row * DM + q * 256 + lane * 4) = (u32x2){0u, 0u};
            *(u32x2*)(PB + (size_t)row * 256 + lane * 4) = (u32x2){0u, 0u};
        }
    }
#undef E1_LOAD
#undef E1_FIN
}
__device__ __forceinline__ void phase_e3(const Args& a, int layer, bool dummy = false) {
    const int tid = otid(), lane = tid & 63, gw = blockIdx.x * 8 + (tid >> 6), nw = gridDim.x * 8;
    const bf16_t* X16 = (const bf16_t*)a.p->out; bf16_t* HX = (bf16_t*)(a.p->ws + (dummy ? WS_DUMMY + 136 * MiB : WS_HX)); const bf16_t* OP = (const bf16_t*)(a.p->ws + WS_R0 + RSZ);
    const float* g = a.p->in[8] + layer * DM;
    f32x4 gv[4];
#pragma unroll
    for (int q = 0; q < 4; ++q) gv[q] = *(const f32x4*)(g + q * 256 + lane * 4);
#define E3_LOADX(XX, r, src0) do { if (layer == 0) { _Pragma("unroll") for (int q = 0; q < 4; ++q) XX[q] = *(const f32x4*)((src0) + q * 256 + lane * 4); } \
        else { _Pragma("unroll") for (int q = 0; q < 4; ++q) { const u32x2 xb = *(const u32x2*)(X16 + (size_t)(r) * DM + q * 256 + lane * 4); XX[q] = (f32x4){bflo(xb.x), bfhi(xb.x), bflo(xb.y), bfhi(xb.y)}; } } } while (0)
#define E3_FIN(v, XX, r) do { float ss = 0.f; _Pragma("unroll") for (int q = 0; q < 4; ++q) ss += v[q][0] * v[q][0] + v[q][1] * v[q][1] + v[q][2] * v[q][2] + v[q][3] * v[q][3]; \
        ss = wave_sum(ss); const float rr = rsqrtf(ss * (1.f / DM) + RMS_EPS); \
        _Pragma("unroll") for (int q = 0; q < 4; ++q) { u32x2 hw; hw.x = pk2(XX[q][0] + v[q][0] * rr * gv[q][0], XX[q][1] + v[q][1] * rr * gv[q][1]); hw.y = pk2(XX[q][2] + v[q][2] * rr * gv[q][2], XX[q][3] + v[q][3] * rr * gv[q][3]); \
            *(u32x2*)(HX + (size_t)(r) * DM + q * 256 + lane * 4) = hw; } } while (0)
#define E3_LOADOP(v, r) do { _Pragma("unroll") for (int q = 0; q < 4; ++q) { const u32x2 ob = *(const u32x2*)(OP + (size_t)(r) * DM + q * 256 + lane * 4); v[q] = (f32x4){bflo(ob.x), bfhi(ob.x), bflo(ob.y), bfhi(ob.y)}; } } while (0)
    for (int row = gw; row < MP; row += 2 * nw) {
        const int r1 = row + nw; const bool has1 = r1 < MP;
        f32x4 v0[4], x0[4], v1[4], x1[4];
        E3_LOADOP(v0, row); E3_LOADX(x0, row, a.p->in[0] + (size_t)row * DM);
        if (has1) { E3_LOADOP(v1, r1); E3_LOADX(x1, r1, a.p->in[0] + (size_t)r1 * DM); }
        E3_FIN(v0, x0, row);
        if (has1) E3_FIN(v1, x1, r1);
    }
    for (int row = MP + gw; row < MA; row += nw) {
        if (row < MV) {
            f32x4 v[4], x[4];
#pragma unroll
            for (int q = 0; q < 4; ++q) { const float* pq = (const float*)(a.p->ws + WS_PART) + (size_t)(row - MP) * 1024 + q * 256 + lane * 4; v[q] = *(const f32x4*)pq;
#pragma unroll
                for (int ks = 1; ks < 8; ++ks) v[q] += *(const f32x4*)(pq + (size_t)ks * 256 * 1024); }
            E3_LOADX(x, row, a.p->in[1] + (size_t)(row - MP) * DM);
            E3_FIN(v, x, row);
        } else {
#pragma unroll
            for (int q = 0; q < 4; ++q) *(u32x2*)(HX + (size_t)row * DM + q * 256 + lane * 4) = (u32x2){0u, 0u};
        }
    }
#undef E3_LOADX
#undef E3_FIN
#undef E3_LOADOP
}

__device__ __forceinline__ void phase_s1(const Args& a, int j, unsigned char* lds, bool dummy = false) {
    constexpr int LP = 136;
    bf16_t* As = (bf16_t*)lds; bf16_t* Bs = As + 128 * LP; float* fl = (float*)(Bs + 128 * LP);
    float* mu = fl, * rs = fl + 128, * t1 = fl + 256, * t2 = fl + 384;
    const int tid = otid(), lane = tid & 63, wid = tid >> 6, fr = lane & 15, fq = lane >> 4;
    const bf16_t* U = (const bf16_t*)(a.p->ws + WS_R0); bf16_t* Uo = (bf16_t*)(a.p->ws + (dummy ? WS_DUMMY : WS_R0)); const bf16_t* VT = (const bf16_t*)(a.p->ws + WS_R0 + RSZ); const bf16_t* ZS = (const bf16_t*)(a.p->ws + WS_R0 + 2 * RSZ);
    const float* stat = (const float*)(a.p->ws + WS_STAT);
    const float* lng_g = a.p->in[10] + j * EB; const float* lnb_g = a.p->in[11] + j * EB; const float* bsv_g = a.p->in[13] + j * 16 * 128;
    float* lng = fl + 512; float* lnb = lng + EB; float* bsv = lnb + EB;
    { *(f32x4*)(lng + tid * 4) = *(const f32x4*)(lng_g + tid * 4); *(f32x4*)(lnb + tid * 4) = *(const f32x4*)(lnb_g + tid * 4); *(f32x4*)(bsv + tid * 4) = *(const f32x4*)(bsv_g + tid * 4); }
    __syncthreads();
    float* gvs = a.p->out + O_GV + (size_t)j * MS * EB;
    constexpr int NU = 257 * 16;
    const int G_ = gridDim.x, w_ = blockIdx.x;
#define S1_UNIT(k) ((G_ == 256) ? ((k) < 16 ? w_ * 16 + (((k) + w_) & 15) :     ((k) == 16 && w_ < 16 ? 4096 + w_ : NU)) : (w_ + (k) * G_))
#define S1_LOAD_AB(u_) do { const int blk_ = (u_) >> 4, g_ = (u_) & 15; \
        const bf16_t* wsrc_ = (const bf16_t*)(a.p->ws + (blk_ == 256 ? WS_WMS : WS_WM)) + ((size_t)(j * 16 + g_) * 128) * 128; const bf16_t* vsrc_ = VT + ((size_t)blk_ * 2048 + g_ * 128) * 128; \
        _Pragma("unroll") for (int q = 0; q < 4; ++q) { ar[q] = *(const u32x4*)(wsrc_ + (tid >> 2) * 128 + (tid & 3) * 32 + q * 8); br[q] = *(const u32x4*)(vsrc_ + (tid >> 2) * 128 + (tid & 3) * 32 + q * 8); } } while (0)
    int un = S1_UNIT(0);
    if (un >= NU) return;
    u32x4 ar[4], br[4];
    S1_LOAD_AB(un);
    int prev_blk = -1;
    for (int k = 0;; ++k) {
        const int blk = un >> 4, g = un & 15, issamp = blk == 256;
        if (blk != prev_blk) {
          { const int r_ = tid >> 2, p_ = tid & 3; const float* sp = stat + (size_t)(blk * 128 + r_) * 64 + p_ * 8;
          const f32x4 s0 = *(const f32x4*)sp, s1 = *(const f32x4*)(sp + 4), q0 = *(const f32x4*)(sp + 32), q1 = *(const f32x4*)(sp + 36);
          float s = ((s0[0] + s0[1]) + (s0[2] + s0[3])) + ((s1[0] + s1[1]) + (s1[2] + s1[3])), q = ((q0[0] + q0[1]) + (q0[2] + q0[3])) + ((q1[0] + q1[1]) + (q1[2] + q1[3]));
          s += __shfl_xor(s, 1); s += __shfl_xor(s, 2); q += __shfl_xor(q, 1); q += __shfl_xor(q, 2);
          if (p_ == 0) { const float m = s * (1.f / EB); const float var = fmaxf(q * (1.f / EB) - m * m, 0.f); mu[r_] = m; rs[r_] = rsqrtf(var + LN_EPS); } }
          __syncthreads(); prev_blk = blk;
        }
        { const int i = tid >> 2, part = tid & 3; float a1 = 0.f, a2 = 0.f;
#pragma unroll
          for (int q = 0; q < 4; ++q) { const int j0 = part * 32 + q * 8; const u32x4 w = ar[q]; const unsigned ww[4] = {w.x, w.y, w.z, w.w}; float o[8];
#pragma unroll
              for (int e = 0; e < 4; ++e) { const float w0 = bflo(ww[e]), w1 = bfhi(ww[e]); const float r0 = rs[j0 + 2 * e], r1 = rs[j0 + 2 * e + 1];
                  o[2 * e] = w0 * r0; o[2 * e + 1] = w1 * r1; a1 += w0 * r0 * mu[j0 + 2 * e] + w1 * r1 * mu[j0 + 2 * e + 1]; a2 += w0 + w1; }
              u32x4 ow; ow.x = pk2(o[0], o[1]); ow.y = pk2(o[2], o[3]); ow.z = pk2(o[4], o[5]); ow.w = pk2(o[6], o[7]);
              *(u32x4*)(As + i * LP + j0) = ow; *(u32x4*)(Bs + i * LP + j0) = br[q]; }
          a1 += __shfl_xor(a1, 1); a1 += __shfl_xor(a1, 2); a2 += __shfl_xor(a2, 1); a2 += __shfl_xor(a2, 2);
          if (part == 0) { t1[i] = a1; t2[i] = a2; }
        }
        __syncthreads();
        const int un_next = S1_UNIT(k + 1); const bool has_next = un_next < NU;
        if (has_next) S1_LOAD_AB(un_next);
        const int i0 = (wid >> 1) * 32, c0 = (wid & 1) * 64;
        f32x4 acc[2][4];
#pragma unroll
        for (int mt = 0; mt < 2; ++mt)
#pragma unroll
            for (int nt = 0; nt < 4; ++nt) acc[mt][nt] = (f32x4){0.f, 0.f, 0.f, 0.f};
#pragma unroll
        for (int kk = 0; kk < 4; ++kk) {
            bf16x8 af[2], bfr[4];
#pragma unroll
            for (int mt = 0; mt < 2; ++mt) af[mt] = *(const bf16x8*)(As + (i0 + mt * 16 + fr) * LP + kk * 32 + fq * 8);
#pragma unroll
            for (int nt = 0; nt < 4; ++nt) bfr[nt] = *(const bf16x8*)(Bs + (c0 + nt * 16 + fr) * LP + kk * 32 + fq * 8);
#pragma unroll
            for (int mt = 0; mt < 2; ++mt)
#pragma unroll
                for (int nt = 0; nt < 4; ++nt) acc[mt][nt] = __builtin_amdgcn_mfma_f32_16x16x32_bf16(bfr[nt], af[mt], acc[mt][nt], 0, 0, 0);
        }
        const int ei = tid >> 2, ec = (tid & 3) * 32; const size_t erow = (size_t)blk * 128 + ei;
        u32x4 uu[4], zz[4];
#pragma unroll
        for (int q = 0; q < 4; ++q) { uu[q] = *(const u32x4*)(U + erow * EB + g * 128 + ec + q * 8); zz[q] = *(const u32x4*)(ZS + erow * EB + g * 128 + ec + q * 8); }
        if (issamp) {
            for (int idx = tid; idx < 128 * 128; idx += 512) { const int c = idx & 127, i = idx >> 7; const float v = __uint_as_float((unsigned)Bs[c * LP + i] << 16);
                gvs[(size_t)i * EB + g * 128 + c] = (v - mu[i]) * rs[i] * lng[g * 128 + c] + lnb[g * 128 + c]; }
        }
        __syncthreads();
        float* S32 = (float*)lds; constexpr int SP = 132;
#pragma unroll
        for (int mt = 0; mt < 2; ++mt)
#pragma unroll
            for (int nt = 0; nt < 4; ++nt) *(f32x4*)(S32 + (i0 + mt * 16 + fr) * SP + c0 + nt * 16 + fq * 4) = acc[mt][nt];
        __syncthreads();
        { const float t1i = t1[ei], t2i = t2[ei], bi = bsv[g * 128 + (issamp ? (ei & 15) : ei)];
#pragma unroll
          for (int q = 0; q < 4; ++q) { const int cg = g * 128 + ec + q * 8;
              const f32x4 sa = *(const f32x4*)(S32 + ei * SP + ec + q * 8), sb = *(const f32x4*)(S32 + ei * SP + ec + q * 8 + 4);
              const f32x4 lga = *(const f32x4*)(lng + cg), lgb = *(const f32x4*)(lng + cg + 4), lba = *(const f32x4*)(lnb + cg), lbb = *(const f32x4*)(lnb + cg + 4);
              float s[8];
#pragma unroll
              for (int e = 0; e < 4; ++e) { s[e] = lga[e] * (sa[e] - t1i) + lba[e] * t2i + bi; s[4 + e] = lgb[e] * (sb[e] - t1i) + lbb[e] * t2i + bi; }
              const unsigned u4[4] = {uu[q].x, uu[q].y, uu[q].z, uu[q].w}, z4[4] = {zz[q].x, zz[q].y, zz[q].z, zz[q].w}; unsigned y4[4];
#pragma unroll
              for (int e = 0; e < 4; ++e) y4[e] = pk2(bflo(u4[e]) * s[2 * e] * bflo(z4[e]), bfhi(u4[e]) * s[2 * e + 1] * bfhi(z4[e]));
              *(u32x4*)(Uo + erow * EB + cg) = (u32x4){y4[0], y4[1], y4[2], y4[3]}; } }
        __syncthreads();
        if (!has_next) break;
        un = un_next;
    }
#undef S1_UNIT
#undef S1_LOAD_AB
}

__device__ __forceinline__ void phase_c1(const Args& a, int j) {
    const int tid = otid(); if ((tid >> 6) != 0) return;
    const int lane = tid & 63;
    for (int sq = blockIdx.x; sq < 256; sq += gridDim.x) {
        if (sq < 128) {
            const int b = sq >> 4, h = sq & 15; const float* src = a.p->out + O_FLP + ((size_t)j * MP + (size_t)b * SEQ) * 16 + h; float* dst = (float*)(a.p->ws + WS_CBP) + (size_t)sq * SEQ;
            float tot = 0.f; for (int s = 0; s < 64; ++s) tot += src[(size_t)(lane * 64 + s) * 16];
            float inc = tot; for (int o = 1; o < 64; o <<= 1) { const float t = __shfl_up(inc, o); if (lane >= o) inc += t; }
            float run = inc - tot;
            for (int s = 0; s < 64; ++s) { run += src[(size_t)(lane * 64 + s) * 16];
                dst[lane * 64 + (((s >> 2) & 1) * 32 + ((s >> 3) & 3) * 4 + (s & 3) + 16 * (s >> 5))] = -run * 11.313708498984761f; }
        } else {
            const int bh = sq - 128, b = bh >> 4, h = bh & 15; const float* c0 = a.p->in[4] + ((size_t)(j * 8 + b) * PAST) * 16 + h; const float* c1 = a.p->out + O_FLS + ((size_t)j * MS + b * TS) * 16 + h;
            float* dst = (float*)(a.p->ws + WS_CBS) + (size_t)bh * SKS;
            float tot = 0.f; for (int s = 0; s < 33; ++s) { const int k = lane * 33 + s; const float v = k < PAST ? c0[(size_t)k * 16] : (k < PAST + TS ? c1[(size_t)(k - PAST) * 16] : 0.f); tot += v; }
            float inc = tot; for (int o = 1; o < 64; o <<= 1) { const float t = __shfl_up(inc, o); if (lane >= o) inc += t; }
            float run = inc - tot;
            for (int s = 0; s < 33; ++s) { const int k = lane * 33 + s; const float v = k < PAST ? c0[(size_t)k * 16] : (k < PAST + TS ? c1[(size_t)(k - PAST) * 16] : 0.f); run += v; dst[k] = -run; }
        }
    }
}

__device__ __forceinline__ void sample_attn(const Args& a, int j, int bh, unsigned char* ldsb, bool dummy = false) {
    constexpr int PP = 136;
    float* wmx = (float*)ldsb;
    bf16_t* Pb = (bf16_t*)(ldsb + 1024);
    float* lfin = (float*)(ldsb + 1024 + 2 * 16 * PP * 2);
    const int tid = otid(), lane = tid & 63, wid = __builtin_amdgcn_readfirstlane(tid >> 6), fr = lane & 15, fq = lane >> 4, b = bh >> 4, h = bh & 15;
    const bf16_t* Qb = (const bf16_t*)(a.p->ws + WS_R0); const bf16_t* ZS = (const bf16_t*)(a.p->ws + WS_R0 + 3 * RSZ); bf16_t* O = (bf16_t*)(a.p->ws + (dummy ? WS_DUMMY : WS_R0));
    const float* ck = a.p->in[2] + (size_t)(j * 8 + b) * PAST * EB + h * 128; const float* cv = a.p->in[3] + (size_t)(j * 8 + b) * PAST * EB + h * 128;
    const float* nk = a.p->out + O_FKS + ((size_t)j * MS + b * TS) * EB + h * 128; const float* nv = a.p->out + O_FVS + ((size_t)j * MS + b * TS) * EB + h * 128;
    const float* cb = (const float*)(a.p->ws + WS_CBS) + (size_t)bh * SKS;
    bf16x8 qf[4];
#pragma unroll
    for (int kk = 0; kk < 4; ++kk) qf[kk] = *(const bf16x8*)(Qb + (size_t)(MP + b * TS + fr) * EB + h * 128 + kk * 32 + fq * 8);
    const int kl = 16 * wid + fr;
    float m[4], ls[4]; f32x4 oacc = {0.f, 0.f, 0.f, 0.f};
#pragma unroll
    for (int r = 0; r < 4; ++r) { m[r] = -1e30f; ls[r] = 0.f; }
    f32x4 kr[8];
#pragma unroll
    for (int q = 0; q < 8; ++q) kr[q] = *(const f32x4*)(ck + (size_t)kl * EB + (q >> 1) * 32 + fq * 8 + (q & 1) * 4);
    int buf = 0;
    for (int c = 0; c < 17; ++c) {
        float vr[32];
        if (c < 16) {
#pragma unroll
            for (int q = 0; q < 32; ++q) vr[q] = cv[(size_t)(c * 128 + (q >> 3) * 32 + fq * 8 + (q & 7)) * EB + 16 * wid + fr];
        } else {
#pragma unroll
            for (int q = 0; q < 32; ++q) { const int key = (q >> 3) * 32 + fq * 8 + (q & 7); vr[q] = key < TS ? nv[(size_t)key * EB + 16 * wid + fr] : 0.f; }
        }
        const float bias = c < 16 ? cb[c * 128 + kl] : (kl < TS ? cb[PAST + kl] : 0.f);
        f32x4 sacc = {0.f, 0.f, 0.f, 0.f};
#pragma unroll
        for (int kk = 0; kk < 4; ++kk) { const f32x4 x0 = kr[2 * kk], x1 = kr[2 * kk + 1];
            u32x4 w; w.x = pk2(x0[0], x0[1]); w.y = pk2(x0[2], x0[3]); w.z = pk2(x1[0], x1[1]); w.w = pk2(x1[2], x1[3]);
            sacc = __builtin_amdgcn_mfma_f32_16x16x32_bf16(qf[kk], __builtin_bit_cast(bf16x8, w), sacc, 0, 0, 0); }
        if (c + 1 < 16) {
#pragma unroll
            for (int q = 0; q < 8; ++q) kr[q] = *(const f32x4*)(ck + (size_t)((c + 1) * 128 + kl) * EB + (q >> 1) * 32 + fq * 8 + (q & 1) * 4);
        } else if (c + 1 == 16) {
#pragma unroll
            for (int q = 0; q < 8; ++q) kr[q] = kl < TS ? *(const f32x4*)(nk + (size_t)kl * EB + (q >> 1) * 32 + fq * 8 + (q & 1) * 4) : (f32x4){0.f, 0.f, 0.f, 0.f};
        }
        float s[4], mw[4];
#pragma unroll
        for (int r = 0; r < 4; ++r) { s[r] = sacc[r] * att::SCALE + bias; if (c == 16 && (kl >= TS || kl > 4 * fq + r)) s[r] = -__builtin_inff(); mw[r] = s[r]; }
#pragma unroll
        for (int o = 1; o < 16; o <<= 1) {
#pragma unroll
            for (int r = 0; r < 4; ++r) mw[r] = fmaxf(mw[r], __shfl_xor(mw[r], o)); }
        if (fr == 0) {
#pragma unroll
            for (int r = 0; r < 4; ++r) wmx[buf * 128 + (4 * fq + r) * 8 + wid] = mw[r]; }
        __syncthreads();
        float p[4];
#pragma unroll
        for (int r = 0; r < 4; ++r) { const f32x4 w0 = *(const f32x4*)(wmx + buf * 128 + (4 * fq + r) * 8), w1 = *(const f32x4*)(wmx + buf * 128 + (4 * fq + r) * 8 + 4);
            const float mc = fmaxf(fmaxf(fmaxf(w0[0], w0[1]), fmaxf(w0[2], w0[3])), fmaxf(fmaxf(w1[0], w1[1]), fmaxf(w1[2], w1[3])));
            const float mn = fmaxf(m[r], mc), al = __expf(m[r] - mn); m[r] = mn; p[r] = __expf(s[r] - mn); ls[r] = ls[r] * al + p[r]; oacc[r] *= al;
            Pb[buf * 16 * PP + (4 * fq + r) * PP + kl] = (bf16_t)f2bf(p[r]); }
        __syncthreads();
#pragma unroll
        for (int kk = 0; kk < 4; ++kk) { const bf16x8 pa = *(const bf16x8*)(Pb + buf * 16 * PP + fr * PP + kk * 32 + fq * 8);
            u32x4 w; w.x = pk2(vr[kk * 8 + 0], vr[kk * 8 + 1]); w.y = pk2(vr[kk * 8 + 2], vr[kk * 8 + 3]); w.z = pk2(vr[kk * 8 + 4], vr[kk * 8 + 5]); w.w = pk2(vr[kk * 8 + 6], vr[kk * 8 + 7]);
            oacc = __builtin_amdgcn_mfma_f32_16x16x32_bf16(pa, __builtin_bit_cast(bf16x8, w), oacc, 0, 0, 0); }
        buf ^= 1;
    }
#pragma unroll
    for (int o = 1; o < 16; o <<= 1) {
#pragma unroll
        for (int r = 0; r < 4; ++r) ls[r] += __shfl_xor(ls[r], o); }
    if (fr == 0) {
#pragma unroll
        for (int r = 0; r < 4; ++r) lfin[wid * 16 + 4 * fq + r] = ls[r]; }
    __syncthreads();
#pragma unroll
    for (int r = 0; r < 4; ++r) { const int i = 4 * fq + r; float l = 0.f;
#pragma unroll
        for (int w = 0; w < 8; ++w) l += lfin[w * 16 + i];
        const size_t off = (size_t)(MP + b * TS + i) * EB + h * 128 + 16 * wid + fr;
        const float z = __uint_as_float((unsigned)ZS[off] << 16); O[off] = (bf16_t)f2bf(oacc[r] / l * z); }
    __syncthreads();
}

__device__ __forceinline__ void phase_attn(const Args& a, int j, unsigned char* ldsb, int mode = 0) {
    using namespace att;
    typedef __hip_bfloat16 T;
    const T* Q = (const T*)(a.p->ws + WS_R0); const T* K = (const T*)(a.p->ws + WS_R0 + RSZ); const T* V = (const T*)(a.p->ws + WS_R0 + 2 * RSZ); const T* Z = (const T*)(a.p->ws + WS_R0 + 3 * RSZ); T* O = (T*)(a.p->ws + (mode == 1 ? WS_DUMMY : WS_R0));
    const float* CB = (const float*)(a.p->ws + WS_CBP);
    char* lds = (char*)ldsb;
    constexpr int nqb = SEQ / QB, nx = nqb / 2, total = nx * NBH;
    const int stride = gridDim.x;
    int L = (gridDim.x == 256) ? (int)((blockIdx.x & 7) * 32 + (blockIdx.x >> 3)) : (int)blockIdx.x;
    if (mode == 2) L = total;
    if (L < total) {
#define MKREF(r, L_, pass_) do { const int bh_ = (L_) / nx, x_ = (L_) - bh_ * nx, qb_ = (pass_) ? x_ : nqb - 1 - x_,     b_ = bh_ >> 4, h_ = bh_ & 15; \
        const size_t ro_ = ((size_t)b_ * SEQ + (size_t)qb_ * QB) * PITCH + h_ * 128, ko_ = ((size_t)b_ * SEQ) * PITCH + h_ * 128; \
        (r).Q = Q + ro_; (r).O = O + ro_; (r).Z = Z + ro_; (r).K = K + ko_; (r).V = V + ko_; (r).CB = CB + (size_t)bh_ * SEQ; (r).P0 = qb_ * QB; } while (0)
        BlockRef<T, T> cur, nxt; int pass = 0;
        MKREF(cur, L, 0);
        Seam<T> S;
        causal_swa_prime<T, T>(cur, SEQ, lds, S);
        for (;;) {
            const bool more_pass = pass == 0, more_item = L + stride < total, last = !more_pass && !more_item;
            int passn = pass + 1, Ln = L;
            if (!more_pass) { passn = 0; Ln = more_item ? L + stride : L; }
            if (last) nxt = cur; else MKREF(nxt, Ln, passn);
            causal_swa_block<T, T>(cur, nxt, SEQ, SEQ, lds, S);
            if (last) break;
            cur = nxt; pass = passn; L = Ln;
        }
#undef MKREF
    }
    __syncthreads();
    if (mode != 1) for (int bh = (int)gridDim.x - 1 - (int)blockIdx.x; bh < NBH; bh += gridDim.x) sample_attn(a, j, bh, ldsb, mode == 2);
}

#define XB_TMO      128
#define XB_XCNT(j)  (256  + 64 * (j))
#define XB_XSUB(j)  (1280 + 64 * (j))
#define XB_XGEN(j)  (2304 + 64 * (j))
#define XB_TOP      3328
#define XB_TOPGEN   3392
#define XCD_BAR_WORDS 3456
#define XB_SPIN_CAP (1u << 18)

__device__ __forceinline__ unsigned xb_ld(unsigned* p)              { return __hip_atomic_load(p, __ATOMIC_RELAXED, __HIP_MEMORY_SCOPE_AGENT); }
__device__ __forceinline__ unsigned xb_add(unsigned* p, unsigned v) { return __hip_atomic_fetch_add(p, v, __ATOMIC_RELAXED, __HIP_MEMORY_SCOPE_AGENT); }
__device__ __forceinline__ unsigned xb_xcc_id() { return (unsigned)__builtin_amdgcn_s_getreg((3 << 11) | 20) & 0xFu; }
#define XB_SPIN(cond, bar) do { unsigned _sp = 0; while (cond) { __builtin_amdgcn_s_sleep(1); \
    if ((++_sp & 255u) == 0u) { if (xb_ld(&(bar)[XB_TMO])) break; if (_sp > XB_SPIN_CAP) { atomicAdd(&(bar)[XB_TMO], 1u); break; } } } } while (0)

struct XcdBarrier {
    unsigned* bar; unsigned x;
    volatile LAS unsigned* st;
};

__device__ __forceinline__ XcdBarrier xcd_barrier_post(unsigned* bar, volatile LAS unsigned* st) {
    XcdBarrier b; b.bar = bar; b.x = xb_xcc_id(); b.st = st;
    if (otid() == 0) (void)xb_add(&bar[XB_XCNT(b.x)], 1u);
    return b;
}
__device__ __forceinline__ void xcd_barrier_complete(unsigned* bar, unsigned x, unsigned& nloc, unsigned& nx) {
    const unsigned G = gridDim.x * gridDim.y * gridDim.z;
    unsigned sum, cnt, mine, sp = 0u;
    for (;;) {
        sum = 0u; cnt = 0u; mine = 0u;
#pragma unroll
        for (unsigned j = 0; j < 16; ++j) { const unsigned c = xb_ld(&bar[XB_XCNT(j)]); sum += c; cnt += (c > 0u) ? 1u : 0u; mine = (j == x) ? c : mine; }
        if (sum == G) break;
        __builtin_amdgcn_s_sleep(1);
        if ((++sp & 255u) == 0u) { if (xb_ld(&bar[XB_TMO])) break; if (sp > XB_SPIN_CAP) { atomicAdd(&bar[XB_TMO], 1u); break; } }
    }
    nloc = mine > 0u ? mine : 1u; nx = cnt > 0u ? cnt : 1u;
}

__device__ __forceinline__ void xcd_barrier(const XcdBarrier& b) {
    asm volatile("s_waitcnt vmcnt(0)" ::: "memory");
    __syncthreads();
    if (otid() == 0) {
        unsigned* bar = b.bar;
        __builtin_amdgcn_s_waitcnt(0);
        unsigned nloc = b.st[0], nx = b.st[1];
        if (nloc == 0u) { xcd_barrier_complete(bar, b.x, nloc, nx); b.st[0] = nloc; b.st[1] = nx; }
        const unsigned old = xb_add(&bar[XB_XSUB(b.x)], 1u);
        const unsigned gen = old / nloc;
        if (old + 1u == (gen + 1u) * nloc) {
            __builtin_amdgcn_fence(__ATOMIC_RELEASE, "agent");
            asm volatile("s_waitcnt vmcnt(0)" ::: "memory");
            const unsigned og = xb_add(&bar[XB_TOP], 1u);
            const unsigned tg = og / nx;
            if (og + 1u == (tg + 1u) * nx) xb_add(&bar[XB_TOPGEN], 1u);
            else XB_SPIN(xb_ld(&bar[XB_TOPGEN]) == tg, bar);
            __builtin_amdgcn_fence(__ATOMIC_ACQUIRE, "agent");
            xb_add(&bar[XB_XGEN(b.x)], 1u);
            asm volatile("s_waitcnt vmcnt(0)" ::: "memory");
        } else {
            XB_SPIN(xb_ld(&bar[XB_XGEN(b.x)]) == gen, bar);
            __builtin_amdgcn_fence(__ATOMIC_ACQUIRE, "agent");
            asm volatile("s_waitcnt vmcnt(0)" ::: "memory");
        }
    }
    __syncthreads();
}
#define WSPTRS() const Args a = getargs(); unsigned char* ws = a.p->ws; (void)ws; \
    bf16_t* HX = (bf16_t*)(ws + WS_HX); bf16_t* TB = (bf16_t*)(ws + WS_TB); bf16_t* PB = (bf16_t*)(ws + WS_PB); (void)HX; (void)TB; (void)PB; \
    bf16_t* R0 = (bf16_t*)(ws + WS_R0); bf16_t* R1 = (bf16_t*)(ws + WS_R0 + RSZ); bf16_t* R2 = (bf16_t*)(ws + WS_R0 + 2 * RSZ); bf16_t* R3 = (bf16_t*)(ws + WS_R0 + 3 * RSZ); (void)R0; (void)R1; (void)R2; (void)R3;
#define XBAR_MK() XcdBarrier xb_; xb_.bar = (unsigned*)(getargs().p->ws) + 1024; xb_.x = xb_xcc_id(); xb_.st = (volatile LAS unsigned*)((LAS unsigned char*)lds + (LDS_BYTES - 64))
#if PROBE_DUP == 7
#define GSYNC() do { XBAR_MK(); xcd_barrier(xb_); xcd_barrier(xb_); } while (0)
#else
#define GSYNC() do { XBAR_MK(); xcd_barrier(xb_); } while (0)
#endif
__global__ void __launch_bounds__(512, 2) fwd_megakernel(ArgsS args_unused) {
    extern __shared__ __attribute__((aligned(16))) unsigned char lds[];
    cg::grid_group grid = cg::this_grid();
    PG8_LAS unsigned char* gl = (PG8_LAS unsigned char*)lds;
    const int G = gridDim.x, c = blockIdx.x;
    { const unsigned hw = (unsigned)__builtin_amdgcn_s_getreg((5 << 11) | 4) & 63u;
      if ((threadIdx.x & 63) == 0) ((LAS int*)((LAS unsigned char*)lds + LDS_WIDTAB))[hw] = (int)(threadIdx.x >> 6);
      if (threadIdx.x < 16) ((LAS unsigned*)((LAS unsigned char*)lds + (LDS_BYTES - 64)))[threadIdx.x] = 0u; }
    __syncthreads();
    { XBAR_MK(); (void)xcd_barrier_post(xb_.bar, xb_.st); }
#ifndef SKIP_PRO
    { const Args a = getargs(); prologue(a, (float*)lds); }
#endif
    { const Args a = getargs(); if (a.p->ws == nullptr) grid.sync(); }
    GSYNC();
    for (int layer = 0; layer < 4; ++layer) {
        const int j = layer >> 1;
#ifndef SKIP_E1
        for (int rp_ = (PROBE_DUP == 4 ? 0 : 1); rp_ < 2; ++rp_) { const Args a = getargs(); phase_e1(a, layer); if (!rp_) GSYNC(); }
#endif
        GSYNC();
        if ((layer & 1) == 0) {
#ifndef SKIP_G1G
            { WSPTRS(); pg8::Gemm g{HX, (const bf16_t*)(ws + WS_WGIN) + (size_t)j * 6144 * 1024, MA, 6144, 1024}; pg8::StaticOrder S; S.init(MA, 6144, G, c);
              EpiGmlpIn E{R0, R1, R2, (float*)(ws + WS_STAT)};
              for (int rp_ = 0; rp_ < (PROBE_DUP == 5 ? 2 : 1); ++rp_) pg8::gemm_phase<EpiGmlpIn, pg8::StaticOrder, true, true>(gl, g, S, E); }
#endif
        } else {
#ifndef SKIP_G1F
            { WSPTRS(); pg8::Gemm g{HX, (const bf16_t*)(ws + WS_WFIN) + (size_t)j * NFIN * 1024, MA, NFIN, 1024}; pg8::StaticOrder S; S.init(MA, NFIN, G, c);
              float* out = a.p->out;
              EpiFoxIn E{R0, R1, R2, R3, out + O_FKP + (size_t)j * MP * EB, out + O_FVP + (size_t)j * MP * EB, out + O_FLP + (size_t)j * MP * 16,
                         out + O_FKS + (size_t)j * MS * EB, out + O_FVS + (size_t)j * MS * EB, out + O_FLS + (size_t)j * MS * 16, a.p->in[16] + j * 16};
              for (int rp_ = 0; rp_ < (PROBE_DUP == 5 ? 2 : 1); ++rp_) pg8::gemm_phase<EpiFoxIn, pg8::StaticOrder, true, true>(gl, g, S, E); }
#endif
        }
#ifndef SKIP_GT
        { WSPTRS(); pg8::Gemm g{PB, (const bf16_t*)(ws + WS_WPP) + (size_t)layer * 1024 * 256, MA, 1024, 256}; const int nb_ = (layer & 1) ? 0 : 24;
          pg8::StaticOrder S; S.init(MA, 1024, G - nb_, c >= nb_ ? G - 1 - c : (1 << 24));
          EpiT E{TB, 1024};
          for (int rp_ = 0; rp_ < (PROBE_DUP == 6 ? 2 : 1); ++rp_) pg8::gemm_phase<EpiT, pg8::StaticOrder, true, true>(gl, g, S, E); }
#endif
        GSYNC();
        if ((layer & 1) == 0) {
#ifndef SKIP_S1
            for (int rp_ = (PROBE_DUP == 3 ? 0 : 1); rp_ < 2; ++rp_) { const Args a = getargs(); phase_s1(a, j, lds, !rp_); if (!rp_) GSYNC(); }
#endif
        } else {
#ifndef SKIP_C1
            { const Args a = getargs(); phase_c1(a, j); }
#endif
            GSYNC();
#ifndef SKIP_ATTN
            for (int rp_ = ((PROBE_DUP == 1 || PROBE_DUP == 2) ? 0 : 1); rp_ < 2; ++rp_) { const Args a = getargs(); phase_attn(a, j, lds, rp_ ? 0 : PROBE_DUP); if (!rp_) GSYNC(); }
#endif
        }
        GSYNC();
#ifndef SKIP_G2
        { WSPTRS(); pg8::Gemm g{R0, (const bf16_t*)(ws + ((layer & 1) ? WS_WFOUT : WS_WGOUT)) + (size_t)j * 1024 * 2048, MP, 1024, 2048}; pg8::StaticOrder S; S.init(MP, 1024, G, c);
          EpiT E{R1, 1024};
          for (int rp_ = 0; rp_ < (PROBE_DUP == 6 ? 2 : 1); ++rp_) pg8::gemm_phase<EpiT, pg8::StaticOrder, true, true>(gl, g, S, E); }
#endif
        { WSPTRS(); int ksl = 256; asm volatile("" : "+s"(ksl)); pg8::Gemm g{R0, (const bf16_t*)(ws + ((layer & 1) ? WS_WFOUT : WS_WGOUT)) + (size_t)j * 1024 * 2048, MA, 1024, ksl, 2048}; SplitOrder S{8, c};
          EpiPart E{(float*)(ws + WS_PART)};
          pg8::gemm_phase<EpiPart, SplitOrder, true, true>(gl, g, S, E); }
        GSYNC();
#ifndef SKIP_E3
        for (int rp_ = (PROBE_DUP == 4 ? 0 : 1); rp_ < 2; ++rp_) { const Args a = getargs(); phase_e3(a, layer, !rp_); if (!rp_) GSYNC(); }
#endif
        GSYNC();
#ifndef SKIP_G3
        { WSPTRS(); pg8::Gemm g{HX, (const bf16_t*)(ws + WS_WPG) + (size_t)layer * 1024 * 1024, MP, 1024, 1024}; pg8::StaticOrder S; S.init(MP, 1024, G, c);
          for (int rp_ = (PROBE_DUP == 6 ? 0 : 1); rp_ < 2; ++rp_) { EpiGate E{HX, rp_ ? a.p->out : (float*)(ws + WS_DUMMY), TB, layer == 3}; pg8::gemm_phase<EpiGate, pg8::StaticOrder, true, true>(gl, g, S, E); } }
#endif
        { WSPTRS(); int ksl = 256; asm volatile("" : "+s"(ksl)); pg8::Gemm g{HX, (const bf16_t*)(ws + WS_WPG) + (size_t)layer * 1024 * 1024, MA, 1024, ksl, 1024}; SplitOrder S{4, c};
          EpiPart E{(float*)(ws + WS_PART)};
          pg8::gemm_phase<EpiPart, SplitOrder, true, true>(gl, g, S, E); }
        GSYNC();
    }
    { const Args a = getargs(); phase_e1(a, 4); }
}

extern "C" void kernel_launch(void* const* d_in, const int* in_sizes, int n_in, void* d_out, int out_size, void* d_ws, size_t ws_size, hipStream_t stream) {
    static int grid = 0;
    if (grid == 0) {
        if (n_in != 20 || ws_size < WS_END) { fprintf(stderr, "kernel_launch: need 20 inputs and >= %zu bytes of workspace; got %d, %zu\n", (size_t)WS_END, n_in, ws_size); grid = -1; return; }
        int dev = 0, cus = 0, per_cu = 0;
        (void)hipGetDevice(&dev); (void)hipDeviceGetAttribute(&cus, hipDeviceAttributeMultiprocessorCount, dev);
        if (hipFuncSetAttribute((const void*)fwd_megakernel, hipFuncAttributeMaxDynamicSharedMemorySize, LDS_BYTES) != hipSuccess) { fprintf(stderr, "kernel_launch: hipFuncSetAttribute failed\n"); grid = -1; return; }
        if (hipOccupancyMaxActiveBlocksPerMultiprocessor(&per_cu, (const void*)fwd_megakernel, 512, LDS_BYTES) != hipSuccess || per_cu < 1) { fprintf(stderr, "kernel_launch: occupancy query says %d\n", per_cu); per_cu = 1; }
        (void)hipGetLastError();
        grid = cus > 0 ? cus : 256;
    }
    if (grid < 0) return;
    if (hipMemsetAsync(d_ws, 0, 65536, stream) != hipSuccess) { fprintf(stderr, "kernel_launch: memset of the barrier words failed\n"); return; }
    ArgsS a{};
    for (int i = 0; i < 20; ++i) a.in[i] = (const float*)d_in[i];
    a.out = (float*)d_out; a.ws = (unsigned char*)d_ws;
    void* args[] = {&a};
    hipError_t e = hipLaunchCooperativeKernel((const void*)fwd_megakernel, dim3(grid), dim3(512), args, LDS_BYTES, stream);
    if (e != hipSuccess) fprintf(stderr, "cooperative launch failed: %s (grid %d)\n", hipGetErrorString(e), grid);
}
```

```cpp
#include <hip/hip_runtime.h>
#include <hip/hip_bf16.h>
#include <hip/hip_cooperative_groups.h>
#include <cstdio>
#include <cstdint>
extern __shared__ __attribute__((aligned(16))) unsigned char g_lds[];
constexpr int LDS_TOTAL = 147456, LDS_WIDTAB = LDS_TOTAL - 512;
__device__ __forceinline__ int otid() {
    const unsigned hw = (unsigned)__builtin_amdgcn_s_getreg((5 << 11) | 4) & 63u;
    int w = ((volatile __attribute__((address_space(3))) int*)((__attribute__((address_space(3))) unsigned char*)g_lds + LDS_WIDTAB))[hw];
    w = __builtin_amdgcn_readfirstlane(w);
    int l; asm volatile("v_mbcnt_lo_u32_b32 %0, -1, 0" : "=v"(l)); asm volatile("v_mbcnt_hi_u32_b32 %0, -1, %0" : "+v"(l));
    return w * 64 + l;
}
namespace pg8 {
#define PG8_LAS __attribute__((address_space(3)))
typedef unsigned short bf16_t;
typedef short bf16x8 __attribute__((ext_vector_type(8)));
typedef float f32x4 __attribute__((ext_vector_type(4)));
typedef unsigned u32x4 __attribute__((ext_vector_type(4)));
constexpr int BM = 256, BK = 64, HALF = 128, HTB = HALF * BK * 2  , STAGE_BYTES = 8 * HTB, NXCD = 8, WGM = 8;

__host__ __device__ __forceinline__ int lds_byte(int r, int c) { const int st = (r >> 4) * 2 + (c >> 5), rr = r & 15, cc = c & 31, ob = rr * 64 + cc * 2; return st * 1024 + (ob ^ (((ob >> 9) & 1) << 5)); }
__host__ __device__ __forceinline__ void stage_rc(int b, int& R, int& C) { const int st = b / 1024, sb = b % 1024, swz = sb ^ (((sb >> 9) & 1) << 5); R = (st >> 1) * 16 + swz / 64; C = (st & 1) * 32 + (swz % 64) / 2; }
__host__ __device__ __forceinline__ int perm32(int rho) { const int n = rho >> 4, i = rho & 15; return 8 * (i >> 2) + 4 * n + (i & 3); }

struct Unit { int pm, pn, ko; };
struct Gemm { const bf16_t* A; const bf16_t* Bt; int M, N, K, ldk; };

struct StaticOrder {
    int nM, nN, nwg, G, c;
    __host__ __device__ void init(int M, int N, int G_, int c_) { nM = M / BM; nN = N / BM; nwg = nM * nN; G = G_; c = c_; }
    __host__ __device__ bool next(int i, Unit& u) const {
        const long L = (long)i * G + c; if (L >= nwg) return false;
        int wgid = (int)L; { const int q = nwg / NXCD, r = nwg % NXCD, xcd = wgid % NXCD, off = wgid / NXCD; wgid = (xcd < r ? xcd * (q + 1) : r * (q + 1) + (xcd - r) * q) + off; }
        const int nig = WGM * nN, gid = wgid / nig, fm = gid * WGM, gsz = (nM - fm) < WGM ? (nM - fm) : WGM;
        u.pm = fm + ((wgid % nig) % gsz); u.pn = (wgid % nig) / gsz; u.ko = 0; return true;
    }
    __device__ __forceinline__ void a_ready(const Unit&) const {}
    __device__ __forceinline__ void done(const Unit&) const {}
};

__device__ __forceinline__ unsigned cvt_pk_bf16(float lo, float hi) { unsigned r; asm volatile("v_cvt_pk_bf16_f32 %0, %1, %2" : "=v"(r) : "v"(lo), "v"(hi)); return r; }
typedef float f32x2 __attribute__((ext_vector_type(2)));
__device__ __forceinline__ f32x2 gelu_pk(f32x2 v) {
    const f32x2 av = __builtin_elementwise_abs(v), d = av * 0.2316418882f + 1.0f;
    f32x2 t; t.x = __builtin_amdgcn_rcpf(d.x); t.y = __builtin_amdgcn_rcpf(d.y);
    f32x2 q = t * 0.5307027145f + (-0.7265760135f); q = q * t + 0.7107068705f; q = q * t + (-0.142248368f); q = q * t + 0.127414796f; q = q * t;
    const f32x2 s = (v * v) * (-0.72134752044f);
    f32x2 e; e.x = __builtin_amdgcn_exp2f(s.x); e.y = __builtin_amdgcn_exp2f(s.y);
    const f32x2 m = v * (q * e), r = v - m;
    f32x2 o; o.x = v.x < 0.f ? m.x : r.x; o.y = v.y < 0.f ? m.y : r.y; return o;
}

template <int ACT  > struct EpiBf16 {
    static constexpr bool PERM = true, AFTER_DRAIN = false; static_assert(ACT == 0 || ACT == 1, "EpiBf16: ACT is 0 (none) or 1 (gelu_pk)");
    bf16_t* O; int ldc; const float* bias; int split_cols; size_t split_stride; float scale0;
    __device__ __forceinline__ void operator()(const f32x4 (&acc)[2][2][4][2], const Unit& u, int wr, int wc, int fr, int fq) const {
        const int row0 = u.pm * BM + wr * 64 + fr; int colt = u.pn * BM; bf16_t* base = O;
        float sc = 1.f; if (split_cols) { const int t = colt / split_cols; base += (size_t)t * split_stride; colt -= t * split_cols; if (t == 0) sc = scale0; }
        const int col0 = colt + wc * 32 + 8 * fq, bcol0 = u.pn * BM + wc * 32 + 8 * fq;
        f32x4 bv[2][2];
#pragma unroll
        for (int bj = 0; bj < 2; ++bj)
#pragma unroll
            for (int n = 0; n < 2; ++n) bv[bj][n] = bias ? *(const f32x4*)(bias + bcol0 + bj * HALF + 4 * n) : (f32x4){0.f, 0.f, 0.f, 0.f};
#pragma unroll
        for (int ai = 0; ai < 2; ++ai)
#pragma unroll
            for (int m = 0; m < 4; ++m) { bf16_t* rowp = base + (size_t)(row0 + ai * HALF + m * 16) * ldc + col0;
#pragma unroll
                for (int bj = 0; bj < 2; ++bj) { f32x4 v0 = acc[ai][bj][m][0] + bv[bj][0], v1 = acc[ai][bj][m][1] + bv[bj][1];
                    if (ACT == 1) { f32x2 a = gelu_pk((f32x2){v0[0], v0[1]}), b = gelu_pk((f32x2){v0[2], v0[3]}), c = gelu_pk((f32x2){v1[0], v1[1]}), d = gelu_pk((f32x2){v1[2], v1[3]});
                        v0 = (f32x4){a.x, a.y, b.x, b.y}; v1 = (f32x4){c.x, c.y, d.x, d.y}; }
                    v0 = v0 * sc; v1 = v1 * sc; u32x4 w; w.x = cvt_pk_bf16(v0[0], v0[1]); w.y = cvt_pk_bf16(v0[2], v0[3]); w.z = cvt_pk_bf16(v1[0], v1[1]); w.w = cvt_pk_bf16(v1[2], v1[3]);
                    *(u32x4*)(rowp + bj * HALF) = w; } }
    }
};


template <class Epi, class Sched, bool ALIGN_EPI = false, bool SP2 = false>
__device__ __forceinline__ void gemm_phase(PG8_LAS unsigned char* lds, const Gemm g, const Sched& S, const Epi& E) {
    const int tid = otid(), wid = __builtin_amdgcn_readfirstlane(tid >> 6), lane = tid & 63, wr = wid >> 2, wc = wid & 3, fr = lane & 15, fq = lane >> 4;
    const int K = g.K, nt = K / BK, LDK = g.ldk ? g.ldk : g.K;
    unsigned voffA[2], voffB[2];
#pragma unroll
    for (int i = 0; i < 2; ++i) { int R, C; stage_rc(tid * 16 + i * 8192, R, C); const int Rb = Epi::PERM ? ((R & ~31) + perm32(R & 31)) : R;
        voffA[i] = (unsigned)(R * LDK + C) * 2u; voffB[i] = (unsigned)(Rb * LDK + C) * 2u; }
    const size_t kstep = (size_t)(BK * 2);
    const size_t hstep = (size_t)HALF * LDK * 2;
    const size_t tstep = 2 * hstep;
    const unsigned ldsw = (unsigned)wid * 1024u;
    const int aoff = lds_byte(wr * 64 + fr, fq * 8), boff = lds_byte(wc * 32 + fr, fq * 8);
#define PG8_SA(b, h) (((b) * 2 + (h)) * HTB)
#define PG8_SB(b, h) ((4 + (b) * 2 + (h)) * HTB)
#define PG8_STAGE(bufoff, gbase, voff) do { _Pragma("unroll") for (int _i = 0; _i < 2; ++_i) \
        __builtin_amdgcn_global_load_lds((const unsigned*)((const char*)(gbase) + (voff)[_i]), (PG8_LAS unsigned*)(lds + (bufoff) + ldsw + _i * 8192), 16, 0, 0); } while (0)
#define PG8_LDA(dst, b, h) do { _Pragma("unroll") for (int m = 0; m < 4; ++m) _Pragma("unroll") for (int k = 0; k < 2; ++k) dst[m][k] = *(const PG8_LAS bf16x8*)(lds + PG8_SA(b, h) + aoff + m * 2048 + k * 1024); } while (0)
#define PG8_LDB(dst, b, h) do { _Pragma("unroll") for (int n = 0; n < 2; ++n) _Pragma("unroll") for (int k = 0; k < 2; ++k) dst[n][k] = *(const PG8_LAS bf16x8*)(lds + PG8_SB(b, h) + boff + n * 2048 + k * 1024); } while (0)
#define PG8_MMA(ai, bj, At, Bt) do { __builtin_amdgcn_s_setprio(1); _Pragma("unroll") for (int m = 0; m < 4; ++m) _Pragma("unroll") for (int n = 0; n < 2; ++n) _Pragma("unroll") for (int k = 0; k < 2; ++k) \
        acc[ai][bj][m][n] = __builtin_amdgcn_mfma_f32_16x16x32_bf16(Bt[n][k], At[m][k], acc[ai][bj][m][n], 0, 0, 0); __builtin_amdgcn_s_setprio(0); } while (0)
#define PG8_WAIT_V(n) asm volatile("s_waitcnt vmcnt(" #n ")" ::: "memory")
#define PG8_WAIT_L(n) asm volatile("s_waitcnt lgkmcnt(" #n ")" ::: "memory")
#define PG8_BAR __builtin_amdgcn_s_barrier()
#define PG8_SCHED __builtin_amdgcn_sched_barrier(0)
    Unit cur, nxt; int ui = 0;
    if (!S.next(0, cur)) return;
    f32x4 acc[2][2][4][2];
#pragma unroll
    for (int a = 0; a < 2; ++a)
#pragma unroll
        for (int b = 0; b < 2; ++b)
#pragma unroll
            for (int m = 0; m < 4; ++m)
#pragma unroll
                for (int n = 0; n < 2; ++n) acc[a][b][m][n] = (f32x4){0.f, 0.f, 0.f, 0.f};
    bf16x8 At[4][2], B0[2][2], B1[2][2];
    const char* cA = (const char*)g.A + (size_t)cur.pm * tstep + (size_t)cur.ko * 2; const char* cB = (const char*)g.Bt + (size_t)cur.pn * tstep + (size_t)cur.ko * 2;
    S.a_ready(cur);
    if constexpr (SP2) {
        PG8_STAGE(PG8_SB(0, 0), cB, voffB); PG8_STAGE(PG8_SB(0, 1), cB + hstep, voffB); PG8_STAGE(PG8_SA(0, 0), cA, voffA); PG8_STAGE(PG8_SA(0, 1), cA + hstep, voffA);
        if (wr == 1) PG8_BAR;
        PG8_WAIT_V(2); PG8_BAR;
        PG8_STAGE(PG8_SB(1, 0), cB + kstep, voffB); PG8_STAGE(PG8_SA(1, 0), cA + kstep, voffA); PG8_STAGE(PG8_SB(1, 1), cB + hstep + kstep, voffB);
        PG8_WAIT_V(6); PG8_BAR;
    } else {
        PG8_STAGE(PG8_SB(0, 0), cB, voffB); PG8_STAGE(PG8_SA(0, 0), cA, voffA); PG8_STAGE(PG8_SB(0, 1), cB + hstep, voffB); PG8_STAGE(PG8_SA(0, 1), cA + hstep, voffA);
        if (wr == 1) PG8_BAR;
        PG8_WAIT_V(4); PG8_BAR;
        PG8_STAGE(PG8_SB(1, 0), cB + kstep, voffB); PG8_STAGE(PG8_SA(1, 0), cA + kstep, voffA); PG8_STAGE(PG8_SB(1, 1), cB + hstep + kstep, voffB);
        PG8_WAIT_V(6); PG8_BAR;
    }
    for (;;) {
        const bool has_next = S.next(ui + 1, nxt);
        const char* nA = has_next ? (const char*)g.A + (size_t)nxt.pm * tstep + (size_t)nxt.ko * 2 : cA; const char* nB = has_next ? (const char*)g.Bt + (size_t)nxt.pn * tstep + (size_t)nxt.ko * 2 : cB;
        for (int t = 0; t < nt; t += 2) {
            const bool last = (t == nt - 2);
            const char* a1 = cA + (size_t)(t + 1) * kstep;
            const char* a2 = last ? nA : cA + (size_t)(t + 2) * kstep; const char* b2 = last ? nB : cB + (size_t)(t + 2) * kstep;
            const char* a3 = a2 + kstep; const char* b3 = b2 + kstep;
            if (last && has_next) S.a_ready(nxt);
            if constexpr (SP2) {
            PG8_LDB(B0, 0, 0); PG8_LDB(B1, 0, 1); PG8_SCHED; PG8_LDA(At, 0, 0); PG8_STAGE(PG8_SA(1, 1), a1 + hstep, voffA);
            PG8_WAIT_V(8); PG8_WAIT_L(0); PG8_BAR; PG8_MMA(0, 0, At, B0); PG8_MMA(0, 1, At, B1); PG8_BAR; PG8_SCHED;
            PG8_LDA(At, 0, 1); PG8_STAGE(PG8_SB(0, 0), b2, voffB); PG8_STAGE(PG8_SB(0, 1), b2 + hstep, voffB); PG8_STAGE(PG8_SA(0, 0), a2, voffA);
            PG8_WAIT_V(8); PG8_WAIT_L(0); PG8_BAR; PG8_MMA(1, 0, At, B0); PG8_MMA(1, 1, At, B1); PG8_BAR; PG8_SCHED;
            PG8_LDB(B0, 1, 0); PG8_LDB(B1, 1, 1); PG8_SCHED; PG8_LDA(At, 1, 0); PG8_STAGE(PG8_SA(0, 1), a2 + hstep, voffA);
            PG8_WAIT_V(8); PG8_WAIT_L(0); PG8_BAR; PG8_MMA(0, 0, At, B0); PG8_MMA(0, 1, At, B1); PG8_BAR; PG8_SCHED;
            PG8_LDA(At, 1, 1); PG8_STAGE(PG8_SB(1, 0), b3, voffB); PG8_STAGE(PG8_SB(1, 1), b3 + hstep, voffB); PG8_STAGE(PG8_SA(1, 0), a3, voffA);
            PG8_WAIT_V(8); PG8_WAIT_L(0); PG8_BAR; PG8_MMA(1, 0, At, B0); PG8_MMA(1, 1, At, B1); PG8_BAR; PG8_SCHED;
            } else {
            PG8_LDB(B0, 0, 0); PG8_SCHED; PG8_LDA(At, 0, 0); PG8_STAGE(PG8_SA(1, 1), a1 + hstep, voffA);
            PG8_WAIT_L(8); PG8_BAR; PG8_WAIT_L(0); PG8_MMA(0, 0, At, B0); PG8_BAR; PG8_SCHED;
            PG8_LDB(B1, 0, 1); PG8_STAGE(PG8_SB(0, 0), b2, voffB);
            PG8_BAR; PG8_WAIT_L(0); PG8_MMA(0, 1, At, B1); PG8_BAR;
            PG8_LDA(At, 0, 1); PG8_STAGE(PG8_SA(0, 0), a2, voffA);
            PG8_BAR; PG8_WAIT_L(0); PG8_MMA(1, 0, At, B0); PG8_BAR; PG8_SCHED;
            PG8_STAGE(PG8_SB(0, 1), b2 + hstep, voffB);
            PG8_WAIT_V(6); PG8_BAR; PG8_MMA(1, 1, At, B1); PG8_BAR;
            PG8_LDB(B0, 1, 0); PG8_SCHED; PG8_LDA(At, 1, 0); PG8_STAGE(PG8_SA(0, 1), a2 + hstep, voffA);
            PG8_WAIT_L(8); PG8_BAR; PG8_WAIT_L(0); PG8_MMA(0, 0, At, B0); PG8_BAR; PG8_SCHED;
            PG8_LDB(B1, 1, 1); PG8_STAGE(PG8_SB(1, 0), b3, voffB);
            PG8_BAR; PG8_WAIT_L(0); PG8_MMA(0, 1, At, B1); PG8_BAR;
            PG8_LDA(At, 1, 1); PG8_STAGE(PG8_SA(1, 0), a3, voffA);
            PG8_BAR; PG8_WAIT_L(0); PG8_MMA(1, 0, At, B0); PG8_BAR; PG8_SCHED;
            PG8_STAGE(PG8_SB(1, 1), b3 + hstep, voffB);
            PG8_WAIT_V(6); PG8_BAR; PG8_MMA(1, 1, At, B1); PG8_BAR;
            }
        }
        if constexpr (ALIGN_EPI) { if (wr == 0) PG8_BAR; }
        if constexpr (!Epi::AFTER_DRAIN) { E(acc, cur, wr, wc, fr, fq); S.done(cur); }
        if (!has_next) break;
#pragma unroll
        for (int a = 0; a < 2; ++a)
#pragma unroll
            for (int b = 0; b < 2; ++b)
#pragma unroll
                for (int m = 0; m < 4; ++m)
#pragma unroll
                    for (int n = 0; n < 2; ++n) acc[a][b][m][n] = (f32x4){0.f, 0.f, 0.f, 0.f};
        cur = nxt; cA = nA; cB = nB; ++ui;
        if constexpr (ALIGN_EPI) { if (wr == 1) PG8_BAR; }
    }
    PG8_WAIT_V(0);
    if constexpr (!ALIGN_EPI) { if (wr == 0) PG8_BAR; }
    PG8_BAR;
    if constexpr (Epi::AFTER_DRAIN) { E.fused(acc, cur, wr, wc, fr, fq, lds, wid, lane); S.done(cur); }
#undef PG8_SA
#undef PG8_SB
#undef PG8_STAGE
#undef PG8_LDA
#undef PG8_LDB
#undef PG8_MMA
#undef PG8_WAIT_V
#undef PG8_WAIT_L
#undef PG8_BAR
#undef PG8_SCHED
}
}
namespace att {
constexpr int D = 128, PITCH = 2048;
constexpr float THR = 8.f;
constexpr bool WSKIP = false;
constexpr float SCALE = 0.08838834764831845f;
constexpr int NW = 8, QBLK = 32, KVBLK = 64, QB = NW * QBLK;
constexpr int SHM_V = KVBLK * D * 2, SHM_K = KVBLK * D * 2;
constexpr int LDS_BYTES = 2 * SHM_V + 2 * SHM_K + NW * 64 * 4 + 512;
using bf16 = __hip_bfloat16;
typedef short bf16x8 __attribute__((ext_vector_type(8)));
typedef short s16x4 __attribute__((ext_vector_type(4)));
typedef float f32x16 __attribute__((ext_vector_type(16)));
typedef float f32x4 __attribute__((ext_vector_type(4)));
typedef unsigned u32x4 __attribute__((ext_vector_type(4)));
template <class A, class Bt> struct same_t { static constexpr bool v = false; };
template <class A> struct same_t<A, A> { static constexpr bool v = true; };

#define BPERM(k) ((((k) >> 2) & 1) * 32 + (((k) >> 3) & 3) * 4 + ((k) & 3))
#define KSWZ(row, colB) ((row) * 256 + ((colB) ^ (((row) & 7) << 4)))
#define SBAR() __builtin_amdgcn_sched_barrier(0)
__device__ __forceinline__ int v_st(int k, int c) { const int kk = (k & ~0xC) | ((k & 4) << 1) | ((k & 8) >> 1); return ((kk >> 3) * 4 + (c >> 5)) * 512 + ((kk & 7) * 32 + (c & 31)) * 2; }
__device__ __forceinline__ int v_rd_base(int lane) { return ((lane & 3) << 3) | (((lane >> 2) & 3) << 6) | (((lane >> 4) & 1) << 5) | (((lane >> 5) & 1) << 8); }
constexpr int v_rd_off(int d0, int ks, int half) { return d0 * 512 + ks * 4096 + half * 2048; }
__device__ __forceinline__ int crow(int r, int hi) { return (r & 3) + 8 * (r >> 2) + 4 * hi; }
__device__ __forceinline__ unsigned cvtpk(float lo, float hi) {
    unsigned r; asm volatile("v_cvt_pk_bf16_f32 %0, %1, %2" : "=v"(r) : "v"(lo), "v"(hi)); return r;
}
__device__ __forceinline__ bf16x8 pack8(f32x4 a, f32x4 b) {
    u32x4 w = {cvtpk(a[0], a[1]), cvtpk(a[2], a[3]), cvtpk(b[0], b[1]), cvtpk(b[2], b[3])};
    return *reinterpret_cast<bf16x8*>(&w);
}
template <class T> __device__ __forceinline__ bf16x8 load8(const T* p) {
    if constexpr (same_t<T, float>::v) { return pack8(*(const f32x4*)p, *(const f32x4*)(p + 4)); }
    else { return *reinterpret_cast<const bf16x8*>(p); }
}
__device__ __forceinline__ void mask_tile(f32x16& p0, f32x16& p1, int dq, unsigned W) {
    const float NEG = -__builtin_inff();
#pragma unroll
    for (int r = 0; r < 16; ++r) {
        const int c = (r & 3) + 8 * (r >> 2);
        if ((unsigned)(dq - c) >= W) p0[r] = NEG;
        if ((unsigned)(dq - c - 32) >= W) p1[r] = NEG;
    }
}
__device__ __forceinline__ void partialSM(f32x16& p0, f32x16& p1, float& m_reg, float& mn, float& alpha) {
    float pmax = p0[0]; for (int r = 1; r < 16; ++r) pmax = fmaxf(pmax, p0[r]); for (int r = 0; r < 16; ++r) pmax = fmaxf(pmax, p1[r]);
    { auto rr = __builtin_amdgcn_permlane32_swap(__float_as_uint(pmax), __float_as_uint(pmax), false, false);
      pmax = fmaxf(__uint_as_float(rr[0]), __uint_as_float(rr[1])); }
    constexpr float C2 = 1.4426950408889634f * SCALE;
    if (__builtin_expect(__all((pmax - m_reg) * SCALE <= THR), 1)) { mn = m_reg; alpha = 1.f; }
    else { mn = fmaxf(m_reg, pmax); alpha = __builtin_amdgcn_exp2f((m_reg - mn) * C2); m_reg = mn; }
    const float mnL = -mn * C2;
    for (int r = 0; r < 16; ++r) p0[r] = fmaf(p0[r], C2, mnL); for (int r = 0; r < 16; ++r) p1[r] = fmaf(p1[r], C2, mnL);
    for (int r = 0; r < 16; ++r) p0[r] = __builtin_amdgcn_exp2f(p0[r]);
}
__device__ __forceinline__ void finishSM(f32x16& p0, f32x16& p1, float alpha, float& l_reg, bf16x8& pa0, bf16x8& pa1, bf16x8& pa2, bf16x8& pa3) {
    for (int r = 0; r < 16; ++r) p1[r] = __builtin_amdgcn_exp2f(p1[r]);
    float ps = 0; for (int r = 0; r < 16; ++r) ps += p0[r]; for (int r = 0; r < 16; ++r) ps += p1[r];
    { auto rr = __builtin_amdgcn_permlane32_swap(__float_as_uint(ps), __float_as_uint(ps), false, false);
      ps = __uint_as_float(rr[0]) + __uint_as_float(rr[1]); }
    l_reg = l_reg * alpha + ps;
#define PK4(P, B_, OUT) do { unsigned a0 = cvtpk(P[B_+0], P[B_+1]), a1 = cvtpk(P[B_+2], P[B_+3]);                          \
        unsigned b0 = cvtpk(P[B_+4], P[B_+5]), b1 = cvtpk(P[B_+6], P[B_+7]);                                             \
        auto r0 = __builtin_amdgcn_permlane32_swap(a0, b0, false, false); auto r1 = __builtin_amdgcn_permlane32_swap(a1, b1, false, false); \
        u32x4 w = {r0[0], r1[0], r0[1], r1[1]}; OUT = *reinterpret_cast<bf16x8*>(&w); } while (0)
    PK4(p0, 0, pa0); PK4(p0, 8, pa1); PK4(p1, 0, pa2); PK4(p1, 8, pa3);
#undef PK4
}
template <int KB, bool SK>
__device__ __forceinline__ void qkt(f32x16& p0, f32x16& p1, const char* K_lds, const float* B_lds, int r32, int hi, const bf16x8* qr, bool act) {
    if (SK && !act) { const float NEG = -__builtin_inff();
#pragma unroll
        for (int r = 0; r < 16; ++r) { p0[r] = NEG; p1[r] = NEG; } return; }
#ifdef ATT_NOBIAS
    p0 = f32x16{}; p1 = f32x16{};
#else
    p0 = *(const f32x16*)(B_lds + KB * 64 + hi * 32); p1 = *(const f32x16*)(B_lds + KB * 64 + hi * 32 + 16);
#endif
    const char* kb[4];
#pragma unroll
    for (int dd = 0; dd < 4; ++dd) kb[dd] = K_lds + KB * SHM_K + KSWZ(r32, (dd * 16 + hi * 8) * 2);
#pragma unroll
    for (int d0 = 0; d0 < 8; ++d0) { const char* a = kb[d0 & 3] + (d0 >> 2) * 128;
        bf16x8 b0 = *reinterpret_cast<const bf16x8*>(a);
        bf16x8 b1 = *reinterpret_cast<const bf16x8*>(a + 32 * 256);
        p0 = __builtin_amdgcn_mfma_f32_32x32x16_bf16(b0, qr[d0], p0, 0, 0, 0);
        p1 = __builtin_amdgcn_mfma_f32_32x32x16_bf16(b1, qr[d0], p1, 0, 0, 0); }
}
template <int VB, bool SK>
__device__ __forceinline__ void pv_tile(f32x16* o, int vb0, bf16x8 pa0, bf16x8 pa1, bf16x8 pa2, bf16x8 pa3, bool act) {
    if (SK && !act) return;
#define TRRD(dst, off) asm volatile("ds_read_b64_tr_b16 %0, %1 offset:%2" : "=&v"(dst) : "v"(vb0), "i"(off) : "memory")
#define PV_D0(d0) do { s16x4 l0, l1, l2, l3, h0, h1, h2, h3; constexpr int b_ = VB * SHM_V + v_rd_off(d0, 0, 0);     \
        TRRD(l0, b_); TRRD(h0, b_ + 2048); TRRD(l1, b_ + 4096); TRRD(h1, b_ + 6144); TRRD(l2, b_ + 8192); TRRD(h2, b_ + 10240); TRRD(l3, b_ + 12288); TRRD(h3, b_ + 14336); \
        asm volatile("s_waitcnt lgkmcnt(0)" ::: "memory"); SBAR();                 \
        o[d0] = __builtin_amdgcn_mfma_f32_32x32x16_bf16(pa0, (bf16x8){l0[0], l0[1], l0[2], l0[3], h0[0], h0[1], h0[2], h0[3]}, o[d0], 0, 0, 0);   \
        o[d0] = __builtin_amdgcn_mfma_f32_32x32x16_bf16(pa1, (bf16x8){l1[0], l1[1], l1[2], l1[3], h1[0], h1[1], h1[2], h1[3]}, o[d0], 0, 0, 0);   \
        o[d0] = __builtin_amdgcn_mfma_f32_32x32x16_bf16(pa2, (bf16x8){l2[0], l2[1], l2[2], l2[3], h2[0], h2[1], h2[2], h2[3]}, o[d0], 0, 0, 0);   \
        o[d0] = __builtin_amdgcn_mfma_f32_32x32x16_bf16(pa3, (bf16x8){l3[0], l3[1], l3[2], l3[3], h3[0], h3[1], h3[2], h3[3]}, o[d0], 0, 0, 0); } while (0)
    PV_D0(0); PV_D0(1); PV_D0(2); PV_D0(3);
#undef PV_D0
#undef TRRD
}

template <class TIn, class TOut> struct BlockRef { const TIn* Q; const TIn* K; const TIn* V; TOut* O; const float* CB; const TIn* Z; int P0; };
template <class TIn> struct Seam {
    bf16x8 qr[8];
    bf16x8 st_v0, st_v1, st_k0, st_k1; float st_b0; f32x4 sf0, sf1, sf2, sf3;
    f32x4 tq[16];
};
__device__ __forceinline__ int swa_jlo(int P0, int W) { const int lowk = P0 - W + 1; return lowk > 0 ? lowk / KVBLK : 0; }
#define ROW(p, k0, rr) ((p) + (unsigned)(((k0) + (rr)) * PITCH + sc))
#define VMW() asm volatile("s_waitcnt vmcnt(0)" ::: "memory")
#define VMWN(n) asm volatile("s_waitcnt vmcnt(%0)" :: "i"(n) : "memory")
#define SLOAD_H(Kp, Vp, Cp, k0) do { S.st_b0 = (Cp)[(unsigned)((k0) + sr + 32 * (tid & 1))]; S.st_v0 = load8<TIn>(ROW(Vp, k0, sr)); S.st_v1 = load8<TIn>(ROW(Vp, k0, 32 + sr));              \
                         S.st_k0 = load8<TIn>(ROW(Kp, k0, sr)); S.st_k1 = load8<TIn>(ROW(Kp, k0, 32 + sr)); } while (0)
#define SWRITE_HK(bf) do { B_lds[(bf) * 64 + sr + 32 * (tid & 1)] = S.st_b0; *(bf16x8*)(K_lds + (bf) * SHM_K + kws) = S.st_k0; *(bf16x8*)(K_lds + (bf) * SHM_K + kws + 32 * 256) = S.st_k1; } while (0)
#define SWRITE_HV(bf) do { *(bf16x8*)(V_lds + (bf) * SHM_V + vst0) = S.st_v0; *(bf16x8*)(V_lds + (bf) * SHM_V + vst1) = S.st_v1; } while (0)
#define SWRITE_H(bf) do { SWRITE_HV(bf); SWRITE_HK(bf); } while (0)
#define SLOAD_F(p, k0) do { S.sf0 = *(const f32x4*)ROW(p, k0, sr); S.sf1 = *(const f32x4*)(ROW(p, k0, sr) + 4);                \
                            S.sf2 = *(const f32x4*)ROW(p, k0, 32 + sr); S.sf3 = *(const f32x4*)(ROW(p, k0, 32 + sr) + 4); } while (0)
#define SWRITE_KF(bf) do { *(bf16x8*)(K_lds + (bf) * SHM_K + kws) = pack8(S.sf0, S.sf1); *(bf16x8*)(K_lds + (bf) * SHM_K + kws + 32 * 256) = pack8(S.sf2, S.sf3); } while (0)
#define SWRITE_VF(bf) do { *(bf16x8*)(V_lds + (bf) * SHM_V + vst0) = pack8(S.sf0, S.sf1); *(bf16x8*)(V_lds + (bf) * SHM_V + vst1) = pack8(S.sf2, S.sf3); } while (0)
template <class TIn, class TOut>
__device__ __forceinline__ void causal_swa_prime(const BlockRef<TIn, TOut>& cur, int W, char* lds, Seam<TIn>& S) {
    constexpr bool F32 = same_t<TIn, float>::v;
    const int tid = otid(), wid = __builtin_amdgcn_readfirstlane(tid >> 6), lane = tid & 63, r32 = lane & 31, hi = lane >> 5;
    const int sr = tid >> 4, sc = (tid & 15) * 8, kws = KSWZ(sr, sc * 2); char* K_lds = lds + 2 * SHM_V; float* B_lds = (float*)(lds + 2 * SHM_V + 2 * SHM_K + NW * 64 * 4);
    const int kb0 = swa_jlo(cur.P0, W) * KVBLK;
    for (int d0 = 0; d0 < 8; ++d0) S.qr[d0] = load8<TIn>(cur.Q + (unsigned)((wid * QBLK + r32) * PITCH + d0 * 16 + hi * 8));
    if constexpr (F32) { SLOAD_F((const float*)cur.K, kb0); VMW(); SWRITE_KF(0); SBAR(); SLOAD_F((const float*)cur.V, kb0); }
    else { SLOAD_H(cur.K, cur.V, cur.CB, kb0); VMW(); SWRITE_HK(0); }
    __syncthreads();
}
template <class TIn, class TOut>
__device__ __forceinline__ void causal_swa_block(const BlockRef<TIn, TOut>& cur, const BlockRef<TIn, TOut>& nxt, int skv, int W, char* lds, Seam<TIn>& S) {
    constexpr bool F32 = same_t<TIn, float>::v;
    const int tid = otid(), wid = __builtin_amdgcn_readfirstlane(tid >> 6), lane = tid & 63, r32 = lane & 31, hi = lane >> 5;
    const int j_lo = swa_jlo(cur.P0, W);
    int j_hi = (cur.P0 + QB - 1) / KVBLK + 1; if (j_hi > skv / KVBLK) j_hi = skv / KVBLK;
    const int NT = j_hi - j_lo;
    const int kbn = swa_jlo(nxt.P0, W) * KVBLK;
    const int qlo = cur.P0 + wid * QBLK, qm = qlo + r32 - 4 * hi;
    char* V_lds = lds; char* K_lds = lds + 2 * SHM_V; float* B_lds = (float*)(lds + 2 * SHM_V + 2 * SHM_K + NW * 64 * 4);
    float* ws = (float*)(lds + 2 * SHM_V + 2 * SHM_K) + wid * 64; float* li_l = ws, * al_l = ws + 32;
    float m_reg = -1e30f, l_reg = 0; f32x16 o[4] = {};
    const int sr = tid >> 4, sc = (tid & 15) * 8, vst0 = v_st(sr, sc), vst1 = v_st(32 + sr, sc), kws = KSWZ(sr, sc * 2);
    const int vb0 = (int)(uintptr_t)V_lds + v_rd_base(lane);
    const TIn* Kh = cur.K; const TIn* Vh = cur.V; const float* Ch = cur.CB;
#define RESC(a) do { if (__any((a) < 1.f)) { if (hi == 0) al_l[r32] = (a); asm volatile("s_waitcnt lgkmcnt(0)" ::: "memory");              \
                     for (int d_ = 0; d_ < 4; ++d_) for (int r = 0; r < 16; ++r) o[d_][r] *= al_l[crow(r, hi)]; } } while (0)
#define KBASE(t) ((j_lo + (t)) * KVBLK)
#define ACT(t) (KBASE(t) <= qlo + QBLK - 1 && KBASE(t) + KVBLK - 1 >= qlo - W + 1)
#define MASKT(P0_, P1_, t) do { const int kb_ = KBASE(t); if ((!SK || ACT(t)) && (kb_ + KVBLK - 1 > qlo || kb_ <= qlo + QBLK - 1 - W)) mask_tile(P0_, P1_, qm - kb_, (unsigned)W); } while (0)
    constexpr int NQL = F32 ? 16 : 8;
    constexpr bool SK = WSKIP && !F32;
#define SEAM_K0() do { VMWN(NQL); if constexpr (F32) { SWRITE_KF(0); SBAR(); SLOAD_F((const float*)nxt.V, kbn); } else { SWRITE_HK(0); } SBAR(); } while (0)
    f32x16 pA0, pA1, pB0, pB1; float mnA, mnB, alA, alB; bf16x8 pa0, pa1, pa2, pa3;
    if constexpr (F32) { VMW(); SWRITE_VF(0); SBAR(); } else { SWRITE_HV(0); SBAR(); }
    if (NT > 1) { if constexpr (F32) SLOAD_F((const float*)Kh, KBASE(1)); else SLOAD_H(Kh, Vh, Ch, KBASE(1)); }
    SBAR(); qkt<0, SK>(pA0, pA1, K_lds, B_lds, r32, hi, S.qr, ACT(0));
    if constexpr (F32) { if (NT > 1) { VMW(); SWRITE_KF(1); SBAR(); SLOAD_F((const float*)Vh, KBASE(1)); } }
    MASKT(pA0, pA1, 0); partialSM(pA0, pA1, m_reg, mnA, alA);
    if (NT > 1) { VMW(); if constexpr (F32) { SWRITE_VF(1); SBAR(); if (NT > 2) SLOAD_F((const float*)Kh, KBASE(2)); } else SWRITE_H(1); }
    __syncthreads();
#define HALF_STEP(PX0, PX1, mnX, alX, PY0, PY1, alY, t, KB, VB, SB) do {                                                      \
        SBAR(); qkt<KB, SK>(PX0, PX1, K_lds, B_lds, r32, hi, S.qr, ACT(t));                                             \
        finishSM(PY0, PY1, alY, l_reg, pa0, pa1, pa2, pa3); SBAR();                                                           \
        if ((t) + 1 < NT) { if constexpr (F32) { VMW(); SWRITE_KF(SB); SBAR(); SLOAD_F((const float*)Vh, KBASE((t) + 1)); }  \
                            else { SLOAD_H(Kh, Vh, Ch, KBASE((t) + 1)); } SBAR(); }                                               \
        pv_tile<VB, SK>(o, vb0, pa0, pa1, pa2, pa3, ACT((t) - 1)); MASKT(PX0, PX1, (t)); partialSM(PX0, PX1, m_reg, mnX, alX);                                        \
        __syncthreads();                                                                                                      \
        if ((t) + 1 < NT) { VMW(); if constexpr (F32) { SWRITE_VF(SB); SBAR(); if ((t) + 2 < NT) SLOAD_F((const float*)Kh, KBASE((t) + 2)); } \
                            else { SWRITE_H(SB); } }                                                                          \
        RESC(alX); __syncthreads(); } while (0)
    for (int t = 1; t + 1 < NT; t += 2) {
        HALF_STEP(pB0, pB1, mnB, alB, pA0, pA1, alA, t, 1, 0, 0);
        HALF_STEP(pA0, pA1, mnA, alA, pB0, pB1, alB, t + 1, 0, 1, 1);
    }
    const bool even = (NT & 1) == 0;
    if (even) { SBAR(); qkt<1, SK>(pB0, pB1, K_lds, B_lds, r32, hi, S.qr, ACT(NT - 1)); SBAR(); }
#define QROW(e) (nxt.Q + (size_t)(wid * QBLK + r32) * PITCH + ((e) >> 1) * 16 + hi * 8 + ((e) & 1) * 4)
    if constexpr (F32) { SLOAD_F((const float*)nxt.K, kbn); SBAR();
#pragma unroll
        for (int e = 0; e < 8; ++e) S.tq[e] = *(const f32x4*)QROW(e); }
    else { SLOAD_H(nxt.K, nxt.V, nxt.CB, kbn); SBAR();
#pragma unroll
        for (int d0 = 0; d0 < 8; ++d0) S.qr[d0] = load8<TIn>(nxt.Q + (unsigned)((wid * QBLK + r32) * PITCH + d0 * 16 + hi * 8)); }
    SBAR();
    finishSM(pA0, pA1, alA, l_reg, pa0, pa1, pa2, pa3); SBAR();
    if constexpr (F32) {
#pragma unroll
        for (int e = 8; e < 16; ++e) S.tq[e] = *(const f32x4*)QROW(e); SBAR(); }
#undef QROW
    pv_tile<0, SK>(o, vb0, pa0, pa1, pa2, pa3, ACT(even ? NT - 2 : NT - 1));
    if (even) { MASKT(pB0, pB1, NT - 1); partialSM(pB0, pB1, m_reg, mnB, alB); __syncthreads(); RESC(alB);
        finishSM(pB0, pB1, alB, l_reg, pa0, pa1, pa2, pa3); SBAR(); pv_tile<1, SK>(o, vb0, pa0, pa1, pa2, pa3, ACT(NT - 1)); }
    SBAR(); SEAM_K0();
    if (hi == 0) li_l[r32] = l_reg; asm volatile("s_waitcnt lgkmcnt(0)" ::: "memory");
    float rli[16];
#pragma unroll
    for (int r = 0; r < 16; ++r) rli[r] = __builtin_amdgcn_rcpf(li_l[crow(r, hi)]);
    TOut* Ow = cur.O + (size_t)(wid * QBLK) * PITCH; const TIn* Zw = cur.Z + (size_t)(wid * QBLK) * PITCH; unsigned lo_ = (unsigned)(4 * hi) * PITCH + r32; asm volatile("" : "+v"(lo_));
#pragma unroll
    for (int rg = 0; rg < 4; ++rg) {
        unsigned zq[4][4];
        if ((r32 & 1) == 0) {
#pragma unroll
            for (int rr = 0; rr < 4; ++rr)
#pragma unroll
                for (int d0 = 0; d0 < 4; ++d0) zq[rr][d0] = *(const unsigned*)(Zw + (lo_ + (unsigned)(crow(rg * 4 + rr, hi) - 4 * hi) * PITCH + d0 * 32));
        }
#pragma unroll
        for (int rr = 0; rr < 4; ++rr) { const int r = rg * 4 + rr; const int orow = crow(r, hi);
#pragma unroll
            for (int d0 = 0; d0 < 4; ++d0) { const float v = o[d0][r] * rli[r]; const float vn = __shfl_xor(v, 1);
                if ((r32 & 1) == 0) { const unsigned of_ = lo_ + (unsigned)(orow - 4 * hi) * PITCH + d0 * 32; const unsigned zz = zq[rr][d0];
                    *(unsigned*)(Ow + of_) = cvtpk(v * __uint_as_float(zz << 16), vn * __uint_as_float(zz & 0xffff0000u)); } } }
    }
    if constexpr (F32) {
#pragma unroll
        for (int d0 = 0; d0 < 8; ++d0) S.qr[d0] = pack8(S.tq[2 * d0], S.tq[2 * d0 + 1]); }
    __syncthreads();
#undef RESC
#undef KBASE
#undef ACT
#undef MASKT
#undef SEAM_K0
#undef HALF_STEP
}
#undef ROW
#undef VMW
#undef VMWN
#undef SLOAD_H
#undef SWRITE_HK
#undef SWRITE_HV
#undef SWRITE_H
#undef SLOAD_F
#undef SWRITE_KF
#undef SWRITE_VF
}

namespace cg = cooperative_groups;
#define LAS __attribute__((address_space(3)))
typedef unsigned short bf16_t;
typedef float f32x4 __attribute__((ext_vector_type(4)));
typedef float f32x2 __attribute__((ext_vector_type(2)));
typedef unsigned u32x4 __attribute__((ext_vector_type(4)));
typedef unsigned u32x2 __attribute__((ext_vector_type(2)));
typedef short bf16x8 __attribute__((ext_vector_type(8)));

constexpr int DM = 1024, EB = 2048, MP = 32768, MS = 128, MV = MP + MS  , MA = 33024  ;
constexpr int SEQ = 4096, NBH = 128, PAST = 2048, TS = 16, SKS = 2112  ;
constexpr int NFIN = 8448;
constexpr float RMS_EPS = 1e-6f, LN_EPS = 1e-5f;
constexpr size_t O_YP = 0, O_YS = 33554432, O_GV = 33685504, O_FKP = 34209792, O_FVP = 168427520, O_FLP = 302645248, O_FKS = 303693824, O_FVS = 304218112, O_FLS = 304742400;
constexpr size_t MiB = 1u << 20;
constexpr size_t WS_WGIN = 1 * MiB;
constexpr size_t WS_WGOUT = 25 * MiB;
constexpr size_t WS_WFIN = 33 * MiB;
constexpr size_t WS_WFOUT = 66 * MiB;
constexpr size_t WS_WPP = 74 * MiB;
constexpr size_t WS_WPG = 76 * MiB;
constexpr size_t WS_WM = 84 * MiB;
constexpr size_t WS_WMS = 85 * MiB;
constexpr size_t WS_PB = 88 * MiB;
constexpr size_t WS_HX = 105 * MiB;
constexpr size_t WS_TB = 170 * MiB;
constexpr size_t WS_STAT = 756 * MiB;
constexpr size_t WS_CBP = 236 * MiB;
constexpr size_t WS_CBS = 238 * MiB + 512 * 1024;
constexpr size_t WS_R0 = 240 * MiB, RSZ = 129 * MiB;
constexpr size_t WS_END = 775 * MiB;
constexpr size_t WS_PART = 766 * MiB;
constexpr size_t WS_DUMMY = 776 * MiB;
constexpr int LDS_BYTES = LDS_TOTAL;
#ifndef PROBE_DUP
#define PROBE_DUP 0
#endif

struct ArgsS { const float* in[20]; float* out; unsigned char* ws; };
typedef const __attribute__((address_space(4))) ArgsS* ArgsP;
struct Args { ArgsP p; };
__device__ __forceinline__ Args getargs() { ArgsP p = (ArgsP)__builtin_amdgcn_kernarg_segment_ptr(); asm volatile("" : "+s"(p)); Args a; a.p = p; return a; }

__device__ __forceinline__ unsigned f2bf(float f) { unsigned u = __builtin_bit_cast(unsigned, f); return (u + 0x7fffu + ((u >> 16) & 1u)) >> 16; }
__device__ __forceinline__ unsigned pk2(float lo, float hi) { return pg8::cvt_pk_bf16(lo, hi); }
__device__ __forceinline__ float bflo(unsigned u) { return __uint_as_float(u << 16); }
__device__ __forceinline__ float bfhi(unsigned u) { return __uint_as_float(u & 0xffff0000u); }
__device__ __forceinline__ float wave_sum(float v) { for (int o = 32; o > 0; o >>= 1) v += __shfl_xor(v, o); return v; }
__device__ __forceinline__ float wave_max(float v) { for (int o = 32; o > 0; o >>= 1) v = fmaxf(v, __shfl_xor(v, o)); return v; }
__device__ __forceinline__ float gelu_t(float x) { const float t = x * x; const float e = __builtin_amdgcn_exp2f((-2.3022082f * x) * (1.f + 0.044715f * t)); return x * __builtin_amdgcn_rcpf(1.f + e); }
__device__ __forceinline__ float silu_f(float x) { return x * __builtin_amdgcn_rcpf(1.f + __builtin_amdgcn_exp2f(-1.4426950408889634f * x)); }
__device__ __forceinline__ float sigm_f(float x) { return __builtin_amdgcn_rcpf(1.f + __builtin_amdgcn_exp2f(-1.4426950408889634f * x)); }
__device__ __forceinline__ f32x2 sigm2(f32x2 v) { const f32x2 a = v * -1.4426950408889634f; f32x2 e; e.x = __builtin_amdgcn_exp2f(a.x); e.y = __builtin_amdgcn_exp2f(a.y); const f32x2 d = e + 1.0f; f32x2 r; r.x = __builtin_amdgcn_rcpf(d.x); r.y = __builtin_amdgcn_rcpf(d.y); return r; }
__device__ __forceinline__ f32x2 silu2(f32x2 v) { return v * sigm2(v); }
__device__ __forceinline__ f32x2 gelu2(f32x2 v) { const f32x2 t = v * v; const f32x2 a = (v * -2.3022082f) * (t * 0.044715f + 1.0f); f32x2 e; e.x = __builtin_amdgcn_exp2f(a.x); e.y = __builtin_amdgcn_exp2f(a.y); const f32x2 d = e + 1.0f; f32x2 r; r.x = __builtin_amdgcn_rcpf(d.x); r.y = __builtin_amdgcn_rcpf(d.y); return v * r; }
__device__ __forceinline__ float logsig_f(float x) { const float e = __expf(-fabsf(x)); const float l = e < 0.03f ? e * (1.f - e * (0.5f - e * (0.33333334f - 0.25f * e))) : __logf(1.f + e); return fminf(x, 0.f) - l; }

using pg8::Unit; using pg8::HALF; using pg8::BM;
struct EpiGmlpIn {
    static constexpr bool PERM = true, AFTER_DRAIN = false;
    bf16_t* U; bf16_t* VT; bf16_t* ZS; float* stat;
    __device__ __forceinline__ void operator()(const pg8::f32x4 (&acc)[2][2][4][2], const Unit& u, int wr, int wc, int fr_, int fq_) const {
        const int lane_ = otid() & 63, fr = lane_ & 15, fq = lane_ >> 4; (void)fr_; (void)fq_;
        const int row0 = u.pm * BM + wr * 64 + fr, colt = u.pn * BM, region = colt >> 11, cb = (colt & 2047) + wc * 32 + 8 * fq;
#pragma unroll
        for (int ai = 0; ai < 2; ++ai)
#pragma unroll
            for (int m = 0; m < 4; ++m) {
                const int row = row0 + ai * HALF + m * 16; float s = 0.f, q = 0.f;
#pragma unroll
                for (int bj = 0; bj < 2; ++bj) {
                    const int col = cb + bj * HALF; const pg8::f32x4 v0 = acc[ai][bj][m][0], v1 = acc[ai][bj][m][1];
                    float x[8] = {v0[0], v0[1], v0[2], v0[3], v1[0], v1[1], v1[2], v1[3]};
                    if (region == 2) {
#pragma unroll
                        for (int e = 0; e < 8; e += 2) { const f32x2 r = silu2((f32x2){x[e], x[e + 1]}); x[e] = r.x; x[e + 1] = r.y; }
                    } else {
#pragma unroll
                        for (int e = 0; e < 8; e += 2) { const f32x2 r = gelu2((f32x2){x[e], x[e + 1]}); x[e] = r.x; x[e + 1] = r.y; }
                    }
                    u32x4 w; w.x = pk2(x[0], x[1]); w.y = pk2(x[2], x[3]); w.z = pk2(x[4], x[5]); w.w = pk2(x[6], x[7]);
                    if (region == 1) {
                        bf16_t* vp = VT + ((size_t)(row >> 7) * 2048 + col) * 128 + (row & 127);
                        const unsigned ww[4] = {w.x, w.y, w.z, w.w};
#pragma unroll
                        for (int e = 0; e < 4; ++e) { vp[(2 * e) * 128] = (bf16_t)(ww[e] & 0xffffu); vp[(2 * e + 1) * 128] = (bf16_t)(ww[e] >> 16);
                            const float a = bflo(ww[e]), b = bfhi(ww[e]); s += a + b; q += a * a + b * b; }
                    } else {
                        bf16_t* dst = (region == 0 ? U : ZS) + (size_t)row * 2048 + col;
                        *(u32x4*)dst = w;
                    }
                }
                if (region == 1) {
                    s += __shfl_xor(s, 16); s += __shfl_xor(s, 32); q += __shfl_xor(q, 16); q += __shfl_xor(q, 32);
                    if (fq == 0) { const int slot = ((colt & 2047) >> 6) + wc; stat[(size_t)row * 64 + slot] = s; stat[(size_t)row * 64 + 32 + slot] = q; }
                }
            }
    }
};
struct EpiFoxIn {
    static constexpr bool PERM = true, AFTER_DRAIN = false;
    bf16_t* QB; bf16_t* KB; bf16_t* VB; bf16_t* ZS; float* okp; float* ovp; float* olp; float* oks; float* ovs; float* ols; const float* bf;
    __device__ __forceinline__ void operator()(const pg8::f32x4 (&acc)[2][2][4][2], const Unit& u, int wr, int wc, int fr_, int fq_) const {
        const int lane_ = otid() & 63, fr = lane_ & 15, fq = lane_ >> 4; (void)fr_; (void)fq_;
        const int row0 = u.pm * BM + wr * 64 + fr, colt = u.pn * BM, region = colt >> 11, cb = (colt & 2047) + wc * 32 + 8 * fq;
        if (region == 4) {
            if (wc != 0 || fq >= 2) return;
#pragma unroll
            for (int ai = 0; ai < 2; ++ai)
#pragma unroll
                for (int m = 0; m < 4; ++m) {
                    const int row = row0 + ai * HALF + m * 16; if (row >= MV) continue;
                    const pg8::f32x4 v0 = acc[ai][0][m][0], v1 = acc[ai][0][m][1];
                    const f32x4 b0 = *(const f32x4*)(bf + 8 * fq), b1 = *(const f32x4*)(bf + 8 * fq + 4);
                    f32x4 r0, r1;
#pragma unroll
                    for (int e = 0; e < 4; ++e) { r0[e] = logsig_f(v0[e] + b0[e]); r1[e] = logsig_f(v1[e] + b1[e]); }
                    float* dst = row < MP ? olp + (size_t)row * 16 + 8 * fq : ols + (size_t)(row - MP) * 16 + 8 * fq;
                    *(f32x4*)dst = r0; *(f32x4*)(dst + 4) = r1;
                }
            return;
        }
        bf16_t* B = region == 0 ? QB : region == 1 ? KB : region == 2 ? VB : ZS;
#pragma unroll
        for (int ai = 0; ai < 2; ++ai)
#pragma unroll
            for (int m = 0; m < 4; ++m) {
                const int row = row0 + ai * HALF + m * 16;
#pragma unroll
                for (int bj = 0; bj < 2; ++bj) {
                    const int col = cb + bj * HALF; pg8::f32x4 v0 = acc[ai][bj][m][0], v1 = acc[ai][bj][m][1];
                    if (region == 3) {
#pragma unroll
                        for (int e = 0; e < 4; e += 2) { const f32x2 r0 = silu2((f32x2){v0[e], v0[e + 1]}), r1 = silu2((f32x2){v1[e], v1[e + 1]}); v0[e] = r0.x; v0[e + 1] = r0.y; v1[e] = r1.x; v1[e + 1] = r1.y; }
                    }
                    u32x4 w; w.x = pk2(v0[0], v0[1]); w.y = pk2(v0[2], v0[3]); w.z = pk2(v1[0], v1[1]); w.w = pk2(v1[2], v1[3]);
                    *(u32x4*)(B + (size_t)row * 2048 + col) = w;
                    if ((region == 1 || region == 2) && row < MV) {
                        float* o = region == 1 ? (row < MP ? okp + (size_t)row * 2048 : oks + (size_t)(row - MP) * 2048) : (row < MP ? ovp + (size_t)row * 2048 : ovs + (size_t)(row - MP) * 2048);
                        *(pg8::f32x4*)(o + col) = v0; *(pg8::f32x4*)(o + col + 4) = v1;
                    }
                }
            }
    }
};
struct EpiT {
    static constexpr bool PERM = true, AFTER_DRAIN = false;
    bf16_t* O; int ldc;
    __device__ __forceinline__ void operator()(const pg8::f32x4 (&acc)[2][2][4][2], const Unit& u, int wr, int wc, int fr_, int fq_) const {
        const int lane_ = otid() & 63, fr = lane_ & 15, fq = lane_ >> 4; (void)fr_; (void)fq_;
        const int row0 = u.pm * BM + wr * 64 + fr, col0 = u.pn * BM + wc * 32 + 8 * fq;
#pragma unroll
        for (int ai = 0; ai < 2; ++ai)
#pragma unroll
            for (int m = 0; m < 4; ++m) { bf16_t* rp = O + (size_t)(row0 + ai * HALF + m * 16) * ldc + col0;
#pragma unroll
                for (int bj = 0; bj < 2; ++bj) { const pg8::f32x4 v0 = acc[ai][bj][m][0], v1 = acc[ai][bj][m][1];
                    u32x4 w; w.x = pk2(v0[0], v0[1]); w.y = pk2(v0[2], v0[3]); w.z = pk2(v1[0], v1[1]); w.w = pk2(v1[2], v1[3]);
                    *(u32x4*)(rp + bj * HALF) = w; } }
    }
};
struct EpiF32 {
    static constexpr bool PERM = true, AFTER_DRAIN = false;
    float* O; int ldc;
    __device__ __forceinline__ void operator()(const pg8::f32x4 (&acc)[2][2][4][2], const Unit& u, int wr, int wc, int fr_, int fq_) const {
        const int lane_ = otid() & 63, fr = lane_ & 15, fq = lane_ >> 4; (void)fr_; (void)fq_;
        const int row0 = u.pm * BM + wr * 64 + fr, col0 = u.pn * BM + wc * 32 + 8 * fq;
#pragma unroll
        for (int ai = 0; ai < 2; ++ai)
#pragma unroll
            for (int m = 0; m < 4; ++m) { float* rp = O + (size_t)(row0 + ai * HALF + m * 16) * ldc + col0;
#pragma unroll
                for (int bj = 0; bj < 2; ++bj) { *(pg8::f32x4*)(rp + bj * HALF) = acc[ai][bj][m][0]; *(pg8::f32x4*)(rp + bj * HALF + 4) = acc[ai][bj][m][1]; } }
    }
};
struct EpiPart {
    static constexpr bool PERM = true, AFTER_DRAIN = false;
    float* P;
    __device__ __forceinline__ void operator()(const pg8::f32x4 (&acc)[2][2][4][2], const Unit& u, int wr, int wc, int fr_, int fq_) const {
        const int lane_ = otid() & 63, fr = lane_ & 15, fq = lane_ >> 4; (void)fr_; (void)fq_;
        const int row0 = wr * 64 + fr, col0 = u.pn * BM + wc * 32 + 8 * fq; float* base = P + (size_t)(u.ko >> 8) * 256 * 1024;
#pragma unroll
        for (int ai = 0; ai < 2; ++ai)
#pragma unroll
            for (int m = 0; m < 4; ++m) { float* rp = base + (size_t)(row0 + ai * HALF + m * 16) * 1024 + col0;
#pragma unroll
                for (int bj = 0; bj < 2; ++bj) { *(pg8::f32x4*)(rp + bj * HALF) = acc[ai][bj][m][0]; *(pg8::f32x4*)(rp + bj * HALF + 4) = acc[ai][bj][m][1]; } }
    }
};
struct SplitOrder {
    int nsplit, c;
    __device__ bool next(int i, Unit& u) const { if (i != 0 || c >= 4 * nsplit) return false; u.pm = 128; u.pn = c & 3; u.ko = (c >> 2) * 256; return true; }
    __device__ __forceinline__ void a_ready(const Unit&) const {}
    __device__ __forceinline__ void done(const Unit&) const {}
};
struct EpiGate {
    static constexpr bool PERM = true, AFTER_DRAIN = false;
    const bf16_t* XB; float* Xo; const bf16_t* T; int f32out;
    __device__ __forceinline__ void operator()(const pg8::f32x4 (&acc)[2][2][4][2], const Unit& u, int wr, int wc, int fr_, int fq_) const {
        const int lane_ = otid() & 63, fr = lane_ & 15, fq = lane_ >> 4; (void)fr_; (void)fq_;
        const int row0 = u.pm * BM + wr * 64 + fr, col0 = u.pn * BM + wc * 32 + 8 * fq;
#pragma unroll
        for (int ai = 0; ai < 2; ++ai)
#pragma unroll
            for (int m = 0; m < 4; ++m) { const int row = row0 + ai * HALF + m * 16; if (row >= MV) continue;
#pragma unroll
                for (int bj = 0; bj < 2; ++bj) { const size_t off = (size_t)row * DM + col0 + bj * HALF;
                    const u32x4 t = *(const u32x4*)(T + off); const u32x4 xb = *(const u32x4*)(XB + off);
                    pg8::f32x4 x0 = {bflo(xb.x), bfhi(xb.x), bflo(xb.y), bfhi(xb.y)}, x1 = {bflo(xb.z), bfhi(xb.z), bflo(xb.w), bfhi(xb.w)};
                    const pg8::f32x4 a0 = acc[ai][bj][m][0], a1 = acc[ai][bj][m][1];
                    { const f32x2 s0 = sigm2((f32x2){a0[0], a0[1]}), s1 = sigm2((f32x2){a0[2], a0[3]}), s2 = sigm2((f32x2){a1[0], a1[1]}), s3 = sigm2((f32x2){a1[2], a1[3]});
                      x0[0] += s0.x * bflo(t.x); x0[1] += s0.y * bfhi(t.x); x0[2] += s1.x * bflo(t.y); x0[3] += s1.y * bfhi(t.y);
                      x1[0] += s2.x * bflo(t.z); x1[1] += s2.y * bfhi(t.z); x1[2] += s3.x * bflo(t.w); x1[3] += s3.y * bfhi(t.w); }
                    if (f32out) { *(pg8::f32x4*)(Xo + off) = x0; *(pg8::f32x4*)(Xo + off + 4) = x1; }
                    else { u32x4 w; w.x = pk2(x0[0], x0[1]); w.y = pk2(x0[2], x0[3]); w.z = pk2(x1[0], x1[1]); w.w = pk2(x1[2], x1[3]); *(u32x4*)((bf16_t*)Xo + off) = w; } } }
    }
};

__device__ __forceinline__ void cvt_wt(const float* __restrict__ W, bf16_t* __restrict__ Wt, int K, int N, int Npad, float* tile  ) {
    const int tid = otid(), ntn = Npad / 64, nt = ntn * (K / 64);
    for (int t = blockIdx.x; t < nt; t += gridDim.x) {
        const int n0 = (t % ntn) * 64, k0 = (t / ntn) * 64;
#pragma unroll
        for (int i = 0; i < 2; ++i) { const int kk = (tid >> 4) + 32 * i, n4 = (tid & 15) * 4;
            f32x4 v = {0.f, 0.f, 0.f, 0.f}; if (n0 + n4 < N) v = *(const f32x4*)(W + (size_t)(k0 + kk) * N + n0 + n4);
            tile[kk * 65 + n4] = v[0]; tile[kk * 65 + n4 + 1] = v[1]; tile[kk * 65 + n4 + 2] = v[2]; tile[kk * 65 + n4 + 3] = v[3]; }
        __syncthreads();
        { const int nn = tid >> 3, k8 = (tid & 7) * 8; u32x4 w;
          w.x = pk2(tile[(k8 + 0) * 65 + nn], tile[(k8 + 1) * 65 + nn]); w.y = pk2(tile[(k8 + 2) * 65 + nn], tile[(k8 + 3) * 65 + nn]);
          w.z = pk2(tile[(k8 + 4) * 65 + nn], tile[(k8 + 5) * 65 + nn]); w.w = pk2(tile[(k8 + 6) * 65 + nn], tile[(k8 + 7) * 65 + nn]);
          *(u32x4*)(Wt + (size_t)(n0 + nn) * K + k0 + k8) = w; }
        __syncthreads();
    }
}
__device__ __forceinline__ void prologue(const Args& a, float* tile) {
    unsigned char* ws = a.p->ws;
    for (int j = 0; j < 2; ++j) {
        cvt_wt(a.p->in[9] + (size_t)j * 1024 * 6144, (bf16_t*)(ws + WS_WGIN) + (size_t)j * 6144 * 1024, 1024, 6144, 6144, tile);
        cvt_wt(a.p->in[14] + (size_t)j * 2048 * 1024, (bf16_t*)(ws + WS_WGOUT) + (size_t)j * 1024 * 2048, 2048, 1024, 1024, tile);
        cvt_wt(a.p->in[15] + (size_t)j * 1024 * 8208, (bf16_t*)(ws + WS_WFIN) + (size_t)j * NFIN * 1024, 1024, 8208, NFIN, tile);
        cvt_wt(a.p->in[17] + (size_t)j * 2048 * 1024, (bf16_t*)(ws + WS_WFOUT) + (size_t)j * 1024 * 2048, 2048, 1024, 1024, tile);
    }
    for (int i = 0; i < 4; ++i) {
        cvt_wt(a.p->in[18] + (size_t)i * 256 * 1024, (bf16_t*)(ws + WS_WPP) + (size_t)i * 1024 * 256, 256, 1024, 1024, tile);
        cvt_wt(a.p->in[19] + (size_t)i * 1024 * 1024, (bf16_t*)(ws + WS_WPG) + (size_t)i * 1024 * 1024, 1024, 1024, 1024, tile);
    }
    const float* wsrc = a.p->in[12]; bf16_t* wm = (bf16_t*)(ws + WS_WM); bf16_t* wms = (bf16_t*)(ws + WS_WMS);
    for (int idx = blockIdx.x * 512 + otid(); idx < 2 * 16 * 128 * 128; idx += gridDim.x * 512) {
        const int jj = idx & 127, i = (idx >> 7) & 127, lg = idx >> 14;
        const float w = wsrc[idx]; wm[idx] = (bf16_t)f2bf((jj >> 6) <= (i >> 6) ? w : 0.f);
        const float w2 = wsrc[((size_t)lg * 128 + (i & 15)) * 128 + (jj & 15)]; wms[idx] = (bf16_t)f2bf((i >> 4) == (jj >> 4) ? w2 : 0.f);
    }
}

__device__ __forceinline__ void phase_e1(const Args& a, int layer) {
    const int tid = otid(), lane = tid & 63, gw = blockIdx.x * 8 + (tid >> 6), nw = gridDim.x * 8;
    float* X = a.p->out; bf16_t* X16 = (bf16_t*)a.p->out; bf16_t* HX = (bf16_t*)(a.p->ws + WS_HX); bf16_t* PB = (bf16_t*)(a.p->ws + WS_PB);
    const float* g = a.p->in[7] + (layer & 3) * DM;
    f32x4 gv[4];
#pragma unroll
    for (int q = 0; q < 4; ++q) gv[q] = *(const f32x4*)(g + q * 256 + lane * 4);
#define E1_LOAD(v, r) do { if (layer == 0) { _Pragma("unroll") for (int q = 0; q < 4; ++q) v[q] = *(const f32x4*)(a.p->in[0] + (size_t)(r) * DM + q * 256 + lane * 4); } \
        else { _Pragma("unroll") for (int q = 0; q < 4; ++q) { const u32x2 xb = *(const u32x2*)(X16 + (size_t)(r) * DM + q * 256 + lane * 4); v[q] = (f32x4){bflo(xb.x), bfhi(xb.x), bflo(xb.y), bfhi(xb.y)}; } } } while (0)
#define E1_FIN(v, r, p) do { float ss = 0.f; _Pragma("unroll") for (int q = 0; q < 4; ++q) ss += v[q][0] * v[q][0] + v[q][1] * v[q][1] + v[q][2] * v[q][2] + v[q][3] * v[q][3]; \
        ss = wave_sum(ss); const float rr = rsqrtf(ss * (1.f / DM) + RMS_EPS); \
        _Pragma("unroll") for (int q = 0; q < 4; ++q) { u32x2 hw; hw.x = pk2(v[q][0] * rr * gv[q][0], v[q][1] * rr * gv[q][1]); hw.y = pk2(v[q][2] * rr * gv[q][2], v[q][3] * rr * gv[q][3]); \
            *(u32x2*)(HX + (size_t)(r) * DM + q * 256 + lane * 4) = hw; } \
        u32x2 pw; pw.x = pk2(p[0], p[1]); pw.y = pk2(p[2], p[3]); *(u32x2*)(PB + (size_t)(r) * 256 + lane * 4) = pw; } while (0)
    if (layer < 4) {
        const float* pp = a.p->in[5] + (size_t)layer * MP * 256;
        for (int row = gw; row < MP; row += 2 * nw) {
            const int r1 = row + nw; const bool has1 = r1 < MP;
            f32x4 v0[4], v1[4]; f32x4 p0, p1 = {0.f, 0.f, 0.f, 0.f};
            E1_LOAD(v0, row); p0 = *(const f32x4*)(pp + (size_t)row * 256 + lane * 4);
            if (has1) { E1_LOAD(v1, r1); p1 = *(const f32x4*)(pp + (size_t)r1 * 256 + lane * 4); }
            E1_FIN(v0, row, p0);
            if (has1) E1_FIN(v1, r1, p1);
        }
    }
    for (int row = MP + gw; row < (layer == 4 ? MV : MA); row += nw) {
        if (row < MV) {
            f32x4 v[4];
            if (layer > 0) {
                const bf16_t* TBp = (const bf16_t*)(a.p->ws + WS_TB);
#pragma unroll
                for (int q = 0; q < 4; ++q) { const size_t off = (size_t)row * DM + q * 256 + lane * 4; const float* pq = (const float*)(a.p->ws + WS_PART) + (size_t)(row - MP) * 1024 + q * 256 + lane * 4;
                    f32x4 g4 = *(const f32x4*)pq;
#pragma unroll
                    for (int ks = 1; ks < 4; ++ks) g4 += *(const f32x4*)(pq + (size_t)ks * 256 * 1024);
                    const u32x2 xb = *(const u32x2*)(HX + off), tb = *(const u32x2*)(TBp + off);
                    v[q] = (f32x4){bflo(xb.x) + sigm_f(g4[0]) * bflo(tb.x), bfhi(xb.x) + sigm_f(g4[1]) * bfhi(tb.x), bflo(xb.y) + sigm_f(g4[2]) * bflo(tb.y), bfhi(xb.y) + sigm_f(g4[3]) * bfhi(tb.y)};
                    if (layer == 4) *(f32x4*)(X + off) = v[q]; else { u32x2 w; w.x = pk2(v[q][0], v[q][1]); w.y = pk2(v[q][2], v[q][3]); *(u32x2*)(X16 + off) = w; } }
                if (layer == 4) continue;
            } else {
#pragma unroll
                for (int q = 0; q < 4; ++q) v[q] = *(const f32x4*)(a.p->in[1] + (size_t)(row - MP) * DM + q * 256 + lane * 4);
            }
            const f32x4 p = *(const f32x4*)(a.p->in[6] + ((size_t)layer * MS + (row - MP)) * 256 + lane * 4);
            E1_FIN(v, row, p);
        } else {
#pragma unroll
            for (int q = 0; q < 4; ++q) *(u32x2*)(HX + (size_t)row * DM + q * 256 + lane * 4) = (u32x2){0u, 0u};
            *(u32x2*)(PB + (size_t)row * 256 + lane * 4) = (u32x2){0u, 0u};
        }
    }
#undef E1_LOAD
#undef E1_FIN
}
__device__ __forceinline__ void phase_e3(const Args& a, int layer, bool dummy = false) {
    const int tid = otid(), lane = tid & 63, gw = blockIdx.x * 8 + (tid >> 6), nw = gridDim.x * 8;
    const bf16_t* X16 = (const bf16_t*)a.p->out; bf16_t* HX = (bf16_t*)(a.p->ws + (dummy ? WS_DUMMY + 136 * MiB : WS_HX)); const bf16_t* OP = (const bf16_t*)(a.p->ws + WS_R0 + RSZ);
    const float* g = a.p->in[8] + layer * DM;
    f32x4 gv[4];
#pragma unroll
    for (int q = 0; q < 4; ++q) gv[q] = *(const f32x4*)(g + q * 256 + lane * 4);
#define E3_LOADX(XX, r, src0) do { if (layer == 0) { _Pragma("unroll") for (int q = 0; q < 4; ++q) XX[q] = *(const f32x4*)((src0) + q * 256 + lane * 4); } \
        else { _Pragma("unroll") for (int q = 0; q < 4; ++q) { const u32x2 xb = *(const u32x2*)(X16 + (size_t)(r) * DM + q * 256 + lane * 4); XX[q] = (f32x4){bflo(xb.x), bfhi(xb.x), bflo(xb.y), bfhi(xb.y)}; } } } while (0)
#define E3_FIN(v, XX, r) do { float ss = 0.f; _Pragma("unroll") for (int q = 0; q < 4; ++q) ss += v[q][0] * v[q][0] + v[q][1] * v[q][1] + v[q][2] * v[q][2] + v[q][3] * v[q][3]; \
        ss = wave_sum(ss); const float rr = rsqrtf(ss * (1.f / DM) + RMS_EPS); \
        _Pragma("unroll") for (int q = 0; q < 4; ++q) { u32x2 hw; hw.x = pk2(XX[q][0] + v[q][0] * rr * gv[q][0], XX[q][1] + v[q][1] * rr * gv[q][1]); hw.y = pk2(XX[q][2] + v[q][2] * rr * gv[q][2], XX[q][3] + v[q][3] * rr * gv[q][3]); \
            *(u32x2*)(HX + (size_t)(r) * DM + q * 256 + lane * 4) = hw; } } while (0)
#define E3_LOADOP(v, r) do { _Pragma("unroll") for (int q = 0; q < 4; ++q) { const u32x2 ob = *(const u32x2*)(OP + (size_t)(r) * DM + q * 256 + lane * 4); v[q] = (f32x4){bflo(ob.x), bfhi(ob.x), bflo(ob.y), bfhi(ob.y)}; } } while (0)
    for (int row = gw; row < MP; row += 2 * nw) {
        const int r1 = row + nw; const bool has1 = r1 < MP;
        f32x4 v0[4], x0[4], v1[4], x1[4];
        E3_LOADOP(v0, row); E3_LOADX(x0, row, a.p->in[0] + (size_t)row * DM);
        if (has1) { E3_LOADOP(v1, r1); E3_LOADX(x1, r1, a.p->in[0] + (size_t)r1 * DM); }
        E3_FIN(v0, x0, row);
        if (has1) E3_FIN(v1, x1, r1);
    }
    for (int row = MP + gw; row < MA; row += nw) {
        if (row < MV) {
            f32x4 v[4], x[4];
#pragma unroll
            for (int q = 0; q < 4; ++q) { const float* pq = (const float*)(a.p->ws + WS_PART) + (size_t)(row - MP) * 1024 + q * 256 + lane * 4; v[q] = *(const f32x4*)pq;
#pragma unroll
                for (int ks = 1; ks < 8; ++ks) v[q] += *(const f32x4*)(pq + (size_t)ks * 256 * 1024); }
            E3_LOADX(x, row, a.p->in[1] + (size_t)(row - MP) * DM);
            E3_FIN(v, x, row);
        } else {
#pragma unroll
            for (int q = 0; q < 4; ++q) *(u32x2*)(HX + (size_t)row * DM + q * 256 + lane * 4) = (u32x2){0u, 0u};
        }
    }
#undef E3_LOADX
#undef E3_FIN
#undef E3_LOADOP
}

__device__ __forceinline__ void phase_s1(const Args& a, int j, unsigned char* lds, bool dummy = false) {
    constexpr int LP = 136;
    bf16_t* As = (bf16_t*)lds; bf16_t* Bs = As + 128 * LP; float* fl = (float*)(Bs + 128 * LP);
    float* mu = fl, * rs = fl + 128, * t1 = fl + 256, * t2 = fl + 384;
    const int tid = otid(), lane = tid & 63, wid = tid >> 6, fr = lane & 15, fq = lane >> 4;
    const bf16_t* U = (const bf16_t*)(a.p->ws + WS_R0); bf16_t* Uo = (bf16_t*)(a.p->ws + (dummy ? WS_DUMMY : WS_R0)); const bf16_t* VT = (const bf16_t*)(a.p->ws + WS_R0 + RSZ); const bf16_t* ZS = (const bf16_t*)(a.p->ws + WS_R0 + 2 * RSZ);
    const float* stat = (const float*)(a.p->ws + WS_STAT);
    const float* lng_g = a.p->in[10] + j * EB; const float* lnb_g = a.p->in[11] + j * EB; const float* bsv_g = a.p->in[13] + j * 16 * 128;
    float* lng = fl + 512; float* lnb = lng + EB; float* bsv = lnb + EB;
    { *(f32x4*)(lng + tid * 4) = *(const f32x4*)(lng_g + tid * 4); *(f32x4*)(lnb + tid * 4) = *(const f32x4*)(lnb_g + tid * 4); *(f32x4*)(bsv + tid * 4) = *(const f32x4*)(bsv_g + tid * 4); }
    __syncthreads();
    float* gvs = a.p->out + O_GV + (size_t)j * MS * EB;
    constexpr int NU = 257 * 16;
    const int G_ = gridDim.x, w_ = blockIdx.x;
#define S1_UNIT(k) ((G_ == 256) ? ((k) < 16 ? w_ * 16 + (((k) + w_) & 15) :     ((k) == 16 && w_ < 16 ? 4096 + w_ : NU)) : (w_ + (k) * G_))
#define S1_LOAD_AB(u_) do { const int blk_ = (u_) >> 4, g_ = (u_) & 15; \
        const bf16_t* wsrc_ = (const bf16_t*)(a.p->ws + (blk_ == 256 ? WS_WMS : WS_WM)) + ((size_t)(j * 16 + g_) * 128) * 128; const bf16_t* vsrc_ = VT + ((size_t)blk_ * 2048 + g_ * 128) * 128; \
        _Pragma("unroll") for (int q = 0; q < 4; ++q) { ar[q] = *(const u32x4*)(wsrc_ + (tid >> 2) * 128 + (tid & 3) * 32 + q * 8); br[q] = *(const u32x4*)(vsrc_ + (tid >> 2) * 128 + (tid & 3) * 32 + q * 8); } } while (0)
    int un = S1_UNIT(0);
    if (un >= NU) return;
    u32x4 ar[4], br[4];
    S1_LOAD_AB(un);
    int prev_blk = -1;
    for (int k = 0;; ++k) {
        const int blk = un >> 4, g = un & 15, issamp = blk == 256;
        if (blk != prev_blk) {
          { const int r_ = tid >> 2, p_ = tid & 3; const float* sp = stat + (size_t)(blk * 128 + r_) * 64 + p_ * 8;
          const f32x4 s0 = *(const f32x4*)sp, s1 = *(const f32x4*)(sp + 4), q0 = *(const f32x4*)(sp + 32), q1 = *(const f32x4*)(sp + 36);
          float s = ((s0[0] + s0[1]) + (s0[2] + s0[3])) + ((s1[0] + s1[1]) + (s1[2] + s1[3])), q = ((q0[0] + q0[1]) + (q0[2] + q0[3])) + ((q1[0] + q1[1]) + (q1[2] + q1[3]));
          s += __shfl_xor(s, 1); s += __shfl_xor(s, 2); q += __shfl_xor(q, 1); q += __shfl_xor(q, 2);
          if (p_ == 0) { const float m = s * (1.f / EB); const float var = fmaxf(q * (1.f / EB) - m * m, 0.f); mu[r_] = m; rs[r_] = rsqrtf(var + LN_EPS); } }
          __syncthreads(); prev_blk = blk;
        }
        { const int i = tid >> 2, part = tid & 3; float a1 = 0.f, a2 = 0.f;
#pragma unroll
          for (int q = 0; q < 4; ++q) { const int j0 = part * 32 + q * 8; const u32x4 w = ar[q]; const unsigned ww[4] = {w.x, w.y, w.z, w.w}; float o[8];
#pragma unroll
              for (int e = 0; e < 4; ++e) { const float w0 = bflo(ww[e]), w1 = bfhi(ww[e]); const float r0 = rs[j0 + 2 * e], r1 = rs[j0 + 2 * e + 1];
                  o[2 * e] = w0 * r0; o[2 * e + 1] = w1 * r1; a1 += w0 * r0 * mu[j0 + 2 * e] + w1 * r1 * mu[j0 + 2 * e + 1]; a2 += w0 + w1; }
              u32x4 ow; ow.x = pk2(o[0], o[1]); ow.y = pk2(o[2], o[3]); ow.z = pk2(o[4], o[5]); ow.w = pk2(o[6], o[7]);
              *(u32x4*)(As + i * LP + j0) = ow; *(u32x4*)(Bs + i * LP + j0) = br[q]; }
          a1 += __shfl_xor(a1, 1); a1 += __shfl_xor(a1, 2); a2 += __shfl_xor(a2, 1); a2 += __shfl_xor(a2, 2);
          if (part == 0) { t1[i] = a1; t2[i] = a2; }
        }
        __syncthreads();
        const int un_next = S1_UNIT(k + 1); const bool has_next = un_next < NU;
        if (has_next) S1_LOAD_AB(un_next);
        const int i0 = (wid >> 1) * 32, c0 = (wid & 1) * 64;
        f32x4 acc[2][4];
#pragma unroll
        for (int mt = 0; mt < 2; ++mt)
#pragma unroll
            for (int nt = 0; nt < 4; ++nt) acc[mt][nt] = (f32x4){0.f, 0.f, 0.f, 0.f};
#pragma unroll
        for (int kk = 0; kk < 4; ++kk) {
            bf16x8 af[2], bfr[4];
#pragma unroll
            for (int mt = 0; mt < 2; ++mt) af[mt] = *(const bf16x8*)(As + (i0 + mt * 16 + fr) * LP + kk * 32 + fq * 8);
#pragma unroll
            for (int nt = 0; nt < 4; ++nt) bfr[nt] = *(const bf16x8*)(Bs + (c0 + nt * 16 + fr) * LP + kk * 32 + fq * 8);
#pragma unroll
            for (int mt = 0; mt < 2; ++mt)
#pragma unroll
                for (int nt = 0; nt < 4; ++nt) acc[mt][nt] = __builtin_amdgcn_mfma_f32_16x16x32_bf16(bfr[nt], af[mt], acc[mt][nt], 0, 0, 0);
        }
        const int ei = tid >> 2, ec = (tid & 3) * 32; const size_t erow = (size_t)blk * 128 + ei;
        u32x4 uu[4], zz[4];
#pragma unroll
        for (int q = 0; q < 4; ++q) { uu[q] = *(const u32x4*)(U + erow * EB + g * 128 + ec + q * 8); zz[q] = *(const u32x4*)(ZS + erow * EB + g * 128 + ec + q * 8); }
        if (issamp) {
            for (int idx = tid; idx < 128 * 128; idx += 512) { const int c = idx & 127, i = idx >> 7; const float v = __uint_as_float((unsigned)Bs[c * LP + i] << 16);
                gvs[(size_t)i * EB + g * 128 + c] = (v - mu[i]) * rs[i] * lng[g * 128 + c] + lnb[g * 128 + c]; }
        }
        __syncthreads();
        float* S32 = (float*)lds; constexpr int SP = 132;
#pragma unroll
        for (int mt = 0; mt < 2; ++mt)
#pragma unroll
            for (int nt = 0; nt < 4; ++nt) *(f32x4*)(S32 + (i0 + mt * 16 + fr) * SP + c0 + nt * 16 + fq * 4) = acc[mt][nt];
        __syncthreads();
        { const float t1i = t1[ei], t2i = t2[ei], bi = bsv[g * 128 + (issamp ? (ei & 15) : ei)];
#pragma unroll
          for (int q = 0; q < 4; ++q) { const int cg = g * 128 + ec + q * 8;
              const f32x4 sa = *(const f32x4*)(S32 + ei * SP + ec + q * 8), sb = *(const f32x4*)(S32 + ei * SP + ec + q * 8 + 4);
              const f32x4 lga = *(const f32x4*)(lng + cg), lgb = *(const f32x4*)(lng + cg + 4), lba = *(const f32x4*)(lnb + cg), lbb = *(const f32x4*)(lnb + cg + 4);
              float s[8];
#pragma unroll
              for (int e = 0; e < 4; ++e) { s[e] = lga[e] * (sa[e] - t1i) + lba[e] * t2i + bi; s[4 + e] = lgb[e] * (sb[e] - t1i) + lbb[e] * t2i + bi; }
              const unsigned u4[4] = {uu[q].x, uu[q].y, uu[q].z, uu[q].w}, z4[4] = {zz[q].x, zz[q].y, zz[q].z, zz[q].w}; unsigned y4[4];
#pragma unroll
              for (int e = 0; e < 4; ++e) y4[e] = pk2(bflo(u4[e]) * s[2 * e] * bflo(z4[e]), bfhi(u4[e]) * s[2 * e + 1] * bfhi(z4[e]));
              *(u32x4*)(Uo + erow * EB + cg) = (u32x4){y4[0], y4[1], y4[2], y4[3]}; } }
        __syncthreads();
        if (!has_next) break;
        un = un_next;
    }
#undef S1_UNIT
#undef S1_LOAD_AB
}

__device__ __forceinline__ void phase_c1(const Args& a, int j) {
    const int tid = otid(); if ((tid >> 6) != 0) return;
    const int lane = tid & 63;
    for (int sq = blockIdx.x; sq < 256; sq += gridDim.x) {
        if (sq < 128) {
            const int b = sq >> 4, h = sq & 15; const float* src = a.p->out + O_FLP + ((size_t)j * MP + (size_t)b * SEQ) * 16 + h; float* dst = (float*)(a.p->ws + WS_CBP) + (size_t)sq * SEQ;
            float tot = 0.f; for (int s = 0; s < 64; ++s) tot += src[(size_t)(lane * 64 + s) * 16];
            float inc = tot; for (int o = 1; o < 64; o <<= 1) { const float t = __shfl_up(inc, o); if (lane >= o) inc += t; }
            float run = inc - tot;
            for (int s = 0; s < 64; ++s) { run += src[(size_t)(lane * 64 + s) * 16];
                dst[lane * 64 + (((s >> 2) & 1) * 32 + ((s >> 3) & 3) * 4 + (s & 3) + 16 * (s >> 5))] = -run * 11.313708498984761f; }
        } else {
            const int bh = sq - 128, b = bh >> 4, h = bh & 15; const float* c0 = a.p->in[4] + ((size_t)(j * 8 + b) * PAST) * 16 + h; const float* c1 = a.p->out + O_FLS + ((size_t)j * MS + b * TS) * 16 + h;
            float* dst = (float*)(a.p->ws + WS_CBS) + (size_t)bh * SKS;
            float tot = 0.f; for (int s = 0; s < 33; ++s) { const int k = lane * 33 + s; const float v = k < PAST ? c0[(size_t)k * 16] : (k < PAST + TS ? c1[(size_t)(k - PAST) * 16] : 0.f); tot += v; }
            float inc = tot; for (int o = 1; o < 64; o <<= 1) { const float t = __shfl_up(inc, o); if (lane >= o) inc += t; }
            float run = inc - tot;
            for (int s = 0; s < 33; ++s) { const int k = lane * 33 + s; const float v = k < PAST ? c0[(size_t)k * 16] : (k < PAST + TS ? c1[(size_t)(k - PAST) * 16] : 0.f); run += v; dst[k] = -run; }
        }
    }
}

__device__ __forceinline__ void sample_attn(const Args& a, int j, int bh, unsigned char* ldsb, bool dummy = false) {
    constexpr int PP = 136;
    float* wmx = (float*)ldsb;
    bf16_t* Pb = (bf16_t*)(ldsb + 1024);
    float* lfin = (float*)(ldsb + 1024 + 2 * 16 * PP * 2);
    const int tid = otid(), lane = tid & 63, wid = __builtin_amdgcn_readfirstlane(tid >> 6), fr = lane & 15, fq = lane >> 4, b = bh >> 4, h = bh & 15;
    const bf16_t* Qb = (const bf16_t*)(a.p->ws + WS_R0); const bf16_t* ZS = (const bf16_t*)(a.p->ws + WS_R0 + 3 * RSZ); bf16_t* O = (bf16_t*)(a.p->ws + (dummy ? WS_DUMMY : WS_R0));
    const float* ck = a.p->in[2] + (size_t)(j * 8 + b) * PAST * EB + h * 128; const float* cv = a.p->in[3] + (size_t)(j * 8 + b) * PAST * EB + h * 128;
    const float* nk = a.p->out + O_FKS + ((size_t)j * MS + b * TS) * EB + h * 128; const float* nv = a.p->out + O_FVS + ((size_t)j * MS + b * TS) * EB + h * 128;
    const float* cb = (const float*)(a.p->ws + WS_CBS) + (size_t)bh * SKS;
    bf16x8 qf[4];
#pragma unroll
    for (int kk = 0; kk < 4; ++kk) qf[kk] = *(const bf16x8*)(Qb + (size_t)(MP + b * TS + fr) * EB + h * 128 + kk * 32 + fq * 8);
    const int kl = 16 * wid + fr;
    float m[4], ls[4]; f32x4 oacc = {0.f, 0.f, 0.f, 0.f};
#pragma unroll
    for (int r = 0; r < 4; ++r) { m[r] = -1e30f; ls[r] = 0.f; }
    f32x4 kr[8];
#pragma unroll
    for (int q = 0; q < 8; ++q) kr[q] = *(const f32x4*)(ck + (size_t)kl * EB + (q >> 1) * 32 + fq * 8 + (q & 1) * 4);
    int buf = 0;
    for (int c = 0; c < 17; ++c) {
        float vr[32];
        if (c < 16) {
#pragma unroll
            for (int q = 0; q < 32; ++q) vr[q] = cv[(size_t)(c * 128 + (q >> 3) * 32 + fq * 8 + (q & 7)) * EB + 16 * wid + fr];
        } else {
#pragma unroll
            for (int q = 0; q < 32; ++q) { const int key = (q >> 3) * 32 + fq * 8 + (q & 7); vr[q] = key < TS ? nv[(size_t)key * EB + 16 * wid + fr] : 0.f; }
        }
        const float bias = c < 16 ? cb[c * 128 + kl] : (kl < TS ? cb[PAST + kl] : 0.f);
        f32x4 sacc = {0.f, 0.f, 0.f, 0.f};
#pragma unroll
        for (int kk = 0; kk < 4; ++kk) { const f32x4 x0 = kr[2 * kk], x1 = kr[2 * kk + 1];
            u32x4 w; w.x = pk2(x0[0], x0[1]); w.y = pk2(x0[2], x0[3]); w.z = pk2(x1[0], x1[1]); w.w = pk2(x1[2], x1[3]);
            sacc = __builtin_amdgcn_mfma_f32_16x16x32_bf16(qf[kk], __builtin_bit_cast(bf16x8, w), sacc, 0, 0, 0); }
        if (c + 1 < 16) {
#pragma unroll
            for (int q = 0; q < 8; ++q) kr[q] = *(const f32x4*)(ck + (size_t)((c + 1) * 128 + kl) * EB + (q >> 1) * 32 + fq * 8 + (q & 1) * 4);
        } else if (c + 1 == 16) {
#pragma unroll
            for (int q = 0; q < 8; ++q) kr[q] = kl < TS ? *(const f32x4*)(nk + (size_t)kl * EB + (q >> 1) * 32 + fq * 8 + (q & 1) * 4) : (f32x4){0.f, 0.f, 0.f, 0.f};
        }
        float s[4], mw[4];
#pragma unroll
        for (int r = 0; r < 4; ++r) { s[r] = sacc[r] * att::SCALE + bias; if (c == 16 && (kl >= TS || kl > 4 * fq + r)) s[r] = -__builtin_inff(); mw[r] = s[r]; }
#pragma unroll
        for (int o = 1; o < 16; o <<= 1) {
#pragma unroll
            for (int r = 0; r < 4; ++r) mw[r] = fmaxf(mw[r], __shfl_xor(mw[r], o)); }
        if (fr == 0) {
#pragma unroll
            for (int r = 0; r < 4; ++r) wmx[buf * 128 + (4 * fq + r) * 8 + wid] = mw[r]; }
        __syncthreads();
        float p[4];
#pragma unroll
        for (int r = 0; r < 4; ++r) { const f32x4 w0 = *(const f32x4*)(wmx + buf * 128 + (4 * fq + r) * 8), w1 = *(const f32x4*)(wmx + buf * 128 + (4 * fq + r) * 8 + 4);
            const float mc = fmaxf(fmaxf(fmaxf(w0[0], w0[1]), fmaxf(w0[2], w0[3])), fmaxf(fmaxf(w1[0], w1[1]), fmaxf(w1[2], w1[3])));
            const float mn = fmaxf(m[r], mc), al = __expf(m[r] - mn); m[r] = mn; p[r] = __expf(s[r] - mn); ls[r] = ls[r] * al + p[r]; oacc[r] *= al;
            Pb[buf * 16 * PP + (4 * fq + r) * PP + kl] = (bf16_t)f2bf(p[r]); }
        __syncthreads();
#pragma unroll
        for (int kk = 0; kk < 4; ++kk) { const bf16x8 pa = *(const bf16x8*)(Pb + buf * 16 * PP + fr * PP + kk * 32 + fq * 8);
            u32x4 w; w.x = pk2(vr[kk * 8 + 0], vr[kk * 8 + 1]); w.y = pk2(vr[kk * 8 + 2], vr[kk * 8 + 3]); w.z = pk2(vr[kk * 8 + 4], vr[kk * 8 + 5]); w.w = pk2(vr[kk * 8 + 6], vr[kk * 8 + 7]);
            oacc = __builtin_amdgcn_mfma_f32_16x16x32_bf16(pa, __builtin_bit_cast(bf16x8, w), oacc, 0, 0, 0); }
        buf ^= 1;
    }
#pragma unroll
    for (int o = 1; o < 16; o <<= 1) {
#pragma unroll
        for (int r = 0; r < 4; ++r) ls[r] += __shfl_xor(ls[r], o); }
    if (fr == 0) {
#pragma unroll
        for (int r = 0; r < 4; ++r) lfin[wid * 16 + 4 * fq + r] = ls[r]; }
    __syncthreads();
#pragma unroll
    for (int r = 0; r < 4; ++r) { const int i = 4 * fq + r; float l = 0.f;
#pragma unroll
        for (int w = 0; w < 8; ++w) l += lfin[w * 16 + i];
        const size_t off = (size_t)(MP + b * TS + i) * EB + h * 128 + 16 * wid + fr;
        const float z = __uint_as_float((unsigned)ZS[off] << 16); O[off] = (bf16_t)f2bf(oacc[r] / l * z); }
    __syncthreads();
}

__device__ __forceinline__ void phase_attn(const Args& a, int j, unsigned char* ldsb, int mode = 0) {
    using namespace att;
    typedef __hip_bfloat16 T;
    const T* Q = (const T*)(a.p->ws + WS_R0); const T* K = (const T*)(a.p->ws + WS_R0 + RSZ); const T* V = (const T*)(a.p->ws + WS_R0 + 2 * RSZ); const T* Z = (const T*)(a.p->ws + WS_R0 + 3 * RSZ); T* O = (T*)(a.p->ws + (mode == 1 ? WS_DUMMY : WS_R0));
    const float* CB = (const float*)(a.p->ws + WS_CBP);
    char* lds = (char*)ldsb;
    constexpr int nqb = SEQ / QB, nx = nqb / 2, total = nx * NBH;
    const int stride = gridDim.x;
    int L = (gridDim.x == 256) ? (int)((blockIdx.x & 7) * 32 + (blockIdx.x >> 3)) : (int)blockIdx.x;
    if (mode == 2) L = total;
    if (L < total) {
#define MKREF(r, L_, pass_) do { const int bh_ = (L_) / nx, x_ = (L_) - bh_ * nx, qb_ = (pass_) ? x_ : nqb - 1 - x_,     b_ = bh_ >> 4, h_ = bh_ & 15; \
        const size_t ro_ = ((size_t)b_ * SEQ + (size_t)qb_ * QB) * PITCH + h_ * 128, ko_ = ((size_t)b_ * SEQ) * PITCH + h_ * 128; \
        (r).Q = Q + ro_; (r).O = O + ro_; (r).Z = Z + ro_; (r).K = K + ko_; (r).V = V + ko_; (r).CB = CB + (size_t)bh_ * SEQ; (r).P0 = qb_ * QB; } while (0)
        BlockRef<T, T> cur, nxt; int pass = 0;
        MKREF(cur, L, 0);
        Seam<T> S;
        causal_swa_prime<T, T>(cur, SEQ, lds, S);
        for (;;) {
            const bool more_pass = pass == 0, more_item = L + stride < total, last = !more_pass && !more_item;
            int passn = pass + 1, Ln = L;
            if (!more_pass) { passn = 0; Ln = more_item ? L + stride : L; }
            if (last) nxt = cur; else MKREF(nxt, Ln, passn);
            causal_swa_block<T, T>(cur, nxt, SEQ, SEQ, lds, S);
            if (last) break;
            cur = nxt; pass = passn; L = Ln;
        }
#undef MKREF
    }
    __syncthreads();
    if (mode != 1) for (int bh = (int)gridDim.x - 1 - (int)blockIdx.x; bh < NBH; bh += gridDim.x) sample_attn(a, j, bh, ldsb, mode == 2);
}

#define XB_TMO      128
#define XB_XCNT(j)  (256  + 64 * (j))
#define XB_XSUB(j)  (1280 + 64 * (j))
#define XB_XGEN(j)  (2304 + 64 * (j))
#define XB_TOP      3328
#define XB_TOPGEN   3392
#define XCD_BAR_WORDS 3456
#define XB_SPIN_CAP (1u << 18)

__device__ __forceinline__ unsigned xb_ld(unsigned* p)              { return __hip_atomic_load(p, __ATOMIC_RELAXED, __HIP_MEMORY_SCOPE_AGENT); }
__device__ __forceinline__ unsigned xb_add(unsigned* p, unsigned v) { return __hip_atomic_fetch_add(p, v, __ATOMIC_RELAXED, __HIP_MEMORY_SCOPE_AGENT); }
__device__ __forceinline__ unsigned xb_xcc_id() { return (unsigned)__builtin_amdgcn_s_getreg((3 << 11) | 20) & 0xFu; }
#define XB_SPIN(cond, bar) do { unsigned _sp = 0; while (cond) { __builtin_amdgcn_s_sleep(1); \
    if ((++_sp & 255u) == 0u) { if (xb_ld(&(bar)[XB_TMO])) break; if (_sp > XB_SPIN_CAP) { atomicAdd(&(bar)[XB_TMO], 1u); break; } } } } while (0)

struct XcdBarrier {
    unsigned* bar; unsigned x;
    volatile LAS unsigned* st;
};

__device__ __forceinline__ XcdBarrier xcd_barrier_post(unsigned* bar, volatile LAS unsigned* st) {
    XcdBarrier b; b.bar = bar; b.x = xb_xcc_id(); b.st = st;
    if (otid() == 0) (void)xb_add(&bar[XB_XCNT(b.x)], 1u);
    return b;
}
__device__ __forceinline__ void xcd_barrier_complete(unsigned* bar, unsigned x, unsigned& nloc, unsigned& nx) {
    const unsigned G = gridDim.x * gridDim.y * gridDim.z;
    unsigned sum, cnt, mine, sp = 0u;
    for (;;) {
        sum = 0u; cnt = 0u; mine = 0u;
#pragma unroll
        for (unsigned j = 0; j < 16; ++j) { const unsigned c = xb_ld(&bar[XB_XCNT(j)]); sum += c; cnt += (c > 0u) ? 1u : 0u; mine = (j == x) ? c : mine; }
        if (sum == G) break;
        __builtin_amdgcn_s_sleep(1);
        if ((++sp & 255u) == 0u) { if (xb_ld(&bar[XB_TMO])) break; if (sp > XB_SPIN_CAP) { atomicAdd(&bar[XB_TMO], 1u); break; } }
    }
    nloc = mine > 0u ? mine : 1u; nx = cnt > 0u ? cnt : 1u;
}

__device__ __forceinline__ void xcd_barrier(const XcdBarrier& b) {
    asm volatile("s_waitcnt vmcnt(0)" ::: "memory");
    __syncthreads();
    if (otid() == 0) {
        unsigned* bar = b.bar;
        __builtin_amdgcn_s_waitcnt(0);
        unsigned nloc = b.st[0], nx = b.st[1];
        if (nloc == 0u) { xcd_barrier_complete(bar, b.x, nloc, nx); b.st[0] = nloc; b.st[1] = nx; }
        const unsigned old = xb_add(&bar[XB_XSUB(b.x)], 1u);
        const unsigned gen = old / nloc;
        if (old + 1u == (gen + 1u) * nloc) {
            __builtin_amdgcn_fence(__ATOMIC_RELEASE, "agent");
            asm volatile("s_waitcnt vmcnt(0)" ::: "memory");
            const unsigned og = xb_add(&bar[XB_TOP], 1u);
            const unsigned tg = og / nx;
            if (og + 1u == (tg + 1u) * nx) xb_add(&bar[XB_TOPGEN], 1u);
            else XB_SPIN(xb_ld(&bar[XB_TOPGEN]) == tg, bar);
            __builtin_amdgcn_fence(__ATOMIC_ACQUIRE, "agent");
            xb_add(&bar[XB_XGEN(b.x)], 1u);
            asm volatile("s_waitcnt vmcnt(0)" ::: "memory");
        } else {
            XB_SPIN(xb_ld(&bar[XB_XGEN(b.x)]) == gen, bar);
            __builtin_amdgcn_fence(__ATOMIC_ACQUIRE, "agent");
            asm volatile("s_waitcnt vmcnt(0)" ::: "memory");
        }
    }
    __syncthreads();
}
#define WSPTRS() const Args a = getargs(); unsigned char* ws = a.p->ws; (void)ws; \
    bf16_t* HX = (bf16_t*)(ws + WS_HX); bf16_t* TB = (bf16_t*)(ws + WS_TB); bf16_t* PB = (bf16_t*)(ws + WS_PB); (void)HX; (void)TB; (void)PB; \
    bf16_t* R0 = (bf16_t*)(ws + WS_R0); bf16_t* R1 = (bf16_t*)(ws + WS_R0 + RSZ); bf16_t* R2 = (bf16_t*)(ws + WS_R0 + 2 * RSZ); bf16_t* R3 = (bf16_t*)(ws + WS_R0 + 3 * RSZ); (void)R0; (void)R1; (void)R2; (void)R3;
#define XBAR_MK() XcdBarrier xb_; xb_.bar = (unsigned*)(getargs().p->ws) + 1024; xb_.x = xb_xcc_id(); xb_.st = (volatile LAS unsigned*)((LAS unsigned char*)lds + (LDS_BYTES - 64))
#if PROBE_DUP == 7
#define GSYNC() do { XBAR_MK(); xcd_barrier(xb_); xcd_barrier(xb_); } while (0)
#else
#define GSYNC() do { XBAR_MK(); xcd_barrier(xb_); } while (0)
#endif
__global__ void __launch_bounds__(512, 2) fwd_megakernel(ArgsS args_unused) {
    extern __shared__ __attribute__((aligned(16))) unsigned char lds[];
    cg::grid_group grid = cg::this_grid();
    PG8_LAS unsigned char* gl = (PG8_LAS unsigned char*)lds;
    const int G = gridDim.x, c = blockIdx.x;
    { const unsigned hw = (unsigned)__builtin_amdgcn_s_getreg((5 << 11) | 4) & 63u;
      if ((threadIdx.x & 63) == 0) ((LAS int*)((LAS unsigned char*)lds + LDS_WIDTAB))[hw] = (int)(threadIdx.x >> 6);
      if (threadIdx.x < 16) ((LAS unsigned*)((LAS unsigned char*)lds + (LDS_BYTES - 64)))[threadIdx.x] = 0u; }
    __syncthreads();
    { XBAR_MK(); (void)xcd_barrier_post(xb_.bar, xb_.st); }
#ifndef SKIP_PRO
    { const Args a = getargs(); prologue(a, (float*)lds); }
#endif
    { const Args a = getargs(); if (a.p->ws == nullptr) grid.sync(); }
    GSYNC();
    for (int layer = 0; layer < 4; ++layer) {
        const int j = layer >> 1;
#ifndef SKIP_E1
        for (int rp_ = (PROBE_DUP == 4 ? 0 : 1); rp_ < 2; ++rp_) { const Args a = getargs(); phase_e1(a, layer); if (!rp_) GSYNC(); }
#endif
        GSYNC();
        if ((layer & 1) == 0) {
#ifndef SKIP_G1G
            { WSPTRS(); pg8::Gemm g{HX, (const bf16_t*)(ws + WS_WGIN) + (size_t)j * 6144 * 1024, MA, 6144, 1024}; pg8::StaticOrder S; S.init(MA, 6144, G, c);
              EpiGmlpIn E{R0, R1, R2, (float*)(ws + WS_STAT)};
              for (int rp_ = 0; rp_ < (PROBE_DUP == 5 ? 2 : 1); ++rp_) pg8::gemm_phase<EpiGmlpIn, pg8::StaticOrder, true, true>(gl, g, S, E); }
#endif
        } else {
#ifndef SKIP_G1F
            { WSPTRS(); pg8::Gemm g{HX, (const bf16_t*)(ws + WS_WFIN) + (size_t)j * NFIN * 1024, MA, NFIN, 1024}; pg8::StaticOrder S; S.init(MA, NFIN, G, c);
              float* out = a.p->out;
              EpiFoxIn E{R0, R1, R2, R3, out + O_FKP + (size_t)j * MP * EB, out + O_FVP + (size_t)j * MP * EB, out + O_FLP + (size_t)j * MP * 16,
                         out + O_FKS + (size_t)j * MS * EB, out + O_FVS + (size_t)j * MS * EB, out + O_FLS + (size_t)j * MS * 16, a.p->in[16] + j * 16};
              for (int rp_ = 0; rp_ < (PROBE_DUP == 5 ? 2 : 1); ++rp_) pg8::gemm_phase<EpiFoxIn, pg8::StaticOrder, true, true>(gl, g, S, E); }
#endif
        }
#ifndef SKIP_GT
        { WSPTRS(); pg8::Gemm g{PB, (const bf16_t*)(ws + WS_WPP) + (size_t)layer * 1024 * 256, MA, 1024, 256}; const int nb_ = (layer & 1) ? 0 : 24;
          pg8::StaticOrder S; S.init(MA, 1024, G - nb_, c >= nb_ ? G - 1 - c : (1 << 24));
          EpiT E{TB, 1024};
          for (int rp_ = 0; rp_ < (PROBE_DUP == 6 ? 2 : 1); ++rp_) pg8::gemm_phase<EpiT, pg8::StaticOrder, true, true>(gl, g, S, E); }
#endif
        GSYNC();
        if ((layer & 1) == 0) {
#ifndef SKIP_S1
            for (int rp_ = (PROBE_DUP == 3 ? 0 : 1); rp_ < 2; ++rp_) { const Args a = getargs(); phase_s1(a, j, lds, !rp_); if (!rp_) GSYNC(); }
#endif
        } else {
#ifndef SKIP_C1
            { const Args a = getargs(); phase_c1(a, j); }
#endif
            GSYNC();
#ifndef SKIP_ATTN
            for (int rp_ = ((PROBE_DUP == 1 || PROBE_DUP == 2) ? 0 : 1); rp_ < 2; ++rp_) { const Args a = getargs(); phase_attn(a, j, lds, rp_ ? 0 : PROBE_DUP); if (!rp_) GSYNC(); }
#endif
        }
        GSYNC();
#ifndef SKIP_G2
        { WSPTRS(); pg8::Gemm g{R0, (const bf16_t*)(ws + ((layer & 1) ? WS_WFOUT : WS_WGOUT)) + (size_t)j * 1024 * 2048, MP, 1024, 2048}; pg8::StaticOrder S; S.init(MP, 1024, G, c);
          EpiT E{R1, 1024};
          for (int rp_ = 0; rp_ < (PROBE_DUP == 6 ? 2 : 1); ++rp_) pg8::gemm_phase<EpiT, pg8::StaticOrder, true, true>(gl, g, S, E); }
#endif
        { WSPTRS(); int ksl = 256; asm volatile("" : "+s"(ksl)); pg8::Gemm g{R0, (const bf16_t*)(ws + ((layer & 1) ? WS_WFOUT : WS_WGOUT)) + (size_t)j * 1024 * 2048, MA, 1024, ksl, 2048}; SplitOrder S{8, c};
          EpiPart E{(float*)(ws + WS_PART)};
          pg8::gemm_phase<EpiPart, SplitOrder, true, true>(gl, g, S, E); }
        GSYNC();
#ifndef SKIP_E3
        for (int rp_ = (PROBE_DUP == 4 ? 0 : 1); rp_ < 2; ++rp_) { const Args a = getargs(); phase_e3(a, layer, !rp_); if (!rp_) GSYNC(); }
#endif
        GSYNC();
#ifndef SKIP_G3
        { WSPTRS(); pg8::Gemm g{HX, (const bf16_t*)(ws + WS_WPG) + (size_t)layer * 1024 * 1024, MP, 1024, 1024}; pg8::StaticOrder S; S.init(MP, 1024, G, c);
          for (int rp_ = (PROBE_DUP == 6 ? 0 : 1); rp_ < 2; ++rp_) { EpiGate E{HX, rp_ ? a.p->out : (float*)(ws + WS_DUMMY), TB, layer == 3}; pg8::gemm_phase<EpiGate, pg8::StaticOrder, true, true>(gl, g, S, E); } }
#endif
        { WSPTRS(); int ksl = 256; asm volatile("" : "+s"(ksl)); pg8::Gemm g{HX, (const bf16_t*)(ws + WS_WPG) + (size_t)layer * 1024 * 1024, MA, 1024, ksl, 1024}; SplitOrder S{4, c};
          EpiPart E{(float*)(ws + WS_PART)};
          pg8::gemm_phase<EpiPart, SplitOrder, true, true>(gl, g, S, E); }
        GSYNC();
    }
    { const Args a = getargs(); phase_e1(a, 4); }
}

extern "C" void kernel_launch(void* const* d_in, const int* in_sizes, int n_in, void* d_out, int out_size, void* d_ws, size_t ws_size, hipStream_t stream) {
    static int grid = 0;
    if (grid == 0) {
        if (n_in != 20 || ws_size < WS_END) { fprintf(stderr, "kernel_launch: need 20 inputs and >= %zu bytes of workspace; got %d, %zu\n", (size_t)WS_END, n_in, ws_size); grid = -1; return; }
        int dev = 0, cus = 0, per_cu = 0;
        (void)hipGetDevice(&dev); (void)hipDeviceGetAttribute(&cus, hipDeviceAttributeMultiprocessorCount, dev);
        if (hipFuncSetAttribute((const void*)fwd_megakernel, hipFuncAttributeMaxDynamicSharedMemorySize, LDS_BYTES) != hipSuccess) { fprintf(stderr, "kernel_launch: hipFuncSetAttribute failed\n"); grid = -1; return; }
        if (hipOccupancyMaxActiveBlocksPerMultiprocessor(&per_cu, (const void*)fwd_megakernel, 512, LDS_BYTES) != hipSuccess || per_cu < 1) { fprintf(stderr, "kernel_launch: occupancy query says %d\n", per_cu); per_cu = 1; }
        (void)hipGetLastError();
        grid = cus > 0 ? cus : 256;
    }
    if (grid < 0) return;
    if (hipMemsetAsync(d_ws, 0, 65536, stream) != hipSuccess) { fprintf(stderr, "kernel_launch: memset of the barrier words failed\n"); return; }
    ArgsS a{};
    for (int i = 0; i < 20; ++i) a.in[i] = (const float*)d_in[i];
    a.out = (float*)d_out; a.ws = (unsigned char*)d_ws;
    void* args[] = {&a};
    hipError_t e = hipLaunchCooperativeKernel((const void*)fwd_megakernel, dim3(grid), dim3(512), args, LDS_BYTES, stream);
    if (e != hipSuccess) fprintf(stderr, "cooperative launch failed: %s (grid %d)\n", hipGetErrorString(e), grid);
}
```

```cpp
#include <hip/hip_runtime.h>
#include <hip/hip_bf16.h>
#include <hip/hip_cooperative_groups.h>
#include <cstdio>
#include <cstdint>
extern __shared__ __attribute__((aligned(16))) unsigned char g_lds[];
constexpr int LDS_TOTAL = 147456, LDS_WIDTAB = LDS_TOTAL - 512;
__device__ __forceinline__ int otid() {
    const unsigned hw = (unsigned)__builtin_amdgcn_s_getreg((5 << 11) | 4) & 63u;
    int w = ((volatile __attribute__((address_space(3))) int*)((__attribute__((address_space(3))) unsigned char*)g_lds + LDS_WIDTAB))[hw];
    w = __builtin_amdgcn_readfirstlane(w);
    int l; asm volatile("v_mbcnt_lo_u32_b32 %0, -1, 0" : "=v"(l)); asm volatile("v_mbcnt_hi_u32_b32 %0, -1, %0" : "+v"(l));
    return w * 64 + l;
}
namespace pg8 {
#define PG8_LAS __attribute__((address_space(3)))
typedef unsigned short bf16_t;
typedef short bf16x8 __attribute__((ext_vector_type(8)));
typedef float f32x4 __attribute__((ext_vector_type(4)));
typedef unsigned u32x4 __attribute__((ext_vector_type(4)));
constexpr int BM = 256, BK = 64, HALF = 128, HTB = HALF * BK * 2  , STAGE_BYTES = 8 * HTB, NXCD = 8, WGM = 8;

__host__ __device__ __forceinline__ int lds_byte(int r, int c) { const int st = (r >> 4) * 2 + (c >> 5), rr = r & 15, cc = c & 31, ob = rr * 64 + cc * 2; return st * 1024 + (ob ^ (((ob >> 9) & 1) << 5)); }
__host__ __device__ __forceinline__ void stage_rc(int b, int& R, int& C) { const int st = b / 1024, sb = b % 1024, swz = sb ^ (((sb >> 9) & 1) << 5); R = (st >> 1) * 16 + swz / 64; C = (st & 1) * 32 + (swz % 64) / 2; }
__host__ __device__ __forceinline__ int perm32(int rho) { const int n = rho >> 4, i = rho & 15; return 8 * (i >> 2) + 4 * n + (i & 3); }

struct Unit { int pm, pn, ko; };
struct Gemm { const bf16_t* A; const bf16_t* Bt; int M, N, K, ldk; };

struct StaticOrder {
    int nM, nN, nwg, G, c;
    __host__ __device__ void init(int M, int N, int G_, int c_) { nM = M / BM; nN = N / BM; nwg = nM * nN; G = G_; c = c_; }
    __host__ __device__ bool next(int i, Unit& u) const {
        const long L = (long)i * G + c; if (L >= nwg) return false;
        int wgid = (int)L; { const int q = nwg / NXCD, r = nwg % NXCD, xcd = wgid % NXCD, off = wgid / NXCD; wgid = (xcd < r ? xcd * (q + 1) : r * (q + 1) + (xcd - r) * q) + off; }
        const int nig = WGM * nN, gid = wgid / nig, fm = gid * WGM, gsz = (nM - fm) < WGM ? (nM - fm) : WGM;
        u.pm = fm + ((wgid % nig) % gsz); u.pn = (wgid % nig) / gsz; u.ko = 0; return true;
    }
    __device__ __forceinline__ void a_ready(const Unit&) const {}
    __device__ __forceinline__ void done(const Unit&) const {}
};

__device__ __forceinline__ unsigned cvt_pk_bf16(float lo, float hi) { unsigned r; asm volatile("v_cvt_pk_bf16_f32 %0, %1, %2" : "=v"(r) : "v"(lo), "v"(hi)); return r; }
typedef float f32x2 __attribute__((ext_vector_type(2)));
__device__ __forceinline__ f32x2 gelu_pk(f32x2 v) {
    const f32x2 av = __builtin_elementwise_abs(v), d = av * 0.2316418882f + 1.0f;
    f32x2 t; t.x = __builtin_amdgcn_rcpf(d.x); t.y = __builtin_amdgcn_rcpf(d.y);
    f32x2 q = t * 0.5307027145f + (-0.7265760135f); q = q * t + 0.7107068705f; q = q * t + (-0.142248368f); q = q * t + 0.127414796f; q = q * t;
    const f32x2 s = (v * v) * (-0.72134752044f);
    f32x2 e; e.x = __builtin_amdgcn_exp2f(s.x); e.y = __builtin_amdgcn_exp2f(s.y);
    const f32x2 m = v * (q * e), r = v - m;
    f32x2 o; o.x = v.x < 0.f ? m.x : r.x; o.y = v.y < 0.f ? m.y : r.y; return o;
}

template <int ACT  > struct EpiBf16 {
    static constexpr bool PERM = true, AFTER_DRAIN = false; static_assert(ACT == 0 || ACT == 1, "EpiBf16: ACT is 0 (none) or 1 (gelu_pk)");
    bf16_t* O; int ldc; const float* bias; int split_cols; size_t split_stride; float scale0;
    __device__ __forceinline__ void operator()(const f32x4 (&acc)[2][2][4][2], const Unit& u, int wr, int wc, int fr, int fq) const {
        const int row0 = u.pm * BM + wr * 64 + fr; int colt = u.pn * BM; bf16_t* base = O;
        float sc = 1.f; if (split_cols) { const int t = colt / split_cols; base += (size_t)t * split_stride; colt -= t * split_cols; if (t == 0) sc = scale0; }
        const int col0 = colt + wc * 32 + 8 * fq, bcol0 = u.pn * BM + wc * 32 + 8 * fq;
        f32x4 bv[2][2];
#pragma unroll
        for (int bj = 0; bj < 2; ++bj)
#pragma unroll
            for (int n = 0; n < 2; ++n) bv[bj][n] = bias ? *(const f32x4*)(bias + bcol0 + bj * HALF + 4 * n) : (f32x4){0.f, 0.f, 0.f, 0.f};
#pragma unroll
        for (int ai = 0; ai < 2; ++ai)
#pragma unroll
            for (int m = 0; m < 4; ++m) { bf16_t* rowp = base + (size_t)(row0 + ai * HALF + m * 16) * ldc + col0;
#pragma unroll
                for (int bj = 0; bj < 2; ++bj) { f32x4 v0 = acc[ai][bj][m][0] + bv[bj][0], v1 = acc[ai][bj][m][1] + bv[bj][1];
                    if (ACT == 1) { f32x2 a = gelu_pk((f32x2){v0[0], v0[1]}), b = gelu_pk((f32x2){v0[2], v0[3]}), c = gelu_pk((f32x2){v1[0], v1[1]}), d = gelu_pk((f32x2){v1[2], v1[3]});
                        v0 = (f32x4){a.x, a.y, b.x, b.y}; v1 = (f32x4){c.x, c.y, d.x, d.y}; }
                    v0 = v0 * sc; v1 = v1 * sc; u32x4 w; w.x = cvt_pk_bf16(v0[0], v0[1]); w.y = cvt_pk_bf16(v0[2], v0[3]); w.z = cvt_pk_bf16(v1[0], v1[1]); w.w = cvt_pk_bf16(v1[2], v1[3]);
                    *(u32x4*)(rowp + bj * HALF) = w; } }
    }
};


template <class Epi, class Sched, bool ALIGN_EPI = false, bool SP2 = false>
__device__ __forceinline__ void gemm_phase(PG8_LAS unsigned char* lds, const Gemm g, const Sched& S, const Epi& E) {
    const int tid = otid(), wid = __builtin_amdgcn_readfirstlane(tid >> 6), lane = tid & 63, wr = wid >> 2, wc = wid & 3, fr = lane & 15, fq = lane >> 4;
    const int K = g.K, nt = K / BK, LDK = g.ldk ? g.ldk : g.K;
    unsigned voffA[2], voffB[2];
#pragma unroll
    for (int i = 0; i < 2; ++i) { int R, C; stage_rc(tid * 16 + i * 8192, R, C); const int Rb = Epi::PERM ? ((R & ~31) + perm32(R & 31)) : R;
        voffA[i] = (unsigned)(R * LDK + C) * 2u; voffB[i] = (unsigned)(Rb * LDK + C) * 2u; }
    const size_t kstep = (size_t)(BK * 2);
    const size_t hstep = (size_t)HALF * LDK * 2;
    const size_t tstep = 2 * hstep;
    const unsigned ldsw = (unsigned)wid * 1024u;
    const int aoff = lds_byte(wr * 64 + fr, fq * 8), boff = lds_byte(wc * 32 + fr, fq * 8);
#define PG8_SA(b, h) (((b) * 2 + (h)) * HTB)
#define PG8_SB(b, h) ((4 + (b) * 2 + (h)) * HTB)
#define PG8_STAGE(bufoff, gbase, voff) do { _Pragma("unroll") for (int _i = 0; _i < 2; ++_i) \
        __builtin_amdgcn_global_load_lds((const unsigned*)((const char*)(gbase) + (voff)[_i]), (PG8_LAS unsigned*)(lds + (bufoff) + ldsw + _i * 8192), 16, 0, 0); } while (0)
#define PG8_LDA(dst, b, h) do { _Pragma("unroll") for (int m = 0; m < 4; ++m) _Pragma("unroll") for (int k = 0; k < 2; ++k) dst[m][k] = *(const PG8_LAS bf16x8*)(lds + PG8_SA(b, h) + aoff + m * 2048 + k * 1024); } while (0)
#define PG8_LDB(dst, b, h) do { _Pragma("unroll") for (int n = 0; n < 2; ++n) _Pragma("unroll") for (int k = 0; k < 2; ++k) dst[n][k] = *(const PG8_LAS bf16x8*)(lds + PG8_SB(b, h) + boff + n * 2048 + k * 1024); } while (0)
#define PG8_MMA(ai, bj, At, Bt) do { __builtin_amdgcn_s_setprio(1); _Pragma("unroll") for (int m = 0; m < 4; ++m) _Pragma("unroll") for (int n = 0; n < 2; ++n) _Pragma("unroll") for (int k = 0; k < 2; ++k) \
        acc[ai][bj][m][n] = __builtin_amdgcn_mfma_f32_16x16x32_bf16(Bt[n][k], At[m][k], acc[ai][bj][m][n], 0, 0, 0); __builtin_amdgcn_s_setprio(0); } while (0)
#define PG8_WAIT_V(n) asm volatile("s_waitcnt vmcnt(" #n ")" ::: "memory")
#define PG8_WAIT_L(n) asm volatile("s_waitcnt lgkmcnt(" #n ")" ::: "memory")
#define PG8_BAR __builtin_amdgcn_s_barrier()
#define PG8_SCHED __builtin_amdgcn_sched_barrier(0)
    Unit cur, nxt; int ui = 0;
    if (!S.next(0, cur)) return;
    f32x4 acc[2][2][4][2];
#pragma unroll
    for (int a = 0; a < 2; ++a)
#pragma unroll
        for (int b = 0; b < 2; ++b)
#pragma unroll
            for (int m = 0; m < 4; ++m)
#pragma unroll
                for (int n = 0; n < 2; ++n) acc[a][b][m][n] = (f32x4){0.f, 0.f, 0.f, 0.f};
    bf16x8 At[4][2], B0[2][2], B1[2][2];
    const char* cA = (const char*)g.A + (size_t)cur.pm * tstep + (size_t)cur.ko * 2; const char* cB = (const char*)g.Bt + (size_t)cur.pn * tstep + (size_t)cur.ko * 2;
    S.a_ready(cur);
    if constexpr (SP2) {
        PG8_STAGE(PG8_SB(0, 0), cB, voffB); PG8_STAGE(PG8_SB(0, 1), cB + hstep, voffB); PG8_STAGE(PG8_SA(0, 0), cA, voffA); PG8_STAGE(PG8_SA(0, 1), cA + hstep, voffA);
        if (wr == 1) PG8_BAR;
        PG8_WAIT_V(2); PG8_BAR;
        PG8_STAGE(PG8_SB(1, 0), cB + kstep, voffB); PG8_STAGE(PG8_SA(1, 0), cA + kstep, voffA); PG8_STAGE(PG8_SB(1, 1), cB + hstep + kstep, voffB);
        PG8_WAIT_V(6); PG8_BAR;
    } else {
        PG8_STAGE(PG8_SB(0, 0), cB, voffB); PG8_STAGE(PG8_SA(0, 0), cA, voffA); PG8_STAGE(PG8_SB(0, 1), cB + hstep, voffB); PG8_STAGE(PG8_SA(0, 1), cA + hstep, voffA);
        if (wr == 1) PG8_BAR;
        PG8_WAIT_V(4); PG8_BAR;
        PG8_STAGE(PG8_SB(1, 0), cB + kstep, voffB); PG8_STAGE(PG8_SA(1, 0), cA + kstep, voffA); PG8_STAGE(PG8_SB(1, 1), cB + hstep + kstep, voffB);
        PG8_WAIT_V(6); PG8_BAR;
    }
    for (;;) {
        const bool has_next = S.next(ui + 1, nxt);
        const char* nA = has_next ? (const char*)g.A + (size_t)nxt.pm * tstep + (size_t)nxt.ko * 2 : cA; const char* nB = has_next ? (const char*)g.Bt + (size_t)nxt.pn * tstep + (size_t)nxt.ko * 2 : cB;
        for (int t = 0; t < nt; t += 2) {
            const bool last = (t == nt - 2);
            const char* a1 = cA + (size_t)(t + 1) * kstep;
            const char* a2 = last ? nA : cA + (size_t)(t + 2) * kstep; const char* b2 = last ? nB : cB + (size_t)(t + 2) * kstep;
            const char* a3 = a2 + kstep; const char* b3 = b2 + kstep;
            if (last && has_next) S.a_ready(nxt);
            if constexpr (SP2) {
            PG8_LDB(B0, 0, 0); PG8_LDB(B1, 0, 1); PG8_SCHED; PG8_LDA(At, 0, 0); PG8_STAGE(PG8_SA(1, 1), a1 + hstep, voffA);
            PG8_WAIT_V(8); PG8_WAIT_L(0); PG8_BAR; PG8_MMA(0, 0, At, B0); PG8_MMA(0, 1, At, B1); PG8_BAR; PG8_SCHED;
            PG8_LDA(At, 0, 1); PG8_STAGE(PG8_SB(0, 0), b2, voffB); PG8_STAGE(PG8_SB(0, 1), b2 + hstep, voffB); PG8_STAGE(PG8_SA(0, 0), a2, voffA);
            PG8_WAIT_V(8); PG8_WAIT_L(0); PG8_BAR; PG8_MMA(1, 0, At, B0); PG8_MMA(1, 1, At, B1); PG8_BAR; PG8_SCHED;
            PG8_LDB(B0, 1, 0); PG8_LDB(B1, 1, 1); PG8_SCHED; PG8_LDA(At, 1, 0); PG8_STAGE(PG8_SA(0, 1), a2 + hstep, voffA);
            PG8_WAIT_V(8); PG8_WAIT_L(0); PG8_BAR; PG8_MMA(0, 0, At, B0); PG8_MMA(0, 1, At, B1); PG8_BAR; PG8_SCHED;
            PG8_LDA(At, 1, 1); PG8_STAGE(PG8_SB(1, 0), b3, voffB); PG8_STAGE(PG8_SB(1, 1), b3 + hstep, voffB); PG8_STAGE(PG8_SA(1, 0), a3, voffA);
            PG8_WAIT_V(8); PG8_WAIT_L(0); PG8_BAR; PG8_MMA(1, 0, At, B0); PG8_MMA(1, 1, At, B1); PG8_BAR; PG8_SCHED;
            } else {
            PG8_LDB(B0, 0, 0); PG8_SCHED; PG8_LDA(At, 0, 0); PG8_STAGE(PG8_SA(1, 1), a1 + hstep, voffA);
            PG8_WAIT_L(8); PG8_BAR; PG8_WAIT_L(0); PG8_MMA(0, 0, At, B0); PG8_BAR; PG8_SCHED;
            PG8_LDB(B1, 0, 1); PG8_STAGE(PG8_SB(0, 0), b2, voffB);
            PG8_BAR; PG8_WAIT_L(0); PG8_MMA(0, 1, At, B1); PG8_BAR;
            PG8_LDA(At, 0, 1); PG8_STAGE(PG8_SA(0, 0), a2, voffA);
            PG8_BAR; PG8_WAIT_L(0); PG8_MMA(1, 0, At, B0); PG8_BAR; PG8_SCHED;
            PG8_STAGE(PG8_SB(0, 1), b2 + hstep, voffB);
            PG8_WAIT_V(6); PG8_BAR; PG8_MMA(1, 1, At, B1); PG8_BAR;
            PG8_LDB(B0, 1, 0); PG8_SCHED; PG8_LDA(At, 1, 0); PG8_STAGE(PG8_SA(0, 1), a2 + hstep, voffA);
            PG8_WAIT_L(8); PG8_BAR; PG8_WAIT_L(0); PG8_MMA(0, 0, At, B0); PG8_BAR; PG8_SCHED;
            PG8_LDB(B1, 1, 1); PG8_STAGE(PG8_SB(1, 0), b3, voffB);
            PG8_BAR; PG8_WAIT_L(0); PG8_MMA(0, 1, At, B1); PG8_BAR;
            PG8_LDA(At, 1, 1); PG8_STAGE(PG8_SA(1, 0), a3, voffA);
            PG8_BAR; PG8_WAIT_L(0); PG8_MMA(1, 0, At, B0); PG8_BAR; PG8_SCHED;
            PG8_STAGE(PG8_SB(1, 1), b3 + hstep, voffB);
            PG8_WAIT_V(6); PG8_BAR; PG8_MMA(1, 1, At, B1); PG8_BAR;
            }
        }
        if constexpr (ALIGN_EPI) { if (wr == 0) PG8_BAR; }
        if constexpr (!Epi::AFTER_DRAIN) { E(acc, cur, wr, wc, fr, fq); S.done(cur); }
        if (!has_next) break;
#pragma unroll
        for (int a = 0; a < 2; ++a)
#pragma unroll
            for (int b = 0; b < 2; ++b)
#pragma unroll
                for (int m = 0; m < 4; ++m)
#pragma unroll
                    for (int n = 0; n < 2; ++n) acc[a][b][m][n] = (f32x4){0.f, 0.f, 0.f, 0.f};
        cur = nxt; cA = nA; cB = nB; ++ui;
        if constexpr (ALIGN_EPI) { if (wr == 1) PG8_BAR; }
    }
    PG8_WAIT_V(0);
    if constexpr (!ALIGN_EPI) { if (wr == 0) PG8_BAR; }
    PG8_BAR;
    if constexpr (Epi::AFTER_DRAIN) { E.fused(acc, cur, wr, wc, fr, fq, lds, wid, lane); S.done(cur); }
#undef PG8_SA
#undef PG8_SB
#undef PG8_STAGE
#undef PG8_LDA
#undef PG8_LDB
#undef PG8_MMA
#undef PG8_WAIT_V
#undef PG8_WAIT_L
#undef PG8_BAR
#undef PG8_SCHED
}
}
namespace att {
constexpr int D = 128, PITCH = 2048;
constexpr float THR = 8.f;
constexpr bool WSKIP = false;
constexpr float SCALE = 0.08838834764831845f;
constexpr int NW = 8, QBLK = 32, KVBLK = 64, QB = NW * QBLK;
constexpr int SHM_V = KVBLK * D * 2, SHM_K = KVBLK * D * 2;
constexpr int LDS_BYTES = 2 * SHM_V + 2 * SHM_K + NW * 64 * 4 + 512;
using bf16 = __hip_bfloat16;
typedef short bf16x8 __attribute__((ext_vector_type(8)));
typedef short s16x4 __attribute__((ext_vector_type(4)));
typedef float f32x16 __attribute__((ext_vector_type(16)));
typedef float f32x4 __attribute__((ext_vector_type(4)));
typedef unsigned u32x4 __attribute__((ext_vector_type(4)));
template <class A, class Bt> struct same_t { static constexpr bool v = false; };
template <class A> struct same_t<A, A> { static constexpr bool v = true; };

#define BPERM(k) ((((k) >> 2) & 1) * 32 + (((k) >> 3) & 3) * 4 + ((k) & 3))
#define KSWZ(row, colB) ((row) * 256 + ((colB) ^ (((row) & 7) << 4)))
#define SBAR() __builtin_amdgcn_sched_barrier(0)
__device__ __forceinline__ int v_st(int k, int c) { const int kk = (k & ~0xC) | ((k & 4) << 1) | ((k & 8) >> 1); return ((kk >> 3) * 4 + (c >> 5)) * 512 + ((kk & 7) * 32 + (c & 31)) * 2; }
__device__ __forceinline__ int v_rd_base(int lane) { return ((lane & 3) << 3) | (((lane >> 2) & 3) << 6) | (((lane >> 4) & 1) << 5) | (((lane >> 5) & 1) << 8); }
constexpr int v_rd_off(int d0, int ks, int half) { return d0 * 512 + ks * 4096 + half * 2048; }
__device__ __forceinline__ int crow(int r, int hi) { return (r & 3) + 8 * (r >> 2) + 4 * hi; }
__device__ __forceinline__ unsigned cvtpk(float lo, float hi) {
    unsigned r; asm volatile("v_cvt_pk_bf16_f32 %0, %1, %2" : "=v"(r) : "v"(lo), "v"(hi)); return r;
}
__device__ __forceinline__ bf16x8 pack8(f32x4 a, f32x4 b) {
    u32x4 w = {cvtpk(a[0], a[1]), cvtpk(a[2], a[3]), cvtpk(b[0], b[1]), cvtpk(b[2], b[3])};
    return *reinterpret_cast<bf16x8*>(&w);
}
template <class T> __device__ __forceinline__ bf16x8 load8(const T* p) {
    if constexpr (same_t<T, float>::v) { return pack8(*(const f32x4*)p, *(const f32x4*)(p + 4)); }
    else { return *reinterpret_cast<const bf16x8*>(p); }
}
__device__ __forceinline__ void mask_tile(f32x16& p0, f32x16& p1, int dq, unsigned W) {
    const float NEG = -__builtin_inff();
#pragma unroll
    for (int r = 0; r < 16; ++r) {
        const int c = (r & 3) + 8 * (r >> 2);
        if ((unsigned)(dq - c) >= W) p0[r] = NEG;
        if ((unsigned)(dq - c - 32) >= W) p1[r] = NEG;
    }
}
__device__ __forceinline__ void partialSM(f32x16& p0, f32x16& p1, float& m_reg, float& mn, float& alpha) {
    float pmax = p0[0]; for (int r = 1; r < 16; ++r) pmax = fmaxf(pmax, p0[r]); for (int r = 0; r < 16; ++r) pmax = fmaxf(pmax, p1[r]);
    { auto rr = __builtin_amdgcn_permlane32_swap(__float_as_uint(pmax), __float_as_uint(pmax), false, false);
      pmax = fmaxf(__uint_as_float(rr[0]), __uint_as_float(rr[1])); }
    constexpr float C2 = 1.4426950408889634f * SCALE;
    if (__builtin_expect(__all((pmax - m_reg) * SCALE <= THR), 1)) { mn = m_reg; alpha = 1.f; }
    else { mn = fmaxf(m_reg, pmax); alpha = __builtin_amdgcn_exp2f((m_reg - mn) * C2); m_reg = mn; }
    const float mnL = -mn * C2;
    for (int r = 0; r < 16; ++r) p0[r] = fmaf(p0[r], C2, mnL); for (int r = 0; r < 16; ++r) p1[r] = fmaf(p1[r], C2, mnL);
    for (int r = 0; r < 16; ++r) p0[r] = __builtin_amdgcn_exp2f(p0[r]);
}
__device__ __forceinline__ void finishSM(f32x16& p0, f32x16& p1, float alpha, float& l_reg, bf16x8& pa0, bf16x8& pa1, bf16x8& pa2, bf16x8& pa3) {
    for (int r = 0; r < 16; ++r) p1[r] = __builtin_amdgcn_exp2f(p1[r]);
    float ps = 0; for (int r = 0; r < 16; ++r) ps += p0[r]; for (int r = 0; r < 16; ++r) ps += p1[r];
    { auto rr = __builtin_amdgcn_permlane32_swap(__float_as_uint(ps), __float_as_uint(ps), false, false);
      ps = __uint_as_float(rr[0]) + __uint_as_float(rr[1]); }
    l_reg = l_reg * alpha + ps;
#define PK4(P, B_, OUT) do { unsigned a0 = cvtpk(P[B_+0], P[B_+1]), a1 = cvtpk(P[B_+2], P[B_+3]);                          \
        unsigned b0 = cvtpk(P[B_+4], P[B_+5]), b1 = cvtpk(P[B_+6], P[B_+7]);                                             \
        auto r0 = __builtin_amdgcn_permlane32_swap(a0, b0, false, false); auto r1 = __builtin_amdgcn_permlane32_swap(a1, b1, false, false); \
        u32x4 w = {r0[0], r1[0], r0[1], r1[1]}; OUT = *reinterpret_cast<bf16x8*>(&w); } while (0)
    PK4(p0, 0, pa0); PK4(p0, 8, pa1); PK4(p1, 0, pa2); PK4(p1, 8, pa3);
#undef PK4
}
template <int KB, bool SK>
__device__ __forceinline__ void qkt(f32x16& p0, f32x16& p1, const char* K_lds, const float* B_lds, int r32, int hi, const bf16x8* qr, bool act) {
    if (SK && !act) { const float NEG = -__builtin_inff();
#pragma unroll
        for (int r = 0; r < 16; ++r) { p0[r] = NEG; p1[r] = NEG; } return; }
#ifdef ATT_NOBIAS
    p0 = f32x16{}; p1 = f32x16{};
#else
    p0 = *(const f32x16*)(B_lds + KB * 64 + hi * 32); p1 = *(const f32x16*)(B_lds + KB * 64 + hi * 32 + 16);
#endif
    const char* kb[4];
#pragma unroll
    for (int dd = 0; dd < 4; ++dd) kb[dd] = K_lds + KB * SHM_K + KSWZ(r32, (dd * 16 + hi * 8) * 2);
#pragma unroll
    for (int d0 = 0; d0 < 8; ++d0) { const char* a = kb[d0 & 3] + (d0 >> 2) * 128;
        bf16x8 b0 = *reinterpret_cast<const bf16x8*>(a);
        bf16x8 b1 = *reinterpret_cast<const bf16x8*>(a + 32 * 256);
        p0 = __builtin_amdgcn_mfma_f32_32x32x16_bf16(b0, qr[d0], p0, 0, 0, 0);
        p1 = __builtin_amdgcn_mfma_f32_32x32x16_bf16(b1, qr[d0], p1, 0, 0, 0); }
}
template <int VB, bool SK>
__device__ __forceinline__ void pv_tile(f32x16* o, int vb0, bf16x8 pa0, bf16x8 pa1, bf16x8 pa2, bf16x8 pa3, bool act) {
    if (SK && !act) return;
#define TRRD(dst, off) asm volatile("ds_read_b64_tr_b16 %0, %1 offset:%2" : "=&v"(dst) : "v"(vb0), "i"(off) : "memory")
#define PV_D0(d0) do { s16x4 l0, l1, l2, l3, h0, h1, h2, h3; constexpr int b_ = VB * SHM_V + v_rd_off(d0, 0, 0);     \
        TRRD(l0, b_); TRRD(h0, b_ + 2048); TRRD(l1, b_ + 4096); TRRD(h1, b_ + 6144); TRRD(l2, b_ + 8192); TRRD(h2, b_ + 10240); TRRD(l3, b_ + 12288); TRRD(h3, b_ + 14336); \
        asm volatile("s_waitcnt lgkmcnt(0)" ::: "memory"); SBAR();                 \
        o[d0] = __builtin_amdgcn_mfma_f32_32x32x16_bf16(pa0, (bf16x8){l0[0], l0[1], l0[2], l0[3], h0[0], h0[1], h0[2], h0[3]}, o[d0], 0, 0, 0);   \
        o[d0] = __builtin_amdgcn_mfma_f32_32x32x16_bf16(pa1, (bf16x8){l1[0], l1[1], l1[2], l1[3], h1[0], h1[1], h1[2], h1[3]}, o[d0], 0, 0, 0);   \
        o[d0] = __builtin_amdgcn_mfma_f32_32x32x16_bf16(pa2, (bf16x8){l2[0], l2[1], l2[2], l2[3], h2[0], h2[1], h2[2], h2[3]}, o[d0], 0, 0, 0);   \
        o[d0] = __builtin_amdgcn_mfma_f32_32x32x16_bf16(pa3, (bf16x8){l3[0], l3[1], l3[2], l3[3], h3[0], h3[1], h3[2], h3[3]}, o[d0], 0, 0, 0); } while (0)
    PV_D0(0); PV_D0(1); PV_D0(2); PV_D0(3);
#undef PV_D0
#undef TRRD
}

template <class TIn, class TOut> struct BlockRef { const TIn* Q; const TIn* K; const TIn* V; TOut* O; const float* CB; const TIn* Z; int P0; };
template <class TIn> struct Seam {
    bf16x8 qr[8];
    bf16x8 st_v0, st_v1, st_k0, st_k1; float st_b0; f32x4 sf0, sf1, sf2, sf3;
    f32x4 tq[16];
};
__device__ __forceinline__ int swa_jlo(int P0, int W) { const int lowk = P0 - W + 1; return lowk > 0 ? lowk / KVBLK : 0; }
#define ROW(p, k0, rr) ((p) + (unsigned)(((k0) + (rr)) * PITCH + sc))
#define VMW() asm volatile("s_waitcnt vmcnt(0)" ::: "memory")
#define VMWN(n) asm volatile("s_waitcnt vmcnt(%0)" :: "i"(n) : "memory")
#define SLOAD_H(Kp, Vp, Cp, k0) do { S.st_b0 = (Cp)[(unsigned)((k0) + sr + 32 * (tid & 1))]; S.st_v0 = load8<TIn>(ROW(Vp, k0, sr)); S.st_v1 = load8<TIn>(ROW(Vp, k0, 32 + sr));              \
                         S.st_k0 = load8<TIn>(ROW(Kp, k0, sr)); S.st_k1 = load8<TIn>(ROW(Kp, k0, 32 + sr)); } while (0)
#define SWRITE_HK(bf) do { B_lds[(bf) * 64 + sr + 32 * (tid & 1)] = S.st_b0; *(bf16x8*)(K_lds + (bf) * SHM_K + kws) = S.st_k0; *(bf16x8*)(K_lds + (bf) * SHM_K + kws + 32 * 256) = S.st_k1; } while (0)
#define SWRITE_HV(bf) do { *(bf16x8*)(V_lds + (bf) * SHM_V + vst0) = S.st_v0; *(bf16x8*)(V_lds + (bf) * SHM_V + vst1) = S.st_v1; } while (0)
#define SWRITE_H(bf) do { SWRITE_HV(bf); SWRITE_HK(bf); } while (0)
#define SLOAD_F(p, k0) do { S.sf0 = *(const f32x4*)ROW(p, k0, sr); S.sf1 = *(const f32x4*)(ROW(p, k0, sr) + 4);                \
                            S.sf2 = *(const f32x4*)ROW(p, k0, 32 + sr); S.sf3 = *(const f32x4*)(ROW(p, k0, 32 + sr) + 4); } while (0)
#define SWRITE_KF(bf) do { *(bf16x8*)(K_lds + (bf) * SHM_K + kws) = pack8(S.sf0, S.sf1); *(bf16x8*)(K_lds + (bf) * SHM_K + kws + 32 * 256) = pack8(S.sf2, S.sf3); } while (0)
#define SWRITE_VF(bf) do { *(bf16x8*)(V_lds + (bf) * SHM_V + vst0) = pack8(S.sf0, S.sf1); *(bf16x8*)(V_lds + (bf) * SHM_V + vst1) = pack8(S.sf2, S.sf3); } while (0)
template <class TIn, class TOut>
__device__ __forceinline__ void causal_swa_prime(const BlockRef<TIn, TOut>& cur, int W, char* lds, Seam<TIn>& S) {
    constexpr bool F32 = same_t<TIn, float>::v;
    const int tid = otid(), wid = __builtin_amdgcn_readfirstlane(tid >> 6), lane = tid & 63, r32 = lane & 31, hi = lane >> 5;
    const int sr = tid >> 4, sc = (tid & 15) * 8, kws = KSWZ(sr, sc * 2); char* K_lds = lds + 2 * SHM_V; float* B_lds = (float*)(lds + 2 * SHM_V + 2 * SHM_K + NW * 64 * 4);
    const int kb0 = swa_jlo(cur.P0, W) * KVBLK;
    for (int d0 = 0; d0 < 8; ++d0) S.qr[d0] = load8<TIn>(cur.Q + (unsigned)((wid * QBLK + r32) * PITCH + d0 * 16 + hi * 8));
    if constexpr (F32) { SLOAD_F((const float*)cur.K, kb0); VMW(); SWRITE_KF(0); SBAR(); SLOAD_F((const float*)cur.V, kb0); }
    else { SLOAD_H(cur.K, cur.V, cur.CB, kb0); VMW(); SWRITE_HK(0); }
    __syncthreads();
}
template <class TIn, class TOut>
__device__ __forceinline__ void causal_swa_block(const BlockRef<TIn, TOut>& cur, const BlockRef<TIn, TOut>& nxt, int skv, int W, char* lds, Seam<TIn>& S) {
    constexpr bool F32 = same_t<TIn, float>::v;
    const int tid = otid(), wid = __builtin_amdgcn_readfirstlane(tid >> 6), lane = tid & 63, r32 = lane & 31, hi = lane >> 5;
    const int j_lo = swa_jlo(cur.P0, W);
    int j_hi = (cur.P0 + QB - 1) / KVBLK + 1; if (j_hi > skv / KVBLK) j_hi = skv / KVBLK;
    const int NT = j_hi - j_lo;
    const int kbn = swa_jlo(nxt.P0, W) * KVBLK;
    const int qlo = cur.P0 + wid * QBLK, qm = qlo + r32 - 4 * hi;
    char* V_lds = lds; char* K_lds = lds + 2 * SHM_V; float* B_lds = (float*)(lds + 2 * SHM_V + 2 * SHM_K + NW * 64 * 4);
    float* ws = (float*)(lds + 2 * SHM_V + 2 * SHM_K) + wid * 64; float* li_l = ws, * al_l = ws + 32;
    float m_reg = -1e30f, l_reg = 0; f32x16 o[4] = {};
    const int sr = tid >> 4, sc = (tid & 15) * 8, vst0 = v_st(sr, sc), vst1 = v_st(32 + sr, sc), kws = KSWZ(sr, sc * 2);
    const int vb0 = (int)(uintptr_t)V_lds + v_rd_base(lane);
    const TIn* Kh = cur.K; const TIn* Vh = cur.V; const float* Ch = cur.CB;
#define RESC(a) do { if (__any((a) < 1.f)) { if (hi == 0) al_l[r32] = (a); asm volatile("s_waitcnt lgkmcnt(0)" ::: "memory");              \
                     for (int d_ = 0; d_ < 4; ++d_) for (int r = 0; r < 16; ++r) o[d_][r] *= al_l[crow(r, hi)]; } } while (0)
#define KBASE(t) ((j_lo + (t)) * KVBLK)
#define ACT(t) (KBASE(t) <= qlo + QBLK - 1 && KBASE(t) + KVBLK - 1 >= qlo - W + 1)
#define MASKT(P0_, P1_, t) do { const int kb_ = KBASE(t); if ((!SK || ACT(t)) && (kb_ + KVBLK - 1 > qlo || kb_ <= qlo + QBLK - 1 - W)) mask_tile(P0_, P1_, qm - kb_, (unsigned)W); } while (0)
    constexpr int NQL = F32 ? 16 : 8;
    constexpr bool SK = WSKIP && !F32;
#define SEAM_K0() do { VMWN(NQL); if constexpr (F32) { SWRITE_KF(0); SBAR(); SLOAD_F((const float*)nxt.V, kbn); } else { SWRITE_HK(0); } SBAR(); } while (0)
    f32x16 pA0, pA1, pB0, pB1; float mnA, mnB, alA, alB; bf16x8 pa0, pa1, pa2, pa3;
    if constexpr (F32) { VMW(); SWRITE_VF(0); SBAR(); } else { SWRITE_HV(0); SBAR(); }
    if (NT > 1) { if constexpr (F32) SLOAD_F((const float*)Kh, KBASE(1)); else SLOAD_H(Kh, Vh, Ch, KBASE(1)); }
    SBAR(); qkt<0, SK>(pA0, pA1, K_lds, B_lds, r32, hi, S.qr, ACT(0));
    if constexpr (F32) { if (NT > 1) { VMW(); SWRITE_KF(1); SBAR(); SLOAD_F((const float*)Vh, KBASE(1)); } }
    MASKT(pA0, pA1, 0); partialSM(pA0, pA1, m_reg, mnA, alA);
    if (NT > 1) { VMW(); if constexpr (F32) { SWRITE_VF(1); SBAR(); if (NT > 2) SLOAD_F((const float*)Kh, KBASE(2)); } else SWRITE_H(1); }
    __syncthreads();
#define HALF_STEP(PX0, PX1, mnX, alX, PY0, PY1, alY, t, KB, VB, SB) do {                                                      \
        SBAR(); qkt<KB, SK>(PX0, PX1, K_lds, B_lds, r32, hi, S.qr, ACT(t));                                             \
        finishSM(PY0, PY1, alY, l_reg, pa0, pa1, pa2, pa3); SBAR();                                                           \
        if ((t) + 1 < NT) { if constexpr (F32) { VMW(); SWRITE_KF(SB); SBAR(); SLOAD_F((const float*)Vh, KBASE((t) + 1)); }  \
                            else { SLOAD_H(Kh, Vh, Ch, KBASE((t) + 1)); } SBAR(); }                                               \
        pv_tile<VB, SK>(o, vb0, pa0, pa1, pa2, pa3, ACT((t) - 1)); MASKT(PX0, PX1, (t)); partialSM(PX0, PX1, m_reg, mnX, alX);                                        \
        __syncthreads();                                                                                                      \
        if ((t) + 1 < NT) { VMW(); if constexpr (F32) { SWRITE_VF(SB); SBAR(); if ((t) + 2 < NT) SLOAD_F((const float*)Kh, KBASE((t) + 2)); } \
                            else { SWRITE_H(SB); } }                                                                          \
        RESC(alX); __syncthreads(); } while (0)
    for (int t = 1; t + 1 < NT; t += 2) {
        HALF_STEP(pB0, pB1, mnB, alB, pA0, pA1, alA, t, 1, 0, 0);
        HALF_STEP(pA0, pA1, mnA, alA, pB0, pB1, alB, t + 1, 0, 1, 1);
    }
    const bool even = (NT & 1) == 0;
    if (even) { SBAR(); qkt<1, SK>(pB0, pB1, K_lds, B_lds, r32, hi, S.qr, ACT(NT - 1)); SBAR(); }
#define QROW(e) (nxt.Q + (size_t)(wid * QBLK + r32) * PITCH + ((e) >> 1) * 16 + hi * 8 + ((e) & 1) * 4)
    if constexpr (F32) { SLOAD_F((const float*)nxt.K, kbn); SBAR();
#pragma unroll
        for (int e = 0; e < 8; ++e) S.tq[e] = *(const f32x4*)QROW(e); }
    else { SLOAD_H(nxt.K, nxt.V, nxt.CB, kbn); SBAR();
#pragma unroll
        for (int d0 = 0; d0 < 8; ++d0) S.qr[d0] = load8<TIn>(nxt.Q + (unsigned)((wid * QBLK + r32) * PITCH + d0 * 16 + hi * 8)); }
    SBAR();
    finishSM(pA0, pA1, alA, l_reg, pa0, pa1, pa2, pa3); SBAR();
    if constexpr (F32) {
#pragma unroll
        for (int e = 8; e < 16; ++e) S.tq[e] = *(const f32x4*)QROW(e); SBAR(); }
#undef QROW
    pv_tile<0, SK>(o, vb0, pa0, pa1, pa2, pa3, ACT(even ? NT - 2 : NT - 1));
    if (even) { MASKT(pB0, pB1, NT - 1); partialSM(pB0, pB1, m_reg, mnB, alB); __syncthreads(); RESC(alB);
        finishSM(pB0, pB1, alB, l_reg, pa0, pa1, pa2, pa3); SBAR(); pv_tile<1, SK>(o, vb0, pa0, pa1, pa2, pa3, ACT(NT - 1)); }
    SBAR(); SEAM_K0();
    if (hi == 0) li_l[r32] = l_reg; asm volatile("s_waitcnt lgkmcnt(0)" ::: "memory");
    float rli[16];
#pragma unroll
    for (int r = 0; r < 16; ++r) rli[r] = __builtin_amdgcn_rcpf(li_l[crow(r, hi)]);
    TOut* Ow = cur.O + (size_t)(wid * QBLK) * PITCH; const TIn* Zw = cur.Z + (size_t)(wid * QBLK) * PITCH; unsigned lo_ = (unsigned)(4 * hi) * PITCH + r32; asm volatile("" : "+v"(lo_));
#pragma unroll
    for (int rg = 0; rg < 4; ++rg) {
        unsigned zq[4][4];
        if ((r32 & 1) == 0) {
#pragma unroll
            for (int rr = 0; rr < 4; ++rr)
#pragma unroll
                for (int d0 = 0; d0 < 4; ++d0) zq[rr][d0] = *(const unsigned*)(Zw + (lo_ + (unsigned)(crow(rg * 4 + rr, hi) - 4 * hi) * PITCH + d0 * 32));
        }
#pragma unroll
        for (int rr = 0; rr < 4; ++rr) { const int r = rg * 4 + rr; const int orow = crow(r, hi);
#pragma unroll
            for (int d0 = 0; d0 < 4; ++d0) { const float v = o[d0][r] * rli[r]; const float vn = __shfl_xor(v, 1);
                if ((r32 & 1) == 0) { const unsigned of_ = lo_ + (unsigned)(orow - 4 * hi) * PITCH + d0 * 32; const unsigned zz = zq[rr][d0];
                    *(unsigned*)(Ow + of_) = cvtpk(v * __uint_as_float(zz << 16), vn * __uint_as_float(zz & 0xffff0000u)); } } }
    }
    if constexpr (F32) {
#pragma unroll
        for (int d0 = 0; d0 < 8; ++d0) S.qr[d0] = pack8(S.tq[2 * d0], S.tq[2 * d0 + 1]); }
    __syncthreads();
#undef RESC
#undef KBASE
#undef ACT
#undef MASKT
#undef SEAM_K0
#undef HALF_STEP
}
#undef ROW
#undef VMW
#undef VMWN
#undef SLOAD_H
#undef SWRITE_HK
#undef SWRITE_HV
#undef SWRITE_H
#undef SLOAD_F
#undef SWRITE_KF
#undef SWRITE_VF
}

namespace cg = cooperative_groups;
#define LAS __attribute__((address_space(3)))
typedef unsigned short bf16_t;
typedef float f32x4 __attribute__((ext_vector_type(4)));
typedef float f32x2 __attribute__((ext_vector_type(2)));
typedef unsigned u32x4 __attribute__((ext_vector_type(4)));
typedef unsigned u32x2 __attribute__((ext_vector_type(2)));
typedef short bf16x8 __attribute__((ext_vector_type(8)));

constexpr int DM = 1024, EB = 2048, MP = 32768, MS = 128, MV = MP + MS  , MA = 33024  ;
constexpr int SEQ = 4096, NBH = 128, PAST = 2048, TS = 16, SKS = 2112  ;
constexpr int NFIN = 8448;
constexpr float RMS_EPS = 1e-6f, LN_EPS = 1e-5f;
constexpr size_t O_YP = 0, O_YS = 33554432, O_GV = 33685504, O_FKP = 34209792, O_FVP = 168427520, O_FLP = 302645248, O_FKS = 303693824, O_FVS = 304218112, O_FLS = 304742400;
constexpr size_t MiB = 1u << 20;
constexpr size_t WS_WGIN = 1 * MiB;
constexpr size_t WS_WGOUT = 25 * MiB;
constexpr size_t WS_WFIN = 33 * MiB;
constexpr size_t WS_WFOUT = 66 * MiB;
constexpr size_t WS_WPP = 74 * MiB;
constexpr size_t WS_WPG = 76 * MiB;
constexpr size_t WS_WM = 84 * MiB;
constexpr size_t WS_WMS = 85 * MiB;
constexpr size_t WS_PB = 88 * MiB;
constexpr size_t WS_HX = 105 * MiB;
constexpr size_t WS_TB = 170 * MiB;
constexpr size_t WS_STAT = 756 * MiB;
constexpr size_t WS_CBP = 236 * MiB;
constexpr size_t WS_CBS = 238 * MiB + 512 * 1024;
constexpr size_t WS_R0 = 240 * MiB, RSZ = 129 * MiB;
constexpr size_t WS_END = 775 * MiB;
constexpr size_t WS_PART = 766 * MiB;
constexpr size_t WS_DUMMY = 776 * MiB;
constexpr int LDS_BYTES = LDS_TOTAL;
#ifndef PROBE_DUP
#define PROBE_DUP 0
#endif

struct ArgsS { const float* in[20]; float* out; unsigned char* ws; };
typedef const __attribute__((address_space(4))) ArgsS* ArgsP;
struct Args { ArgsP p; };
__device__ __forceinline__ Args getargs() { ArgsP p = (ArgsP)__builtin_amdgcn_kernarg_segment_ptr(); asm volatile("" : "+s"(p)); Args a; a.p = p; return a; }

__device__ __forceinline__ unsigned f2bf(float f) { unsigned u = __builtin_bit_cast(unsigned, f); return (u + 0x7fffu + ((u >> 16) & 1u)) >> 16; }
__device__ __forceinline__ unsigned pk2(float lo, float hi) { return pg8::cvt_pk_bf16(lo, hi); }
__device__ __forceinline__ float bflo(unsigned u) { return __uint_as_float(u << 16); }
__device__ __forceinline__ float bfhi(unsigned u) { return __uint_as_float(u & 0xffff0000u); }
__device__ __forceinline__ float wave_sum(float v) { for (int o = 32; o > 0; o >>= 1) v += __shfl_xor(v, o); return v; }
__device__ __forceinline__ float wave_max(float v) { for (int o = 32; o > 0; o >>= 1) v = fmaxf(v, __shfl_xor(v, o)); return v; }
__device__ __forceinline__ float gelu_t(float x) { const float t = x * x; const float e = __builtin_amdgcn_exp2f((-2.3022082f * x) * (1.f + 0.044715f * t)); return x * __builtin_amdgcn_rcpf(1.f + e); }
__device__ __forceinline__ float silu_f(float x) { return x * __builtin_amdgcn_rcpf(1.f + __builtin_amdgcn_exp2f(-1.4426950408889634f * x)); }
__device__ __forceinline__ float sigm_f(float x) { return __builtin_amdgcn_rcpf(1.f + __builtin_amdgcn_exp2f(-1.4426950408889634f * x)); }
__device__ __forceinline__ f32x2 sigm2(f32x2 v) { const f32x2 a = v * -1.4426950408889634f; f32x2 e; e.x = __builtin_amdgcn_exp2f(a.x); e.y = __builtin_amdgcn_exp2f(a.y); const f32x2 d = e + 1.0f; f32x2 r; r.x = __builtin_amdgcn_rcpf(d.x); r.y = __builtin_amdgcn_rcpf(d.y); return r; }
__device__ __forceinline__ f32x2 silu2(f32x2 v) { return v * sigm2(v); }
__device__ __forceinline__ f32x2 gelu2(f32x2 v) { const f32x2 t = v * v; const f32x2 a = (v * -2.3022082f) * (t * 0.044715f + 1.0f); f32x2 e; e.x = __builtin_amdgcn_exp2f(a.x); e.y = __builtin_amdgcn_exp2f(a.y); const f32x2 d = e + 1.0f; f32x2 r; r.x = __builtin_amdgcn_rcpf(d.x); r.y = __builtin_amdgcn_rcpf(d.y); return v * r; }
__device__ __forceinline__ float logsig_f(float x) { const float e = __expf(-fabsf(x)); const float l = e < 0.03f ? e * (1.f - e * (0.5f - e * (0.33333334f - 0.25f * e))) : __logf(1.f + e); return fminf(x, 0.f) - l; }

using pg8::Unit; using pg8::HALF; using pg8::BM;
struct EpiGmlpIn {
    static constexpr bool PERM = true, AFTER_DRAIN = false;
    bf16_t* U; bf16_t* VT; bf16_t* ZS; float* stat;
    __device__ __forceinline__ void operator()(const pg8::f32x4 (&acc)[2][2][4][2], const Unit& u, int wr, int wc, int fr_, int fq_) const {
        const int lane_ = otid() & 63, fr = lane_ & 15, fq = lane_ >> 4; (void)fr_; (void)fq_;
        const int row0 = u.pm * BM + wr * 64 + fr, colt = u.pn * BM, region = colt >> 11, cb = (colt & 2047) + wc * 32 + 8 * fq;
#pragma unroll
        for (int ai = 0; ai < 2; ++ai)
#pragma unroll
            for (int m = 0; m < 4; ++m) {
                const int row = row0 + ai * HALF + m * 16; float s = 0.f, q = 0.f;
#pragma unroll
                for (int bj = 0; bj < 2; ++bj) {
                    const int col = cb + bj * HALF; const pg8::f32x4 v0 = acc[ai][bj][m][0], v1 = acc[ai][bj][m][1];
                    float x[8] = {v0[0], v0[1], v0[2], v0[3], v1[0], v1[1], v1[2], v1[3]};
                    if (region == 2) {
#pragma unroll
                        for (int e = 0; e < 8; e += 2) { const f32x2 r = silu2((f32x2){x[e], x[e + 1]}); x[e] = r.x; x[e + 1] = r.y; }
                    } else {
#pragma unroll
                        for (int e = 0; e < 8; e += 2) { const f32x2 r = gelu2((f32x2){x[e], x[e + 1]}); x[e] = r.x; x[e + 1] = r.y; }
                    }
                    u32x4 w; w.x = pk2(x[0], x[1]); w.y = pk2(x[2], x[3]); w.z = pk2(x[4], x[5]); w.w = pk2(x[6], x[7]);
                    if (region == 1) {
                        bf16_t* vp = VT + ((size_t)(row >> 7) * 2048 + col) * 128 + (row & 127);
                        const unsigned ww[4] = {w.x, w.y, w.z, w.w};
#pragma unroll
                        for (int e = 0; e < 4; ++e) { vp[(2 * e) * 128] = (bf16_t)(ww[e] & 0xffffu); vp[(2 * e + 1) * 128] = (bf16_t)(ww[e] >> 16);
                            const float a = bflo(ww[e]), b = bfhi(ww[e]); s += a + b; q += a * a + b * b; }
                    } else {
                        bf16_t* dst = (region == 0 ? U : ZS) + (size_t)row * 2048 + col;
                        *(u32x4*)dst = w;
                    }
                }
                if (region == 1) {
                    s += __shfl_xor(s, 16); s += __shfl_xor(s, 32); q += __shfl_xor(q, 16); q += __shfl_xor(q, 32);
                    if (fq == 0) { const int slot = ((colt & 2047) >> 6) + wc; stat[(size_t)row * 64 + slot] = s; stat[(size_t)row * 64 + 32 + slot] = q; }
                }
            }
    }
};
struct EpiFoxIn {
    static constexpr bool PERM = true, AFTER_DRAIN = false;
    bf16_t* QB; bf16_t* KB; bf16_t* VB; bf16_t* ZS; float* okp; float* ovp; float* olp; float* oks; float* ovs; float* ols; const float* bf;
    __device__ __forceinline__ void operator()(const pg8::f32x4 (&acc)[2][2][4][2], const Unit& u, int wr, int wc, int fr_, int fq_) const {
        const int lane_ = otid() & 63, fr = lane_ & 15, fq = lane_ >> 4; (void)fr_; (void)fq_;
        const int row0 = u.pm * BM + wr * 64 + fr, colt = u.pn * BM, region = colt >> 11, cb = (colt & 2047) + wc * 32 + 8 * fq;
        if (region == 4) {
            if (wc != 0 || fq >= 2) return;
#pragma unroll
            for (int ai = 0; ai < 2; ++ai)
#pragma unroll
                for (int m = 0; m < 4; ++m) {
                    const int row = row0 + ai * HALF + m * 16; if (row >= MV) continue;
                    const pg8::f32x4 v0 = acc[ai][0][m][0], v1 = acc[ai][0][m][1];
                    const f32x4 b0 = *(const f32x4*)(bf + 8 * fq), b1 = *(const f32x4*)(bf + 8 * fq + 4);
                    f32x4 r0, r1;
#pragma unroll
                    for (int e = 0; e < 4; ++e) { r0[e] = logsig_f(v0[e] + b0[e]); r1[e] = logsig_f(v1[e] + b1[e]); }
                    float* dst = row < MP ? olp + (size_t)row * 16 + 8 * fq : ols + (size_t)(row - MP) * 16 + 8 * fq;
                    *(f32x4*)dst = r0; *(f32x4*)(dst + 4) = r1;
                }
            return;
        }
        bf16_t* B = region == 0 ? QB : region == 1 ? KB : region == 2 ? VB : ZS;
#pragma unroll
        for (int ai = 0; ai < 2; ++ai)
#pragma unroll
            for (int m = 0; m < 4; ++m) {
                const int row = row0 + ai * HALF + m * 16;
#pragma unroll
                for (int bj = 0; bj < 2; ++bj) {
                    const int col = cb + bj * HALF; pg8::f32x4 v0 = acc[ai][bj][m][0], v1 = acc[ai][bj][m][1];
                    if (region == 3) {
#pragma unroll
                        for (int e = 0; e < 4; e += 2) { const f32x2 r0 = silu2((f32x2){v0[e], v0[e + 1]}), r1 = silu2((f32x2){v1[e], v1[e + 1]}); v0[e] = r0.x; v0[e + 1] = r0.y; v1[e] = r1.x; v1[e + 1] = r1.y; }
                    }
                    u32x4 w; w.x = pk2(v0[0], v0[1]); w.y = pk2(v0[2], v0[3]); w.z = pk2(v1[0], v1[1]); w.w = pk2(v1[2], v1[3]);
                    *(u32x4*)(B + (size_t)row * 2048 + col) = w;
                    if ((region == 1 || region == 2) && row < MV) {
                        float* o = region == 1 ? (row < MP ? okp + (size_t)row * 2048 : oks + (size_t)(row - MP) * 2048) : (row < MP ? ovp + (size_t)row * 2048 : ovs + (size_t)(row - MP) * 2048);
                        *(pg8::f32x4*)(o + col) = v0; *(pg8::f32x4*)(o + col + 4) = v1;
                    }
                }
            }
    }
};
struct EpiT {
    static constexpr bool PERM = true, AFTER_DRAIN = false;
    bf16_t* O; int ldc;
    __device__ __forceinline__ void operator()(const pg8::f32x4 (&acc)[2][2][4][2], const Unit& u, int wr, int wc, int fr_, int fq_) const {
        const int lane_ = otid() & 63, fr = lane_ & 15, fq = lane_ >> 4; (void)fr_; (void)fq_;
        const int row0 = u.pm * BM + wr * 64 + fr, col0 = u.pn * BM + wc * 32 + 8 * fq;
#pragma unroll
        for (int ai = 0; ai < 2; ++ai)
#pragma unroll
            for (int m = 0; m < 4; ++m) { bf16_t* rp = O + (size_t)(row0 + ai * HALF + m * 16) * ldc + col0;
#pragma unroll
                for (int bj = 0; bj < 2; ++bj) { const pg8::f32x4 v0 = acc[ai][bj][m][0], v1 = acc[ai][bj][m][1];
                    u32x4 w; w.x = pk2(v0[0], v0[1]); w.y = pk2(v0[2], v0[3]); w.z = pk2(v1[0], v1[1]); w.w = pk2(v1[2], v1[3]);
                    *(u32x4*)(rp + bj * HALF) = w; } }
    }
};
struct EpiF32 {
    static constexpr bool PERM = true, AFTER_DRAIN = false;
    float* O; int ldc;
    __device__ __forceinline__ void operator()(const pg8::f32x4 (&acc)[2][2][4][2], const Unit& u, int wr, int wc, int fr_, int fq_) const {
        const int lane_ = otid() & 63, fr = lane_ & 15, fq = lane_ >> 4; (void)fr_; (void)fq_;
        const int row0 = u.pm * BM + wr * 64 + fr, col0 = u.pn * BM + wc * 32 + 8 * fq;
#pragma unroll
        for (int ai = 0; ai < 2; ++ai)
#pragma unroll
            for (int m = 0; m < 4; ++m) { float* rp = O + (size_t)(row0 + ai * HALF + m * 16) * ldc + col0;
#pragma unroll
                for (int bj = 0; bj < 2; ++bj) { *(pg8::f32x4*)(rp + bj * HALF) = acc[ai][bj][m][0]; *(pg8::f32x4*)(rp + bj * HALF + 4) = acc[ai][bj][m][1]; } }
    }
};
struct EpiPart {
    static constexpr bool PERM = true, AFTER_DRAIN = false;
    float* P;
    __device__ __forceinline__ void operator()(const pg8::f32x4 (&acc)[2][2][4][2], const Unit& u, int wr, int wc, int fr_, int fq_) const {
        const int lane_ = otid() & 63, fr = lane_ & 15, fq = lane_ >> 4; (void)fr_; (void)fq_;
        const int row0 = wr * 64 + fr, col0 = u.pn * BM + wc * 32 + 8 * fq; float* base = P + (size_t)(u.ko >> 8) * 256 * 1024;
#pragma unroll
        for (int ai = 0; ai < 2; ++ai)
#pragma unroll
            for (int m = 0; m < 4; ++m) { float* rp = base + (size_t)(row0 + ai * HALF + m * 16) * 1024 + col0;
#pragma unroll
                for (int bj = 0; bj < 2; ++bj) { *(pg8::f32x4*)(rp + bj * HALF) = acc[ai][bj][m][0]; *(pg8::f32x4*)(rp + bj * HALF + 4) = acc[ai][bj][m][1]; } }
    }
};
struct SplitOrder {
    int nsplit, c;
    __device__ bool next(int i, Unit& u) const { if (i != 0 || c >= 4 * nsplit) return false; u.pm = 128; u.pn = c & 3; u.ko = (c >> 2) * 256; return true; }
    __device__ __forceinline__ void a_ready(const Unit&) const {}
    __device__ __forceinline__ void done(const Unit&) const {}
};
struct EpiGate {
    static constexpr bool PERM = true, AFTER_DRAIN = false;
    const bf16_t* XB; float* Xo; const bf16_t* T; int f32out;
    __device__ __forceinline__ void operator()(const pg8::f32x4 (&acc)[2][2][4][2], const Unit& u, int wr, int wc, int fr_, int fq_) const {
        const int lane_ = otid() & 63, fr = lane_ & 15, fq = lane_ >> 4; (void)fr_; (void)fq_;
        const int row0 = u.pm * BM + wr * 64 + fr, col0 = u.pn * BM + wc * 32 + 8 * fq;
#pragma unroll
        for (int ai = 0; ai < 2; ++ai)
#pragma unroll
            for (int m = 0; m < 4; ++m) { const int row = row0 + ai * HALF + m * 16; if (row >= MV) continue;
#pragma unroll
                for (int bj = 0; bj < 2; ++bj) { const size_t off = (size_t)row * DM + col0 + bj * HALF;
                    const u32x4 t = *(const u32x4*)(T + off); const u32x4 xb = *(const u32x4*)(XB + off);
                    pg8::f32x4 x0 = {bflo(xb.x), bfhi(xb.x), bflo(xb.y), bfhi(xb.y)}, x1 = {bflo(xb.z), bfhi(xb.z), bflo(xb.w), bfhi(xb.w)};
                    const pg8::f32x4 a0 = acc[ai][bj][m][0], a1 = acc[ai][bj][m][1];
                    { const f32x2 s0 = sigm2((f32x2){a0[0], a0[1]}), s1 = sigm2((f32x2){a0[2], a0[3]}), s2 = sigm2((f32x2){a1[0], a1[1]}), s3 = sigm2((f32x2){a1[2], a1[3]});
                      x0[0] += s0.x * bflo(t.x); x0[1] += s0.y * bfhi(t.x); x0[2] += s1.x * bflo(t.y); x0[3] += s1.y * bfhi(t.y);
                      x1[0] += s2.x * bflo(t.z); x1[1] += s2.y * bfhi(t.z); x1[2] += s3.x * bflo(t.w); x1[3] += s3.y * bfhi(t.w); }
                    if (f32out) { *(pg8::f32x4*)(Xo + off) = x0; *(pg8::f32x4*)(Xo + off + 4) = x1; }
                    else { u32x4 w; w.x = pk2(x0[0], x0[1]); w.y = pk2(x0[2], x0[3]); w.z = pk2(x1[0], x1[1]); w.w = pk2(x1[2], x1[3]); *(u32x4*)((bf16_t*)Xo + off) = w; } } }
    }
};

__device__ __forceinline__ void cvt_wt(const float* __restrict__ W, bf16_t* __restrict__ Wt, int K, int N, int Npad, float* tile  ) {
    const int tid = otid(), ntn = Npad / 64, nt = ntn * (K / 64);
    for (int t = blockIdx.x; t < nt; t += gridDim.x) {
        const int n0 = (t % ntn) * 64, k0 = (t / ntn) * 64;
#pragma unroll
        for (int i = 0; i < 2; ++i) { const int kk = (tid >> 4) + 32 * i, n4 = (tid & 15) * 4;
            f32x4 v = {0.f, 0.f, 0.f, 0.f}; if (n0 + n4 < N) v = *(const f32x4*)(W + (size_t)(k0 + kk) * N + n0 + n4);
            tile[kk * 65 + n4] = v[0]; tile[kk * 65 + n4 + 1] = v[1]; tile[kk * 65 + n4 + 2] = v[2]; tile[kk * 65 + n4 + 3] = v[3]; }
        __syncthreads();
        { const int nn = tid >> 3, k8 = (tid & 7) * 8; u32x4 w;
          w.x = pk2(tile[(k8 + 0) * 65 + nn], tile[(k8 + 1) * 65 + nn]); w.y = pk2(tile[(k8 + 2) * 65 + nn], tile[(k8 + 3) * 65 + nn]);
          w.z = pk2(tile[(k8 + 4) * 65 + nn], tile[(k8 + 5) * 65 + nn]); w.w = pk2(tile[(k8 + 6) * 65 + nn], tile[(k8 + 7) * 65 + nn]);
          *(u32x4*)(Wt + (size_t)(n0 + nn) * K + k0 + k8) = w; }
        __syncthreads();
    }
}
__device__ __forceinline__ void prologue(const Args& a, float* tile) {
    unsigned char* ws = a.p->ws;
    for (int j = 0; j < 2; ++j) {
        cvt_wt(a.p->in[9] + (size_t)j * 1024 * 6144, (bf16_t*)(ws + WS_WGIN) + (size_t)j * 6144 * 1024, 1024, 6144, 6144, tile);
        cvt_wt(a.p->in[14] + (size_t)j * 2048 * 1024, (bf16_t*)(ws + WS_WGOUT) + (size_t)j * 1024 * 2048, 2048, 1024, 1024, tile);
        cvt_wt(a.p->in[15] + (size_t)j * 1024 * 8208, (bf16_t*)(ws + WS_WFIN) + (size_t)j * NFIN * 1024, 1024, 8208, NFIN, tile);
        cvt_wt(a.p->in[17] + (size_t)j * 2048 * 1024, (bf16_t*)(ws + WS_WFOUT) + (size_t)j * 1024 * 2048, 2048, 1024, 1024, tile);
    }
    for (int i = 0; i < 4; ++i) {
        cvt_wt(a.p->in[18] + (size_t)i * 256 * 1024, (bf16_t*)(ws + WS_WPP) + (size_t)i * 1024 * 256, 256, 1024, 1024, tile);
        cvt_wt(a.p->in[19] + (size_t)i * 1024 * 1024, (bf16_t*)(ws + WS_WPG) + (size_t)i * 1024 * 1024, 1024, 1024, 1024, tile);
    }
    const float* wsrc = a.p->in[12]; bf16_t* wm = (bf16_t*)(ws + WS_WM); bf16_t* wms = (bf16_t*)(ws + WS_WMS);
    for (int idx = blockIdx.x * 512 + otid(); idx < 2 * 16 * 128 * 128; idx += gridDim.x * 512) {
        const int jj = idx & 127, i = (idx >> 7) & 127, lg = idx >> 14;
        const float w = wsrc[idx]; wm[idx] = (bf16_t)f2bf((jj >> 6) <= (i >> 6) ? w : 0.f);
        const float w2 = wsrc[((size_t)lg * 128 + (i & 15)) * 128 + (jj & 15)]; wms[idx] = (bf16_t)f2bf((i >> 4) == (jj >> 4) ? w2 : 0.f);
    }
}

__device__ __forceinline__ void phase_e1(const Args& a, int layer) {
    const int tid = otid(), lane = tid & 63, gw = blockIdx.x * 8 + (tid >> 6), nw = gridDim.x * 8;
    float* X = a.p->out; bf16_t* X16 = (bf16_t*)a.p->out; bf16_t* HX = (bf16_t*)(a.p->ws + WS_HX); bf16_t* PB = (bf16_t*)(a.p->ws + WS_PB);
    const float* g = a.p->in[7] + (layer & 3) * DM;
    f32x4 gv[4];
#pragma unroll
    for (int q = 0; q < 4; ++q) gv[q] = *(const f32x4*)(g + q * 256 + lane * 4);
#define E1_LOAD(v, r) do { if (layer == 0) { _Pragma("unroll") for (int q = 0; q < 4; ++q) v[q] = *(const f32x4*)(a.p->in[0] + (size_t)(r) * DM + q * 256 + lane * 4); } \
        else { _Pragma("unroll") for (int q = 0; q < 4; ++q) { const u32x2 xb = *(const u32x2*)(X16 + (size_t)(r) * DM + q * 256 + lane * 4); v[q] = (f32x4){bflo(xb.x), bfhi(xb.x), bflo(xb.y), bfhi(xb.y)}; } } } while (0)
#define E1_FIN(v, r, p) do { float ss = 0.f; _Pragma("unroll") for (int q = 0; q < 4; ++q) ss += v[q][0] * v[q][0] + v[q][1] * v[q][1] + v[q][2] * v[q][2] + v[q][3] * v[q][3]; \
        ss = wave_sum(ss); const float rr = rsqrtf(ss * (1.f / DM) + RMS_EPS); \
        _Pragma("unroll") for (int q = 0; q < 4; ++q) { u32x2 hw; hw.x = pk2(v[q][0] * rr * gv[q][0], v[q][1] * rr * gv[q][1]); hw.y = pk2(v[q][2] * rr * gv[q][2], v[q][3] * rr * gv[q][3]); \
            *(u32x2*)(HX + (size_t)(r) * DM + q * 256 + lane * 4) = hw; } \
        u32x2 pw; pw.x = pk2(p[0], p[1]); pw.y = pk2(p[2], p[3]); *(u32x2*)(PB + (size_t)(r) * 256 + lane * 4) = pw; } while (0)
    if (layer < 4) {
        const float* pp = a.p->in[5] + (size_t)layer * MP * 256;
        for (int row = gw; row < MP; row += 2 * nw) {
            const int r1 = row + nw; const bool has1 = r1 < MP;
            f32x4 v0[4], v1[4]; f32x4 p0, p1 = {0.f, 0.f, 0.f, 0.f};
            E1_LOAD(v0, row); p0 = *(const f32x4*)(pp + (size_t)row * 256 + lane * 4);
            if (has1) { E1_LOAD(v1, r1); p1 = *(const f32x4*)(pp + (size_t)r1 * 256 + lane * 4); }
            E1_FIN(v0, row, p0);
            if (has1) E1_FIN(v1, r1, p1);
        }
    }
    for (int row = MP + gw; row < (layer == 4 ? MV : MA); row += nw) {
        if (row < MV) {
            f32x4 v[4];
            if (layer > 0) {
                const bf16_t* TBp = (const bf16_t*)(a.p->ws + WS_TB);
#pragma unroll
                for (int q = 0; q < 4; ++q) { const size_t off = (size_t)row * DM + q * 256 + lane * 4; const float* pq = (const float*)(a.p->ws + WS_PART) + (size_t)(row - MP) * 1024 + q * 256 + lane * 4;
                    f32x4 g4 = *(const f32x4*)pq;
#pragma unroll
                    for (int ks = 1; ks < 4; ++ks) g4 += *(const f32x4*)(pq + (size_t)ks * 256 * 1024);
                    const u32x2 xb = *(const u32x2*)(HX + off), tb = *(const u32x2*)(TBp + off);
                    v[q] = (f32x4){bflo(xb.x) + sigm_f(g4[0]) * bflo(tb.x), bfhi(xb.x) + sigm_f(g4[1]) * bfhi(tb.x), bflo(xb.y) + sigm_f(g4[2]) * bflo(tb.y), bfhi(xb.y) + sigm_f(g4[3]) * bfhi(tb.y)};
                    if (layer == 4) *(f32x4*)(X + off) = v[q]; else { u32x2 w; w.x = pk2(v[q][0], v[q][1]); w.y = pk2(v[q][2], v[q][3]); *(u32x2*)(X16 + off) = w; } }
                if (layer == 4) continue;
            } else {
#pragma unroll
                for (int q = 0; q < 4; ++q) v[q] = *(const f32x4*)(a.p->in[1] + (size_t)(row - MP) * DM + q * 256 + lane * 4);
            }
            const f32x4 p = *(const f32x4*)(a.p->in[6] + ((size_t)layer * MS + (row - MP)) * 256 + lane * 4);
            E1_FIN(v, row, p);
        } else {
#pragma unroll
            for (int q = 0; q < 4; ++q) *(u32x2*)(HX + (size_t)row * DM + q * 256 + lane * 4) = (u32x2){0u, 0u};
            *(u32x2*)(PB + (size_t)row * 256 + lane * 4) = (u32x2){0u, 0u};
        }
    }
#undef E1_LOAD
#undef E1_FIN
}
__device__ __forceinline__ void phase_e3(const Args& a, int layer, bool dummy = false) {
    const int tid = otid(), lane = tid & 63, gw = blockIdx.x * 8 + (tid >> 6), nw = gridDim.x * 8;
    const bf16_t* X16 = (const bf16_t*)a.p->out; bf16_t* HX = (bf16_t*)(a.p->ws + (dummy ? WS_DUMMY + 136 * MiB : WS_HX)); const bf16_t* OP = (const bf16_t*)(a.p->ws + WS_R0 + RSZ);
    const float* g = a.p->in[8] + layer * DM;
    f32x4 gv[4];
#pragma unroll
    for (int q = 0; q < 4; ++q) gv[q] = *(const f32x4*)(g + q * 256 + lane * 4);
#define E3_LOADX(XX, r, src0) do { if (layer == 0) { _Pragma("unroll") for (int q = 0; q < 4; ++q) XX[q] = *(const f32x4*)((src0) + q * 256 + lane * 4); } \
        else { _Pragma("unroll") for (int q = 0; q < 4; ++q) { const u32x2 xb = *(const u32x2*)(X16 + (size_t)(r) * DM + q * 256 + lane * 4); XX[q] = (f32x4){bflo(xb.x), bfhi(xb.x), bflo(xb.y), bfhi(xb.y)}; } } } while (0)
#define E3_FIN(v, XX, r) do { float ss = 0.f; _Pragma("unroll") for (int q = 0; q < 4; ++q) ss += v[q][0] * v[q][0] + v[q][1] * v[q][1] + v[q][2] * v[q][2] + v[q][3] * v[q][3]; \
        ss = wave_sum(ss); const float rr = rsqrtf(ss * (1.f / DM) + RMS_EPS); \
        _Pragma("unroll") for (int q = 0; q < 4; ++q) { u32x2 hw; hw.x = pk2(XX[q][0] + v[q][0] * rr * gv[q][0], XX[q][1] + v[q][1] * rr * gv[q][1]); hw.y = pk2(XX[q][2] + v[q][2] * rr * gv[q][2], XX[q][3] + v[q][3] * rr * gv[q][3]); \
            *(u32x2*)(HX + (size_t)(r) * DM + q * 256 + lane * 4) = hw; } } while (0)
#define E3_LOADOP(v, r) do { _Pragma("unroll") for (int q = 0; q < 4; ++q) { const u32x2 ob = *(const u32x2*)(OP + (size_t)(r) * DM + q * 256 + lane * 4); v[q] = (f32x4){bflo(ob.x), bfhi(ob.x), bflo(ob.y), bfhi(ob.y)}; } } while (0)
    for (int row = gw; row < MP; row += 2 * nw) {
        const int r1 = row + nw; const bool has1 = r1 < MP;
        f32x4 v0[4], x0[4], v1[4], x1[4];
        E3_LOADOP(v0, row); E3_LOADX(x0, row, a.p->in[0] + (size_t)row * DM);
        if (has1) { E3_LOADOP(v1, r1); E3_LOADX(x1, r1, a.p->in[0] + (size_t)r1 * DM); }
        E3_FIN(v0, x0, row);
        if (has1) E3_FIN(v1, x1, r1);
    }
    for (int row = MP + gw; row < MA; row += nw) {
        if (row < MV) {
            f32x4 v[4], x[4];
#pragma unroll
            for (int q = 0; q < 4; ++q) { const float* pq = (const float*)(a.p->ws + WS_PART) + (size_t)(row - MP) * 1024 + q * 256 + lane * 4; v[q] = *(const f32x4*)pq;
#pragma unroll
                for (int ks = 1; ks < 8; ++ks) v[q] += *(const f32x4*)(pq + (size_t)ks * 256 * 1024); }
            E3_LOADX(x, row, a.p->in[1] + (size_t)(row - MP) * DM);
            E3_FIN(v, x, row);
        } else {
#pragma unroll
            for (int q = 0; q < 4; ++q) *(u32x2*)(HX + (size_t)row * DM + q * 256 + lane * 4) = (u32x2){0u, 0u};
        }
    }
#undef E3_LOADX
#undef E3_FIN
#undef E3_LOADOP
}

__device__ __forceinline__ void phase_s1(const Args& a, int j, unsigned char* lds, bool dummy = false) {
    constexpr int LP = 136;
    bf16_t* As = (bf16_t*)lds; bf16_t* Bs = As + 128 * LP; float* fl = (float*)(Bs + 128 * LP);
    float* mu = fl, * rs = fl + 128, * t1 = fl + 256, * t2 = fl + 384;
    const int tid = otid(), lane = tid & 63, wid = tid >> 6, fr = lane & 15, fq = lane >> 4;
    const bf16_t* U = (const bf16_t*)(a.p->ws + WS_R0); bf16_t* Uo = (bf16_t*)(a.p->ws + (dummy ? WS_DUMMY : WS_R0)); const bf16_t* VT = (const bf16_t*)(a.p->ws + WS_R0 + RSZ); const bf16_t* ZS = (const bf16_t*)(a.p->ws + WS_R0 + 2 * RSZ);
    const float* stat = (const float*)(a.p->ws + WS_STAT);
    const float* lng_g = a.p->in[10] + j * EB; const float* lnb_g = a.p->in[11] + j * EB; const float* bsv_g = a.p->in[13] + j * 16 * 128;
    float* lng = fl + 512; float* lnb = lng + EB; float* bsv = lnb + EB;
    { *(f32x4*)(lng + tid * 4) = *(const f32x4*)(lng_g + tid * 4); *(f32x4*)(lnb + tid * 4) = *(const f32x4*)(lnb_g + tid * 4); *(f32x4*)(bsv + tid * 4) = *(const f32x4*)(bsv_g + tid * 4); }
    __syncthreads();
    float* gvs = a.p->out + O_GV + (size_t)j * MS * EB;
    constexpr int NU = 257 * 16;
    const int G_ = gridDim.x, w_ = blockIdx.x;
#define S1_UNIT(k) ((G_ == 256) ? ((k) < 16 ? w_ * 16 + (((k) + w_) & 15) :     ((k) == 16 && w_ < 16 ? 4096 + w_ : NU)) : (w_ + (k) * G_))
#define S1_LOAD_AB(u_) do { const int blk_ = (u_) >> 4, g_ = (u_) & 15; \
        const bf16_t* wsrc_ = (const bf16_t*)(a.p->ws + (blk_ == 256 ? WS_WMS : WS_WM)) + ((size_t)(j * 16 + g_) * 128) * 128; const bf16_t* vsrc_ = VT + ((size_t)blk_ * 2048 + g_ * 128) * 128; \
        _Pragma("unroll") for (int q = 0; q < 4; ++q) { ar[q] = *(const u32x4*)(wsrc_ + (tid >> 2) * 128 + (tid & 3) * 32 + q * 8); br[q] = *(const u32x4*)(vsrc_ + (tid >> 2) * 128 + (tid & 3) * 32 + q * 8); } } while (0)
    int un = S1_UNIT(0);
    if (un >= NU) return;
    u32x4 ar[4], br[4];
    S1_LOAD_AB(un);
    int prev_blk = -1;
    for (int k = 0;; ++k) {
        const int blk = un >> 4, g = un & 15, issamp = blk == 256;
        if (blk != prev_blk) {
          { const int r_ = tid >> 2, p_ = tid & 3; const float* sp = stat + (size_t)(blk * 128 + r_) * 64 + p_ * 8;
          const f32x4 s0 = *(const f32x4*)sp, s1 = *(const f32x4*)(sp + 4), q0 = *(const f32x4*)(sp + 32), q1 = *(const f32x4*)(sp + 36);
          float s = ((s0[0] + s0[1]) + (s0[2] + s0[3])) + ((s1[0] + s1[1]) + (s1[2] + s1[3])), q = ((q0[0] + q0[1]) + (q0[2] + q0[3])) + ((q1[0] + q1[1]) + (q1[2] + q1[3]));
          s += __shfl_xor(s, 1); s += __shfl_xor(s, 2); q += __shfl_xor(q, 1); q += __shfl_xor(q, 2);
          if (p_ == 0) { const float m = s * (1.f / EB); const float var = fmaxf(q * (1.f / EB) - m * m, 0.f); mu[r_] = m; rs[r_] = rsqrtf(var + LN_EPS); } }
          __syncthreads(); prev_blk = blk;
        }
        { const int i = tid >> 2, part = tid & 3; float a1 = 0.f, a2 = 0.f;
#pragma unroll
          for (int q = 0; q < 4; ++q) { const int j0 = part * 32 + q * 8; const u32x4 w = ar[q]; const unsigned ww[4] = {w.x, w.y, w.z, w.w}; float o[8];
#pragma unroll
              for (int e = 0; e < 4; ++e) { const float w0 = bflo(ww[e]), w1 = bfhi(ww[e]); const float r0 = rs[j0 + 2 * e], r1 = rs[j0 + 2 * e + 1];
                  o[2 * e] = w0 * r0; o[2 * e + 1] = w1 * r1; a1 += w0 * r0 * mu[j0 + 2 * e] + w1 * r1 * mu[j0 + 2 * e + 1]; a2 += w0 + w1; }
              u32x4 ow; ow.x = pk2(o[0], o[1]); ow.y = pk2(o[2], o[3]); ow.z = pk2(o[4], o[5]); ow.w = pk2(o[6], o[7]);
              *(u32x4*)(As + i * LP + j0) = ow; *(u32x4*)(Bs + i * LP + j0) = br[q]; }
          a1 += __shfl_xor(a1, 1); a1 += __shfl_xor(a1, 2); a2 += __shfl_xor(a2, 1); a2 += __shfl_xor(a2, 2);
          if (part == 0) { t1[i] = a1; t2[i] = a2; }
        }
        __syncthreads();
        const int un_next = S1_UNIT(k + 1); const bool has_next = un_next < NU;
        if (has_next) S1_LOAD_AB(un_next);
        const int i0 = (wid >> 1) * 32, c0 = (wid & 1) * 64;
        f32x4 acc[2][4];
#pragma unroll
        for (int mt = 0; mt < 2; ++mt)
#pragma unroll
            for (int nt = 0; nt < 4; ++nt) acc[mt][nt] = (f32x4){0.f, 0.f, 0.f, 0.f};
#pragma unroll
        for (int kk = 0; kk < 4; ++kk) {
            bf16x8 af[2], bfr[4];
#pragma unroll
            for (int mt = 0; mt < 2; ++mt) af[mt] = *(const bf16x8*)(As + (i0 + mt * 16 + fr) * LP + kk * 32 + fq * 8);
#pragma unroll
            for (int nt = 0; nt < 4; ++nt) bfr[nt] = *(const bf16x8*)(Bs + (c0 + nt * 16 + fr) * LP + kk * 32 + fq * 8);
#pragma unroll
            for (int mt = 0; mt < 2; ++mt)
#pragma unroll
                for (int nt = 0; nt < 4; ++nt) acc[mt][nt] = __builtin_amdgcn_mfma_f32_16x16x32_bf16(bfr[nt], af[mt], acc[mt][nt], 0, 0, 0);
        }
        const int ei = tid >> 2, ec = (tid & 3) * 32; const size_t erow = (size_t)blk * 128 + ei;
        u32x4 uu[4], zz[4];
#pragma unroll
        for (int q = 0; q < 4; ++q) { uu[q] = *(const u32x4*)(U + erow * EB + g * 128 + ec + q * 8); zz[q] = *(const u32x4*)(ZS + erow * EB + g * 128 + ec + q * 8); }
        if (issamp) {
            for (int idx = tid; idx < 128 * 128; idx += 512) { const int c = idx & 127, i = idx >> 7; const float v = __uint_as_float((unsigned)Bs[c * LP + i] << 16);
                gvs[(size_t)i * EB + g * 128 + c] = (v - mu[i]) * rs[i] * lng[g * 128 + c] + lnb[g * 128 + c]; }
        }
        __syncthreads();
        float* S32 = (float*)lds; constexpr int SP = 132;
#pragma unroll
        for (int mt = 0; mt < 2; ++mt)
#pragma unroll
            for (int nt = 0; nt < 4; ++nt) *(f32x4*)(S32 + (i0 + mt * 16 + fr) * SP + c0 + nt * 16 + fq * 4) = acc[mt][nt];
        __syncthreads();
        { const float t1i = t1[ei], t2i = t2[ei], bi = bsv[g * 128 + (issamp ? (ei & 15) : ei)];
#pragma unroll
          for (int q = 0; q < 4; ++q) { const int cg = g * 128 + ec + q * 8;
              const f32x4 sa = *(const f32x4*)(S32 + ei * SP + ec + q * 8), sb = *(const f32x4*)(S32 + ei * SP + ec + q * 8 + 4);
              const f32x4 lga = *(const f32x4*)(lng + cg), lgb = *(const f32x4*)(lng + cg + 4), lba = *(const f32x4*)(lnb + cg), lbb = *(const f32x4*)(lnb + cg + 4);
              float s[8];
#pragma unroll
              for (int e = 0; e < 4; ++e) { s[e] = lga[e] * (sa[e] - t1i) + lba[e] * t2i + bi; s[4 + e] = lgb[e] * (sb[e] - t1i) + lbb[e] * t2i + bi; }
              const unsigned u4[4] = {uu[q].x, uu[q].y, uu[q].z, uu[q].w}, z4[4] = {zz[q].x, zz[q].y, zz[q].z, zz[q].w}; unsigned y4[4];
#pragma unroll
              for (int e = 0; e < 4; ++e) y4[e] = pk2(bflo(u4[e]) * s[2 * e] * bflo(z4[e]), bfhi(u4[e]) * s[2 * e + 1] * bfhi(z4[e]));
              *(u32x4*)(Uo + erow * EB + cg) = (u32x4){y4[0], y4[1], y4[2], y4[3]}; } }
        __syncthreads();
        if (!has_next) break;
        un = un_next;
    }
#undef S1_UNIT
#undef S1_LOAD_AB
}

__device__ __forceinline__ void phase_c1(const Args& a, int j) {
    const int tid = otid(); if ((tid >> 6) != 0) return;
    const int lane = tid & 63;
    for (int sq = blockIdx.x; sq < 256; sq += gridDim.x) {
        if (sq < 128) {
            const int b = sq >> 4, h = sq & 15; const float* src = a.p->out + O_FLP + ((size_t)j * MP + (size_t)b * SEQ) * 16 + h; float* dst = (float*)(a.p->ws + WS_CBP) + (size_t)sq * SEQ;
            float v[64]; float tot = 0.f;
#pragma unroll
            for (int s = 0; s < 64; ++s) v[s] = src[(size_t)(lane * 64 + s) * 16];
#pragma unroll
            for (int s = 0; s < 64; ++s) tot += v[s];
            float inc = tot; for (int o = 1; o < 64; o <<= 1) { const float t = __shfl_up(inc, o); if (lane >= o) inc += t; }
            float run = inc - tot;
#pragma unroll
            for (int s = 0; s < 64; ++s) { run += v[s];
                dst[lane * 64 + (((s >> 2) & 1) * 32 + ((s >> 3) & 3) * 4 + (s & 3) + 16 * (s >> 5))] = -run * 11.313708498984761f; }
        } else {
            const int bh = sq - 128, b = bh >> 4, h = bh & 15; const float* c0 = a.p->in[4] + ((size_t)(j * 8 + b) * PAST) * 16 + h; const float* c1 = a.p->out + O_FLS + ((size_t)j * MS + b * TS) * 16 + h;
            float* dst = (float*)(a.p->ws + WS_CBS) + (size_t)bh * SKS;
            float v[33]; float tot = 0.f;
#pragma unroll
            for (int s = 0; s < 33; ++s) { const int k = lane * 33 + s; v[s] = k < PAST ? c0[(size_t)k * 16] : (k < PAST + TS ? c1[(size_t)(k - PAST) * 16] : 0.f); }
#pragma unroll
            for (int s = 0; s < 33; ++s) tot += v[s];
            float inc = tot; for (int o = 1; o < 64; o <<= 1) { const float t = __shfl_up(inc, o); if (lane >= o) inc += t; }
            float run = inc - tot;
#pragma unroll
            for (int s = 0; s < 33; ++s) { run += v[s]; dst[lane * 33 + s] = -run; }
        }
    }
}

__device__ __forceinline__ void sample_attn(const Args& a, int j, int bh, unsigned char* ldsb, bool dummy = false) {
    constexpr int PP = 136;
    float* wmx = (float*)ldsb;
    bf16_t* Pb = (bf16_t*)(ldsb + 1024);
    float* lfin = (float*)(ldsb + 1024 + 2 * 16 * PP * 2);
    const int tid = otid(), lane = tid & 63, wid = __builtin_amdgcn_readfirstlane(tid >> 6), fr = lane & 15, fq = lane >> 4, b = bh >> 4, h = bh & 15;
    const bf16_t* Qb = (const bf16_t*)(a.p->ws + WS_R0); const bf16_t* ZS = (const bf16_t*)(a.p->ws + WS_R0 + 3 * RSZ); bf16_t* O = (bf16_t*)(a.p->ws + (dummy ? WS_DUMMY : WS_R0));
    const float* ck = a.p->in[2] + (size_t)(j * 8 + b) * PAST * EB + h * 128; const float* cv = a.p->in[3] + (size_t)(j * 8 + b) * PAST * EB + h * 128;
    const float* nk = a.p->out + O_FKS + ((size_t)j * MS + b * TS) * EB + h * 128; const float* nv = a.p->out + O_FVS + ((size_t)j * MS + b * TS) * EB + h * 128;
    const float* cb = (const float*)(a.p->ws + WS_CBS) + (size_t)bh * SKS;
    bf16x8 qf[4];
#pragma unroll
    for (int kk = 0; kk < 4; ++kk) qf[kk] = *(const bf16x8*)(Qb + (size_t)(MP + b * TS + fr) * EB + h * 128 + kk * 32 + fq * 8);
    const int kl = 16 * wid + fr;
    float m[4], ls[4]; f32x4 oacc = {0.f, 0.f, 0.f, 0.f};
#pragma unroll
    for (int r = 0; r < 4; ++r) { m[r] = -1e30f; ls[r] = 0.f; }
    f32x4 kr[8];
#pragma unroll
    for (int q = 0; q < 8; ++q) kr[q] = *(const f32x4*)(ck + (size_t)kl * EB + (q >> 1) * 32 + fq * 8 + (q & 1) * 4);
    int buf = 0;
    for (int c = 0; c < 17; ++c) {
        float vr[32];
        if (c < 16) {
#pragma unroll
            for (int q = 0; q < 32; ++q) vr[q] = cv[(size_t)(c * 128 + (q >> 3) * 32 + fq * 8 + (q & 7)) * EB + 16 * wid + fr];
        } else {
#pragma unroll
            for (int q = 0; q < 32; ++q) { const int key = (q >> 3) * 32 + fq * 8 + (q & 7); vr[q] = key < TS ? nv[(size_t)key * EB + 16 * wid + fr] : 0.f; }
        }
        const float bias = c < 16 ? cb[c * 128 + kl] : (kl < TS ? cb[PAST + kl] : 0.f);
        f32x4 sacc = {0.f, 0.f, 0.f, 0.f};
#pragma unroll
        for (int kk = 0; kk < 4; ++kk) { const f32x4 x0 = kr[2 * kk], x1 = kr[2 * kk + 1];
            u32x4 w; w.x = pk2(x0[0], x0[1]); w.y = pk2(x0[2], x0[3]); w.z = pk2(x1[0], x1[1]); w.w = pk2(x1[2], x1[3]);
            sacc = __builtin_amdgcn_mfma_f32_16x16x32_bf16(qf[kk], __builtin_bit_cast(bf16x8, w), sacc, 0, 0, 0); }
        if (c + 1 < 16) {
#pragma unroll
            for (int q = 0; q < 8; ++q) kr[q] = *(const f32x4*)(ck + (size_t)((c + 1) * 128 + kl) * EB + (q >> 1) * 32 + fq * 8 + (q & 1) * 4);
        } else if (c + 1 == 16) {
#pragma unroll
            for (int q = 0; q < 8; ++q) kr[q] = kl < TS ? *(const f32x4*)(nk + (size_t)kl * EB + (q >> 1) * 32 + fq * 8 + (q & 1) * 4) : (f32x4){0.f, 0.f, 0.f, 0.f};
        }
        float s[4], mw[4];
#pragma unroll
        for (int r = 0; r < 4; ++r) { s[r] = sacc[r] * att::SCALE + bias; if (c == 16 && (kl >= TS || kl > 4 * fq + r)) s[r] = -__builtin_inff(); mw[r] = s[r]; }
#pragma unroll
        for (int o = 1; o < 16; o <<= 1) {
#pragma unroll
            for (int r = 0; r < 4; ++r) mw[r] = fmaxf(mw[r], __shfl_xor(mw[r], o)); }
        if (fr == 0) {
#pragma unroll
            for (int r = 0; r < 4; ++r) wmx[buf * 128 + (4 * fq + r) * 8 + wid] = mw[r]; }
        __syncthreads();
        float p[4];
#pragma unroll
        for (int r = 0; r < 4; ++r) { const f32x4 w0 = *(const f32x4*)(wmx + buf * 128 + (4 * fq + r) * 8), w1 = *(const f32x4*)(wmx + buf * 128 + (4 * fq + r) * 8 + 4);
            const float mc = fmaxf(fmaxf(fmaxf(w0[0], w0[1]), fmaxf(w0[2], w0[3])), fmaxf(fmaxf(w1[0], w1[1]), fmaxf(w1[2], w1[3])));
            const float mn = fmaxf(m[r], mc), al = __expf(m[r] - mn); m[r] = mn; p[r] = __expf(s[r] - mn); ls[r] = ls[r] * al + p[r]; oacc[r] *= al;
            Pb[buf * 16 * PP + (4 * fq + r) * PP + kl] = (bf16_t)f2bf(p[r]); }
        __syncthreads();
#pragma unroll
        for (int kk = 0; kk < 4; ++kk) { const bf16x8 pa = *(const bf16x8*)(Pb + buf * 16 * PP + fr * PP + kk * 32 + fq * 8);
            u32x4 w; w.x = pk2(vr[kk * 8 + 0], vr[kk * 8 + 1]); w.y = pk2(vr[kk * 8 + 2], vr[kk * 8 + 3]); w.z = pk2(vr[kk * 8 + 4], vr[kk * 8 + 5]); w.w = pk2(vr[kk * 8 + 6], vr[kk * 8 + 7]);
            oacc = __builtin_amdgcn_mfma_f32_16x16x32_bf16(pa, __builtin_bit_cast(bf16x8, w), oacc, 0, 0, 0); }
        buf ^= 1;
    }
#pragma unroll
    for (int o = 1; o < 16; o <<= 1) {
#pragma unroll
        for (int r = 0; r < 4; ++r) ls[r] += __shfl_xor(ls[r], o); }
    if (fr == 0) {
#pragma unroll
        for (int r = 0; r < 4; ++r) lfin[wid * 16 + 4 * fq + r] = ls[r]; }
    __syncthreads();
#pragma unroll
    for (int r = 0; r < 4; ++r) { const int i = 4 * fq + r; float l = 0.f;
#pragma unroll
        for (int w = 0; w < 8; ++w) l += lfin[w * 16 + i];
        const size_t off = (size_t)(MP + b * TS + i) * EB + h * 128 + 16 * wid + fr;
        const float z = __uint_as_float((unsigned)ZS[off] << 16); O[off] = (bf16_t)f2bf(oacc[r] / l * z); }
    __syncthreads();
}

__device__ __forceinline__ void phase_attn(const Args& a, int j, unsigned char* ldsb, int mode = 0) {
    using namespace att;
    typedef __hip_bfloat16 T;
    const T* Q = (const T*)(a.p->ws + WS_R0); const T* K = (const T*)(a.p->ws + WS_R0 + RSZ); const T* V = (const T*)(a.p->ws + WS_R0 + 2 * RSZ); const T* Z = (const T*)(a.p->ws + WS_R0 + 3 * RSZ); T* O = (T*)(a.p->ws + (mode == 1 ? WS_DUMMY : WS_R0));
    const float* CB = (const float*)(a.p->ws + WS_CBP);
    char* lds = (char*)ldsb;
    constexpr int nqb = SEQ / QB, nx = nqb / 2, total = nx * NBH;
    const int stride = gridDim.x;
    int L = (gridDim.x == 256) ? (int)((blockIdx.x & 7) * 32 + (blockIdx.x >> 3)) : (int)blockIdx.x;
    if (mode == 2) L = total;
    if (L < total) {
#define MKREF(r, L_, pass_) do { const int bh_ = (L_) / nx, x_ = (L_) - bh_ * nx, qb_ = (pass_) ? x_ : nqb - 1 - x_,     b_ = bh_ >> 4, h_ = bh_ & 15; \
        const size_t ro_ = ((size_t)b_ * SEQ + (size_t)qb_ * QB) * PITCH + h_ * 128, ko_ = ((size_t)b_ * SEQ) * PITCH + h_ * 128; \
        (r).Q = Q + ro_; (r).O = O + ro_; (r).Z = Z + ro_; (r).K = K + ko_; (r).V = V + ko_; (r).CB = CB + (size_t)bh_ * SEQ; (r).P0 = qb_ * QB; } while (0)
        BlockRef<T, T> cur, nxt; int pass = 0;
        MKREF(cur, L, 0);
        Seam<T> S;
        causal_swa_prime<T, T>(cur, SEQ, lds, S);
        for (;;) {
            const bool more_pass = pass == 0, more_item = L + stride < total, last = !more_pass && !more_item;
            int passn = pass + 1, Ln = L;
            if (!more_pass) { passn = 0; Ln = more_item ? L + stride : L; }
            if (last) nxt = cur; else MKREF(nxt, Ln, passn);
            causal_swa_block<T, T>(cur, nxt, SEQ, SEQ, lds, S);
            if (last) break;
            cur = nxt; pass = passn; L = Ln;
        }
#undef MKREF
    }
    __syncthreads();
    if (mode != 1) for (int bh = (int)gridDim.x - 1 - (int)blockIdx.x; bh < NBH; bh += gridDim.x) sample_attn(a, j, bh, ldsb, mode == 2);
}

#define XB_TMO      128
#define XB_XCNT(j)  (256  + 64 * (j))
#define XB_XSUB(j)  (1280 + 64 * (j))
#define XB_XGEN(j)  (2304 + 64 * (j))
#define XB_TOP      3328
#define XB_TOPGEN   3392
#define XCD_BAR_WORDS 3456
#define XB_SPIN_CAP (1u << 18)

__device__ __forceinline__ unsigned xb_ld(unsigned* p)              { return __hip_atomic_load(p, __ATOMIC_RELAXED, __HIP_MEMORY_SCOPE_AGENT); }
__device__ __forceinline__ unsigned xb_add(unsigned* p, unsigned v) { return __hip_atomic_fetch_add(p, v, __ATOMIC_RELAXED, __HIP_MEMORY_SCOPE_AGENT); }
__device__ __forceinline__ unsigned xb_xcc_id() { return (unsigned)__builtin_amdgcn_s_getreg((3 << 11) | 20) & 0xFu; }
#define XB_SPIN(cond, bar) do { unsigned _sp = 0; while (cond) { __builtin_amdgcn_s_sleep(1); \
    if ((++_sp & 255u) == 0u) { if (xb_ld(&(bar)[XB_TMO])) break; if (_sp > XB_SPIN_CAP) { atomicAdd(&(bar)[XB_TMO], 1u); break; } } } } while (0)

struct XcdBarrier {
    unsigned* bar; unsigned x;
    volatile LAS unsigned* st;
};

__device__ __forceinline__ XcdBarrier xcd_barrier_post(unsigned* bar, volatile LAS unsigned* st) {
    XcdBarrier b; b.bar = bar; b.x = xb_xcc_id(); b.st = st;
    if (otid() == 0) (void)xb_add(&bar[XB_XCNT(b.x)], 1u);
    return b;
}
__device__ __forceinline__ void xcd_barrier_complete(unsigned* bar, unsigned x, unsigned& nloc, unsigned& nx) {
    const unsigned G = gridDim.x * gridDim.y * gridDim.z;
    unsigned sum, cnt, mine, sp = 0u;
    for (;;) {
        sum = 0u; cnt = 0u; mine = 0u;
#pragma unroll
        for (unsigned j = 0; j < 16; ++j) { const unsigned c = xb_ld(&bar[XB_XCNT(j)]); sum += c; cnt += (c > 0u) ? 1u : 0u; mine = (j == x) ? c : mine; }
        if (sum == G) break;
        __builtin_amdgcn_s_sleep(1);
        if ((++sp & 255u) == 0u) { if (xb_ld(&bar[XB_TMO])) break; if (sp > XB_SPIN_CAP) { atomicAdd(&bar[XB_TMO], 1u); break; } }
    }
    nloc = mine > 0u ? mine : 1u; nx = cnt > 0u ? cnt : 1u;
}

__device__ __forceinline__ void xcd_barrier(const XcdBarrier& b) {
    asm volatile("s_waitcnt vmcnt(0)" ::: "memory");
    __syncthreads();
    if (otid() == 0) {
        unsigned* bar = b.bar;
        __builtin_amdgcn_s_waitcnt(0);
        unsigned nloc = b.st[0], nx = b.st[1];
        if (nloc == 0u) { xcd_barrier_complete(bar, b.x, nloc, nx); b.st[0] = nloc; b.st[1] = nx; }
        const unsigned old = xb_add(&bar[XB_XSUB(b.x)], 1u);
        const unsigned gen = old / nloc;
        if (old + 1u == (gen + 1u) * nloc) {
            __builtin_amdgcn_fence(__ATOMIC_RELEASE, "agent");
            asm volatile("s_waitcnt vmcnt(0)" ::: "memory");
            const unsigned og = xb_add(&bar[XB_TOP], 1u);
            const unsigned tg = og / nx;
            if (og + 1u == (tg + 1u) * nx) xb_add(&bar[XB_TOPGEN], 1u);
            else XB_SPIN(xb_ld(&bar[XB_TOPGEN]) == tg, bar);
            __builtin_amdgcn_fence(__ATOMIC_ACQUIRE, "agent");
            xb_add(&bar[XB_XGEN(b.x)], 1u);
            asm volatile("s_waitcnt vmcnt(0)" ::: "memory");
        } else {
            XB_SPIN(xb_ld(&bar[XB_XGEN(b.x)]) == gen, bar);
            __builtin_amdgcn_fence(__ATOMIC_ACQUIRE, "agent");
            asm volatile("s_waitcnt vmcnt(0)" ::: "memory");
        }
    }
    __syncthreads();
}
#define WSPTRS() const Args a = getargs(); unsigned char* ws = a.p->ws; (void)ws; \
    bf16_t* HX = (bf16_t*)(ws + WS_HX); bf16_t* TB = (bf16_t*)(ws + WS_TB); bf16_t* PB = (bf16_t*)(ws + WS_PB); (void)HX; (void)TB; (void)PB; \
    bf16_t* R0 = (bf16_t*)(ws + WS_R0); bf16_t* R1 = (bf16_t*)(ws + WS_R0 + RSZ); bf16_t* R2 = (bf16_t*)(ws + WS_R0 + 2 * RSZ); bf16_t* R3 = (bf16_t*)(ws + WS_R0 + 3 * RSZ); (void)R0; (void)R1; (void)R2; (void)R3;
#define XBAR_MK() XcdBarrier xb_; xb_.bar = (unsigned*)(getargs().p->ws) + 1024; xb_.x = xb_xcc_id(); xb_.st = (volatile LAS unsigned*)((LAS unsigned char*)lds + (LDS_BYTES - 64))
#if PROBE_DUP == 7
#define GSYNC() do { XBAR_MK(); xcd_barrier(xb_); xcd_barrier(xb_); } while (0)
#else
#define GSYNC() do { XBAR_MK(); xcd_barrier(xb_); } while (0)
#endif
__global__ void __launch_bounds__(512, 2) fwd_megakernel(ArgsS args_unused) {
    extern __shared__ __attribute__((aligned(16))) unsigned char lds[];
    cg::grid_group grid = cg::this_grid();
    PG8_LAS unsigned char* gl = (PG8_LAS unsigned char*)lds;
    const int G = gridDim.x, c = blockIdx.x;
    { const unsigned hw = (unsigned)__builtin_amdgcn_s_getreg((5 << 11) | 4) & 63u;
      if ((threadIdx.x & 63) == 0) ((LAS int*)((LAS unsigned char*)lds + LDS_WIDTAB))[hw] = (int)(threadIdx.x >> 6);
      if (threadIdx.x < 16) ((LAS unsigned*)((LAS unsigned char*)lds + (LDS_BYTES - 64)))[threadIdx.x] = 0u; }
    __syncthreads();
    { XBAR_MK(); (void)xcd_barrier_post(xb_.bar, xb_.st); }
#ifndef SKIP_PRO
    { const Args a = getargs(); prologue(a, (float*)lds); }
#endif
    { const Args a = getargs(); if (a.p->ws == nullptr) grid.sync(); }
    GSYNC();
    for (int layer = 0; layer < 4; ++layer) {
        const int j = layer >> 1;
#ifndef SKIP_E1
        for (int rp_ = (PROBE_DUP == 4 ? 0 : 1); rp_ < 2; ++rp_) { const Args a = getargs(); phase_e1(a, layer); if (!rp_) GSYNC(); }
#endif
        GSYNC();
        if ((layer & 1) == 0) {
#ifndef SKIP_G1G
            { WSPTRS(); pg8::Gemm g{HX, (const bf16_t*)(ws + WS_WGIN) + (size_t)j * 6144 * 1024, MA, 6144, 1024}; pg8::StaticOrder S; S.init(MA, 6144, G, c);
              EpiGmlpIn E{R0, R1, R2, (float*)(ws + WS_STAT)};
              for (int rp_ = 0; rp_ < (PROBE_DUP == 5 ? 2 : 1); ++rp_) pg8::gemm_phase<EpiGmlpIn, pg8::StaticOrder, true, true>(gl, g, S, E); }
#endif
        } else {
#ifndef SKIP_G1F
            { WSPTRS(); pg8::Gemm g{HX, (const bf16_t*)(ws + WS_WFIN) + (size_t)j * NFIN * 1024, MA, NFIN, 1024}; pg8::StaticOrder S; S.init(MA, NFIN, G, c);
              float* out = a.p->out;
              EpiFoxIn E{R0, R1, R2, R3, out + O_FKP + (size_t)j * MP * EB, out + O_FVP + (size_t)j * MP * EB, out + O_FLP + (size_t)j * MP * 16,
                         out + O_FKS + (size_t)j * MS * EB, out + O_FVS + (size_t)j * MS * EB, out + O_FLS + (size_t)j * MS * 16, a.p->in[16] + j * 16};
              for (int rp_ = 0; rp_ < (PROBE_DUP == 5 ? 2 : 1); ++rp_) pg8::gemm_phase<EpiFoxIn, pg8::StaticOrder, true, true>(gl, g, S, E); }
#endif
        }
#ifndef SKIP_GT
        { WSPTRS(); pg8::Gemm g{PB, (const bf16_t*)(ws + WS_WPP) + (size_t)layer * 1024 * 256, MA, 1024, 256}; const int nb_ = (layer & 1) ? 0 : 24;
          pg8::StaticOrder S; S.init(MA, 1024, G - nb_, c >= nb_ ? G - 1 - c : (1 << 24));
          EpiT E{TB, 1024};
          for (int rp_ = 0; rp_ < (PROBE_DUP == 6 ? 2 : 1); ++rp_) pg8::gemm_phase<EpiT, pg8::StaticOrder, true, true>(gl, g, S, E); }
#endif
        GSYNC();
        if ((layer & 1) == 0) {
#ifndef SKIP_S1
            for (int rp_ = (PROBE_DUP == 3 ? 0 : 1); rp_ < 2; ++rp_) { const Args a = getargs(); phase_s1(a, j, lds, !rp_); if (!rp_) GSYNC(); }
#endif
        } else {
#ifndef SKIP_C1
            { const Args a = getargs(); phase_c1(a, j); }
#endif
            GSYNC();
#ifndef SKIP_ATTN
            for (int rp_ = ((PROBE_DUP == 1 || PROBE_DUP == 2) ? 0 : 1); rp_ < 2; ++rp_) { const Args a = getargs(); phase_attn(a, j, lds, rp_ ? 0 : PROBE_DUP); if (!rp_) GSYNC(); }
#endif
        }
        GSYNC();
#ifndef SKIP_G2
        { WSPTRS(); pg8::Gemm g{R0, (const bf16_t*)(ws + ((layer & 1) ? WS_WFOUT : WS_WGOUT)) + (size_t)j * 1024 * 2048, MP, 1024, 2048}; pg8::StaticOrder S; S.init(MP, 1024, G, c);
          EpiT E{R1, 1024};
          for (int rp_ = 0; rp_ < (PROBE_DUP == 6 ? 2 : 1); ++rp_) pg8::gemm_phase<EpiT, pg8::StaticOrder, true, true>(gl, g, S, E); }
#endif
        { WSPTRS(); int ksl = 256; asm volatile("" : "+s"(ksl)); pg8::Gemm g{R0, (const bf16_t*)(ws + ((layer & 1) ? WS_WFOUT : WS_WGOUT)) + (size_t)j * 1024 * 2048, MA, 1024, ksl, 2048}; SplitOrder S{8, c};
          EpiPart E{(float*)(ws + WS_PART)};
          pg8::gemm_phase<EpiPart, SplitOrder, true, true>(gl, g, S, E); }
        GSYNC();
#ifndef SKIP_E3
        for (int rp_ = (PROBE_DUP == 4 ? 0 : 1); rp_ < 2; ++rp_) { const Args a = getargs(); phase_e3(a, layer, !rp_); if (!rp_) GSYNC(); }
#endif
        GSYNC();
#ifndef SKIP_G3
        { WSPTRS(); pg8::Gemm g{HX, (const bf16_t*)(ws + WS_WPG) + (size_t)layer * 1024 * 1024, MP, 1024, 1024}; pg8::StaticOrder S; S.init(MP, 1024, G, c);
          for (int rp_ = (PROBE_DUP == 6 ? 0 : 1); rp_ < 2; ++rp_) { EpiGate E{HX, rp_ ? a.p->out : (float*)(ws + WS_DUMMY), TB, layer == 3}; pg8::gemm_phase<EpiGate, pg8::StaticOrder, true, true>(gl, g, S, E); } }
#endif
        { WSPTRS(); int ksl = 256; asm volatile("" : "+s"(ksl)); pg8::Gemm g{HX, (const bf16_t*)(ws + WS_WPG) + (size_t)layer * 1024 * 1024, MA, 1024, ksl, 1024}; SplitOrder S{4, c};
          EpiPart E{(float*)(ws + WS_PART)};
          pg8::gemm_phase<EpiPart, SplitOrder, true, true>(gl, g, S, E); }
        GSYNC();
    }
    { const Args a = getargs(); phase_e1(a, 4); }
}

extern "C" void kernel_launch(void* const* d_in, const int* in_sizes, int n_in, void* d_out, int out_size, void* d_ws, size_t ws_size, hipStream_t stream) {
    static int grid = 0;
    if (grid == 0) {
        if (n_in != 20 || ws_size < WS_END) { fprintf(stderr, "kernel_launch: need 20 inputs and >= %zu bytes of workspace; got %d, %zu\n", (size_t)WS_END, n_in, ws_size); grid = -1; return; }
        int dev = 0, cus = 0, per_cu = 0;
        (void)hipGetDevice(&dev); (void)hipDeviceGetAttribute(&cus, hipDeviceAttributeMultiprocessorCount, dev);
        if (hipFuncSetAttribute((const void*)fwd_megakernel, hipFuncAttributeMaxDynamicSharedMemorySize, LDS_BYTES) != hipSuccess) { fprintf(stderr, "kernel_launch: hipFuncSetAttribute failed\n"); grid = -1; return; }
        if (hipOccupancyMaxActiveBlocksPerMultiprocessor(&per_cu, (const void*)fwd_megakernel, 512, LDS_BYTES) != hipSuccess || per_cu < 1) { fprintf(stderr, "kernel_launch: occupancy query says %d\n", per_cu); per_cu = 1; }
        (void)hipGetLastError();
        grid = cus > 0 ? cus : 256;
    }
    if (grid < 0) return;
    if (hipMemsetAsync(d_ws, 0, 65536, stream) != hipSuccess) { fprintf(stderr, "kernel_launch: memset of the barrier words failed\n"); return; }
    ArgsS a{};
    for (int i = 0; i < 20; ++i) a.in[i] = (const float*)d_in[i];
    a.out = (float*)d_out; a.ws = (unsigned char*)d_ws;
    void* args[] = {&a};
    hipError_t e = hipLaunchCooperativeKernel((const void*)fwd_megakernel, dim3(grid), dim3(512), args, LDS_BYTES, stream);
    if (e != hipSuccess) fprintf(stderr, "cooperative launch failed: %s (grid %d)\n", hipGetErrorString(e), grid);
}
```
